# Optimizing an MI355X kernel written in HIP

```python
import math
import jax, jax.numpy as jnp
from jax import lax
import numpy as np

D_MODEL = 1024
BATCH = 16
SEQ = 2048
DEPTH = 2

GRID_W = 64
CTX_LEN = 256

FOURIER_WIDTH = 256
FOURIER_GROUPS = 4
FOURIER_GROUP_DIM = FOURIER_WIDTH // FOURIER_GROUPS
ATTN_WIDTH = D_MODEL - FOURIER_WIDTH
DIFF_HEAD_DIM = 64
DIFF_HEADS = ATTN_WIDTH // (2 * DIFF_HEAD_DIM)
DIFF_SUBHEADS = 2 * DIFF_HEADS
DIFF_V_DIM = 2 * DIFF_HEAD_DIM
MIX_WIDTH = FOURIER_WIDTH + ATTN_WIDTH
IN_WIDTH = FOURIER_WIDTH + 3 * ATTN_WIDTH
Q_OFF = FOURIER_WIDTH
K_OFF = FOURIER_WIDTH + ATTN_WIDTH
V_OFF = FOURIER_WIDTH + 2 * ATTN_WIDTH
Q_BLOCK = 128
ROPE_BASE = 10000.0
ROPE_AXIS_DIM = DIFF_HEAD_DIM // 2

N_EXPERTS = 16
N_GROUPS = 4
EXPERTS_PER_GROUP = N_EXPERTS // N_GROUPS
TOP_K = 2
D_EXPERT = D_MODEL // 2

ALPHA = (2 * DEPTH) ** 0.25
BETA = (8 * DEPTH) ** -0.25
LN_EPS = 1e-5

kernel_name = "hybrid_fourier_diffattn_grouped_moe_dit"


def layer_norm(x, g=None, b=None):
    xf = x.astype(jnp.float32)
    mu = jnp.mean(xf, axis=-1, keepdims=True)
    var = jnp.mean(jnp.square(xf - mu), axis=-1, keepdims=True)
    y = (xf - mu) * lax.rsqrt(var + LN_EPS)
    if g is not None:
        y = y * g.astype(jnp.float32) + b.astype(jnp.float32)
    return y.astype(x.dtype)


def modulate(x, shift, scale):
    return x * (1 + scale) + shift


def fourier_mix(u, w_f):
    B, T, _ = u.shape
    ug = u.reshape(B, T, FOURIER_GROUPS, FOURIER_GROUP_DIM).astype(jnp.float32)
    f = jnp.fft.fft2(ug, axes=(1, 3)).real * (1.0 / math.sqrt(T * FOURIER_GROUP_DIM))
    f = f.astype(u.dtype)
    return jnp.einsum('btgc,gcd->btgd', f, w_f).reshape(B, T, FOURIER_WIDTH)


def rope1d(x, ang):
    half = x.shape[-1] // 2
    cos = jnp.cos(ang)[:, None, :].astype(x.dtype)
    sin = jnp.sin(ang)[:, None, :].astype(x.dtype)
    x1, x2 = x[..., :half], x[..., half:]
    return jnp.concatenate([x1 * cos - x2 * sin, x2 * cos + x1 * sin], axis=-1)


def rope2d(x, ang_row, ang_col):
    return jnp.concatenate([rope1d(x[..., :ROPE_AXIS_DIM], ang_row),
                            rope1d(x[..., ROPE_AXIS_DIM:], ang_col)], axis=-1)


def diff_weights(s, lam):
    p = jax.nn.softmax(s, axis=-1)
    p = p.reshape(p.shape[0], DIFF_HEADS, 2, p.shape[2], p.shape[3])
    return p[:, :, 0] - lam * p[:, :, 1]


def diff_attn_latent(q, k, v, kc, vc, lam):
    B, S = q.shape[0], q.shape[1]
    keys = jnp.concatenate([kc, k], axis=1).transpose(0, 2, 1, 3)
    vals = jnp.concatenate([vc, v], axis=1).transpose(0, 2, 1, 3)
    n_blk = S // Q_BLOCK
    qb = q.reshape(B, n_blk, Q_BLOCK, DIFF_SUBHEADS, DIFF_HEAD_DIM).transpose(1, 0, 3, 2, 4)
    scale = DIFF_HEAD_DIM ** -0.5

    def attend(qblk):
        s = jnp.einsum('bhqd,bhkd->bhqk', qblk, keys).astype(jnp.float32) * scale
        a = diff_weights(s, lam)
        return jnp.einsum('bhqk,bhkv->bhqv', a.astype(vals.dtype), vals)

    o = lax.map(attend, qb)
    return o.transpose(1, 0, 3, 2, 4).reshape(B, S, DIFF_HEADS, DIFF_V_DIM)


def diff_attn_context(qc, kc, vc, lam):
    s = jnp.einsum('bqhd,bkhd->bhqk', qc, kc).astype(jnp.float32) * (DIFF_HEAD_DIM ** -0.5)
    a = diff_weights(s, lam)
    return jnp.einsum('bhqk,bkhv->bqhv', a.astype(vc.dtype), vc)


def head_norm(o, g, lam_init):
    of = o.astype(jnp.float32)
    of = of * lax.rsqrt(jnp.mean(jnp.square(of), axis=-1, keepdims=True) + LN_EPS)
    of = of * g.astype(jnp.float32) * (1.0 - lam_init)
    return of.astype(o.dtype).reshape(o.shape[0], o.shape[1], ATTN_WIDTH)


def moe_ffn(h, w_router, router_bias, w_gate, w_up, w_down):
    scores = jax.nn.sigmoid((h @ w_router).astype(jnp.float32))
    sel = scores + router_bias.astype(jnp.float32)
    grp_sel = sel.reshape(sel.shape[:-1] + (N_GROUPS, EXPERTS_PER_GROUP))
    grp_score = lax.top_k(grp_sel, TOP_K)[0].sum(-1)
    best_grp = jnp.argmax(grp_score, axis=-1)
    in_grp = (jnp.arange(N_EXPERTS) // EXPERTS_PER_GROUP) == best_grp[..., None]
    masked = jnp.where(in_grp, sel, -jnp.inf)
    _, idx = lax.top_k(masked, TOP_K)
    w = jnp.take_along_axis(scores, idx, axis=-1)
    w = w / jnp.sum(w, axis=-1, keepdims=True)
    combine = jnp.sum(jax.nn.one_hot(idx, N_EXPERTS, dtype=jnp.float32) * w[..., None], axis=-2)
    combine = combine.astype(h.dtype)
    y = jnp.zeros_like(h)
    for e in range(N_EXPERTS):
        a = jax.nn.silu(h @ w_gate[e]) * (h @ w_up[e])
        y = y + combine[..., e:e + 1] * (a @ w_down[e])
    return y


def setup_inputs(seed: int = 0) -> dict:
    key = jax.random.key(seed)
    ks = jax.random.split(key, 20)

    def n(k, shape, s):
        return jax.random.normal(k, shape, jnp.float32) * s

    C = FOURIER_GROUP_DIM
    return {
        "x": n(ks[0], (BATCH, SEQ, D_MODEL), 1.0),
        "c": n(ks[1], (BATCH, D_MODEL), 1.0),
        "ctx": n(ks[2], (BATCH, CTX_LEN, D_MODEL), 1.0),
        "c_ctx": n(ks[3], (D_MODEL,), 1.0),
        "w_mod": n(ks[4], (DEPTH, D_MODEL, 6 * D_MODEL), D_MODEL ** -0.5),
        "b_mod": n(ks[5], (DEPTH, 6 * D_MODEL), 0.02),
        "w_in": n(ks[6], (DEPTH, D_MODEL, IN_WIDTH), D_MODEL ** -0.5),
        "w_fourier": n(ks[7], (DEPTH, FOURIER_GROUPS, C, C), C ** -0.5),
        "lam_qk": n(ks[8], (DEPTH, 4, DIFF_HEAD_DIM), 0.1),
        "subln_g": 1.0 + n(ks[9], (DEPTH, DIFF_V_DIM), 0.02),
        "w_out": n(ks[10], (DEPTH, MIX_WIDTH, D_MODEL), MIX_WIDTH ** -0.5 * BETA),
        "ln_attn_g": 1.0 + n(ks[11], (DEPTH, D_MODEL), 0.02),
        "ln_attn_b": n(ks[12], (DEPTH, D_MODEL), 0.02),
        "ln_ffn_g": 1.0 + n(ks[13], (DEPTH, D_MODEL), 0.02),
        "ln_ffn_b": n(ks[14], (DEPTH, D_MODEL), 0.02),
        "w_router": n(ks[15], (D_MODEL, N_EXPERTS), D_MODEL ** -0.5),
        "router_bias": n(ks[16], (N_EXPERTS,), 0.01),
        "w_gate": n(ks[17], (DEPTH, N_EXPERTS, D_MODEL, D_EXPERT), D_MODEL ** -0.5),
        "w_up": n(ks[18], (DEPTH, N_EXPERTS, D_MODEL, D_EXPERT), D_MODEL ** -0.5),
        "w_down": n(ks[19], (DEPTH, N_EXPERTS, D_EXPERT, D_MODEL), D_EXPERT ** -0.5 * BETA),
    }


def reference(x, c, ctx, c_ctx, w_mod, b_mod, w_in, w_fourier, lam_qk, subln_g, w_out,
              ln_attn_g, ln_attn_b, ln_ffn_g, ln_ffn_b, w_router, router_bias,
              w_gate, w_up, w_down):
    B, S, _ = x.shape
    L = ctx.shape[1]
    ROWS = S // GRID_W
    row = jnp.repeat(jnp.arange(ROWS), GRID_W).astype(jnp.float32)
    col = jnp.tile(jnp.arange(GRID_W), ROWS).astype(jnp.float32)
    freqs = ROPE_BASE ** (-jnp.arange(0, ROPE_AXIS_DIM, 2, dtype=jnp.float32) / ROPE_AXIS_DIM)
    ang_row = row[:, None] * freqs
    ang_col = col[:, None] * freqs

    silu_c = jax.nn.silu(c)
    silu_cc = jax.nn.silu(c_ctx)
    xc = ctx

    for l in range(DEPTH):
        last = l == DEPTH - 1
        lam_init = 0.8 - 0.6 * math.exp(-0.3 * l)
        lq = lam_qk[l].astype(jnp.float32)
        lam = jnp.exp(jnp.sum(lq[0] * lq[1])) - jnp.exp(jnp.sum(lq[2] * lq[3])) + lam_init

        mod = silu_c @ w_mod[l] + b_mod[l]
        sh_a, sc_a, g_a, sh_f, sc_f, g_f = [m[:, None, :] for m in jnp.split(mod, 6, axis=-1)]
        mod_c = silu_cc @ w_mod[l] + b_mod[l]
        csh_a, csc_a, cg_a, csh_f, csc_f, cg_f = jnp.split(mod_c, 6)

        h = modulate(layer_norm(x), sh_a, sc_a)
        hc = modulate(layer_norm(xc), csh_a, csc_a)
        p = h @ w_in[l]
        u = p[..., :Q_OFF]
        q = rope2d(p[..., Q_OFF:K_OFF].reshape(B, S, DIFF_SUBHEADS, DIFF_HEAD_DIM), ang_row, ang_col)
        k = rope2d(p[..., K_OFF:V_OFF].reshape(B, S, DIFF_SUBHEADS, DIFF_HEAD_DIM), ang_row, ang_col)
        v = p[..., V_OFF:].reshape(B, S, DIFF_HEADS, DIFF_V_DIM)
        if last:
            pkv = hc @ w_in[l][:, K_OFF:]
            kc = pkv[..., :ATTN_WIDTH].reshape(B, L, DIFF_SUBHEADS, DIFF_HEAD_DIM)
            vc = pkv[..., ATTN_WIDTH:].reshape(B, L, DIFF_HEADS, DIFF_V_DIM)
        else:
            pc = hc @ w_in[l]
            uc = pc[..., :Q_OFF]
            qc = pc[..., Q_OFF:K_OFF].reshape(B, L, DIFF_SUBHEADS, DIFF_HEAD_DIM)
            kc = pc[..., K_OFF:V_OFF].reshape(B, L, DIFF_SUBHEADS, DIFF_HEAD_DIM)
            vc = pc[..., V_OFF:].reshape(B, L, DIFF_HEADS, DIFF_V_DIM)

        o_attn = head_norm(diff_attn_latent(q, k, v, kc, vc, lam), subln_g[l], lam_init)
        o = jnp.concatenate([fourier_mix(u, w_fourier[l]), o_attn], axis=-1) @ w_out[l]
        x_new = layer_norm(ALPHA * x + g_a * o, ln_attn_g[l], ln_attn_b[l])

        if not last:
            oc_attn = head_norm(diff_attn_context(qc, kc, vc, lam), subln_g[l], lam_init)
            oc = jnp.concatenate([fourier_mix(uc, w_fourier[l]), oc_attn], axis=-1) @ w_out[l]
            xc = layer_norm(ALPHA * xc + cg_a * oc, ln_attn_g[l], ln_attn_b[l])
        x = x_new

        h = modulate(layer_norm(x), sh_f, sc_f)
        if last:
            y = moe_ffn(h, w_router, router_bias, w_gate[l], w_up[l], w_down[l])
        else:
            hc = modulate(layer_norm(xc), csh_f, csc_f)
            y_all = moe_ffn(jnp.concatenate([hc, h], axis=1), w_router, router_bias,
                            w_gate[l], w_up[l], w_down[l])
            yc, y = y_all[:, :L], y_all[:, L:]
            xc = layer_norm(ALPHA * xc + cg_f * yc, ln_ffn_g[l], ln_ffn_b[l])
        x = layer_norm(ALPHA * x + g_f * y, ln_ffn_g[l], ln_ffn_b[l])

    return x
```

```cpp
#include <hip/hip_runtime.h>
#include <math.h>
#include <stdio.h>
#ifndef MK_DEBUG
#define MK_DEBUG 0
#endif
#undef MK_DEBUG
#define MK_DEBUG 0
typedef unsigned short bf16_t;
typedef short bf16x8 __attribute__((ext_vector_type(8)));
typedef short s16x4 __attribute__((ext_vector_type(4)));
typedef float f32x4 __attribute__((ext_vector_type(4)));
typedef float f32x16 __attribute__((ext_vector_type(16)));
typedef unsigned u32x4 __attribute__((ext_vector_type(4)));
typedef unsigned u32x2 __attribute__((ext_vector_type(2)));
typedef float f32x2_t __attribute__((ext_vector_type(2)));
typedef __bf16 bf16x2_t __attribute__((ext_vector_type(2)));
#define LAS __attribute__((address_space(3)))

__device__ __forceinline__ unsigned cvtpk(float lo, float hi) { f32x2_t v = {lo, hi}; bf16x2_t b = __builtin_convertvector(v, bf16x2_t); return __builtin_bit_cast(unsigned, b); }
__device__ __forceinline__ float bf_lo(unsigned w) { return __uint_as_float(w << 16); }
__device__ __forceinline__ float bf_hi(unsigned w) { return __uint_as_float(w & 0xffff0000u); }
__device__ __forceinline__ float bf2f(bf16_t b) { return __uint_as_float(((unsigned)b) << 16); }

#define XB_TMO      128
#define XB_XCNT(j)  (256  + 64 * (j))
#define XB_XSUB(j)  (1280 + 64 * (j))
#define XB_XGEN(j)  (2304 + 64 * (j))
#define XB_TOP      3328
#define XB_TOPGEN   3392
#define XCD_BAR_WORDS 3456
#define XB_SPIN_CAP (1u << 18)
__device__ __forceinline__ unsigned xb_ld(unsigned* p)              { return __hip_atomic_load(p, __ATOMIC_RELAXED, __HIP_MEMORY_SCOPE_AGENT); }
__device__ __forceinline__ unsigned xb_add(unsigned* p, unsigned v) { return __hip_atomic_fetch_add(p, v, __ATOMIC_RELAXED, __HIP_MEMORY_SCOPE_AGENT); }
__device__ __forceinline__ unsigned xb_xcc_id() { return (unsigned)__builtin_amdgcn_s_getreg((3 << 11) | 20) & 0xFu; }
#define XB_SPIN(cond, bar) do { unsigned _sp = 0; while (cond) { __builtin_amdgcn_s_sleep(1); \
    if ((++_sp & 255u) == 0u) { if (xb_ld(&(bar)[XB_TMO])) break; if (_sp > XB_SPIN_CAP) { atomicAdd(&(bar)[XB_TMO], 1u); break; } } } } while (0)
struct XcdBarrier { unsigned* bar; unsigned x; volatile LAS unsigned* st; };
__device__ __forceinline__ XcdBarrier xcd_barrier_post(unsigned* bar, volatile LAS unsigned* st) {
    XcdBarrier b; b.bar = bar; b.x = xb_xcc_id(); b.st = st;
    if (threadIdx.x == 0) (void)xb_add(&bar[XB_XCNT(b.x)], 1u);
    return b;
}
__device__ __forceinline__ void xcd_barrier_complete(unsigned* bar, unsigned x, unsigned& nloc, unsigned& nx) {
    const unsigned G = gridDim.x * gridDim.y * gridDim.z;
    unsigned sum, cnt, mine, sp = 0u;
    for (;;) {
        sum = 0u; cnt = 0u; mine = 0u;
#pragma unroll
        for (unsigned j = 0; j < 16; ++j) { const unsigned c = xb_ld(&bar[XB_XCNT(j)]); sum += c; cnt += (c > 0u) ? 1u : 0u; mine = (j == x) ? c : mine; }
        if (sum == G) break;
        __builtin_amdgcn_s_sleep(1);
        if ((++sp & 255u) == 0u) { if (xb_ld(&bar[XB_TMO])) break; if (sp > XB_SPIN_CAP) { atomicAdd(&bar[XB_TMO], 1u); break; } }
    }
    nloc = mine > 0u ? mine : 1u; nx = cnt > 0u ? cnt : 1u;
}
__device__ __forceinline__ void xcd_barrier(const XcdBarrier& b) {
    asm volatile("s_waitcnt vmcnt(0)" ::: "memory");
    __syncthreads();
    if (threadIdx.x == 0) {
        unsigned* bar = b.bar;
        __builtin_amdgcn_s_waitcnt(0);
        unsigned nloc = b.st[0], nx = b.st[1];
        if (nloc == 0u) { xcd_barrier_complete(bar, b.x, nloc, nx); b.st[0] = nloc; b.st[1] = nx; }
        const unsigned old = xb_add(&bar[XB_XSUB(b.x)], 1u);
        const unsigned gen = old / nloc;
        if (old + 1u == (gen + 1u) * nloc) {
            __builtin_amdgcn_fence(__ATOMIC_RELEASE, "agent");
            asm volatile("s_waitcnt vmcnt(0)" ::: "memory");
            const unsigned og = xb_add(&bar[XB_TOP], 1u);
            const unsigned tg = og / nx;
            if (og + 1u == (tg + 1u) * nx) xb_add(&bar[XB_TOPGEN], 1u);
            else XB_SPIN(xb_ld(&bar[XB_TOPGEN]) == tg, bar);
            __builtin_amdgcn_fence(__ATOMIC_ACQUIRE, "agent");
            xb_add(&bar[XB_XGEN(b.x)], 1u);
            asm volatile("s_waitcnt vmcnt(0)" ::: "memory");
        } else {
            XB_SPIN(xb_ld(&bar[XB_XGEN(b.x)]) == gen, bar);
            __builtin_amdgcn_fence(__ATOMIC_ACQUIRE, "agent");
            asm volatile("s_waitcnt vmcnt(0)" ::: "memory");
        }
    }
    __syncthreads();
}

namespace g8 {
constexpr int BM = 256, BK = 64, HALF = 128, HTB = HALF * BK * 2, STAGE_BYTES = 8 * HTB;
__device__ __forceinline__ int lds_byte(int r, int c) { const int st = (r >> 4) * 2 + (c >> 5), rr = r & 15, cc = c & 31, ob = rr * 64 + cc * 2; return st * 1024 + (ob ^ (((ob >> 9) & 1) << 5)); }
__device__ __forceinline__ void stage_rc(int b, int& R, int& C) { const int st = b / 1024, sb = b % 1024, swz = sb ^ (((sb >> 9) & 1) << 5); R = (st >> 1) * 16 + swz / 64; C = (st & 1) * 32 + (swz % 64) / 2; }
__device__ __forceinline__ int perm32(int rho) { const int n = rho >> 4, i = rho & 15; return 8 * (i >> 2) + 4 * n + (i & 3); }

struct Unit { const char* A; const char* B; const int* gl; int gcount; int kind, p0, p1; };

template <bool GATHER, class Epi, class Sched>
__device__ __forceinline__ void gemm_phase(LAS unsigned char* lds, const int K, const unsigned lda2, const unsigned ldb2, const Sched& S, const Epi& E) {
    int tid = threadIdx.x; asm volatile("" : "+v"(tid));
    const int wid = __builtin_amdgcn_readfirstlane(tid >> 6), lane = tid & 63, wr = wid >> 2, wc = wid & 3, fr = lane & 15, fq = lane >> 4;
    const int nt = K / BK;
    int Rr[2], Cc[2];
    unsigned vB[2];
#pragma unroll
    for (int i = 0; i < 2; ++i) { stage_rc(tid * 16 + i * 8192, Rr[i], Cc[i]); const int Rb = (Rr[i] & ~31) + perm32(Rr[i] & 31); vB[i] = (unsigned)Rb * ldb2 + (unsigned)Cc[i] * 2u; }
    const unsigned hB = (unsigned)HALF * ldb2, hA = (unsigned)HALF * lda2;
    const size_t kstep = (size_t)(BK * 2);
    const unsigned ldsw = (unsigned)wid * 1024u;
    const int aoff = lds_byte(wr * 64 + fr, fq * 8), boff = lds_byte(wc * 32 + fr, fq * 8);
    Unit cur, nxt; int ui = 0;
    if (!S.next(0, cur)) return;
    unsigned vA[2][2], nvA[2][2];
#define G8_CALCVA(u, v) do { _Pragma("unroll") for (int _h = 0; _h < 2; ++_h) _Pragma("unroll") for (int _i = 0; _i < 2; ++_i) { const int _r = _h * HALF + Rr[_i]; \
        if (GATHER) { const int _tok = (_r < (u).gcount) ? ((u).gl[_r] >> 1) : 0; v[_h][_i] = (unsigned)_tok * lda2 + (unsigned)Cc[_i] * 2u; } \
        else v[_h][_i] = (unsigned)_r * lda2 + (unsigned)Cc[_i] * 2u; } } while (0)
    G8_CALCVA(cur, vA);
#define G8_SA(b, h) (((b) * 2 + (h)) * HTB)
#define G8_SB(b, h) ((4 + (b) * 2 + (h)) * HTB)
#define G8_STAGE_A(bufoff, gbase, VV, hh) do { _Pragma("unroll") for (int _i = 0; _i < 2; ++_i) \
        __builtin_amdgcn_global_load_lds((const unsigned*)(((const char*)(gbase) + (GATHER ? (size_t)0 : (size_t)((hh) * hA))) + VV[GATHER ? (hh) : 0][_i]), (LAS unsigned*)(lds + (bufoff) + ldsw + _i * 8192), 16, 0, 0); } while (0)
#define G8_STAGE_B(bufoff, gbase, h) do { _Pragma("unroll") for (int _i = 0; _i < 2; ++_i) \
        __builtin_amdgcn_global_load_lds((const unsigned*)((const char*)(gbase) + (size_t)((h) * hB) + vB[_i]), (LAS unsigned*)(lds + (bufoff) + ldsw + _i * 8192), 16, 0, 0); } while (0)
#define G8_LDA(dst, b, h) do { _Pragma("unroll") for (int m = 0; m < 4; ++m) _Pragma("unroll") for (int k = 0; k < 2; ++k) dst[m][k] = *(const LAS bf16x8*)(lds + G8_SA(b, h) + aoff + m * 2048 + k * 1024); } while (0)
#define G8_LDB(dst, b, h) do { _Pragma("unroll") for (int n = 0; n < 2; ++n) _Pragma("unroll") for (int k = 0; k < 2; ++k) dst[n][k] = *(const LAS bf16x8*)(lds + G8_SB(b, h) + boff + n * 2048 + k * 1024); } while (0)
#define G8_MMA(ai, bj, At, Bt) do { __builtin_amdgcn_s_setprio(1); _Pragma("unroll") for (int m = 0; m < 4; ++m) _Pragma("unroll") for (int n = 0; n < 2; ++n) _Pragma("unroll") for (int k = 0; k < 2; ++k) \
        acc[ai][bj][m][n] = __builtin_amdgcn_mfma_f32_16x16x32_bf16(Bt[n][k], At[m][k], acc[ai][bj][m][n], 0, 0, 0); __builtin_amdgcn_s_setprio(0); } while (0)
#define G8_WAIT_V(n) asm volatile("s_waitcnt vmcnt(" #n ")" ::: "memory")
#define G8_WAIT_L(n) asm volatile("s_waitcnt lgkmcnt(" #n ")" ::: "memory")
#define G8_BAR __builtin_amdgcn_s_barrier()
#define G8_SCHED __builtin_amdgcn_sched_barrier(0)
    f32x4 acc[2][2][4][2];
#pragma unroll
    for (int a = 0; a < 2; ++a)
#pragma unroll
        for (int b = 0; b < 2; ++b)
#pragma unroll
            for (int m = 0; m < 4; ++m)
#pragma unroll
                for (int n = 0; n < 2; ++n) acc[a][b][m][n] = (f32x4){0.f, 0.f, 0.f, 0.f};
    bf16x8 At[4][2], B0[2][2], B1[2][2];
    const char* cA = cur.A; const char* cB = cur.B;
    G8_STAGE_B(G8_SB(0, 0), cB, 0); G8_STAGE_B(G8_SB(0, 1), cB, 1); G8_STAGE_A(G8_SA(0, 0), cA, vA, 0); G8_STAGE_A(G8_SA(0, 1), cA, vA, 1);
    if (wr == 1) G8_BAR;
    G8_WAIT_V(2); G8_BAR;
    G8_STAGE_B(G8_SB(1, 0), cB + kstep, 0); G8_STAGE_A(G8_SA(1, 0), cA + kstep, vA, 0); G8_STAGE_B(G8_SB(1, 1), cB + kstep, 1);
    G8_WAIT_V(6); G8_BAR;
    for (;;) {
        const bool has_next = S.next(ui + 1, nxt);
        const char* nA = has_next ? nxt.A : cA; const char* nB = has_next ? nxt.B : cB;
        if (GATHER && has_next) { G8_CALCVA(nxt, nvA); } else {
#pragma unroll
            for (int h = 0; h < 2; ++h)
#pragma unroll
                for (int i = 0; i < 2; ++i) nvA[h][i] = vA[h][i]; }
#pragma clang loop unroll(disable)
        for (int t = 0; t < nt; t += 2) {
            const bool last = (t == nt - 2);
            const char* a1 = cA + (size_t)(t + 1) * kstep;
            const char* a2 = last ? nA : cA + (size_t)(t + 2) * kstep; const char* b2 = last ? nB : cB + (size_t)(t + 2) * kstep;
            const char* a3 = a2 + kstep; const char* b3 = b2 + kstep;
            unsigned o2[2][2];
#pragma unroll
            for (int h = 0; h < 2; ++h)
#pragma unroll
                for (int i = 0; i < 2; ++i) o2[h][i] = (GATHER && last) ? nvA[h][i] : vA[h][i];
            G8_LDB(B0, 0, 0); G8_LDB(B1, 0, 1); G8_SCHED; G8_LDA(At, 0, 0); G8_STAGE_A(G8_SA(1, 1), a1, vA, 1);
            G8_WAIT_V(8); G8_WAIT_L(0); G8_BAR; G8_MMA(0, 0, At, B0); G8_MMA(0, 1, At, B1); G8_BAR; G8_SCHED;
            G8_LDA(At, 0, 1); G8_STAGE_B(G8_SB(0, 0), b2, 0); G8_STAGE_B(G8_SB(0, 1), b2, 1); G8_STAGE_A(G8_SA(0, 0), a2, o2, 0);
            G8_WAIT_V(8); G8_WAIT_L(0); G8_BAR; G8_MMA(1, 0, At, B0); G8_MMA(1, 1, At, B1); G8_BAR; G8_SCHED;
            G8_LDB(B0, 1, 0); G8_LDB(B1, 1, 1); G8_SCHED; G8_LDA(At, 1, 0); G8_STAGE_A(G8_SA(0, 1), a2, o2, 1);
            G8_WAIT_V(8); G8_WAIT_L(0); G8_BAR; G8_MMA(0, 0, At, B0); G8_MMA(0, 1, At, B1); G8_BAR; G8_SCHED;
            G8_LDA(At, 1, 1); G8_STAGE_B(G8_SB(1, 0), b3, 0); G8_STAGE_B(G8_SB(1, 1), b3, 1); G8_STAGE_A(G8_SA(1, 0), a3, o2, 0);
            G8_WAIT_V(8); G8_WAIT_L(0); G8_BAR; G8_MMA(1, 0, At, B0); G8_MMA(1, 1, At, B1); G8_BAR; G8_SCHED;
        }
        E(acc, cur, wr, wc, fr, fq);
        if (!has_next) break;
#pragma unroll
        for (int a = 0; a < 2; ++a)
#pragma unroll
            for (int b = 0; b < 2; ++b)
#pragma unroll
                for (int m = 0; m < 4; ++m)
#pragma unroll
                    for (int n = 0; n < 2; ++n) acc[a][b][m][n] = (f32x4){0.f, 0.f, 0.f, 0.f};
        cur = nxt; cA = nA; cB = nB; ++ui;
#pragma unroll
        for (int h = 0; h < 2; ++h)
#pragma unroll
            for (int i = 0; i < 2; ++i) vA[h][i] = nvA[h][i];
    }
    G8_WAIT_V(0);
    if (wr == 0) G8_BAR;
    G8_BAR;
#undef G8_CALCVA
#undef G8_SA
#undef G8_SB
#undef G8_STAGE_A
#undef G8_STAGE_B
#undef G8_LDA
#undef G8_LDB
#undef G8_MMA
#undef G8_WAIT_V
#undef G8_WAIT_L
#undef G8_BAR
#undef G8_SCHED
}
}
namespace mk {
constexpr int NB = 16, S = 2048, L = 256, D = 1024, RB = L + S, NTOK = NB * RB;
constexpr int QKVW = 2304, CW = 1280, MODW = 6 * D, CAP = NTOK, NPAIR = 2 * NTOK, SORT_ROWS = NPAIR + 16 * 256;
constexpr float ALPHA = 1.41421356237309515f, EPS = 1e-5f, QSCALE = 0.125f * 1.4426950408889634f;
constexpr size_t al256(size_t x) { return (x + 255) & ~(size_t)255; }
constexpr size_t CTL_BYTES = 65536, CTL_BAR_STRIDE = 13824  , CTL_CNT = 57344  ;
constexpr size_t OFF_MOD = CTL_BYTES, SZ_MOD = (size_t)2 * 17 * MODW * 4;
constexpr size_t OFF_LAM = OFF_MOD + al256(SZ_MOD);
constexpr size_t OFF_RC = OFF_LAM + 256, OFF_RS = OFF_RC + 4096;
constexpr size_t OFF_MH = OFF_RS + 4096, SZ_MH = (size_t)2 * 2 * 4 * 64 * 64 * 4;
constexpr size_t OFF_TABL = OFF_MH + SZ_MH, SZ_TABL = (size_t)2 * S * S * 2;
constexpr size_t OFF_TABC = OFF_TABL + SZ_TABL, SZ_TABC = (size_t)2 * L * L * 2;
constexpr size_t OFF_WQKV = OFF_TABC + SZ_TABC, SZ_WQKV = (size_t)2 * QKVW * D * 2;
constexpr size_t OFF_WU = OFF_WQKV + SZ_WQKV, SZ_WU = (size_t)2 * 512 * D * 2;
constexpr size_t OFF_WOUT = OFF_WU + SZ_WU, SZ_WOUT = (size_t)2 * D * CW * 2;
constexpr size_t OFF_LIST = OFF_WOUT + SZ_WOUT, SZ_LIST = (size_t)16 * CAP * 4;
constexpr size_t OFF_WPAIR = OFF_LIST + SZ_LIST, SZ_WPAIR = (size_t)NPAIR * 4;
constexpr size_t OFF_SELN = OFF_WPAIR + SZ_WPAIR, SZ_SELN = (size_t)NTOK * 16;
constexpr size_t OFF_RESC = OFF_SELN + SZ_SELN, SZ_RESC = (size_t)NB * L * D * 4;
constexpr size_t OFF_ARENA = OFF_RESC + SZ_RESC;
constexpr size_t SZ_H = (size_t)NTOK * D * 2, SZ_CC = (size_t)NTOK * CW * 2, SZ_QKV = (size_t)NTOK * QKVW * 2, SZ_UTL = (size_t)NB * 2 * 256 * S * 2, SZ_UTC = (size_t)NB * 2 * 256 * L * 2;
constexpr size_t SZ_ASORT = (size_t)SORT_ROWS * 512 * 2, SZ_Y2 = (size_t)NPAIR * D * 2, SZ_WGU = (size_t)16 * 1024 * 1024 * 2, SZ_WD = (size_t)16 * 1024 * 512 * 2;
constexpr size_t AR_H = 0, AR_CC = 0, AR_QKV = SZ_CC, AR_UTL = AR_QKV + SZ_QKV, AR_UTC = AR_UTL + SZ_UTL, AR_O = SZ_CC, AR_ASORT = 0, AR_Y2 = SZ_ASORT, AR_WGU = AR_Y2 + SZ_Y2, AR_WD = AR_WGU + SZ_WGU;
constexpr size_t SZ_ARENA = (AR_UTC + SZ_UTC) > (AR_WD + SZ_WD) ? (AR_UTC + SZ_UTC) : (AR_WD + SZ_WD);
constexpr size_t WS_NEED = OFF_ARENA + SZ_ARENA;
static_assert(AR_ASORT + SZ_ASORT <= AR_O, "ASORT must not overlap O/H2");
static_assert(AR_WGU >= AR_O + SZ_H, "MoE weights must not overlap O/H2");
static_assert(AR_H + SZ_H <= AR_Y2, "next layer's H must not overlap Y2");
constexpr int LDS_MISC = 131072, LDS_BYTES = LDS_MISC + 4096;

struct Args {
    const float* in[20]; float* out; unsigned char* ws; int ph_lo, ph_hi, li, pad;
};
enum { I_X = 0, I_C, I_CTX, I_CCTX, I_WMOD, I_BMOD, I_WIN, I_WF, I_LAMQK, I_SUBLN, I_WOUT, I_LNAG, I_LNAB, I_LNFG, I_LNFB, I_WR, I_RB, I_WG, I_WUP, I_WDN };

template <class T> __device__ __forceinline__ T* wsp(const Args& a, size_t off) { return (T*)(a.ws + off); }

__device__ __forceinline__ float wave_sum(float v) {
#pragma unroll
    for (int o = 32; o > 0; o >>= 1) v += __shfl_xor(v, o);
    return v;
}
struct Row { f32x4 v[4]; };
__device__ __forceinline__ Row row_load(const float* p, int lane) { Row r;
#pragma unroll
    for (int i = 0; i < 4; ++i) r.v[i] = *(const f32x4*)(p + i * 256 + lane * 4);
    return r; }
__device__ __forceinline__ void row_store(float* p, int lane, const Row& r) {
#pragma unroll
    for (int i = 0; i < 4; ++i) *(f32x4*)(p + i * 256 + lane * 4) = r.v[i]; }
__device__ __forceinline__ Row row_load_bf16(const bf16_t* p, int lane) { Row r;
#pragma unroll
    for (int i = 0; i < 4; ++i) { const u32x2 w = *(const u32x2*)(p + i * 256 + lane * 4); r.v[i] = (f32x4){bf_lo(w.x), bf_hi(w.x), bf_lo(w.y), bf_hi(w.y)}; }
    return r; }
__device__ __forceinline__ void row_store_bf16(bf16_t* p, int lane, const Row& r) {
#pragma unroll
    for (int i = 0; i < 4; ++i) { u32x2 w; w.x = cvtpk(r.v[i][0], r.v[i][1]); w.y = cvtpk(r.v[i][2], r.v[i][3]); *(u32x2*)(p + i * 256 + lane * 4) = w; } }
__device__ __forceinline__ void row_ln(Row& r) {
    float s = 0.f;
#pragma unroll
    for (int i = 0; i < 4; ++i) s += (r.v[i][0] + r.v[i][1]) + (r.v[i][2] + r.v[i][3]);
    const float mean = wave_sum(s) * (1.f / 1024.f);
    float q = 0.f;
#pragma unroll
    for (int i = 0; i < 4; ++i) { r.v[i] = r.v[i] - mean; q += (r.v[i][0] * r.v[i][0] + r.v[i][1] * r.v[i][1]) + (r.v[i][2] * r.v[i][2] + r.v[i][3] * r.v[i][3]); }
    const float rstd = rsqrtf(wave_sum(q) * (1.f / 1024.f) + EPS);
#pragma unroll
    for (int i = 0; i < 4; ++i) r.v[i] = r.v[i] * rstd;
}
__device__ __forceinline__ float* res_ptr(const Args& a, int row) { const int b = row / RB, j = row - b * RB; return j < L ? wsp<float>(a, OFF_RESC) + ((size_t)b * L + j) * D : a.out + ((size_t)b * S + (j - L)) * D; }
__device__ __forceinline__ const float* xin_ptr(const Args& a, int row) { const int b = row / RB, j = row - b * RB; return j < L ? a.in[I_CTX] + ((size_t)b * L + j) * D : a.in[I_X] + ((size_t)b * S + (j - L)) * D; }
__device__ __forceinline__ int thin_row(int i, bool last) { return last ? ((i >> 11) * RB + L + (i & 2047)) : i; }

__device__ __forceinline__ void tr_item(const float* __restrict__ src, size_t ld_src, bf16_t* __restrict__ dst, size_t ld_dst, int lane) {
    float v[64];
#pragma unroll
    for (int r = 0; r < 64; ++r) v[r] = src[(size_t)r * ld_src + lane];
    bf16_t* d = dst + (size_t)lane * ld_dst;
#pragma unroll
    for (int q = 0; q < 8; ++q) { u32x4 w; w.x = cvtpk(v[q * 8 + 0], v[q * 8 + 1]); w.y = cvtpk(v[q * 8 + 2], v[q * 8 + 3]); w.z = cvtpk(v[q * 8 + 4], v[q * 8 + 5]); w.w = cvtpk(v[q * 8 + 6], v[q * 8 + 7]); *(u32x4*)(d + q * 8) = w; }
}

__device__ __forceinline__ void phase0a(const Args& a, LAS unsigned char* lds) {
    int tid = threadIdx.x; asm volatile("" : "+v"(tid));
    const int lane = tid & 63, wid = __builtin_amdgcn_readfirstlane(tid >> 6), blk = blockIdx.x, G = gridDim.x, gw = blk * 8 + wid, nw = G * 8, gt = blk * 512 + tid, ntr = G * 512;
    if (blk < 192) {
        LAS float* SIL = (LAS float*)lds; LAS float* red = (LAS float*)(lds + 69632);
        for (int i = tid; i < 17 * 1024; i += 512) { const float x = i < 16 * 1024 ? a.in[I_C][i] : a.in[I_CCTX][i - 16 * 1024]; SIL[i] = x / (1.f + __expf(-x)); }
        __syncthreads();
        for (int item = blk; item < 192; item += G) {
            const int l = item / 96, cg = item - l * 96, n = cg * 64 + lane;
            float acc[17];
#pragma unroll
            for (int r = 0; r < 17; ++r) acc[r] = 0.f;
            const float* w = a.in[I_WMOD] + (size_t)l * D * MODW + n;
            for (int k = wid * 128; k < wid * 128 + 128; ++k) {
                const float wv = w[(size_t)k * MODW];
#pragma unroll
                for (int r = 0; r < 17; ++r) acc[r] += SIL[r * 1024 + k] * wv;
            }
#pragma unroll
            for (int r = 0; r < 17; ++r) red[(wid * 17 + r) * 64 + lane] = acc[r];
            __syncthreads();
            if (wid == 0) {
#pragma unroll
                for (int r = 0; r < 17; ++r) { float s = a.in[I_BMOD][(size_t)l * MODW + n];
#pragma unroll
                    for (int q = 0; q < 8; ++q) s += red[(q * 17 + r) * 64 + lane];
                    wsp<float>(a, OFF_MOD)[((size_t)l * 17 + r) * MODW + n] = s; }
            }
            __syncthreads();
        }
    }
    for (int it = gw; it < 1152 + 512; it += nw) {
        if (it < 1152) { const int l = it / 576, r = it - l * 576, kb = r / 36, nb = r - kb * 36;
            tr_item(a.in[I_WIN] + (size_t)l * D * 2560 + (size_t)(kb * 64) * 2560 + 256 + nb * 64, 2560, wsp<bf16_t>(a, OFF_WQKV) + ((size_t)l * QKVW + nb * 64) * D + kb * 64, D, lane);
        } else { const int q = it - 1152, l = q >> 8, r = q & 255, kb = r >> 4, nb = r & 15;
            const float* src = a.in[I_WOUT] + (size_t)l * D * D + (size_t)(kb * 64) * D + nb * 64;
            bf16_t* dst = wsp<bf16_t>(a, OFF_WOUT) + ((size_t)l * D + nb * 64) * CW;
            tr_item(src, D, dst + kb * 64 + 256, CW, lane);
            if (kb < 4) tr_item(src, D, dst + kb * 64, CW, lane);
        }
    }
    {
        const float nl = 0.0027621358640099515f  , nc = 0.0078125f  ;
        bf16_t* TL = wsp<bf16_t>(a, OFF_TABL); bf16_t* TC = wsp<bf16_t>(a, OFF_TABC);
        for (int it = gt; it < S * (S / 8) + L * (L / 8); it += ntr) {
            int T, tp, t0; float nn; bf16_t* base;
            if (it < S * (S / 8)) { T = S; tp = it / (S / 8); t0 = (it - tp * (S / 8)) * 8; nn = nl; base = TL; }
            else { const int q = it - S * (S / 8); T = L; tp = q / (L / 8); t0 = (q - tp * (L / 8)) * 8; nn = nc; base = TC; }
            float cv[8], sv[8];
#pragma unroll
            for (int j = 0; j < 8; ++j) { const int m = ((t0 + j) * tp) & (T - 1); const float x = 2.f * (float)m / (float)T; cv[j] = cospif(x) * nn; sv[j] = -sinpif(x) * nn; }
            u32x4 wc, wsn; wc.x = cvtpk(cv[0], cv[1]); wc.y = cvtpk(cv[2], cv[3]); wc.z = cvtpk(cv[4], cv[5]); wc.w = cvtpk(cv[6], cv[7]);
            wsn.x = cvtpk(sv[0], sv[1]); wsn.y = cvtpk(sv[2], sv[3]); wsn.z = cvtpk(sv[4], sv[5]); wsn.w = cvtpk(sv[6], sv[7]);
            *(u32x4*)(base + (size_t)tp * T + t0) = wc; *(u32x4*)(base + (size_t)T * T + (size_t)tp * T + t0) = wsn;
        }
    }
    for (int i = gt; i < 65536 + 1024 + 2; i += ntr) {
        if (i < 65536) { const int d = i & 63, c = (i >> 6) & 63, g = (i >> 12) & 3, half = (i >> 14) & 1, l = i >> 15;
            const float* wf = a.in[I_WF] + ((size_t)(l * 4 + g) * 64) * 64 + d; float s = 0.f;
            for (int cp = 0; cp < 64; ++cp) { const int m = (c * cp) & 63; const float x = (float)m * (1.f / 32.f); s += (half ? sinpif(x) : cospif(x)) * wf[cp * 64]; }
            wsp<float>(a, OFF_MH)[i] = s;
        } else if (i < 65536 + 1024) { const int q = i - 65536, pos = q >> 4, f = q & 15; const float ang = (float)pos * powf(10000.f, -(float)f / 16.f);
            wsp<float>(a, OFF_RC)[q] = cosf(ang); wsp<float>(a, OFF_RS)[q] = sinf(ang);
        } else { const int l = i - 65536 - 1024; const float* q = a.in[I_LAMQK] + l * 256; float s1 = 0.f, s2 = 0.f;
            for (int k = 0; k < 64; ++k) { s1 += q[k] * q[64 + k]; s2 += q[128 + k] * q[192 + k]; }
            wsp<float>(a, OFF_LAM)[l] = expf(s1) - expf(s2) + (0.8f - 0.6f * expf(-0.3f * (float)l)); }
    }
}

__device__ __forceinline__ void h_from_row(const Args& a, Row& r, int row, int l, int sh_off, int sc_off, int lane) {
    row_ln(r);
    const int b = row / RB, j = row - b * RB;
    const float* mrow = wsp<float>(a, OFF_MOD) + ((size_t)l * 17 + (j < L ? 16 : b)) * MODW;
    const Row sh = row_load(mrow + sh_off, lane), sc = row_load(mrow + sc_off, lane);
#pragma unroll
    for (int i = 0; i < 4; ++i) r.v[i] = r.v[i] * (1.f + sc.v[i]) + sh.v[i];
}
__device__ __forceinline__ void phase0b(const Args& a) {
    int tid = threadIdx.x; asm volatile("" : "+v"(tid));
    const int lane = tid & 63, wid = __builtin_amdgcn_readfirstlane(tid >> 6), gw = blockIdx.x * 8 + wid, nw = gridDim.x * 8;
    for (int row = gw; row < NTOK; row += nw) {
        Row r = row_load(xin_ptr(a, row), lane);
        h_from_row(a, r, row, 0, 0, 1024, lane);
        row_store_bf16(wsp<bf16_t>(a, OFF_ARENA + AR_H) + (size_t)row * D, lane, r);
    }
    for (int it = gw; it < 1024; it += nw) {
        const int l = it >> 9, n = it & 511, half = n >> 8, g = (n >> 6) & 3, d = n & 63;
        const float* mh = wsp<float>(a, OFF_MH) + ((size_t)((l * 2 + half) * 4 + g) * 64) * 64 + d;
        bf16_t* dst = wsp<bf16_t>(a, OFF_WU) + ((size_t)l * 512 + n) * D;
        for (int i = 0; i < 16; ++i) { const int k = lane + 64 * i; const float* wrow = a.in[I_WIN] + (size_t)l * D * 2560 + (size_t)k * 2560 + g * 64; float s = 0.f;
#pragma unroll
            for (int c4 = 0; c4 < 16; ++c4) { const f32x4 w = *(const f32x4*)(wrow + c4 * 4); s += w[0] * mh[(c4 * 4 + 0) * 64] + w[1] * mh[(c4 * 4 + 1) * 64] + w[2] * mh[(c4 * 4 + 2) * 64] + w[3] * mh[(c4 * 4 + 3) * 64]; }
            dst[k] = (bf16_t)(cvtpk(s, 0.f) & 0xffffu); }
    }
}

struct SchedInproj {
    const char* H; const char* WQ; const char* WUp; int G, c; bool last;
    __device__ __forceinline__ bool next(int i, g8::Unit& u) const {
        const int Lu = i * G + c, nq = last ? 1248 : 1296, nu = last ? 256 : 288;
        u.gl = nullptr; u.gcount = 0;
        if (Lu < nq) { int pm, pn;
            if (!last) { const int grp = Lu / 72, w = Lu - grp * 72; pm = grp * 8 + (w & 7); pn = w >> 3; }
            else if (Lu < 1152) { const int grp = Lu / 72, w = Lu - grp * 72, q = grp * 8 + (w & 7); pm = (q >> 3) * 9 + 1 + (q & 7); pn = w >> 3; }
            else { const int q = Lu - 1152; pm = (q & 15) * 9; pn = 3 + (q >> 4); }
            u.A = H + (size_t)pm * 256 * 2048; u.B = WQ + (size_t)pn * 256 * 2048; u.kind = 0; u.p0 = pm; u.p1 = pn; return true; }
        const int q = Lu - nq;
        if (q < nu) { const int half = q & 1, tt = q >> 1, pmT = last ? ((tt >> 3) * 9 + 1 + (tt & 7)) : tt;
            u.A = WUp + (size_t)half * 256 * 2048; u.B = H + (size_t)pmT * 256 * 2048; u.kind = 1; u.p0 = half; u.p1 = pmT; return true; }
        return false;
    }
};
struct EpiInproj {
    bf16_t* QKV; bf16_t* UTL; bf16_t* UTC; const float* RC; const float* RS;
    __device__ __forceinline__ void operator()(const f32x4 (&acc)[2][2][4][2], const g8::Unit& u, int wr, int wc, int fr, int fq) const {
        if (u.kind == 0) {
            const int pm = u.p0, pn = u.p1, b = pm / 9, jt = pm - b * 9;
            const bool rope = (jt != 0) && (pn < 6);
            const float qs = pn < 3 ? QSCALE : 1.f, sgn = (fq & 2) ? 1.f : -1.f;
#pragma unroll
            for (int ai = 0; ai < 2; ++ai)
#pragma unroll
                for (int m = 0; m < 4; ++m) {
                    const int r = 128 * ai + 64 * wr + 16 * m + fr;
                    bf16_t* rowp = QKV + (size_t)(pm * 256 + r) * QKVW + pn * 256 + 32 * wc + 8 * fq;
                    f32x4 c0 = {1.f, 1.f, 1.f, 1.f}, c1 = c0, s0 = {0.f, 0.f, 0.f, 0.f}, s1 = s0;
                    if (rope) { const int t = (jt - 1) * 256 + r, pos = (wc & 1) ? (t & 63) : (t >> 6); const float* cp = RC + pos * 16 + 8 * (fq & 1); const float* sp = RS + pos * 16 + 8 * (fq & 1);
                        c0 = *(const f32x4*)cp; c1 = *(const f32x4*)(cp + 4); s0 = *(const f32x4*)sp; s1 = *(const f32x4*)(sp + 4); }
#pragma unroll
                    for (int bj = 0; bj < 2; ++bj) {
                        f32x4 v0 = acc[ai][bj][m][0], v1 = acc[ai][bj][m][1];
                        if (rope) { f32x4 p0, p1;
#pragma unroll
                            for (int j = 0; j < 4; ++j) { p0[j] = __shfl_xor(v0[j], 32); p1[j] = __shfl_xor(v1[j], 32); }
                            v0 = v0 * c0 + (p0 * s0) * sgn; v1 = v1 * c1 + (p1 * s1) * sgn; }
                        v0 = v0 * qs; v1 = v1 * qs;
                        u32x4 w; w.x = cvtpk(v0[0], v0[1]); w.y = cvtpk(v0[2], v0[3]); w.z = cvtpk(v1[0], v1[1]); w.w = cvtpk(v1[2], v1[3]);
                        *(u32x4*)(rowp + bj * 128) = w; }
                }
        } else {
            const int half = u.p0, pmT = u.p1, b = pmT / 9, jt = pmT - b * 9;
#pragma unroll
            for (int ai = 0; ai < 2; ++ai)
#pragma unroll
                for (int m = 0; m < 4; ++m) {
                    const int r = 128 * ai + 64 * wr + 16 * m + fr, col = 32 * wc + 8 * fq;
                    bf16_t* rowp = (jt == 0) ? UTC + ((size_t)((b * 2 + half) * 256 + r)) * L + col : UTL + ((size_t)((b * 2 + half) * 256 + r)) * S + (jt - 1) * 256 + col;
#pragma unroll
                    for (int bj = 0; bj < 2; ++bj) { const f32x4 v0 = acc[ai][bj][m][0], v1 = acc[ai][bj][m][1];
                        u32x4 w; w.x = cvtpk(v0[0], v0[1]); w.y = cvtpk(v0[2], v0[3]); w.z = cvtpk(v1[0], v1[1]); w.w = cvtpk(v1[2], v1[3]);
                        *(u32x4*)(rowp + bj * 128) = w; }
                }
        }
    }
};
struct EpiStore {
    bf16_t* dst; int ld;
    __device__ __forceinline__ void operator()(const f32x4 (&acc)[2][2][4][2], const g8::Unit& u, int wr, int wc, int fr, int fq) const {
#pragma unroll
        for (int ai = 0; ai < 2; ++ai)
#pragma unroll
            for (int m = 0; m < 4; ++m) { const int r = 128 * ai + 64 * wr + 16 * m + fr;
                bf16_t* rowp = dst + (size_t)(u.p0 + r) * ld + u.p1 + 32 * wc + 8 * fq;
#pragma unroll
                for (int bj = 0; bj < 2; ++bj) { const f32x4 v0 = acc[ai][bj][m][0], v1 = acc[ai][bj][m][1];
                    u32x4 w; w.x = cvtpk(v0[0], v0[1]); w.y = cvtpk(v0[2], v0[3]); w.z = cvtpk(v1[0], v1[1]); w.w = cvtpk(v1[2], v1[3]);
                    *(u32x4*)(rowp + bj * 128) = w; } }
    }
};
struct SchedFourier {
    const char* TAB; const char* UT; int G, c; bool ctx;
    __device__ __forceinline__ bool next(int i, g8::Unit& u) const {
        const int Lu = i * G + c; u.gl = nullptr; u.gcount = 0; u.kind = 2;
        if (!ctx) { if (Lu >= 256) return false; const int pm = Lu & 7, half = (Lu >> 3) & 1, b = Lu >> 4;
            u.A = TAB + ((size_t)half * S + pm * 256) * S * 2; u.B = UT + ((size_t)(b * 2 + half) * 256) * S * 2; u.p0 = b * RB + L + pm * 256; u.p1 = half * 256; return true; }
        if (Lu >= 32) return false; { const int half = Lu & 1, b = Lu >> 1;
            u.A = TAB + ((size_t)half * L) * L * 2; u.B = UT + ((size_t)(b * 2 + half) * 256) * L * 2; u.p0 = b * RB; u.p1 = half * 256; return true; }
    }
};
struct SchedOutproj {
    const char* CC; const char* W; int G, c; bool last;
    __device__ __forceinline__ bool next(int i, g8::Unit& u) const {
        const int Lu = i * G + c, n = last ? 512 : 576; if (Lu >= n) return false;
        const int grp = Lu >> 5, w = Lu & 31, q = grp * 8 + (w & 7), pn = w >> 3, pm = last ? ((q >> 3) * 9 + 1 + (q & 7)) : q;
        u.gl = nullptr; u.gcount = 0; u.kind = 2; u.A = CC + (size_t)pm * 256 * CW * 2; u.B = W + (size_t)pn * 256 * CW * 2; u.p0 = pm * 256; u.p1 = pn * 256; return true;
    }
};
struct SchedMoe {
    const LAS int* pre; const LAS int* cnt; const int* LIST; const char* Abase; const char* Wbase; size_t wstride; unsigned arow2, wtile2; int G, c; bool gather;
    __device__ __forceinline__ bool next(int i, g8::Unit& u) const {
        const int Lu = i * G + c, rt = Lu >> 2, pn = Lu & 3; if (rt >= pre[16]) return false;
        int e = 0;
#pragma unroll
        for (int q = 1; q < 16; ++q) e += (rt >= pre[q]) ? 1 : 0;
        const int lt = rt - pre[e], rem = cnt[e] - lt * 256;
        u.gl = LIST + (size_t)e * CAP + lt * 256; u.gcount = rem < 256 ? rem : 256; u.kind = 3; u.p0 = rt; u.p1 = pn;
        u.A = gather ? Abase : Abase + (size_t)rt * 256 * arow2; u.B = Wbase + (size_t)e * wstride + (size_t)pn * wtile2; return true;
    }
};
struct EpiGateUp {
    bf16_t* ASORT;
    __device__ __forceinline__ void operator()(const f32x4 (&acc)[2][2][4][2], const g8::Unit& u, int wr, int wc, int fr, int fq) const {
#pragma unroll
        for (int ai = 0; ai < 2; ++ai)
#pragma unroll
            for (int m = 0; m < 4; ++m) { const int r = 128 * ai + 64 * wr + 16 * m + fr;
                float o[8];
#pragma unroll
                for (int n = 0; n < 2; ++n)
#pragma unroll
                    for (int j = 0; j < 4; ++j) { const float g = acc[ai][0][m][n][j], up = acc[ai][1][m][n][j]; o[n * 4 + j] = g * __builtin_amdgcn_rcpf(1.f + __expf(-g)) * up; }
                u32x4 w; w.x = cvtpk(o[0], o[1]); w.y = cvtpk(o[2], o[3]); w.z = cvtpk(o[4], o[5]); w.w = cvtpk(o[6], o[7]);
                *(u32x4*)(ASORT + (size_t)(u.p0 * 256 + r) * 512 + u.p1 * 128 + 32 * wc + 8 * fq) = w; }
    }
};
struct EpiDown {
    bf16_t* Y2; const float* WPAIR;
    __device__ __forceinline__ void operator()(const f32x4 (&acc)[2][2][4][2], const g8::Unit& u, int wr, int wc, int fr, int fq) const {
#pragma unroll
        for (int ai = 0; ai < 2; ++ai)
#pragma unroll
            for (int m = 0; m < 4; ++m) { const int r = 128 * ai + 64 * wr + 16 * m + fr;
                if (r < u.gcount) { const int pair = u.gl[r]; const float wgt = WPAIR[pair];
                    bf16_t* rowp = Y2 + (size_t)pair * D + u.p1 * 256 + 32 * wc + 8 * fq;
#pragma unroll
                    for (int bj = 0; bj < 2; ++bj) { const f32x4 v0 = acc[ai][bj][m][0] * wgt, v1 = acc[ai][bj][m][1] * wgt;
                        u32x4 w; w.x = cvtpk(v0[0], v0[1]); w.y = cvtpk(v0[2], v0[3]); w.z = cvtpk(v1[0], v1[1]); w.w = cvtpk(v1[2], v1[3]);
                        *(u32x4*)(rowp + bj * 128) = w; } } }
    }
};

__device__ __forceinline__ void attn_unit(LAS unsigned char* lds, const bf16_t* __restrict__ QKV, bf16_t* __restrict__ CC, const int q_row0, const int key_row0, const int ntiles, const int h, const float lam, const float oml) {
    int tid = threadIdx.x; asm volatile("" : "+v"(tid));
    const int lane = tid & 63, wid = __builtin_amdgcn_readfirstlane(tid >> 6);
    const int qb = wid & 3, sub = wid >> 2, r32 = lane & 31, hi = lane >> 5;
    bf16x8 qr[4];
    { const bf16_t* qp = QKV + (size_t)(q_row0 + qb * 32 + r32) * QKVW + (2 * h + sub) * 64 + hi * 8;
#pragma unroll
      for (int d0 = 0; d0 < 4; ++d0) qr[d0] = *(const bf16x8*)(qp + d0 * 16); }
    const int c0 = 2 * (wid & 3), vp0 = 2 * wid;
    const char* ksrc = (const char*)(QKV + (size_t)(key_row0 + lane) * QKVW + 768 + (2 * h + sub) * 64 + c0 * 8);
    const char* vsrc = (const char*)(QKV + (size_t)(key_row0 + (vp0 & 3) * 16 + (lane >> 2)) * QKVW + 1536 + h * 128 + (vp0 >> 2) * 32 + (lane & 3) * 8);
    const size_t tstep = (size_t)64 * QKVW * 2;
    const unsigned kd = (unsigned)(sub * 8192 + c0 * 1024), vd = (unsigned)(16384 + vp0 * 1024);
#define AT_GLDS(g, l) __builtin_amdgcn_global_load_lds((const unsigned*)(g), (LAS unsigned*)(l), 16, 0, 0)
#define AT_DMA(t, st) do { const char* kk_ = ksrc + (size_t)(t) * tstep; const char* vv_ = vsrc + (size_t)(t) * tstep; LAS unsigned char* sb_ = lds + (st) * 32768; \
        AT_GLDS(kk_, sb_ + kd); AT_GLDS(kk_ + 16, sb_ + kd + 1024); AT_GLDS(vv_, sb_ + vd); AT_GLDS(vv_ + (size_t)16 * QKVW * 2, sb_ + vd + 1024); } while (0)
    const int kread = sub * 8192 + hi * 1024 + r32 * 16;
    const int vread = 16384 + ((lane >> 4) & 1) * 32 + (lane & 3) * 8 + (4 * hi + ((lane & 15) >> 2)) * 64;
    f32x16 oT[4];
#pragma unroll
    for (int d = 0; d < 4; ++d) oT[d] = (f32x16){};
    float m_run = -INFINITY, l_run = 0.f;
    AT_DMA(0, 0);
    for (int t = 0; t < ntiles; ++t) {
        asm volatile("s_waitcnt vmcnt(0)" ::: "memory");
        __syncthreads();
        if (t + 1 < ntiles) AT_DMA(t + 1, (t + 1) & 1);
        LAS const unsigned char* sb = lds + (t & 1) * 32768;
        f32x16 p0 = (f32x16){}, p1 = (f32x16){};
#pragma unroll
        for (int j = 0; j < 4; ++j) {
            const bf16x8 k0 = *(LAS const bf16x8*)(sb + kread + j * 2048), k1 = *(LAS const bf16x8*)(sb + kread + j * 2048 + 512);
            p0 = __builtin_amdgcn_mfma_f32_32x32x16_bf16(k0, qr[j], p0, 0, 0, 0);
            p1 = __builtin_amdgcn_mfma_f32_32x32x16_bf16(k1, qr[j], p1, 0, 0, 0);
        }
        float tm = fmaxf(p0[0], p1[0]);
#pragma unroll
        for (int r = 1; r < 16; ++r) tm = fmaxf(tm, fmaxf(p0[r], p1[r]));
        { auto rr = __builtin_amdgcn_permlane32_swap(__float_as_uint(tm), __float_as_uint(tm), false, false); tm = fmaxf(__uint_as_float(rr[0]), __uint_as_float(rr[1])); }
        const float mnew = fmaxf(m_run, tm);
        const float alpha = __builtin_amdgcn_exp2f(m_run - mnew);
        m_run = mnew; l_run *= alpha;
#pragma unroll
        for (int d = 0; d < 4; ++d)
#pragma unroll
            for (int r = 0; r < 16; ++r) oT[d][r] *= alpha;
        float ls = 0.f;
#pragma unroll
        for (int r = 0; r < 16; ++r) { p0[r] = __builtin_amdgcn_exp2f(p0[r] - mnew); p1[r] = __builtin_amdgcn_exp2f(p1[r] - mnew); ls += p0[r] + p1[r]; }
        l_run += ls;
        u32x4 pw[4];
#pragma unroll
        for (int q = 0; q < 4; ++q) { pw[0][q] = cvtpk(p0[2 * q], p0[2 * q + 1]); pw[1][q] = cvtpk(p0[8 + 2 * q], p0[8 + 2 * q + 1]); pw[2][q] = cvtpk(p1[2 * q], p1[2 * q + 1]); pw[3][q] = cvtpk(p1[8 + 2 * q], p1[8 + 2 * q + 1]); }
#pragma unroll
        for (int d = 0; d < 4; ++d)
#pragma unroll
            for (int ks = 0; ks < 4; ++ks) {
                const s16x4 lo = __builtin_bit_cast(s16x4, __builtin_amdgcn_ds_read_tr16_b64_v4i16((LAS s16x4*)(sb + vread + d * 4096 + ks * 1024)));
                const s16x4 hh = __builtin_bit_cast(s16x4, __builtin_amdgcn_ds_read_tr16_b64_v4i16((LAS s16x4*)(sb + vread + d * 4096 + ks * 1024 + 512)));
                const bf16x8 vf = (bf16x8){lo[0], lo[1], lo[2], lo[3], hh[0], hh[1], hh[2], hh[3]};
                oT[d] = __builtin_amdgcn_mfma_f32_32x32x16_bf16(vf, __builtin_bit_cast(bf16x8, pw[ks]), oT[d], 0, 0, 0);
            }
    }
    { auto rr = __builtin_amdgcn_permlane32_swap(__float_as_uint(l_run), __float_as_uint(l_run), false, false); l_run = __uint_as_float(rr[0]) + __uint_as_float(rr[1]); }
    const float inv = 1.f / l_run;
    LAS float* xch = (LAS float*)(lds + 65536 + qb * 16384);
    if (sub == 1) {
#pragma unroll
        for (int d = 0; d < 4; ++d)
#pragma unroll
            for (int r = 0; r < 16; ++r) xch[(d * 16 + r) * 64 + lane] = oT[d][r] * inv;
    }
    __syncthreads();
    if (sub == 0) {
        float ss = 0.f;
#pragma unroll
        for (int d = 0; d < 4; ++d)
#pragma unroll
            for (int r = 0; r < 16; ++r) { const float o = oT[d][r] * inv - lam * xch[(d * 16 + r) * 64 + lane]; oT[d][r] = o; ss += o * o; }
        { auto rr = __builtin_amdgcn_permlane32_swap(__float_as_uint(ss), __float_as_uint(ss), false, false); ss = __uint_as_float(rr[0]) + __uint_as_float(rr[1]); }
        const float rms = rsqrtf(ss * (1.f / 128.f) + EPS) * oml;
        const LAS float* gl = (const LAS float*)(lds + LDS_MISC + 3072);
        LAS unsigned char* stg = (LAS unsigned char*)xch;
#pragma unroll
        for (int d = 0; d < 4; ++d)
#pragma unroll
            for (int rq = 0; rq < 4; ++rq) { const int dd = d * 32 + 8 * rq + 4 * hi;
                const f32x4 g = *(const LAS f32x4*)(gl + dd);
                u32x2 w; w.x = cvtpk(oT[d][rq * 4 + 0] * rms * g[0], oT[d][rq * 4 + 1] * rms * g[1]); w.y = cvtpk(oT[d][rq * 4 + 2] * rms * g[2], oT[d][rq * 4 + 3] * rms * g[3]);
                *(LAS u32x2*)(stg + r32 * 272 + dd * 2) = w; }
        bf16_t* orow = CC + (size_t)(q_row0 + qb * 32) * CW + 512 + h * 128;
#pragma unroll
        for (int it = 0; it < 8; ++it) { const int row = it * 4 + (lane >> 4), ch = lane & 15;
            const u32x4 v = *(const LAS u32x4*)(stg + row * 272 + ch * 16);
            *(u32x4*)(orow + (size_t)row * CW + ch * 8) = v; }
    }
    __syncthreads();
#undef AT_GLDS
#undef AT_DMA
}
__device__ __forceinline__ void phase_attn(const Args& a, LAS unsigned char* lds, int l) {
    const bool last = (l == 1);
    const int c = blockIdx.x, G = gridDim.x, v = (c & 7) * (G >> 3) + (c >> 3);
    const bf16_t* QKV = wsp<bf16_t>(a, OFF_ARENA + AR_QKV); bf16_t* CC = wsp<bf16_t>(a, OFF_ARENA + AR_CC);
    const float lam = wsp<float>(a, OFF_LAM)[l], oml = 1.f - (0.8f - 0.6f * expf(-0.3f * (float)l));
    if (threadIdx.x < 128) ((LAS float*)(lds + LDS_MISC + 3072))[threadIdx.x] = a.in[I_SUBLN][l * 128 + threadIdx.x];
    __syncthreads();
    for (int id = v; id < 1536; id += G) { const int bh = id >> 4, qt = id & 15, b = bh / 6, h = bh - b * 6;
        attn_unit(lds, QKV, CC, b * RB + L + qt * 128, b * RB, 36, h, lam, oml); }
    if (!last) for (int id = v; id < 192; id += G) { const int bh = id >> 1, qt = id & 1, b = bh / 6, h = bh - b * 6;
        attn_unit(lds, QKV, CC, b * RB + qt * 128, b * RB, 4, h, lam, oml); }
}

__device__ __forceinline__ void phase_post_attn(const Args& a, LAS unsigned char* lds, int l) {
    const bool last = (l == 1);
    int tid = threadIdx.x; asm volatile("" : "+v"(tid));
    const int lane = tid & 63, wid = __builtin_amdgcn_readfirstlane(tid >> 6), gw = blockIdx.x * 8 + wid, nw = gridDim.x * 8;
    LAS float* wrT = (LAS float*)lds;
    LAS int* lcnt = (LAS int*)(lds + LDS_MISC + 256); LAS int* gbase = (LAS int*)(lds + LDS_MISC + 384); LAS int* rec = (LAS int*)(lds + LDS_MISC + 512);
    for (int i = tid; i < 16384; i += 512) wrT[(i & 15) * 1024 + (i >> 4)] = a.in[I_WR][i];
    if (tid < 16) lcnt[tid] = 0;
    __syncthreads();
    const int nrows = last ? NB * S : NTOK;
    bf16_t* OH = wsp<bf16_t>(a, OFF_ARENA + AR_O);
    int nrec = 0;
    for (int i = gw; i < nrows; i += nw) {
        const int row = thin_row(i, last), b = row / RB, j = row - b * RB;
        const float* mrow = wsp<float>(a, OFF_MOD) + ((size_t)l * 17 + (j < L ? 16 : b)) * MODW;
        Row x = row_load(l == 0 ? xin_ptr(a, row) : res_ptr(a, row), lane);
        { const Row o = row_load_bf16(OH + (size_t)row * D, lane), g = row_load(mrow + 2048, lane);
#pragma unroll
          for (int q = 0; q < 4; ++q) x.v[q] = x.v[q] * ALPHA + g.v[q] * o.v[q]; }
        row_ln(x);
        { const Row gg = row_load(a.in[I_LNAG] + l * D, lane), bb = row_load(a.in[I_LNAB] + l * D, lane);
#pragma unroll
          for (int q = 0; q < 4; ++q) x.v[q] = x.v[q] * gg.v[q] + bb.v[q]; }
        row_store(res_ptr(a, row), lane, x);
        h_from_row(a, x, row, l, 3072, 4096, lane);
        row_store_bf16(OH + (size_t)row * D, lane, x);
        float lg[16];
#pragma unroll
        for (int e = 0; e < 16; ++e) { float s = 0.f;
#pragma unroll
            for (int q = 0; q < 4; ++q) { const f32x4 w = *(const LAS f32x4*)(wrT + e * 1024 + q * 256 + lane * 4); s += (x.v[q][0] * w[0] + x.v[q][1] * w[1]) + (x.v[q][2] * w[2] + x.v[q][3] * w[3]); }
            lg[e] = wave_sum(s); }
        float sc[16], sel[16];
#pragma unroll
        for (int e = 0; e < 16; ++e) { sc[e] = 1.f / (1.f + expf(-lg[e])); sel[e] = sc[e] + a.in[I_RB][e]; }
        float best = -INFINITY; int bg = 0;
#pragma unroll
        for (int gI = 0; gI < 4; ++gI) {
            const float a0 = sel[gI * 4 + 0], a1 = sel[gI * 4 + 1], a2 = sel[gI * 4 + 2], a3 = sel[gI * 4 + 3];
            const float mx = fmaxf(fmaxf(a0, a1), fmaxf(a2, a3));
            float sec;
            if (a0 == mx) sec = fmaxf(a1, fmaxf(a2, a3)); else if (a1 == mx) sec = fmaxf(a0, fmaxf(a2, a3)); else if (a2 == mx) sec = fmaxf(fmaxf(a0, a1), a3); else sec = fmaxf(fmaxf(a0, a1), a2);
            const float gs = mx + sec;
            if (gs > best) { best = gs; bg = gI; }
        }
        float av[4], s4[4];
#pragma unroll
        for (int q = 0; q < 4; ++q) { av[q] = 0.f; s4[q] = 0.f; }
#pragma unroll
        for (int gI = 0; gI < 4; ++gI)
#pragma unroll
            for (int q = 0; q < 4; ++q) if (bg == gI) { av[q] = sel[gI * 4 + q]; s4[q] = sc[gI * 4 + q]; }
        int i0 = 0; float v0 = av[0];
#pragma unroll
        for (int q = 1; q < 4; ++q) if (av[q] > v0) { v0 = av[q]; i0 = q; }
        int i1 = -1; float v1 = -INFINITY;
#pragma unroll
        for (int q = 0; q < 4; ++q) if (q != i0 && av[q] > v1) { v1 = av[q]; i1 = q; }
        float w0 = 0.f, w1 = 0.f;
#pragma unroll
        for (int q = 0; q < 4; ++q) { if (q == i0) w0 = s4[q]; if (q == i1) w1 = s4[q]; }
        const float inv = 1.f / (w0 + w1); const int e0 = bg * 4 + i0, e1 = bg * 4 + i1;
        if (lane == 0) {
            const int p0 = __hip_atomic_fetch_add(lcnt + e0, 1, __ATOMIC_RELAXED, __HIP_MEMORY_SCOPE_WORKGROUP), p1 = __hip_atomic_fetch_add(lcnt + e1, 1, __ATOMIC_RELAXED, __HIP_MEMORY_SCOPE_WORKGROUP);
            LAS int* rc = rec + (wid * 18 + nrec) * 4; rc[0] = row; rc[1] = e0 | (e1 << 8); rc[2] = p0; rc[3] = p1;
            wsp<float>(a, OFF_WPAIR)[2 * row] = w0 * inv; wsp<float>(a, OFF_WPAIR)[2 * row + 1] = w1 * inv;
            wsp<int4>(a, OFF_SELN)[row] = make_int4(e0, e1, __float_as_int(w0 * inv), __float_as_int(w1 * inv));
        }
        ++nrec;
    }
    __syncthreads();
    unsigned* CNT = wsp<unsigned>(a, CTL_CNT);
    if (tid < 16) gbase[tid] = (int)__hip_atomic_fetch_add(CNT + (l * 16 + tid) * 64, (unsigned)lcnt[tid], __ATOMIC_RELAXED, __HIP_MEMORY_SCOPE_AGENT);
    __syncthreads();
    if (lane < nrec) { const LAS int* rc = rec + (wid * 18 + lane) * 4; const int row = rc[0], e0 = rc[1] & 255, e1 = rc[1] >> 8;
        int* LIST = wsp<int>(a, OFF_LIST);
        LIST[(size_t)e0 * CAP + gbase[e0] + rc[2]] = 2 * row; LIST[(size_t)e1 * CAP + gbase[e1] + rc[3]] = 2 * row + 1; }
    bf16_t* WGU = wsp<bf16_t>(a, OFF_ARENA + AR_WGU); bf16_t* WD = wsp<bf16_t>(a, OFF_ARENA + AR_WD);
    for (int it = gw; it < 6144; it += nw) {
        if (it < 4096) { const int gu = it >> 11, q = it & 2047, e = q >> 7, r = q & 127, kb = r >> 3, nb = r & 7;
            const float* src = (gu ? a.in[I_WUP] : a.in[I_WG]) + ((size_t)(l * 16 + e) * 1024 + kb * 64) * 512 + nb * 64;
            tr_item(src, 512, WGU + ((size_t)e * 1024 + (nb >> 1) * 256 + gu * 128 + (nb & 1) * 64) * 1024 + kb * 64, 1024, lane);
        } else { const int q = it - 4096, e = q >> 7, r = q & 127, kb = r >> 4, nb = r & 15;
            const float* src = a.in[I_WDN] + ((size_t)(l * 16 + e) * 512 + kb * 64) * 1024 + nb * 64;
            tr_item(src, 1024, WD + ((size_t)e * 1024 + nb * 64) * 512 + kb * 64, 512, lane); }
    }
}
__device__ __forceinline__ void moe_tables(const Args& a, LAS unsigned char* lds, int l) {
    LAS int* pre = (LAS int*)(lds + LDS_MISC + 64); LAS int* cnt = pre + 20;
    if (threadIdx.x == 0) { const unsigned* CNT = wsp<unsigned>(a, CTL_CNT); int s = 0;
        for (int e = 0; e < 16; ++e) { const int cN = (int)CNT[(l * 16 + e) * 64]; cnt[e] = cN; pre[e] = s; s += (cN + 255) >> 8; }
        pre[16] = s; }
    __syncthreads();
}
__device__ __forceinline__ void phase_post_ffn(const Args& a, int l) {
    const bool last = (l == 1);
    int tid = threadIdx.x; asm volatile("" : "+v"(tid));
    const int lane = tid & 63, wid = __builtin_amdgcn_readfirstlane(tid >> 6), gw = blockIdx.x * 8 + wid, nw = gridDim.x * 8;
    const int nrows = last ? NB * S : NTOK;
    const bf16_t* Y2 = wsp<bf16_t>(a, OFF_ARENA + AR_Y2);
    for (int i = gw; i < nrows; i += nw) {
        const int row = thin_row(i, last), b = row / RB, j = row - b * RB;
        const float* mrow = wsp<float>(a, OFF_MOD) + ((size_t)l * 17 + (j < L ? 16 : b)) * MODW;
        float* rp = res_ptr(a, row);
        Row x = row_load(rp, lane);
        { const Row y0 = row_load_bf16(Y2 + (size_t)(2 * row) * D, lane), y1 = row_load_bf16(Y2 + (size_t)(2 * row + 1) * D, lane), g = row_load(mrow + 5120, lane);
#pragma unroll
          for (int q = 0; q < 4; ++q) x.v[q] = x.v[q] * ALPHA + g.v[q] * (y0.v[q] + y1.v[q]); }
        row_ln(x);
        { const Row gg = row_load(a.in[I_LNFG] + l * D, lane), bb = row_load(a.in[I_LNFB] + l * D, lane);
#pragma unroll
          for (int q = 0; q < 4; ++q) x.v[q] = x.v[q] * gg.v[q] + bb.v[q]; }
        row_store(rp, lane, x);
        if (!last) { h_from_row(a, x, row, 1, 0, 1024, lane); row_store_bf16(wsp<bf16_t>(a, OFF_ARENA + AR_H) + (size_t)row * D, lane, x); }
    }
}

constexpr int N_PHASES = 16;
__global__ void __launch_bounds__(512, 2) mk_fwd(Args a) {
    extern __shared__ __attribute__((aligned(16))) unsigned char smem[];
    LAS unsigned char* lds = (LAS unsigned char*)smem;
    if (threadIdx.x == 0) *(LAS u32x4*)(lds + LDS_MISC) = (u32x4){0u, 0u, 0u, 0u};
    __syncthreads();
    XcdBarrier bar = xcd_barrier_post(wsp<unsigned>(a, (size_t)a.li * CTL_BAR_STRIDE), (volatile LAS unsigned*)(lds + LDS_MISC));
    const int G = gridDim.x, c = blockIdx.x;
#ifndef MK_ONLY
#define MK_ONLY -1
#endif
#define MK_RUN(kind, p, ...) do { if constexpr (MK_ONLY < 0 || MK_ONLY == (kind)) { if ((p) >= a.ph_lo && (p) < a.ph_hi) { __VA_ARGS__; if ((p) + 1 < a.ph_hi) xcd_barrier(bar); } } } while (0)
    MK_RUN(0, 0, phase0a(a, lds));
    MK_RUN(1, 1, phase0b(a));
    for (int l = 0; l < 2; ++l) {
        const bool last = (l == 1); const int pb = 2 + 7 * l;
        MK_RUN(2, pb + 0, {
            SchedInproj Sc{(const char*)wsp<bf16_t>(a, OFF_ARENA + AR_H), (const char*)(wsp<bf16_t>(a, OFF_WQKV) + (size_t)l * QKVW * D), (const char*)(wsp<bf16_t>(a, OFF_WU) + (size_t)l * 512 * D), G, c, last};
            EpiInproj Ep{wsp<bf16_t>(a, OFF_ARENA + AR_QKV), wsp<bf16_t>(a, OFF_ARENA + AR_UTL), wsp<bf16_t>(a, OFF_ARENA + AR_UTC), wsp<float>(a, OFF_RC), wsp<float>(a, OFF_RS)};
            g8::gemm_phase<false>(lds, 1024, 2048u, 2048u, Sc, Ep); });
        MK_RUN(3, pb + 1, {
#ifndef MK_NO_ATTN
            phase_attn(a, lds, l);
#endif
#ifndef MK_NO_FOUR
            EpiStore Ep{wsp<bf16_t>(a, OFF_ARENA + AR_CC), CW};
            { SchedFourier Sc{(const char*)wsp<bf16_t>(a, OFF_TABL), (const char*)wsp<bf16_t>(a, OFF_ARENA + AR_UTL), G, c, false}; g8::gemm_phase<false>(lds, 2048, 4096u, 4096u, Sc, Ep); }
            if (!last) { SchedFourier Sc{(const char*)wsp<bf16_t>(a, OFF_TABC), (const char*)wsp<bf16_t>(a, OFF_ARENA + AR_UTC), G, c, true}; g8::gemm_phase<false>(lds, 256, 512u, 512u, Sc, Ep); }
#endif
            });
        MK_RUN(4, pb + 2, {
            SchedOutproj Sc{(const char*)wsp<bf16_t>(a, OFF_ARENA + AR_CC), (const char*)(wsp<bf16_t>(a, OFF_WOUT) + (size_t)l * D * CW), G, c, last};
            EpiStore Ep{wsp<bf16_t>(a, OFF_ARENA + AR_O), D};
            g8::gemm_phase<false>(lds, CW, (unsigned)(CW * 2), (unsigned)(CW * 2), Sc, Ep); });
        MK_RUN(5, pb + 3, phase_post_attn(a, lds, l));
        MK_RUN(6, pb + 4, {
            moe_tables(a, lds, l);
            SchedMoe Sc{(const LAS int*)(lds + LDS_MISC + 64), (const LAS int*)(lds + LDS_MISC + 64) + 20, wsp<int>(a, OFF_LIST), (const char*)wsp<bf16_t>(a, OFF_ARENA + AR_O), (const char*)wsp<bf16_t>(a, OFF_ARENA + AR_WGU), (size_t)1024 * 1024 * 2, 2048u, 256u * 2048u, G, c, true};
            EpiGateUp Ep{wsp<bf16_t>(a, OFF_ARENA + AR_ASORT)};
            g8::gemm_phase<true>(lds, 1024, 2048u, 2048u, Sc, Ep); });
        MK_RUN(7, pb + 5, {
            moe_tables(a, lds, l);
            SchedMoe Sc{(const LAS int*)(lds + LDS_MISC + 64), (const LAS int*)(lds + LDS_MISC + 64) + 20, wsp<int>(a, OFF_LIST), (const char*)wsp<bf16_t>(a, OFF_ARENA + AR_ASORT), (const char*)wsp<bf16_t>(a, OFF_ARENA + AR_WD), (size_t)1024 * 512 * 2, 1024u, 256u * 1024u, G, c, false};
            EpiDown Ep{wsp<bf16_t>(a, OFF_ARENA + AR_Y2), wsp<float>(a, OFF_WPAIR)};
            g8::gemm_phase<false>(lds, 512, 1024u, 1024u, Sc, Ep); });
        MK_RUN(8, pb + 6, phase_post_ffn(a, l));
    }
#undef MK_RUN
}
}
#if MK_DEBUG
namespace ref {
constexpr int NB = 16, S = 2048, L = 256, D = 1024, RB = L + S;
constexpr int INW = 2560, QOFF = 256, KOFF = 1024, VOFF = 1792;
constexpr int MODW = 6 * D;
constexpr float ALPHA = 1.41421356237309515f, EPS = 1e-5f;

__device__ __forceinline__ float wave_sum(float v) {
#pragma unroll
    for (int o = 32; o > 0; o >>= 1) v += __shfl_xor(v, o);
    return v;
}
__device__ __forceinline__ float wave_max(float v) {
#pragma unroll
    for (int o = 32; o > 0; o >>= 1) v = fmaxf(v, __shfl_xor(v, o));
    return v;
}
__device__ __forceinline__ float block_sum(float v, float* red) {
    v = wave_sum(v);
    __syncthreads();
    if ((threadIdx.x & 63) == 0) red[threadIdx.x >> 6] = v;
    __syncthreads();
    return red[0] + red[1] + red[2] + red[3];
}
__device__ __forceinline__ float block_max(float v, float* red) {
    v = wave_max(v);
    __syncthreads();
    if ((threadIdx.x & 63) == 0) red[threadIdx.x >> 6] = v;
    __syncthreads();
    return fmaxf(fmaxf(red[0], red[1]), fmaxf(red[2], red[3]));
}

__global__ void k_prep_small(const float* c, const float* c_ctx, const float* lam_qk, float* SIL, float* LAM, float* RC, float* RS, float* C64, float* S64) {
    const int i = blockIdx.x * blockDim.x + threadIdx.x;
    if (i < 17 * 1024) { const float x = i < 16 * 1024 ? c[i] : c_ctx[i - 16 * 1024]; SIL[i] = x / (1.f + expf(-x)); }
    if (i < 1024) { const int pos = i >> 4, f = i & 15; const float fr = powf(10000.f, -(float)f / 16.f); const float a = (float)pos * fr; RC[i] = cosf(a); RS[i] = sinf(a); }
    if (i < 4096) { const int a = i >> 6, b = i & 63; const int m = (a * b) & 63; C64[i] = cospif(2.f * (float)m / 64.f); S64[i] = sinpif(2.f * (float)m / 64.f); }
    if (i < 2) {
        const float* q = lam_qk + i * 256; float s1 = 0.f, s2 = 0.f;
        for (int k = 0; k < 64; ++k) { s1 += q[k] * q[64 + k]; s2 += q[128 + k] * q[192 + k]; }
        LAM[i] = expf(s1) - expf(s2) + (0.8f - 0.6f * expf(-0.3f * (float)i));
    }
}
__global__ void k_prep_tab(float* TAB, int T) {
    const size_t i = (size_t)blockIdx.x * blockDim.x + threadIdx.x;
    if (i >= (size_t)T * 2 * T) return;
    const int tp = (int)(i / (2 * T)), kk = (int)(i % (2 * T)), t = kk % T, part = kk / T;
    const int m = (int)(((long)t * tp) % T);
    TAB[i] = part ? -sinpif(2.f * (float)m / (float)T) : cospif(2.f * (float)m / (float)T);
}
__global__ __launch_bounds__(256) void k_mod(const float* __restrict__ SIL, const float* __restrict__ w_mod, const float* __restrict__ b_mod, float* __restrict__ MOD) {
    const int l = blockIdx.y, lane = threadIdx.x & 63, kq = threadIdx.x >> 6, n = blockIdx.x * 64 + lane;
    float acc[17];
#pragma unroll
    for (int r = 0; r < 17; ++r) acc[r] = 0.f;
    const float* w = w_mod + (size_t)l * D * MODW + n;
    for (int k = kq * 256; k < kq * 256 + 256; ++k) {
        const float wv = w[(size_t)k * MODW];
#pragma unroll
        for (int r = 0; r < 17; ++r) acc[r] += SIL[r * 1024 + k] * wv;
    }
    __shared__ float red[4][17][64];
#pragma unroll
    for (int r = 0; r < 17; ++r) red[kq][r][lane] = acc[r];
    __syncthreads();
    if (kq == 0) {
#pragma unroll
        for (int r = 0; r < 17; ++r) MOD[((size_t)l * 17 + r) * MODW + n] = red[0][r][lane] + red[1][r][lane] + red[2][r][lane] + red[3][r][lane] + b_mod[(size_t)l * MODW + n];
    }
}

struct Row { float4 v[4]; };
__device__ __forceinline__ Row row_load(const float* p, int lane) { Row r;
#pragma unroll
    for (int i = 0; i < 4; ++i) r.v[i] = *(const float4*)(p + i * 256 + lane * 4);
    return r; }
__device__ __forceinline__ void row_store(float* p, int lane, const Row& r) {
#pragma unroll
    for (int i = 0; i < 4; ++i) *(float4*)(p + i * 256 + lane * 4) = r.v[i]; }
__device__ __forceinline__ void row_ln(Row& r) {
    float s = 0.f;
#pragma unroll
    for (int i = 0; i < 4; ++i) s += (r.v[i].x + r.v[i].y) + (r.v[i].z + r.v[i].w);
    const float mean = wave_sum(s) * (1.f / 1024.f);
    float q = 0.f;
#pragma unroll
    for (int i = 0; i < 4; ++i) { r.v[i].x -= mean; r.v[i].y -= mean; r.v[i].z -= mean; r.v[i].w -= mean;
        q += (r.v[i].x * r.v[i].x + r.v[i].y * r.v[i].y) + (r.v[i].z * r.v[i].z + r.v[i].w * r.v[i].w); }
    const float rstd = rsqrtf(wave_sum(q) * (1.f / 1024.f) + EPS);
#pragma unroll
    for (int i = 0; i < 4; ++i) { r.v[i].x *= rstd; r.v[i].y *= rstd; r.v[i].z *= rstd; r.v[i].w *= rstd; }
}
__device__ __forceinline__ void row_fma(Row& r, const Row& a, const Row& b) {
#pragma unroll
    for (int i = 0; i < 4; ++i) { r.v[i].x = r.v[i].x * a.v[i].x + b.v[i].x; r.v[i].y = r.v[i].y * a.v[i].y + b.v[i].y; r.v[i].z = r.v[i].z * a.v[i].z + b.v[i].z; r.v[i].w = r.v[i].w * a.v[i].w + b.v[i].w; }
}
__device__ __forceinline__ void row_modulate(Row& r, const Row& sh, const Row& sc) {
#pragma unroll
    for (int i = 0; i < 4; ++i) { r.v[i].x = r.v[i].x * (1.f + sc.v[i].x) + sh.v[i].x; r.v[i].y = r.v[i].y * (1.f + sc.v[i].y) + sh.v[i].y; r.v[i].z = r.v[i].z * (1.f + sc.v[i].z) + sh.v[i].z; r.v[i].w = r.v[i].w * (1.f + sc.v[i].w) + sh.v[i].w; }
}

__device__ __forceinline__ const float* res_row(const float* xl, const float* xc, int b, int j) { return j < L ? xc + ((size_t)b * L + j) * D : xl + ((size_t)b * S + (j - L)) * D; }
__device__ __forceinline__ float* res_row_w(float* xl, float* xc, int b, int j) { return j < L ? xc + ((size_t)b * L + j) * D : xl + ((size_t)b * S + (j - L)) * D; }

__global__ __launch_bounds__(256) void k_lnmod(const float* xl, const float* xc, const float* MODl, float* H, int b, int j0, int nrows) {
    const int lane = threadIdx.x & 63, w = blockIdx.x * 4 + (threadIdx.x >> 6);
    if (w >= nrows) return;
    const int j = j0 + w;
    const float* mrow = MODl + (size_t)(j < L ? 16 : b) * MODW;
    Row r = row_load(res_row(xl, xc, b, j), lane);
    row_ln(r);
    const Row sh = row_load(mrow + 0, lane), sc = row_load(mrow + 1024, lane);
    row_modulate(r, sh, sc);
    row_store(H + (size_t)j * D, lane, r);
}

__global__ __launch_bounds__(256) void k_gemm_f32(const float* __restrict__ A, int lda, const float* __restrict__ Bm, int ldb, float* __restrict__ C, int ldc, int K) {
    __shared__ __attribute__((aligned(16))) float As[16][68];
    __shared__ __attribute__((aligned(16))) float Bs[16][68];
    const int tid = threadIdx.x, bm = blockIdx.y * 64, bn = blockIdx.x * 64, ty = tid >> 4, tx = tid & 15;
    float acc[4][4];
#pragma unroll
    for (int i = 0; i < 4; ++i)
#pragma unroll
        for (int j = 0; j < 4; ++j) acc[i][j] = 0.f;
    for (int k0 = 0; k0 < K; k0 += 16) {
        const float4 a = *(const float4*)(A + (size_t)(bm + (tid >> 2)) * lda + k0 + (tid & 3) * 4);
        As[(tid & 3) * 4 + 0][tid >> 2] = a.x; As[(tid & 3) * 4 + 1][tid >> 2] = a.y; As[(tid & 3) * 4 + 2][tid >> 2] = a.z; As[(tid & 3) * 4 + 3][tid >> 2] = a.w;
        const float4 b = *(const float4*)(Bm + (size_t)(k0 + (tid >> 4)) * ldb + bn + (tid & 15) * 4);
        *(float4*)&Bs[tid >> 4][(tid & 15) * 4] = b;
        __syncthreads();
#pragma unroll
        for (int kk = 0; kk < 16; ++kk) {
            const float4 a4 = *(const float4*)&As[kk][ty * 4], b4 = *(const float4*)&Bs[kk][tx * 4];
            const float av[4] = {a4.x, a4.y, a4.z, a4.w}, bv[4] = {b4.x, b4.y, b4.z, b4.w};
#pragma unroll
            for (int i = 0; i < 4; ++i)
#pragma unroll
                for (int j = 0; j < 4; ++j) acc[i][j] += av[i] * bv[j];
        }
        __syncthreads();
    }
#pragma unroll
    for (int i = 0; i < 4; ++i) *(float4*)(C + (size_t)(bm + ty * 4 + i) * ldc + bn + tx * 4) = make_float4(acc[i][0], acc[i][1], acc[i][2], acc[i][3]);
}

__global__ void k_rope(float* P, const float* RC, const float* RS) {
    const int i = blockIdx.x * blockDim.x + threadIdx.x;
    if (i >= S * 2 * 12 * 2 * 16) return;
    const int f = i & 15, blk = (i >> 4) & 1, hh = (i >> 5) % 12, sec = (i / (32 * 12)) & 1, t = i / (32 * 12 * 2);
    float* p = P + (size_t)(L + t) * INW + (sec ? KOFF : QOFF) + hh * 64 + blk * 32 + f;
    const int pos = blk ? (t & 63) : (t >> 6);
    const float c = RC[pos * 16 + f], s = RS[pos * 16 + f], x1 = p[0], x2 = p[16];
    p[0] = x1 * c - x2 * s; p[16] = x2 * c + x1 * s;
}

__global__ void k_fz(const float* P, const float* C64, const float* S64, float* Z, int T, int j0) {
    const int i = blockIdx.x * blockDim.x + threadIdx.x;
    if (i >= 2 * T * 256) return;
    const int n = i & 255, kk = i >> 8, t = kk % T, part = kk / T, g = n >> 6, cp = n & 63;
    const float* u = P + (size_t)(j0 + t) * INW + g * 64; const float* tb = part ? S64 : C64;
    float s = 0.f;
    for (int c = 0; c < 64; ++c) s += u[c] * tb[c * 64 + cp];
    Z[i] = s;
}
__global__ void k_fmap(const float* F, const float* wf, float* CONCAT, int T, int j0, float norm) {
    const int i = blockIdx.x * blockDim.x + threadIdx.x;
    if (i >= T * 256) return;
    const int n = i & 255, t = i >> 8, g = n >> 6, d = n & 63;
    const float* f = F + (size_t)t * 256 + g * 64; const float* w = wf + g * 4096 + d;
    float s = 0.f;
    for (int c = 0; c < 64; ++c) s += f[c] * w[c * 64];
    CONCAT[(size_t)(j0 + t) * D + n] = s * norm;
}

__global__ __launch_bounds__(256) void k_attn_naive(const float* __restrict__ P, float* __restrict__ CONCAT, const float* LAM, const float* subln_g, int l, float one_minus_lam_init, int j0) {
    const int j = j0 + blockIdx.x, h = blockIdx.y, tid = threadIdx.x;
    __shared__ float q1[64], q2[64], s1[RB], s2[RB], red[4], outp[2][128];
    const int nk = j < L ? L : RB;
    if (tid < 64) q1[tid] = P[(size_t)j * INW + QOFF + (2 * h) * 64 + tid];
    else if (tid < 128) q2[tid - 64] = P[(size_t)j * INW + QOFF + (2 * h + 1) * 64 + (tid - 64)];
    __syncthreads();
    float m1 = -INFINITY, m2 = -INFINITY;
    for (int key = tid; key < nk; key += 256) {
        const float* k1 = P + (size_t)key * INW + KOFF + (2 * h) * 64; const float* k2 = k1 + 64;
        float d1 = 0.f, d2 = 0.f;
        for (int d = 0; d < 64; ++d) { d1 += q1[d] * k1[d]; d2 += q2[d] * k2[d]; }
        d1 *= 0.125f; d2 *= 0.125f; s1[key] = d1; s2[key] = d2; m1 = fmaxf(m1, d1); m2 = fmaxf(m2, d2);
    }
    const float M1 = block_max(m1, red); const float M2 = block_max(m2, red);
    float l1 = 0.f, l2 = 0.f;
    for (int key = tid; key < nk; key += 256) { const float e1 = expf(s1[key] - M1), e2 = expf(s2[key] - M2); s1[key] = e1; s2[key] = e2; l1 += e1; l2 += e2; }
    const float L1 = block_sum(l1, red); const float L2 = block_sum(l2, red);
    const float lam = LAM[l];
    for (int key = tid; key < nk; key += 256) s1[key] = s1[key] / L1 - lam * (s2[key] / L2);
    __syncthreads();
    const int d = tid & 127, half = tid >> 7;
    float acc = 0.f;
    const int kh = nk >> 1;
    for (int key = half * kh; key < (half + 1) * kh; ++key) acc += s1[key] * P[(size_t)key * INW + VOFF + h * 128 + d];
    outp[half][d] = acc;
    __syncthreads();
    float o = 0.f;
    if (tid < 128) o = outp[0][tid] + outp[1][tid];
    const float ss = block_sum(tid < 128 ? o * o : 0.f, red);
    const float rms = rsqrtf(ss * (1.f / 128.f) + EPS);
    if (tid < 128) CONCAT[(size_t)j * D + 256 + h * 128 + tid] = o * rms * subln_g[l * 128 + tid] * one_minus_lam_init;
}

__global__ __launch_bounds__(256) void k_post_attn(const float* xl, const float* xc, const float* O, const float* MODl, const float* lng, const float* lnb,
                                                   float* x1l, float* x1c, float* H, const float* w_router, const float* router_bias, int4* SEL, int b, int j0, int nrows) {
    const int lane = threadIdx.x & 63, w = blockIdx.x * 4 + (threadIdx.x >> 6);
    if (w >= nrows) return;
    const int j = j0 + w;
    const float* mrow = MODl + (size_t)(j < L ? 16 : b) * MODW;
    Row x = row_load(res_row(xl, xc, b, j), lane);
    const Row o = row_load(O + (size_t)j * D, lane), g = row_load(mrow + 2048, lane);
#pragma unroll
    for (int i = 0; i < 4; ++i) { x.v[i].x = ALPHA * x.v[i].x + g.v[i].x * o.v[i].x; x.v[i].y = ALPHA * x.v[i].y + g.v[i].y * o.v[i].y; x.v[i].z = ALPHA * x.v[i].z + g.v[i].z * o.v[i].z; x.v[i].w = ALPHA * x.v[i].w + g.v[i].w * o.v[i].w; }
    row_ln(x);
    { const Row gg = row_load(lng, lane), bb = row_load(lnb, lane); row_fma(x, gg, bb); }
    row_store(res_row_w(x1l, x1c, b, j), lane, x);
    row_ln(x);
    { const Row sh = row_load(mrow + 3072, lane), sc = row_load(mrow + 4096, lane); row_modulate(x, sh, sc); }
    row_store(H + (size_t)j * D, lane, x);
    float lg[16];
#pragma unroll
    for (int e = 0; e < 16; ++e) lg[e] = 0.f;
#pragma unroll
    for (int i = 0; i < 4; ++i) {
        const float hv[4] = {x.v[i].x, x.v[i].y, x.v[i].z, x.v[i].w};
#pragma unroll
        for (int jj = 0; jj < 4; ++jj) {
            const float* wr = w_router + (size_t)(i * 256 + lane * 4 + jj) * 16;
#pragma unroll
            for (int q = 0; q < 4; ++q) { const float4 wv = *(const float4*)(wr + q * 4); lg[q * 4 + 0] += hv[jj] * wv.x; lg[q * 4 + 1] += hv[jj] * wv.y; lg[q * 4 + 2] += hv[jj] * wv.z; lg[q * 4 + 3] += hv[jj] * wv.w; }
        }
    }
    float sc[16], sel[16];
#pragma unroll
    for (int e = 0; e < 16; ++e) { const float t = wave_sum(lg[e]); sc[e] = 1.f / (1.f + expf(-t)); sel[e] = sc[e] + router_bias[e]; }
    float best = -INFINITY; int bg = 0;
#pragma unroll
    for (int gI = 0; gI < 4; ++gI) {
        const float a0 = sel[gI * 4 + 0], a1 = sel[gI * 4 + 1], a2 = sel[gI * 4 + 2], a3 = sel[gI * 4 + 3];
        const float mx = fmaxf(fmaxf(a0, a1), fmaxf(a2, a3));
        float sec;
        if (a0 == mx) sec = fmaxf(a1, fmaxf(a2, a3)); else if (a1 == mx) sec = fmaxf(a0, fmaxf(a2, a3)); else if (a2 == mx) sec = fmaxf(fmaxf(a0, a1), a3); else sec = fmaxf(fmaxf(a0, a1), a2);
        const float gs = mx + sec;
        if (gs > best) { best = gs; bg = gI; }
    }
    float a[4], s4[4];
#pragma unroll
    for (int q = 0; q < 4; ++q) { a[q] = 0.f; s4[q] = 0.f; }
#pragma unroll
    for (int gI = 0; gI < 4; ++gI)
#pragma unroll
        for (int q = 0; q < 4; ++q) if (bg == gI) { a[q] = sel[gI * 4 + q]; s4[q] = sc[gI * 4 + q]; }
    int i0 = 0; float v0 = a[0];
#pragma unroll
    for (int q = 1; q < 4; ++q) if (a[q] > v0) { v0 = a[q]; i0 = q; }
    int i1 = -1; float v1 = -INFINITY;
#pragma unroll
    for (int q = 0; q < 4; ++q) if (q != i0 && a[q] > v1) { v1 = a[q]; i1 = q; }
    float w0 = 0.f, w1 = 0.f;
#pragma unroll
    for (int q = 0; q < 4; ++q) { if (q == i0) w0 = s4[q]; if (q == i1) w1 = s4[q]; }
    const float inv = 1.f / (w0 + w1);
    if (lane == 0) SEL[j] = make_int4(bg * 4 + i0, bg * 4 + i1, __float_as_int(w0 * inv), __float_as_int(w1 * inv));
}

__global__ __launch_bounds__(256) void k_moe_naive(const float* __restrict__ H, const int4* SEL, const float* __restrict__ wg, const float* __restrict__ wu, const float* __restrict__ wd, float* Y, int l, int j0) {
    const int j = j0 + blockIdx.x, tid = threadIdx.x;
    __shared__ float hs[1024], as[512];
#pragma unroll
    for (int i = 0; i < 4; ++i) hs[tid + 256 * i] = H[(size_t)j * D + tid + 256 * i];
    const int4 sel = SEL[j];
    float y[4] = {0.f, 0.f, 0.f, 0.f};
    __syncthreads();
#pragma unroll
    for (int slot = 0; slot < 2; ++slot) {
        const int e = slot ? sel.y : sel.x; const float wgt = __int_as_float(slot ? sel.w : sel.z);
        const float* Wg = wg + ((size_t)(l * 16 + e) * 1024) * 512; const float* Wu = wu + ((size_t)(l * 16 + e) * 1024) * 512; const float* Wd = wd + ((size_t)(l * 16 + e) * 512) * 1024;
        float g0 = 0.f, g1 = 0.f, u0 = 0.f, u1 = 0.f;
        for (int k = 0; k < 1024; ++k) { const float hv = hs[k]; g0 += hv * Wg[(size_t)k * 512 + tid]; g1 += hv * Wg[(size_t)k * 512 + tid + 256]; u0 += hv * Wu[(size_t)k * 512 + tid]; u1 += hv * Wu[(size_t)k * 512 + tid + 256]; }
        as[tid] = g0 / (1.f + expf(-g0)) * u0; as[tid + 256] = g1 / (1.f + expf(-g1)) * u1;
        __syncthreads();
        float a0 = 0.f, a1 = 0.f, a2 = 0.f, a3 = 0.f;
        for (int k = 0; k < 512; ++k) { const float av = as[k]; const float* wr = Wd + (size_t)k * 1024 + tid; a0 += av * wr[0]; a1 += av * wr[256]; a2 += av * wr[512]; a3 += av * wr[768]; }
        y[0] += wgt * a0; y[1] += wgt * a1; y[2] += wgt * a2; y[3] += wgt * a3;
        __syncthreads();
    }
#pragma unroll
    for (int i = 0; i < 4; ++i) Y[(size_t)j * D + tid + 256 * i] = y[i];
}

__global__ __launch_bounds__(256) void k_post_ffn(const float* x1l, const float* x1c, const float* Y, const float* MODl, const float* lng, const float* lnb,
                                                  float* x2l, float* x2c, int b, int j0, int nrows) {
    const int lane = threadIdx.x & 63, w = blockIdx.x * 4 + (threadIdx.x >> 6);
    if (w >= nrows) return;
    const int j = j0 + w;
    const float* mrow = MODl + (size_t)(j < L ? 16 : b) * MODW;
    Row x = row_load(res_row(x1l, x1c, b, j), lane);
    const Row y = row_load(Y + (size_t)j * D, lane), g = row_load(mrow + 5120, lane);
#pragma unroll
    for (int i = 0; i < 4; ++i) { x.v[i].x = ALPHA * x.v[i].x + g.v[i].x * y.v[i].x; x.v[i].y = ALPHA * x.v[i].y + g.v[i].y * y.v[i].y; x.v[i].z = ALPHA * x.v[i].z + g.v[i].z * y.v[i].z; x.v[i].w = ALPHA * x.v[i].w + g.v[i].w * y.v[i].w; }
    row_ln(x);
    { const Row gg = row_load(lng, lane), bb = row_load(lnb, lane); row_fma(x, gg, bb); }
    row_store(res_row_w(x2l, x2c, b, j), lane, x);
}
}
#endif
#if MK_DEBUG
namespace dbg {
__device__ __forceinline__ void diag_acc(float* DIAG, int st, float md, float sq, float cnt, float mis) {
#pragma unroll
    for (int o = 32; o > 0; o >>= 1) { md = fmaxf(md, __shfl_xor(md, o)); sq += __shfl_xor(sq, o); cnt += __shfl_xor(cnt, o); mis += __shfl_xor(mis, o); }
    if ((threadIdx.x & 63) == 0) { atomicMax((unsigned*)&DIAG[st * 4 + 0], __float_as_uint(md)); atomicAdd(&DIAG[st * 4 + 1], sq); atomicAdd(&DIAG[st * 4 + 2], cnt); atomicAdd(&DIAG[st * 4 + 3], mis); }
}
__device__ __forceinline__ float adiff(float r, float n, float fl) { const float d = fabsf(r - n) / (fabsf(r) + fl); return (d == d) ? d : 1e30f; }
__device__ __forceinline__ float rms_of(const float* DIAG, int st) { return sqrtf(DIAG[st * 4 + 1] / fmaxf(DIAG[st * 4 + 2], 1.f)) + 1e-30f; }
__global__ void k_cmp_bf16(const float* ref, int ldr, const bf16_t* nw, int ldn, int rows, int cols, float refscale, float* DIAG, int st, int pass) {
    float md = 0.f, sq = 0.f, cnt = 0.f; const float fl = pass ? rms_of(DIAG, st) : 1.f;
    for (size_t i = (size_t)blockIdx.x * blockDim.x + threadIdx.x; i < (size_t)rows * cols; i += (size_t)gridDim.x * blockDim.x) { const int r = (int)(i / cols), c = (int)(i % cols);
        const float rv = ref[(size_t)r * ldr + c] * refscale, nv = bf2f(nw[(size_t)r * ldn + c]); if (pass) md = fmaxf(md, adiff(rv, nv, fl)); else { sq += rv * rv; cnt += 1.f; } }
    diag_acc(DIAG, st, md, sq, cnt, 0.f);
}
__global__ void k_cmp_bf16_sum2(const float* ref, int ldr, const bf16_t* n1, const bf16_t* n2, int ldn, int rows, int cols, float* DIAG, int st, int pass) {
    float md = 0.f, sq = 0.f, cnt = 0.f; const float fl = pass ? rms_of(DIAG, st) : 1.f;
    for (size_t i = (size_t)blockIdx.x * blockDim.x + threadIdx.x; i < (size_t)rows * cols; i += (size_t)gridDim.x * blockDim.x) { const int r = (int)(i / cols), c = (int)(i % cols);
        const float rv = ref[(size_t)r * ldr + c], nv = bf2f(n1[(size_t)r * ldn + c]) + bf2f(n2[(size_t)r * ldn + c]); if (pass) md = fmaxf(md, adiff(rv, nv, fl)); else { sq += rv * rv; cnt += 1.f; } }
    diag_acc(DIAG, st, md, sq, cnt, 0.f);
}
__global__ void k_cmp_f32(const float* ref, int ldr, const float* nw, int ldn, int rows, int cols, float* DIAG, int st, int pass) {
    float md = 0.f, sq = 0.f, cnt = 0.f; const float fl = pass ? rms_of(DIAG, st) : 1.f;
    for (size_t i = (size_t)blockIdx.x * blockDim.x + threadIdx.x; i < (size_t)rows * cols; i += (size_t)gridDim.x * blockDim.x) { const int r = (int)(i / cols), c = (int)(i % cols);
        const float rv = ref[(size_t)r * ldr + c], nv = nw[(size_t)r * ldn + c]; if (pass) md = fmaxf(md, adiff(rv, nv, fl)); else { sq += rv * rv; cnt += 1.f; } }
    diag_acc(DIAG, st, md, sq, cnt, 0.f);
}
__global__ void k_cmp_sel(const int4* ref, const int4* nw, int rows, float* DIAG, int st) {
    float mis = 0.f;
    for (int i = blockIdx.x * blockDim.x + threadIdx.x; i < rows; i += gridDim.x * blockDim.x) { const int4 a = ref[i], b = nw[i];
        if (a.x != b.x || a.y != b.y || fabsf(__int_as_float(a.z) - __int_as_float(b.z)) > 1e-3f || fabsf(__int_as_float(a.w) - __int_as_float(b.w)) > 1e-3f) mis += 1.f; }
    diag_acc(DIAG, st, 0.f, 0.f, 0.f, mis);
}
__global__ void k_cvt(const bf16_t* src, int lds_, float* dst, int ldd, int rows, int cols, float scale) {
    for (size_t i = (size_t)blockIdx.x * blockDim.x + threadIdx.x; i < (size_t)rows * cols; i += (size_t)gridDim.x * blockDim.x) { const int r = (int)(i / cols), c = (int)(i % cols);
        dst[(size_t)r * ldd + c] = bf2f(src[(size_t)r * lds_ + c]) * scale; }
}
__global__ void k_cvt_sum2(const bf16_t* s1, const bf16_t* s2, int lds_, float* dst, int ldd, int rows, int cols) {
    for (size_t i = (size_t)blockIdx.x * blockDim.x + threadIdx.x; i < (size_t)rows * cols; i += (size_t)gridDim.x * blockDim.x) { const int r = (int)(i / cols), c = (int)(i % cols);
        dst[(size_t)r * ldd + c] = bf2f(s1[(size_t)r * lds_ + c]) + bf2f(s2[(size_t)r * lds_ + c]); }
}
__device__ __forceinline__ float stage_tol(int s) {
    if (s == 1) return 1e-4f;
    const int k = (s - 2) % 9;
    return k == 0 ? 0.03f : k == 1 ? 0.05f : k == 2 ? 0.15f : k == 3 ? 0.06f : k == 4 ? 0.06f : k == 5 ? 2e-3f : k == 6 ? 0.03f : k == 7 ? 0.08f : 2e-3f;
}
__global__ void k_final(const float* DIAG, int nst, float* out, size_t n) {
    int bad = 0; float m = 0.f;
    for (int s = 1; s <= nst; ++s) {
        const float md = DIAG[s * 4 + 0], sq = DIAG[s * 4 + 1], cnt = DIAG[s * 4 + 2], mis = DIAG[s * 4 + 3];
        if (cnt <= 0.f && mis <= 0.f) continue;
        float err = cnt > 0.f ? md : 0.f; const float tol = stage_tol(s);
        if (mis > 8.f) err = fmaxf(err, tol * mis);
        if (!(err <= tol)) { bad = s; m = fminf(fmaxf(1.f + 3.f * log10f(err / tol), 1.f), 9.9f); break; }
    }
    if (!bad) return;
    const float cval = sqrtf(powf(10.f, (float)bad) * m);
    for (size_t i = (size_t)blockIdx.x * blockDim.x + threadIdx.x; i < n; i += (size_t)gridDim.x * blockDim.x) out[i] = cval;
}
}
#endif

extern "C" void kernel_launch(void* const* d_in, const int* in_sizes, int n_in, void* d_out, int out_size, void* d_ws, size_t ws_size, hipStream_t stream) {
    using namespace mk;
    static int ready = 0;
    if (!ready) {
        if (n_in != 20 || out_size != NB * S * D) { fprintf(stderr, "kernel_launch: unexpected problem shape\n"); ready = -1; return; }
        if (ws_size < WS_NEED) { fprintf(stderr, "kernel_launch: workspace too small: need %zu have %zu\n", (size_t)WS_NEED, ws_size); ready = -1; return; }
        if (hipFuncSetAttribute((const void*)mk_fwd, hipFuncAttributeMaxDynamicSharedMemorySize, LDS_BYTES) != hipSuccess) { fprintf(stderr, "kernel_launch: hipFuncSetAttribute failed\n"); ready = -1; return; }
        ready = 1;
    }
    if (ready < 0) return;
    Args a{};
    for (int i = 0; i < 20; ++i) a.in[i] = (const float*)d_in[i];
    a.out = (float*)d_out; a.ws = (unsigned char*)d_ws; a.pad = 0;
    (void)hipMemsetAsync(d_ws, 0, CTL_BYTES, stream);
    const int grid = 256;
#if !MK_DEBUG
#ifndef MK_CUTS
    a.ph_lo = 0; a.ph_hi = N_PHASES; a.li = 0;
    hipLaunchKernelGGL(mk_fwd, dim3(grid), dim3(512), LDS_BYTES, stream, a);
#else
    for (int p = 0; p < N_PHASES; ++p) { a.ph_lo = p; a.ph_hi = p + 1; a.li = 0; hipLaunchKernelGGL(mk_fwd, dim3(grid), dim3(512), LDS_BYTES, stream, a); }
#endif
#else
    unsigned char* ws = (unsigned char*)d_ws;
    size_t off = (WS_NEED + 255) & ~(size_t)255;
    auto take = [&](size_t nfloats) { float* p = (float*)(ws + off); off += ((nfloats * 4 + 255) & ~(size_t)255); return p; };
    float* DIAG = take(256);
    float* Hr = take((size_t)RB * D); float* Pr = take((size_t)RB * 2560); float* CCr = take((size_t)RB * D); float* Or = take((size_t)RB * D); float* Yr = take((size_t)RB * D);
    float* Z = take((size_t)2 * S * 256); float* F = take((size_t)S * 256); float* TABr = take((size_t)S * 2 * S); float* TABcr = take((size_t)L * 2 * L);
    float* MODr = take((size_t)2 * 17 * MODW); float* SILr = take(17 * 1024); float* LAMr = take(64); float* RCr = take(1024); float* RSr = take(1024); float* C64r = take(4096); float* S64r = take(4096);
    float* A_lat = take((size_t)S * D); float* A_ctx = take((size_t)L * D); float* B_lat = take((size_t)S * D); float* B_ctx = take((size_t)L * D); float* XS_lat = take((size_t)S * D); float* XS_ctx = take((size_t)L * D);
    int4* SELr = (int4*)take((size_t)RB * 4);
    if (off > ws_size) { fprintf(stderr, "kernel_launch(debug): workspace too small: need %zu have %zu\n", off, ws_size); return; }
    (void)hipMemsetAsync(DIAG, 0, 1024, stream);
    const float* x = a.in[I_X]; const float* ctx = a.in[I_CTX];
    bf16_t* Hn = (bf16_t*)(ws + OFF_ARENA + AR_H); bf16_t* QKVn = (bf16_t*)(ws + OFF_ARENA + AR_QKV); bf16_t* CCn = (bf16_t*)(ws + OFF_ARENA + AR_CC); bf16_t* On = (bf16_t*)(ws + OFF_ARENA + AR_O); bf16_t* Y2n = (bf16_t*)(ws + OFF_ARENA + AR_Y2);
    float* MODn = (float*)(ws + OFF_MOD); float* LAMn = (float*)(ws + OFF_LAM); float* RESCn = (float*)(ws + OFF_RESC); int4* SELn = (int4*)(ws + OFF_SELN);
    auto run = [&](int p) { a.ph_lo = p; a.ph_hi = p + 1; a.li = 0; hipLaunchKernelGGL(mk_fwd, dim3(grid), dim3(512), LDS_BYTES, stream, a); };
    const int CB = 1024;
    ref::k_prep_small<<<(17 * 1024 + 255) / 256, 256, 0, stream>>>(a.in[I_C], a.in[I_CCTX], a.in[I_LAMQK], SILr, LAMr, RCr, RSr, C64r, S64r);
    ref::k_prep_tab<<<(unsigned)(((size_t)S * 2 * S + 255) / 256), 256, 0, stream>>>(TABr, S);
    ref::k_prep_tab<<<(unsigned)(((size_t)L * 2 * L + 255) / 256), 256, 0, stream>>>(TABcr, L);
    ref::k_mod<<<dim3(MODW / 64, 2), 256, 0, stream>>>(SILr, a.in[I_WMOD], a.in[I_BMOD], MODr);
    run(0);
    dbg::k_cmp_f32<<<CB, 256, 0, stream>>>(MODr, MODW, MODn, MODW, 34, MODW, DIAG, 1, 0); dbg::k_cmp_f32<<<CB, 256, 0, stream>>>(MODr, MODW, MODn, MODW, 34, MODW, DIAG, 1, 1);
    dbg::k_cmp_f32<<<1, 64, 0, stream>>>(LAMr, 2, LAMn, 2, 1, 2, DIAG, 1, 0); dbg::k_cmp_f32<<<1, 64, 0, stream>>>(LAMr, 2, LAMn, 2, 1, 2, DIAG, 1, 1);
    run(1);
    int nst = 1;
#ifndef MK_DBG_PHASES
#define MK_DBG_PHASES 16
#endif
    for (int l = 0; l < 2; ++l) {
        const bool last = (l == 1); const int pb = 2 + 7 * l, sb = 2 + 9 * l, j0 = last ? L : 0, nr = RB - j0;
        if (pb >= MK_DBG_PHASES) break;
        const float* MODl = MODn + (size_t)l * 17 * MODW;
        const float* win = a.in[I_WIN] + (size_t)l * D * 2560; const float* wout = a.in[I_WOUT] + (size_t)l * D * D; const float* wf = a.in[I_WF] + (size_t)l * 4 * 64 * 64;
        const float omli = (float)(1.0 - (0.8 - 0.6 * exp(-0.3 * (double)l)));
        const float* xl = l == 0 ? x : a.out; const float* xc = l == 0 ? ctx : RESCn;
        ref::k_lnmod<<<RB / 4, 256, 0, stream>>>(xl, xc, MODl, Hr, 0, 0, RB);
        dbg::k_cmp_bf16<<<CB, 256, 0, stream>>>(Hr, D, Hn, D, RB, D, 1.f, DIAG, sb + 0, 0); dbg::k_cmp_bf16<<<CB, 256, 0, stream>>>(Hr, D, Hn, D, RB, D, 1.f, DIAG, sb + 0, 1); nst = sb + 0;
        run(pb + 0);
        dbg::k_cvt<<<CB, 256, 0, stream>>>(Hn, D, Hr, D, RB, D, 1.f);
        ref::k_gemm_f32<<<dim3(2560 / 64, RB / 64), 256, 0, stream>>>(Hr, D, win, 2560, Pr, 2560, D);
        ref::k_rope<<<(S * 2 * 12 * 2 * 16 + 255) / 256, 256, 0, stream>>>(Pr, RCr, RSr);
        dbg::k_cmp_bf16<<<CB, 256, 0, stream>>>(Pr + (size_t)j0 * 2560 + 256, 2560, QKVn + (size_t)j0 * QKVW, QKVW, nr, 768, QSCALE, DIAG, sb + 1, 0); dbg::k_cmp_bf16<<<CB, 256, 0, stream>>>(Pr + (size_t)j0 * 2560 + 256, 2560, QKVn + (size_t)j0 * QKVW, QKVW, nr, 768, QSCALE, DIAG, sb + 1, 1);
        dbg::k_cmp_bf16<<<CB, 256, 0, stream>>>(Pr + 1024, 2560, QKVn + 768, QKVW, RB, 1536, 1.f, DIAG, sb + 1, 0); dbg::k_cmp_bf16<<<CB, 256, 0, stream>>>(Pr + 1024, 2560, QKVn + 768, QKVW, RB, 1536, 1.f, DIAG, sb + 1, 1); nst = sb + 1;
        if (pb + 1 >= MK_DBG_PHASES) break;
        run(pb + 1);
        ref::k_fz<<<(2 * S * 256 + 255) / 256, 256, 0, stream>>>(Pr, C64r, S64r, Z, S, L);
        ref::k_gemm_f32<<<dim3(256 / 64, S / 64), 256, 0, stream>>>(TABr, 2 * S, Z, 256, F, 256, 2 * S);
        ref::k_fmap<<<(S * 256 + 255) / 256, 256, 0, stream>>>(F, wf, CCr, S, L, 1.0f / sqrtf((float)S * 64.f));
        if (!last) {
            ref::k_fz<<<(2 * L * 256 + 255) / 256, 256, 0, stream>>>(Pr, C64r, S64r, Z, L, 0);
            ref::k_gemm_f32<<<dim3(256 / 64, L / 64), 256, 0, stream>>>(TABcr, 2 * L, Z, 256, F, 256, 2 * L);
            ref::k_fmap<<<(L * 256 + 255) / 256, 256, 0, stream>>>(F, wf, CCr, L, 0, 1.0f / sqrtf((float)L * 64.f));
        }
        dbg::k_cmp_bf16_sum2<<<CB, 256, 0, stream>>>(CCr + (size_t)j0 * D, D, CCn + (size_t)j0 * CW, CCn + (size_t)j0 * CW + 256, CW, nr, 256, DIAG, sb + 2, 0); dbg::k_cmp_bf16_sum2<<<CB, 256, 0, stream>>>(CCr + (size_t)j0 * D, D, CCn + (size_t)j0 * CW, CCn + (size_t)j0 * CW + 256, CW, nr, 256, DIAG, sb + 2, 1); nst = sb + 2;
        dbg::k_cvt<<<CB, 256, 0, stream>>>(QKVn, QKVW, Pr + 256, 2560, RB, 768, 1.f / QSCALE);
        dbg::k_cvt<<<CB, 256, 0, stream>>>(QKVn + 768, QKVW, Pr + 1024, 2560, RB, 1536, 1.f);
        ref::k_attn_naive<<<dim3(nr, 6), 256, 0, stream>>>(Pr, CCr, LAMn, a.in[I_SUBLN], l, omli, j0);
        dbg::k_cmp_bf16<<<CB, 256, 0, stream>>>(CCr + (size_t)j0 * D + 256, D, CCn + (size_t)j0 * CW + 512, CW, nr, 768, 1.f, DIAG, sb + 3, 0); dbg::k_cmp_bf16<<<CB, 256, 0, stream>>>(CCr + (size_t)j0 * D + 256, D, CCn + (size_t)j0 * CW + 512, CW, nr, 768, 1.f, DIAG, sb + 3, 1); nst = sb + 3;
        if (pb + 2 >= MK_DBG_PHASES) break;
        run(pb + 2);
        dbg::k_cvt_sum2<<<CB, 256, 0, stream>>>(CCn, CCn + 256, CW, CCr, D, RB, 256);
        dbg::k_cvt<<<CB, 256, 0, stream>>>(CCn + 512, CW, CCr + 256, D, RB, 768, 1.f);
        ref::k_gemm_f32<<<dim3(D / 64, nr / 64), 256, 0, stream>>>(CCr + (size_t)j0 * D, D, wout, D, Or + (size_t)j0 * D, D, D);
        dbg::k_cmp_bf16<<<CB, 256, 0, stream>>>(Or + (size_t)j0 * D, D, On + (size_t)j0 * D, D, nr, D, 1.f, DIAG, sb + 4, 0); dbg::k_cmp_bf16<<<CB, 256, 0, stream>>>(Or + (size_t)j0 * D, D, On + (size_t)j0 * D, D, nr, D, 1.f, DIAG, sb + 4, 1); nst = sb + 4;
        if (pb + 3 >= MK_DBG_PHASES) break;
        dbg::k_cvt<<<CB, 256, 0, stream>>>(On, D, Or, D, RB, D, 1.f);
        if (last) { (void)hipMemcpyAsync(XS_lat, a.out, (size_t)S * D * 4, hipMemcpyDeviceToDevice, stream); (void)hipMemcpyAsync(XS_ctx, RESCn, (size_t)L * D * 4, hipMemcpyDeviceToDevice, stream); }
        run(pb + 3);
        ref::k_post_attn<<<nr / 4, 256, 0, stream>>>(last ? XS_lat : x, last ? XS_ctx : ctx, Or, MODl, a.in[I_LNAG] + l * D, a.in[I_LNAB] + l * D, A_lat, A_ctx, Hr, a.in[I_WR], a.in[I_RB], SELr, 0, j0, nr);
        dbg::k_cmp_f32<<<CB, 256, 0, stream>>>(A_lat, D, a.out, D, S, D, DIAG, sb + 5, 0); dbg::k_cmp_f32<<<CB, 256, 0, stream>>>(A_lat, D, a.out, D, S, D, DIAG, sb + 5, 1);
        if (!last) { dbg::k_cmp_f32<<<CB, 256, 0, stream>>>(A_ctx, D, RESCn, D, L, D, DIAG, sb + 5, 0); dbg::k_cmp_f32<<<CB, 256, 0, stream>>>(A_ctx, D, RESCn, D, L, D, DIAG, sb + 5, 1); }
        dbg::k_cmp_bf16<<<CB, 256, 0, stream>>>(Hr + (size_t)j0 * D, D, On + (size_t)j0 * D, D, nr, D, 1.f, DIAG, sb + 6, 0); dbg::k_cmp_bf16<<<CB, 256, 0, stream>>>(Hr + (size_t)j0 * D, D, On + (size_t)j0 * D, D, nr, D, 1.f, DIAG, sb + 6, 1);
        dbg::k_cmp_sel<<<16, 256, 0, stream>>>(SELr + j0, SELn + j0, nr, DIAG, sb + 6); nst = sb + 6;
        dbg::k_cvt<<<CB, 256, 0, stream>>>(On, D, Hr, D, RB, D, 1.f);
        if (pb + 5 >= MK_DBG_PHASES) break;
        run(pb + 4); run(pb + 5);
        ref::k_moe_naive<<<nr, 256, 0, stream>>>(Hr, SELn, a.in[I_WG], a.in[I_WUP], a.in[I_WDN], Yr, l, j0);
        dbg::k_cmp_bf16_sum2<<<CB, 256, 0, stream>>>(Yr + (size_t)j0 * D, D, Y2n + (size_t)(2 * j0) * D, Y2n + (size_t)(2 * j0 + 1) * D, 2 * D, nr, D, DIAG, sb + 7, 0); dbg::k_cmp_bf16_sum2<<<CB, 256, 0, stream>>>(Yr + (size_t)j0 * D, D, Y2n + (size_t)(2 * j0) * D, Y2n + (size_t)(2 * j0 + 1) * D, 2 * D, nr, D, DIAG, sb + 7, 1); nst = sb + 7;
        if (pb + 6 >= MK_DBG_PHASES) break;
        (void)hipMemcpyAsync(A_lat, a.out, (size_t)S * D * 4, hipMemcpyDeviceToDevice, stream); (void)hipMemcpyAsync(A_ctx, RESCn, (size_t)L * D * 4, hipMemcpyDeviceToDevice, stream);
        dbg::k_cvt_sum2<<<CB, 256, 0, stream>>>(Y2n, Y2n + D, 2 * D, Yr, D, RB, D);
        run(pb + 6);
        ref::k_post_ffn<<<nr / 4, 256, 0, stream>>>(A_lat, A_ctx, Yr, MODl, a.in[I_LNFG] + l * D, a.in[I_LNFB] + l * D, B_lat, B_ctx, 0, j0, nr);
        dbg::k_cmp_f32<<<CB, 256, 0, stream>>>(B_lat, D, a.out, D, S, D, DIAG, sb + 8, 0); dbg::k_cmp_f32<<<CB, 256, 0, stream>>>(B_lat, D, a.out, D, S, D, DIAG, sb + 8, 1);
        if (!last) { dbg::k_cmp_f32<<<CB, 256, 0, stream>>>(B_ctx, D, RESCn, D, L, D, DIAG, sb + 8, 0); dbg::k_cmp_f32<<<CB, 256, 0, stream>>>(B_ctx, D, RESCn, D, L, D, DIAG, sb + 8, 1); }
        nst = sb + 8;
    }
#if MK_DBG_PHASES < 16
    (void)hipMemsetAsync(d_out, 0, (size_t)out_size * 4, stream);
#endif
    dbg::k_final<<<1024, 256, 0, stream>>>(DIAG, nst, (float*)d_out, (size_t)out_size);
#endif
}
```

```cpp
#include <hip/hip_runtime.h>
#include <math.h>
#include <stdio.h>
#ifndef MK_DEBUG
#define MK_DEBUG 0
#endif
#undef MK_DEBUG
#define MK_DEBUG 0
typedef unsigned short bf16_t;
typedef short bf16x8 __attribute__((ext_vector_type(8)));
typedef short s16x4 __attribute__((ext_vector_type(4)));
typedef float f32x4 __attribute__((ext_vector_type(4)));
typedef float f32x16 __attribute__((ext_vector_type(16)));
typedef unsigned u32x4 __attribute__((ext_vector_type(4)));
typedef unsigned u32x2 __attribute__((ext_vector_type(2)));
typedef float f32x2_t __attribute__((ext_vector_type(2)));
typedef __bf16 bf16x2_t __attribute__((ext_vector_type(2)));
#define LAS __attribute__((address_space(3)))

__device__ __forceinline__ unsigned cvtpk(float lo, float hi) { f32x2_t v = {lo, hi}; bf16x2_t b = __builtin_convertvector(v, bf16x2_t); return __builtin_bit_cast(unsigned, b); }
__device__ __forceinline__ float bf_lo(unsigned w) { return __uint_as_float(w << 16); }
__device__ __forceinline__ float bf_hi(unsigned w) { return __uint_as_float(w & 0xffff0000u); }
__device__ __forceinline__ float bf2f(bf16_t b) { return __uint_as_float(((unsigned)b) << 16); }

#define XB_TMO      128
#define XB_XCNT(j)  (256  + 64 * (j))
#define XB_XSUB(j)  (1280 + 64 * (j))
#define XB_XGEN(j)  (2304 + 64 * (j))
#define XB_TOP      3328
#define XB_TOPGEN   3392
#define XCD_BAR_WORDS 3456
#define XB_SPIN_CAP (1u << 18)
__device__ __forceinline__ unsigned xb_ld(unsigned* p)              { return __hip_atomic_load(p, __ATOMIC_RELAXED, __HIP_MEMORY_SCOPE_AGENT); }
__device__ __forceinline__ unsigned xb_add(unsigned* p, unsigned v) { return __hip_atomic_fetch_add(p, v, __ATOMIC_RELAXED, __HIP_MEMORY_SCOPE_AGENT); }
__device__ __forceinline__ unsigned xb_xcc_id() { return (unsigned)__builtin_amdgcn_s_getreg((3 << 11) | 20) & 0xFu; }
#define XB_SPIN(cond, bar) do { unsigned _sp = 0; while (cond) { __builtin_amdgcn_s_sleep(1); \
    if ((++_sp & 255u) == 0u) { if (xb_ld(&(bar)[XB_TMO])) break; if (_sp > XB_SPIN_CAP) { atomicAdd(&(bar)[XB_TMO], 1u); break; } } } } while (0)
struct XcdBarrier { unsigned* bar; unsigned x; volatile LAS unsigned* st; };
__device__ __forceinline__ XcdBarrier xcd_barrier_post(unsigned* bar, volatile LAS unsigned* st) {
    XcdBarrier b; b.bar = bar; b.x = xb_xcc_id(); b.st = st;
    if (threadIdx.x == 0) (void)xb_add(&bar[XB_XCNT(b.x)], 1u);
    return b;
}
__device__ __forceinline__ void xcd_barrier_complete(unsigned* bar, unsigned x, unsigned& nloc, unsigned& nx) {
    const unsigned G = gridDim.x * gridDim.y * gridDim.z;
    unsigned sum, cnt, mine, sp = 0u;
    for (;;) {
        sum = 0u; cnt = 0u; mine = 0u;
#pragma unroll
        for (unsigned j = 0; j < 16; ++j) { const unsigned c = xb_ld(&bar[XB_XCNT(j)]); sum += c; cnt += (c > 0u) ? 1u : 0u; mine = (j == x) ? c : mine; }
        if (sum == G) break;
        __builtin_amdgcn_s_sleep(1);
        if ((++sp & 255u) == 0u) { if (xb_ld(&bar[XB_TMO])) break; if (sp > XB_SPIN_CAP) { atomicAdd(&bar[XB_TMO], 1u); break; } }
    }
    nloc = mine > 0u ? mine : 1u; nx = cnt > 0u ? cnt : 1u;
}
__device__ __forceinline__ void xcd_barrier(const XcdBarrier& b, unsigned long long* stamp = nullptr) {
    asm volatile("s_waitcnt vmcnt(0)" ::: "memory");
    __syncthreads();
    if (threadIdx.x == 0) {
        unsigned* bar = b.bar;
        __builtin_amdgcn_s_waitcnt(0);
        unsigned nloc = b.st[0], nx = b.st[1];
        if (nloc == 0u) { xcd_barrier_complete(bar, b.x, nloc, nx); b.st[0] = nloc; b.st[1] = nx; }
        const unsigned old = xb_add(&bar[XB_XSUB(b.x)], 1u);
        const unsigned gen = old / nloc;
        if (old + 1u == (gen + 1u) * nloc) {
            __builtin_amdgcn_fence(__ATOMIC_RELEASE, "agent");
            asm volatile("s_waitcnt vmcnt(0)" ::: "memory");
            const unsigned og = xb_add(&bar[XB_TOP], 1u);
            const unsigned tg = og / nx;
            if (og + 1u == (tg + 1u) * nx) xb_add(&bar[XB_TOPGEN], 1u);
            else XB_SPIN(xb_ld(&bar[XB_TOPGEN]) == tg, bar);
            __builtin_amdgcn_fence(__ATOMIC_ACQUIRE, "agent");
            xb_add(&bar[XB_XGEN(b.x)], 1u);
            asm volatile("s_waitcnt vmcnt(0)" ::: "memory");
        } else {
            XB_SPIN(xb_ld(&bar[XB_XGEN(b.x)]) == gen, bar);
            __builtin_amdgcn_fence(__ATOMIC_ACQUIRE, "agent");
            asm volatile("s_waitcnt vmcnt(0)" ::: "memory");
        }
        if (stamp) *stamp = wall_clock64();
    }
    __syncthreads();
}

namespace g8 {
constexpr int BM = 256, BK = 64, HALF = 128, HTB = HALF * BK * 2, STAGE_BYTES = 8 * HTB;
__device__ __forceinline__ int lds_byte(int r, int c) { const int st = (r >> 4) * 2 + (c >> 5), rr = r & 15, cc = c & 31, ob = rr * 64 + cc * 2; return st * 1024 + (ob ^ (((ob >> 9) & 1) << 5)); }
__device__ __forceinline__ void stage_rc(int b, int& R, int& C) { const int st = b / 1024, sb = b % 1024, swz = sb ^ (((sb >> 9) & 1) << 5); R = (st >> 1) * 16 + swz / 64; C = (st & 1) * 32 + (swz % 64) / 2; }
__device__ __forceinline__ int perm32(int rho) { const int n = rho >> 4, i = rho & 15; return 8 * (i >> 2) + 4 * n + (i & 3); }

struct Unit { const char* A; const char* B; const int* gl; int gcount; int kind, p0, p1; };

template <bool GATHER, class Epi, class Sched>
__device__ __forceinline__ void gemm_phase(LAS unsigned char* lds, const int K, const unsigned lda2, const unsigned ldb2, const Sched& S, const Epi& E) {
    int tid = threadIdx.x; asm volatile("" : "+v"(tid));
    const int wid = __builtin_amdgcn_readfirstlane(tid >> 6), lane = tid & 63, wr = wid >> 2, wc = wid & 3, fr = lane & 15, fq = lane >> 4;
    const int nt = K / BK;
    int Rr[2], Cc[2];
    unsigned vB[2];
#pragma unroll
    for (int i = 0; i < 2; ++i) { stage_rc(tid * 16 + i * 8192, Rr[i], Cc[i]); const int Rb = (Rr[i] & ~31) + perm32(Rr[i] & 31); vB[i] = (unsigned)Rb * ldb2 + (unsigned)Cc[i] * 2u; }
    const unsigned hB = (unsigned)HALF * ldb2, hA = (unsigned)HALF * lda2;
    const size_t kstep = (size_t)(BK * 2);
    const unsigned ldsw = (unsigned)wid * 1024u;
    const int aoff = lds_byte(wr * 64 + fr, fq * 8), boff = lds_byte(wc * 32 + fr, fq * 8);
    Unit cur, nxt; int ui = 0;
    if (!S.next(0, cur)) return;
    unsigned vA[2][2], nvA[2][2];
#define G8_CALCVA(u, v) do { _Pragma("unroll") for (int _h = 0; _h < 2; ++_h) _Pragma("unroll") for (int _i = 0; _i < 2; ++_i) { const int _r = _h * HALF + Rr[_i]; \
        if (GATHER) { const int _tok = (_r < (u).gcount) ? ((u).gl[_r] >> 1) : 256;     v[_h][_i] = (unsigned)_tok * lda2 + (unsigned)Cc[_i] * 2u; } \
        else v[_h][_i] = (unsigned)_r * lda2 + (unsigned)Cc[_i] * 2u; } } while (0)
    G8_CALCVA(cur, vA);
#define G8_SA(b, h) (((b) * 2 + (h)) * HTB)
#define G8_SB(b, h) ((4 + (b) * 2 + (h)) * HTB)
#define G8_STAGE_A(bufoff, gbase, VV, hh) do { _Pragma("unroll") for (int _i = 0; _i < 2; ++_i) \
        __builtin_amdgcn_global_load_lds((const unsigned*)(((const char*)(gbase) + (GATHER ? (size_t)0 : (size_t)((hh) * hA))) + VV[GATHER ? (hh) : 0][_i]), (LAS unsigned*)(lds + (bufoff) + ldsw + _i * 8192), 16, 0, 0); } while (0)
#define G8_STAGE_B(bufoff, gbase, h) do { _Pragma("unroll") for (int _i = 0; _i < 2; ++_i) \
        __builtin_amdgcn_global_load_lds((const unsigned*)((const char*)(gbase) + (size_t)((h) * hB) + vB[_i]), (LAS unsigned*)(lds + (bufoff) + ldsw + _i * 8192), 16, 0, 0); } while (0)
#define G8_LDA(dst, b, h) do { _Pragma("unroll") for (int m = 0; m < 4; ++m) _Pragma("unroll") for (int k = 0; k < 2; ++k) dst[m][k] = *(const LAS bf16x8*)(lds + G8_SA(b, h) + aoff + m * 2048 + k * 1024); } while (0)
#define G8_LDB(dst, b, h) do { _Pragma("unroll") for (int n = 0; n < 2; ++n) _Pragma("unroll") for (int k = 0; k < 2; ++k) dst[n][k] = *(const LAS bf16x8*)(lds + G8_SB(b, h) + boff + n * 2048 + k * 1024); } while (0)
#define G8_MMA(ai, bj, At, Bt) do { __builtin_amdgcn_s_setprio(1); _Pragma("unroll") for (int m = 0; m < 4; ++m) _Pragma("unroll") for (int n = 0; n < 2; ++n) _Pragma("unroll") for (int k = 0; k < 2; ++k) \
        acc[ai][bj][m][n] = __builtin_amdgcn_mfma_f32_16x16x32_bf16(Bt[n][k], At[m][k], acc[ai][bj][m][n], 0, 0, 0); __builtin_amdgcn_s_setprio(0); } while (0)
#define G8_WAIT_V(n) asm volatile("s_waitcnt vmcnt(" #n ")" ::: "memory")
#define G8_WAIT_L(n) asm volatile("s_waitcnt lgkmcnt(" #n ")" ::: "memory")
#define G8_BAR __builtin_amdgcn_s_barrier()
#define G8_SCHED __builtin_amdgcn_sched_barrier(0)
    f32x4 acc[2][2][4][2];
#pragma unroll
    for (int a = 0; a < 2; ++a)
#pragma unroll
        for (int b = 0; b < 2; ++b)
#pragma unroll
            for (int m = 0; m < 4; ++m)
#pragma unroll
                for (int n = 0; n < 2; ++n) acc[a][b][m][n] = (f32x4){0.f, 0.f, 0.f, 0.f};
    bf16x8 At[4][2], B0[2][2], B1[2][2];
    const char* cA = cur.A; const char* cB = cur.B;
    G8_STAGE_B(G8_SB(0, 0), cB, 0); G8_STAGE_B(G8_SB(0, 1), cB, 1); G8_STAGE_A(G8_SA(0, 0), cA, vA, 0); G8_STAGE_A(G8_SA(0, 1), cA, vA, 1);
    if (wr == 1) G8_BAR;
    G8_WAIT_V(2); G8_BAR;
    G8_STAGE_B(G8_SB(1, 0), cB + kstep, 0); G8_STAGE_A(G8_SA(1, 0), cA + kstep, vA, 0); G8_STAGE_B(G8_SB(1, 1), cB + kstep, 1);
    G8_WAIT_V(6); G8_BAR;
    for (;;) {
        const bool has_next = S.next(ui + 1, nxt);
        const char* nA = has_next ? nxt.A : cA; const char* nB = has_next ? nxt.B : cB;
        if (GATHER && has_next) { G8_CALCVA(nxt, nvA); } else {
#pragma unroll
            for (int h = 0; h < 2; ++h)
#pragma unroll
                for (int i = 0; i < 2; ++i) nvA[h][i] = vA[h][i]; }
#pragma clang loop unroll(disable)
        for (int t = 0; t < nt; t += 2) {
            const bool last = (t == nt - 2);
            const char* a1 = cA + (size_t)(t + 1) * kstep;
            const char* a2 = last ? nA : cA + (size_t)(t + 2) * kstep; const char* b2 = last ? nB : cB + (size_t)(t + 2) * kstep;
            const char* a3 = a2 + kstep; const char* b3 = b2 + kstep;
            unsigned o2[2][2];
#pragma unroll
            for (int h = 0; h < 2; ++h)
#pragma unroll
                for (int i = 0; i < 2; ++i) o2[h][i] = (GATHER && last) ? nvA[h][i] : vA[h][i];
            G8_LDB(B0, 0, 0); G8_LDB(B1, 0, 1); G8_SCHED; G8_LDA(At, 0, 0); G8_STAGE_A(G8_SA(1, 1), a1, vA, 1);
            G8_WAIT_V(8); G8_WAIT_L(0); G8_BAR; G8_MMA(0, 0, At, B0); G8_MMA(0, 1, At, B1); G8_BAR; G8_SCHED;
            G8_LDA(At, 0, 1); G8_STAGE_B(G8_SB(0, 0), b2, 0); G8_STAGE_B(G8_SB(0, 1), b2, 1); G8_STAGE_A(G8_SA(0, 0), a2, o2, 0);
            G8_WAIT_V(8); G8_WAIT_L(0); G8_BAR; G8_MMA(1, 0, At, B0); G8_MMA(1, 1, At, B1); G8_BAR; G8_SCHED;
            G8_LDB(B0, 1, 0); G8_LDB(B1, 1, 1); G8_SCHED; G8_LDA(At, 1, 0); G8_STAGE_A(G8_SA(0, 1), a2, o2, 1);
            G8_WAIT_V(8); G8_WAIT_L(0); G8_BAR; G8_MMA(0, 0, At, B0); G8_MMA(0, 1, At, B1); G8_BAR; G8_SCHED;
            G8_LDA(At, 1, 1); G8_STAGE_B(G8_SB(1, 0), b3, 0); G8_STAGE_B(G8_SB(1, 1), b3, 1); G8_STAGE_A(G8_SA(1, 0), a3, o2, 0);
            G8_WAIT_V(8); G8_WAIT_L(0); G8_BAR; G8_MMA(1, 0, At, B0); G8_MMA(1, 1, At, B1); G8_BAR; G8_SCHED;
        }
        if (wr == 0) G8_BAR;
        E(acc, cur, wr, wc, fr, fq);
        if (!has_next) break;
#pragma unroll
        for (int a = 0; a < 2; ++a)
#pragma unroll
            for (int b = 0; b < 2; ++b)
#pragma unroll
                for (int m = 0; m < 4; ++m)
#pragma unroll
                    for (int n = 0; n < 2; ++n) acc[a][b][m][n] = (f32x4){0.f, 0.f, 0.f, 0.f};
        cur = nxt; cA = nA; cB = nB; ++ui;
#pragma unroll
        for (int h = 0; h < 2; ++h)
#pragma unroll
            for (int i = 0; i < 2; ++i) vA[h][i] = nvA[h][i];
        if (wr == 1) G8_BAR;
    }
    G8_WAIT_V(0);
    G8_BAR;
#undef G8_CALCVA
#undef G8_SA
#undef G8_SB
#undef G8_STAGE_A
#undef G8_STAGE_B
#undef G8_LDA
#undef G8_LDB
#undef G8_MMA
#undef G8_WAIT_V
#undef G8_WAIT_L
#undef G8_BAR
#undef G8_SCHED
}
}
namespace mk {
constexpr int NB = 16, S = 2048, L = 256, D = 1024, RB = L + S, NTOK = NB * RB;
constexpr int QKVW = 2304, CW = 1280, MODW = 6 * D, CAP = NTOK, NPAIR = 2 * NTOK, SORT_ROWS = NPAIR + 16 * 256;
constexpr float ALPHA = 1.41421356237309515f, EPS = 1e-5f, QSCALE = 0.125f * 1.4426950408889634f;
constexpr size_t al256(size_t x) { return (x + 255) & ~(size_t)255; }
constexpr size_t CTL_BYTES = 65536, CTL_BAR_STRIDE = 13824  , CTL_CNT = 57344  ;
constexpr size_t OFF_MOD = CTL_BYTES, SZ_MOD = (size_t)2 * 17 * MODW * 4;
constexpr size_t OFF_LAM = OFF_MOD + al256(SZ_MOD);
constexpr size_t OFF_RC = OFF_LAM + 256, OFF_RS = OFF_RC + 4096;
constexpr size_t OFF_MH = OFF_RS + 4096, SZ_MH = (size_t)2 * 2 * 4 * 64 * 64 * 4;
constexpr size_t OFF_TABL = OFF_MH + SZ_MH, SZ_TABL = (size_t)2 * S * S * 2;
constexpr size_t OFF_TABC = OFF_TABL + SZ_TABL, SZ_TABC = (size_t)2 * L * L * 2;
constexpr size_t OFF_WQKV = OFF_TABC + SZ_TABC, SZ_WQKV = (size_t)2 * QKVW * D * 2;
constexpr size_t OFF_WU = OFF_WQKV + SZ_WQKV, SZ_WU = (size_t)2 * 512 * D * 2;
constexpr size_t OFF_WOUT = OFF_WU + SZ_WU, SZ_WOUT = (size_t)2 * D * CW * 2;
constexpr size_t OFF_LIST = OFF_WOUT + SZ_WOUT, SZ_LIST = (size_t)16 * CAP * 4;
constexpr size_t OFF_WPAIR = OFF_LIST + SZ_LIST, SZ_WPAIR = (size_t)16 * CAP * 4;
constexpr size_t OFF_SELN = OFF_WPAIR + SZ_WPAIR, SZ_SELN = (size_t)NTOK * 16;
constexpr size_t OFF_RES = OFF_SELN + SZ_SELN, SZ_RES = (size_t)NTOK * D * 2;
constexpr size_t OFF_ARENA = OFF_RES + SZ_RES;
constexpr size_t SZ_H = (size_t)NTOK * D * 2, SZ_CC = (size_t)NTOK * CW * 2, SZ_QKV = (size_t)NTOK * QKVW * 2, SZ_UTL = (size_t)NB * 2 * 256 * S * 2, SZ_UTC = (size_t)NB * 2 * 256 * L * 2;
constexpr size_t SZ_ASORT = (size_t)SORT_ROWS * 512 * 2, SZ_Y2 = (size_t)NPAIR * D * 2, SZ_WGU = (size_t)16 * 1024 * 1024 * 2, SZ_WD = (size_t)16 * 1024 * 512 * 2;
constexpr size_t AR_H = 0, AR_CC = 0, AR_QKV = SZ_CC, AR_UTL = AR_QKV + SZ_QKV, AR_UTC = AR_UTL + SZ_UTL, AR_O = SZ_CC, AR_ASORT = 0, AR_Y2 = SZ_ASORT, AR_WGU = AR_Y2 + SZ_Y2, AR_WD = AR_WGU + SZ_WGU;
constexpr size_t SZ_ARENA = (AR_UTC + SZ_UTC) > (AR_WD + SZ_WD) ? (AR_UTC + SZ_UTC) : (AR_WD + SZ_WD);
constexpr size_t WS_NEED = OFF_ARENA + SZ_ARENA;
static_assert(AR_ASORT + SZ_ASORT <= AR_O, "ASORT must not overlap O/H2");
static_assert(AR_WGU >= AR_O + SZ_H, "MoE weights must not overlap O/H2");
static_assert(AR_H + SZ_H <= AR_Y2, "next layer's H must not overlap Y2");
constexpr int LDS_MISC = 131072, LDS_ROPE = LDS_MISC + 4096  , LDS_BYTES = LDS_ROPE + 8192;

struct Args {
    const float* in[20]; float* out; unsigned char* ws; int ph_lo, ph_hi, li, rep_attn; int rep[16]; int attn_var, pad2;
};
enum { I_X = 0, I_C, I_CTX, I_CCTX, I_WMOD, I_BMOD, I_WIN, I_WF, I_LAMQK, I_SUBLN, I_WOUT, I_LNAG, I_LNAB, I_LNFG, I_LNFB, I_WR, I_RB, I_WG, I_WUP, I_WDN };

template <class T> __device__ __forceinline__ T* wsp(const Args& a, size_t off) { return (T*)(a.ws + off); }

__device__ __forceinline__ float wave_sum(float v) {
    v += __builtin_bit_cast(float, __builtin_amdgcn_update_dpp(0, __builtin_bit_cast(int, v), 0xB1, 0xF, 0xF, true));
    v += __builtin_bit_cast(float, __builtin_amdgcn_update_dpp(0, __builtin_bit_cast(int, v), 0x4E, 0xF, 0xF, true));
    v += __builtin_bit_cast(float, __builtin_amdgcn_update_dpp(0, __builtin_bit_cast(int, v), 0x124, 0xF, 0xF, true));
    v += __builtin_bit_cast(float, __builtin_amdgcn_update_dpp(0, __builtin_bit_cast(int, v), 0x128, 0xF, 0xF, true));
    const int vi = __builtin_bit_cast(int, v);
    return (__builtin_bit_cast(float, __builtin_amdgcn_readlane(vi, 0)) + __builtin_bit_cast(float, __builtin_amdgcn_readlane(vi, 16))) +
           (__builtin_bit_cast(float, __builtin_amdgcn_readlane(vi, 32)) + __builtin_bit_cast(float, __builtin_amdgcn_readlane(vi, 48)));
}
struct Row { f32x4 v[4]; };
__device__ __forceinline__ Row row_load(const float* p, int lane) { Row r;
#pragma unroll
    for (int i = 0; i < 4; ++i) r.v[i] = *(const f32x4*)(p + i * 256 + lane * 4);
    return r; }
__device__ __forceinline__ void row_store(float* p, int lane, const Row& r) {
#pragma unroll
    for (int i = 0; i < 4; ++i) *(f32x4*)(p + i * 256 + lane * 4) = r.v[i]; }
__device__ __forceinline__ Row row_load_bf16(const bf16_t* p, int lane) { Row r;
#pragma unroll
    for (int i = 0; i < 4; ++i) { const u32x2 w = *(const u32x2*)(p + i * 256 + lane * 4); r.v[i] = (f32x4){bf_lo(w.x), bf_hi(w.x), bf_lo(w.y), bf_hi(w.y)}; }
    return r; }
struct RowB { u32x2 w[4]; };
__device__ __forceinline__ RowB rowb_load(const bf16_t* p, int lane) { RowB r;
#pragma unroll
    for (int i = 0; i < 4; ++i) r.w[i] = *(const u32x2*)(p + i * 256 + lane * 4);
    return r; }
__device__ __forceinline__ Row rowb_f32(const RowB& b) { Row r;
#pragma unroll
    for (int i = 0; i < 4; ++i) r.v[i] = (f32x4){bf_lo(b.w[i].x), bf_hi(b.w[i].x), bf_lo(b.w[i].y), bf_hi(b.w[i].y)};
    return r; }
__device__ __forceinline__ void row_store_bf16(bf16_t* p, int lane, const Row& r) {
#pragma unroll
    for (int i = 0; i < 4; ++i) { u32x2 w; w.x = cvtpk(r.v[i][0], r.v[i][1]); w.y = cvtpk(r.v[i][2], r.v[i][3]); *(u32x2*)(p + i * 256 + lane * 4) = w; } }
__device__ __forceinline__ void row_ln(Row& r) {
    float s = 0.f;
#pragma unroll
    for (int i = 0; i < 4; ++i) s += (r.v[i][0] + r.v[i][1]) + (r.v[i][2] + r.v[i][3]);
    const float mean = wave_sum(s) * (1.f / 1024.f);
    float q = 0.f;
#pragma unroll
    for (int i = 0; i < 4; ++i) { r.v[i] = r.v[i] - mean; q += (r.v[i][0] * r.v[i][0] + r.v[i][1] * r.v[i][1]) + (r.v[i][2] * r.v[i][2] + r.v[i][3] * r.v[i][3]); }
    const float rstd = rsqrtf(wave_sum(q) * (1.f / 1024.f) + EPS);
#pragma unroll
    for (int i = 0; i < 4; ++i) r.v[i] = r.v[i] * rstd;
}
__device__ __forceinline__ bf16_t* res_ptr(const Args& a, int row) { return wsp<bf16_t>(a, OFF_RES) + (size_t)row * D; }
__device__ __forceinline__ float* out_ptr(const Args& a, int row) { const int b = row / RB, j = row - b * RB; return a.out + ((size_t)b * S + (j - L)) * D; }
__device__ __forceinline__ const float* xin_ptr(const Args& a, int row) { const int b = row / RB, j = row - b * RB; return j < L ? a.in[I_CTX] + ((size_t)b * L + j) * D : a.in[I_X] + ((size_t)b * S + (j - L)) * D; }
__device__ __forceinline__ int thin_row(int i, bool last) { return last ? ((i >> 11) * RB + L + (i & 2047)) : i; }

__device__ __forceinline__ void tr_item(const float* __restrict__ src, size_t ld_src, bf16_t* __restrict__ dst, size_t ld_dst, int lane) {
    float v[64];
#pragma unroll
    for (int r = 0; r < 64; ++r) v[r] = src[(size_t)r * ld_src + lane];
    bf16_t* d = dst + (size_t)lane * ld_dst;
#pragma unroll
    for (int q = 0; q < 8; ++q) { u32x4 w; w.x = cvtpk(v[q * 8 + 0], v[q * 8 + 1]); w.y = cvtpk(v[q * 8 + 2], v[q * 8 + 3]); w.z = cvtpk(v[q * 8 + 4], v[q * 8 + 5]); w.w = cvtpk(v[q * 8 + 6], v[q * 8 + 7]); *(u32x4*)(d + q * 8) = w; }
}

__device__ __forceinline__ void phase0a(const Args& a, LAS unsigned char* lds) {
    int tid = threadIdx.x; asm volatile("" : "+v"(tid));
    const int lane = tid & 63, wid = __builtin_amdgcn_readfirstlane(tid >> 6), blk = blockIdx.x, G = gridDim.x, gw = blk * 8 + wid, nw = G * 8, gt = blk * 512 + tid, ntr = G * 512;
    if (blk < 192) {
        LAS float* SIL = (LAS float*)lds; LAS float* red = (LAS float*)(lds + 69632);
        for (int i = tid; i < 17 * 1024; i += 512) { const float x = i < 16 * 1024 ? a.in[I_C][i] : a.in[I_CCTX][i - 16 * 1024]; SIL[i] = x / (1.f + __expf(-x)); }
        __syncthreads();
        for (int item = blk; item < 192; item += G) {
            const int l = item / 96, cg = item - l * 96, n = cg * 64 + lane;
            float acc[17];
#pragma unroll
            for (int r = 0; r < 17; ++r) acc[r] = 0.f;
            const float* w = a.in[I_WMOD] + (size_t)l * D * MODW;
            float wn[8];
#pragma unroll
            for (int q = 0; q < 8; ++q) wn[q] = (w + (size_t)(wid * 128 + q) * MODW)[n];
            for (int k0 = wid * 128; k0 < wid * 128 + 128; k0 += 8) {
                float wv[8];
#pragma unroll
                for (int q = 0; q < 8; ++q) wv[q] = wn[q];
                if (k0 + 8 < wid * 128 + 128) {
#pragma unroll
                    for (int q = 0; q < 8; ++q) wn[q] = (w + (size_t)(k0 + 8 + q) * MODW)[n]; }
#pragma unroll
                for (int r = 0; r < 17; ++r) { const f32x4 s0 = *(const LAS f32x4*)(SIL + r * 1024 + k0), s1 = *(const LAS f32x4*)(SIL + r * 1024 + k0 + 4);
                    acc[r] += ((s0[0] * wv[0] + s0[1] * wv[1]) + (s0[2] * wv[2] + s0[3] * wv[3])) + ((s1[0] * wv[4] + s1[1] * wv[5]) + (s1[2] * wv[6] + s1[3] * wv[7])); }
            }
#pragma unroll
            for (int r = 0; r < 17; ++r) red[(wid * 17 + r) * 64 + lane] = acc[r];
            __syncthreads();
            if (wid == 0) {
#pragma unroll
                for (int r = 0; r < 17; ++r) { float s = a.in[I_BMOD][(size_t)l * MODW + n];
#pragma unroll
                    for (int q = 0; q < 8; ++q) s += red[(q * 17 + r) * 64 + lane];
                    wsp<float>(a, OFF_MOD)[((size_t)l * 17 + r) * MODW + n] = s; }
            }
            __syncthreads();
        }
    }
    for (int it = gw; it < 1152 + 128 + 384; it += nw) {
        if (it < 1152) { const int l = it / 576, r = it - l * 576, kb = r / 36, nb = r - kb * 36;
            tr_item(a.in[I_WIN] + (size_t)l * D * 2560 + (size_t)(kb * 64) * 2560 + 256 + nb * 64, 2560, wsp<bf16_t>(a, OFF_WQKV) + ((size_t)l * QKVW + nb * 64) * D + kb * 64, D, lane);
        } else if (it < 1152 + 128) { const int q = it - 1152, l = q >> 6, r = q & 63, kb = r >> 2, nb = r & 3;
            tr_item(a.in[I_WIN] + (size_t)l * D * 2560 + (size_t)(kb * 64) * 2560 + nb * 64, 2560, wsp<bf16_t>(a, OFF_WU) + ((size_t)l * 256 + nb * 64) * D + kb * 64, D, lane);
        } else { const int q = it - 1280, l = q / 192, r = q - l * 192, kb = 4 + (r >> 4), nb = r & 15;
            const float* src = a.in[I_WOUT] + (size_t)l * D * D + (size_t)(kb * 64) * D + nb * 64;
            bf16_t* dst = wsp<bf16_t>(a, OFF_WOUT) + ((size_t)l * D + nb * 64) * CW;
            tr_item(src, D, dst + kb * 64 + 256, CW, lane);
        }
    }
    {
        const float nl = 0.0027621358640099515f  , nc = 0.0078125f  ;
        bf16_t* TL = wsp<bf16_t>(a, OFF_TABL); bf16_t* TC = wsp<bf16_t>(a, OFF_TABC);
        for (int it = gt; it < S * (S / 8) + L * (L / 8); it += ntr) {
            int T, tp, t0; float nn; bf16_t* base;
            if (it < S * (S / 8)) { T = S; tp = it / (S / 8); t0 = (it - tp * (S / 8)) * 8; nn = nl; base = TL; }
            else { const int q = it - S * (S / 8); T = L; tp = q / (L / 8); t0 = (q - tp * (L / 8)) * 8; nn = nc; base = TC; }
            float cv[8], sv[8];
#pragma unroll
            for (int j = 0; j < 8; ++j) { const int m = ((t0 + j) * tp) & (T - 1); const float x = 2.f * (float)m / (float)T; cv[j] = cospif(x) * nn; sv[j] = -sinpif(x) * nn; }
            u32x4 wc, wsn; wc.x = cvtpk(cv[0], cv[1]); wc.y = cvtpk(cv[2], cv[3]); wc.z = cvtpk(cv[4], cv[5]); wc.w = cvtpk(cv[6], cv[7]);
            wsn.x = cvtpk(sv[0], sv[1]); wsn.y = cvtpk(sv[2], sv[3]); wsn.z = cvtpk(sv[4], sv[5]); wsn.w = cvtpk(sv[6], sv[7]);
            *(u32x4*)(base + (size_t)tp * T + t0) = wc; *(u32x4*)(base + (size_t)T * T + (size_t)tp * T + t0) = wsn;
        }
    }
    for (int i = gt; i < 65536 + 1024 + 2; i += ntr) {
        if (i < 65536) { const int d = i & 63, c = (i >> 6) & 63, g = (i >> 12) & 3, half = (i >> 14) & 1, l = i >> 15;
            const float* wf = a.in[I_WF] + ((size_t)(l * 4 + g) * 64) * 64 + d; float s = 0.f;
            for (int cp = 0; cp < 64; ++cp) { const int m = (c * cp) & 63; const float x = (float)m * (1.f / 32.f); s += (half ? sinpif(x) : cospif(x)) * wf[cp * 64]; }
            wsp<float>(a, OFF_MH)[i] = s;
        } else if (i < 65536 + 1024) { const int q = i - 65536, pos = q >> 4, f = q & 15; const float ang = (float)pos * powf(10000.f, -(float)f / 16.f);
            wsp<float>(a, OFF_RC)[q] = cosf(ang); wsp<float>(a, OFF_RS)[q] = sinf(ang);
        } else { const int l = i - 65536 - 1024; const float* q = a.in[I_LAMQK] + l * 256; float s1 = 0.f, s2 = 0.f;
            for (int k = 0; k < 64; ++k) { s1 += q[k] * q[64 + k]; s2 += q[128 + k] * q[192 + k]; }
            wsp<float>(a, OFF_LAM)[l] = expf(s1) - expf(s2) + (0.8f - 0.6f * expf(-0.3f * (float)l)); }
    }
}

__device__ __forceinline__ void h_from_row(const Args& a, Row& r, int row, int l, int sh_off, int sc_off, int lane) {
    row_ln(r);
    const int b = row / RB, j = row - b * RB;
    const float* mrow = wsp<float>(a, OFF_MOD) + ((size_t)l * 17 + (j < L ? 16 : b)) * MODW;
    const Row sh = row_load(mrow + sh_off, lane), sc = row_load(mrow + sc_off, lane);
#pragma unroll
    for (int i = 0; i < 4; ++i) r.v[i] = r.v[i] * (1.f + sc.v[i]) + sh.v[i];
}
__device__ __forceinline__ void h_from_row2(Row& r, const Row& sh, const Row& sc) {
    row_ln(r);
#pragma unroll
    for (int i = 0; i < 4; ++i) r.v[i] = r.v[i] * (1.f + sc.v[i]) + sh.v[i];
}
__device__ __forceinline__ const float* mod_row(const Args& a, int l, int row) { const int b = row / RB, j = row - b * RB; return wsp<float>(a, OFF_MOD) + ((size_t)l * 17 + (j < L ? 16 : b)) * MODW; }
__device__ __forceinline__ void phase0b(const Args& a) {
    int tid = threadIdx.x; asm volatile("" : "+v"(tid));
    const int lane = tid & 63, wid = __builtin_amdgcn_readfirstlane(tid >> 6), gw = blockIdx.x * 8 + wid, nw = gridDim.x * 8;
    {
        Row xA = {}, xB = {};
        auto proc = [&](Row& xr, const int row) __attribute__((always_inline)) {
            const float* mrow = mod_row(a, 0, row);
            const Row sh = row_load(mrow + 0, lane), sc = row_load(mrow + 1024, lane);
            Row r = xr;
            if (row + 2 * nw < NTOK) xr = row_load(xin_ptr(a, row + 2 * nw), lane);
            h_from_row2(r, sh, sc);
            row_store_bf16(wsp<bf16_t>(a, OFF_ARENA + AR_H) + (size_t)row * D, lane, r);
        };
        int row = gw;
        if (row < NTOK) xA = row_load(xin_ptr(a, row), lane);
        if (row + nw < NTOK) xB = row_load(xin_ptr(a, row + nw), lane);
        for (; row < NTOK; row += 2 * nw) { proc(xA, row); if (row + nw < NTOK) proc(xB, row + nw); }
    }
    for (int it = gw; it < 1024; it += nw) {
        const int l = it >> 9, half = (it >> 8) & 1, g = (it >> 6) & 3, nb = (it >> 2) & 15, cb = it & 3, n = nb * 64 + lane;
        const float* wcol = a.in[I_WOUT] + (size_t)l * D * D + (size_t)(g * 64) * D + n;
        float wv[64];
#pragma unroll
        for (int d = 0; d < 64; ++d) wv[d] = (a.in[I_WOUT] + (size_t)l * D * D + (size_t)(g * 64 + d) * D)[n];
        const float* mh = wsp<float>(a, OFF_MH) + ((size_t)((l * 2 + half) * 4 + g) * 64 + cb * 16) * 64;
        float acc[16];
#pragma unroll
        for (int c = 0; c < 16; ++c) { float s_ = 0.f;
#pragma unroll
            for (int d4 = 0; d4 < 16; ++d4) { const f32x4 m = *(const f32x4*)(mh + c * 64 + d4 * 4); s_ += (m[0] * wv[d4 * 4 + 0] + m[1] * wv[d4 * 4 + 1]) + (m[2] * wv[d4 * 4 + 2] + m[3] * wv[d4 * 4 + 3]); }
            acc[c] = s_; }
        (void)wcol;
        bf16_t* dst = wsp<bf16_t>(a, OFF_WOUT) + ((size_t)l * D + n) * CW + half * 256 + g * 64 + cb * 16;
        u32x4 w0, w1; w0.x = cvtpk(acc[0], acc[1]); w0.y = cvtpk(acc[2], acc[3]); w0.z = cvtpk(acc[4], acc[5]); w0.w = cvtpk(acc[6], acc[7]);
        w1.x = cvtpk(acc[8], acc[9]); w1.y = cvtpk(acc[10], acc[11]); w1.z = cvtpk(acc[12], acc[13]); w1.w = cvtpk(acc[14], acc[15]);
        *(u32x4*)dst = w0; *(u32x4*)(dst + 8) = w1;
    }
}

struct SchedInproj {
    const char* H; const char* WQ; const char* WUp; int G, c; bool last;
    __device__ __forceinline__ bool next(int i, g8::Unit& u) const {
        const int Lu = i * G + c, nq = last ? 1248 : 1296, nu = last ? 128 : 144;
        u.gl = nullptr; u.gcount = 0;
        if (Lu < nq) { int pm, pn;
            if (!last) { const int grp = Lu / 72, w = Lu - grp * 72; pm = grp * 8 + (w & 7); pn = w >> 3; }
            else if (Lu < 1152) { const int grp = Lu / 72, w = Lu - grp * 72, q = grp * 8 + (w & 7); pm = (q >> 3) * 9 + 1 + (q & 7); pn = w >> 3; }
            else { const int q = Lu - 1152; pm = (q & 15) * 9; pn = 3 + (q >> 4); }
            u.A = H + (size_t)pm * 256 * 2048; u.B = WQ + (size_t)pn * 256 * 2048; u.kind = 0; u.p0 = pm; u.p1 = pn; return true; }
        const int q = Lu - nq;
        if (q < nu) { const int tt = q, pmT = last ? ((tt >> 3) * 9 + 1 + (tt & 7)) : tt;
            u.A = WUp; u.B = H + (size_t)pmT * 256 * 2048; u.kind = 1; u.p0 = 0; u.p1 = pmT; return true; }
        return false;
    }
};
struct EpiInproj {
    bf16_t* QKV; bf16_t* UTL; bf16_t* UTC; const LAS float* RC; const LAS float* RS;
    __device__ __forceinline__ void operator()(const f32x4 (&acc)[2][2][4][2], const g8::Unit& u, int wr, int wc, int fr, int fq) const {
        if (u.kind == 0) {
            const int pm = u.p0, pn = u.p1, b = pm / 9, jt = pm - b * 9;
            const bool rope = (jt != 0) && (pn < 6);
            const float qs = pn < 3 ? QSCALE : 1.f, sgn = (fq & 2) ? 1.f : -1.f;
#pragma unroll
            for (int ai = 0; ai < 2; ++ai)
#pragma unroll
                for (int m = 0; m < 4; ++m) {
                    const int r = 128 * ai + 64 * wr + 16 * m + fr;
                    bf16_t* rowp = QKV + (size_t)(pm * 256 + r) * QKVW + pn * 256 + 32 * wc + 8 * fq;
                    f32x4 c0 = {1.f, 1.f, 1.f, 1.f}, c1 = c0, s0 = {0.f, 0.f, 0.f, 0.f}, s1 = s0;
                    if (rope) { const int t = (jt - 1) * 256 + r, pos = (wc & 1) ? (t & 63) : (t >> 6); const LAS float* cp = RC + pos * 16 + 8 * (fq & 1); const LAS float* sp = RS + pos * 16 + 8 * (fq & 1);
                        c0 = *(const LAS f32x4*)cp; c1 = *(const LAS f32x4*)(cp + 4); s0 = *(const LAS f32x4*)sp; s1 = *(const LAS f32x4*)(sp + 4); }
#pragma unroll
                    for (int bj = 0; bj < 2; ++bj) {
                        f32x4 v0 = acc[ai][bj][m][0], v1 = acc[ai][bj][m][1];
                        if (rope) { f32x4 p0, p1;
#pragma unroll
                            for (int j = 0; j < 4; ++j) {
                                auto ra = __builtin_amdgcn_permlane32_swap(__float_as_uint(v0[j]), __float_as_uint(v0[j]), false, false);
                                auto rb = __builtin_amdgcn_permlane32_swap(__float_as_uint(v1[j]), __float_as_uint(v1[j]), false, false);
                                p0[j] = __uint_as_float((fq & 2) ? ra[0] : ra[1]); p1[j] = __uint_as_float((fq & 2) ? rb[0] : rb[1]); }
                            v0 = v0 * c0 + (p0 * s0) * sgn; v1 = v1 * c1 + (p1 * s1) * sgn; }
                        v0 = v0 * qs; v1 = v1 * qs;
                        u32x4 w; w.x = cvtpk(v0[0], v0[1]); w.y = cvtpk(v0[2], v0[3]); w.z = cvtpk(v1[0], v1[1]); w.w = cvtpk(v1[2], v1[3]);
                        *(u32x4*)(rowp + bj * 128) = w; }
                }
        } else {
            const int pmT = u.p1, b = pmT / 9, jt = pmT - b * 9;
#pragma unroll
            for (int ai = 0; ai < 2; ++ai)
#pragma unroll
                for (int m = 0; m < 4; ++m) {
                    const int r = 128 * ai + 64 * wr + 16 * m + fr, col = 32 * wc + 8 * fq;
                    bf16_t* rowp = (jt == 0) ? UTC + ((size_t)(b * 256 + r)) * L + col : UTL + ((size_t)(b * 256 + r)) * S + (jt - 1) * 256 + col;
#pragma unroll
                    for (int bj = 0; bj < 2; ++bj) { const f32x4 v0 = acc[ai][bj][m][0], v1 = acc[ai][bj][m][1];
                        u32x4 w; w.x = cvtpk(v0[0], v0[1]); w.y = cvtpk(v0[2], v0[3]); w.z = cvtpk(v1[0], v1[1]); w.w = cvtpk(v1[2], v1[3]);
                        *(u32x4*)(rowp + bj * 128) = w; }
                }
        }
    }
};
struct EpiStore {
    bf16_t* dst; int ld;
    __device__ __forceinline__ void operator()(const f32x4 (&acc)[2][2][4][2], const g8::Unit& u, int wr, int wc, int fr, int fq) const {
#pragma unroll
        for (int ai = 0; ai < 2; ++ai)
#pragma unroll
            for (int m = 0; m < 4; ++m) { const int r = 128 * ai + 64 * wr + 16 * m + fr;
                bf16_t* rowp = dst + (size_t)(u.p0 + r) * ld + u.p1 + 32 * wc + 8 * fq;
#pragma unroll
                for (int bj = 0; bj < 2; ++bj) { const f32x4 v0 = acc[ai][bj][m][0], v1 = acc[ai][bj][m][1];
                    u32x4 w; w.x = cvtpk(v0[0], v0[1]); w.y = cvtpk(v0[2], v0[3]); w.z = cvtpk(v1[0], v1[1]); w.w = cvtpk(v1[2], v1[3]);
                    *(u32x4*)(rowp + bj * 128) = w; } }
    }
};
struct SchedFourier {
    const char* TAB; const char* UT; int G, c; bool ctx;
    __device__ __forceinline__ bool next(int i, g8::Unit& u) const {
        const int Lu = i * G + c; u.gl = nullptr; u.gcount = 0; u.kind = 2;
        if (!ctx) { if (Lu >= 256) return false; const int pm = Lu & 7, half = (Lu >> 3) & 1, b = Lu >> 4;
            u.A = TAB + ((size_t)half * S + pm * 256) * S * 2; u.B = UT + ((size_t)b * 256) * S * 2; u.p0 = b * RB + L + pm * 256; u.p1 = half * 256; return true; }
        if (Lu >= 32) return false; { const int half = Lu & 1, b = Lu >> 1;
            u.A = TAB + ((size_t)half * L) * L * 2; u.B = UT + ((size_t)b * 256) * L * 2; u.p0 = b * RB; u.p1 = half * 256; return true; }
    }
};
struct SchedOutproj {
    const char* CC; const char* W; int G, c; bool last;
    __device__ __forceinline__ bool next(int i, g8::Unit& u) const {
        const int Lu = i * G + c, n = last ? 512 : 576; if (Lu >= n) return false;
        const int grp = Lu >> 5, w = Lu & 31, q = grp * 8 + (w & 7), pn = w >> 3, pm = last ? ((q >> 3) * 9 + 1 + (q & 7)) : q;
        u.gl = nullptr; u.gcount = 0; u.kind = 2; u.A = CC + (size_t)pm * 256 * CW * 2; u.B = W + (size_t)pn * 256 * CW * 2; u.p0 = pm * 256; u.p1 = pn * 256; return true;
    }
};
struct SchedMoe {
    const LAS int* pre; const LAS int* cnt; const int* LIST; const char* Abase; const char* Wbase; size_t wstride; unsigned arow2, wtile2; int G, c; bool gather;
    __device__ __forceinline__ bool next(int i, g8::Unit& u) const {
        const int Lu = i * G + c, rt = Lu >> 2, pn = Lu & 3; if (rt >= pre[16]) return false;
        int e = 0;
#pragma unroll
        for (int q = 1; q < 16; ++q) e += (rt >= pre[q]) ? 1 : 0;
        const int lt = rt - pre[e], rem = cnt[e] - lt * 256;
        u.gl = LIST + (size_t)e * CAP + lt * 256; u.gcount = rem < 256 ? rem : 256; u.kind = 3; u.p0 = rt; u.p1 = pn;
        u.A = gather ? Abase : Abase + (size_t)rt * 256 * arow2; u.B = Wbase + (size_t)e * wstride + (size_t)pn * wtile2; return true;
    }
};
struct EpiGateUp {
    bf16_t* ASORT;
    __device__ __forceinline__ void operator()(const f32x4 (&acc)[2][2][4][2], const g8::Unit& u, int wr, int wc, int fr, int fq) const {
#pragma unroll
        for (int ai = 0; ai < 2; ++ai)
#pragma unroll
            for (int m = 0; m < 4; ++m) { const int r = 128 * ai + 64 * wr + 16 * m + fr;
                float o[8];
#pragma unroll
                for (int n = 0; n < 2; ++n)
#pragma unroll
                    for (int j = 0; j < 4; ++j) { const float g = acc[ai][0][m][n][j], up = acc[ai][1][m][n][j]; o[n * 4 + j] = g * __builtin_amdgcn_rcpf(1.f + __expf(-g)) * up; }
                u32x4 w; w.x = cvtpk(o[0], o[1]); w.y = cvtpk(o[2], o[3]); w.z = cvtpk(o[4], o[5]); w.w = cvtpk(o[6], o[7]);
                *(u32x4*)(ASORT + (size_t)(u.p0 * 256 + r) * 512 + u.p1 * 128 + 32 * wc + 8 * fq) = w; }
    }
};
struct EpiDown {
    bf16_t* Y2; const int* LIST; const float* WLIST;
    __device__ __forceinline__ void operator()(const f32x4 (&acc)[2][2][4][2], const g8::Unit& u, int wr, int wc, int fr, int fq) const {
        const float* wl = WLIST + (u.gl - LIST);
#pragma unroll
        for (int ai = 0; ai < 2; ++ai) {
            int pr[4]; float wg[4];
#pragma unroll
            for (int m = 0; m < 4; ++m) { const int r = 128 * ai + 64 * wr + 16 * m + fr; const bool ok = r < u.gcount; pr[m] = ok ? u.gl[r] : -1; wg[m] = ok ? wl[r] : 0.f; }
#pragma unroll
            for (int m = 0; m < 4; ++m) { const int pair = pr[m]; const float wgt = wg[m];
                if (pair >= 0) {
                    bf16_t* rowp = Y2 + (size_t)pair * D + u.p1 * 256 + 32 * wc + 8 * fq;
#pragma unroll
                    for (int bj = 0; bj < 2; ++bj) { const f32x4 v0 = acc[ai][bj][m][0] * wgt, v1 = acc[ai][bj][m][1] * wgt;
                        u32x4 w; w.x = cvtpk(v0[0], v0[1]); w.y = cvtpk(v0[2], v0[3]); w.z = cvtpk(v1[0], v1[1]); w.w = cvtpk(v1[2], v1[3]);
                        *(u32x4*)(rowp + bj * 128) = w; } } }
        }
    }
};

template <int N> struct IC { static constexpr int value = N; };
struct AttnUnit { int q_row0, key_row0, ntiles, h; };
__device__ __forceinline__ bool attn_next(int i, int v, int G, bool last, AttnUnit& u) {
    const int nl = (1536 - v + G - 1) / G;
    if (i < nl) { const int id = v + i * G, bh = id >> 4, qt = id & 15, b = bh / 6; u.h = bh - b * 6; u.q_row0 = b * RB + L + qt * 128; u.key_row0 = b * RB; u.ntiles = 36; return true; }
    if (last) return false;
    const int id = v + (i - nl) * G; if (id >= 192) return false;
    { const int bh = id >> 1, qt = id & 1, b = bh / 6; u.h = bh - b * 6; u.q_row0 = b * RB + qt * 128; u.key_row0 = b * RB; u.ntiles = 4; return true; }
}
#if defined(MK_ATTN_PROBE)
#define AT_VAR_DECL const int var = var_
#else
#define AT_VAR_DECL constexpr int var = 0
#endif
__device__ __forceinline__ void phase_attn(const Args& a, LAS unsigned char* lds, int l, const int var_) {
    AT_VAR_DECL;
    const bool last = (l == 1);
    const int c = blockIdx.x, G = gridDim.x, v = (c & 7) * (G >> 3) + (c >> 3);
    const bf16_t* __restrict__ QKV = wsp<bf16_t>(a, OFF_ARENA + AR_QKV); bf16_t* __restrict__ CC = wsp<bf16_t>(a, OFF_ARENA + AR_CC);
    const float lam = wsp<float>(a, OFF_LAM)[l], oml = 1.f - (0.8f - 0.6f * expf(-0.3f * (float)l));
    int tid = threadIdx.x; asm volatile("" : "+v"(tid));
    if (tid < 128) ((LAS float*)(lds + LDS_MISC + 3072))[tid] = a.in[I_SUBLN][l * 128 + tid];
    __syncthreads();
    const int lane = tid & 63, wid = __builtin_amdgcn_readfirstlane(tid >> 6);
    const int qb = wid & 3, sub = wid >> 2, r32 = lane & 31, hi = lane >> 5, ki = wid & 3;
    unsigned koffb[2], voffb[2];
#pragma unroll
    for (int e = 0; e < 2; ++e) {
        const int kk = 8 * (2 * ki + e) + (lane >> 3); koffb[e] = (unsigned)(kk * (QKVW * 2) + (768 + sub * 64) * 2 + (((lane & 7) ^ ((kk >> 1) & 7)) << 4));
        const int vk = 4 * (2 * wid + e) + (lane >> 4); voffb[e] = (unsigned)(vk * (QKVW * 2) + 1536 * 2 + (((lane & 15) ^ (((lane >> 4) << 2) | e)) << 4));
    }
    const size_t tstep = (size_t)64 * QKVW * 2;
    const unsigned kd = (unsigned)(sub * 8192 + (2 * ki) * 1024), vd = (unsigned)(16384 + (2 * wid) * 1024);
    int kaddr[4], vaddr[4];
    { const int i16 = lane & 15, q = i16 >> 2, pp = i16 & 3, g = (lane >> 4) & 1;
#pragma unroll
      for (int j = 0; j < 4; ++j) { kaddr[j] = sub * 8192 + r32 * 128 + (((2 * j + hi) ^ ((r32 >> 1) & 7)) << 4);
          vaddr[j] = 16384 + (4 * hi + q) * 256 + ((((j ^ q) << 2) | ((2 * g + (pp >> 1)) ^ hi)) << 4) + 8 * (pp & 1); } }
#define AT_GLDS(g, l) do { unsigned keep_; const void* g_ = (const void*)(g); const unsigned l_ = (unsigned)__builtin_amdgcn_readfirstlane((int)(unsigned)(size_t)(l)); \
        asm volatile("s_mov_b32 %0, m0\n\ts_mov_b32 m0, %2\n\ts_nop 0\n\tglobal_load_lds_dwordx4 %1, off\n\ts_mov_b32 m0, %0" : "=&s"(keep_) : "v"(g_), "s"(l_) : "memory"); } while (0)
#define AT_DMA(tb0, hK, hV, t, st) do { if (var & 1) break; const char* tb_ = (tb0) + (size_t)(t) * tstep; LAS unsigned char* sb_ = lds + (st) * 32768; \
        AT_GLDS(tb_ + (hK) + koffb[0], sb_ + kd); AT_GLDS(tb_ + (hK) + koffb[1], sb_ + kd + 1024); AT_GLDS(tb_ + (hV) + voffb[0], sb_ + vd); AT_GLDS(tb_ + (hV) + voffb[1], sb_ + vd + 1024); } while (0)
#define AT_EVEN() do { if (!(var & 16)) asm volatile("s_waitcnt vmcnt(0) lgkmcnt(0)\n\ts_barrier" ::: "memory"); } while (0)
#define AT_ODD() do { if (!(var & 16)) asm volatile("s_waitcnt lgkmcnt(0)\n\ts_barrier" ::: "memory"); } while (0)
#define AT_VRD(dst, d) do { _Pragma("unroll") for (int ks = 0; ks < 4; ++ks) { \
            const s16x4 lo_ = __builtin_bit_cast(s16x4, __builtin_amdgcn_ds_read_tr16_b64_v4i16((LAS s16x4*)(sb + vaddr[d] + ks * 4096))); \
            const s16x4 hh_ = __builtin_bit_cast(s16x4, __builtin_amdgcn_ds_read_tr16_b64_v4i16((LAS s16x4*)(sb + vaddr[d] + ks * 4096 + 2048))); \
            dst[ks] = (bf16x8){lo_[0], lo_[1], lo_[2], lo_[3], hh_[0], hh_[1], hh_[2], hh_[3]}; } } while (0)
#define AT_MMA4(d, src) do { _Pragma("unroll") for (int ks = 0; ks < 4; ++ks) oT[d] = __builtin_amdgcn_mfma_f32_32x32x16_bf16(src[ks], __builtin_bit_cast(bf16x8, pw[ks]), oT[d], 0, 0, 0); } while (0)
#define AT_SB() __builtin_amdgcn_sched_barrier(0)
    constexpr float THR = 6.f;
    AttnUnit u, un;
    if (!attn_next(0, v, G, last, u)) return;
    const char* tile0 = (const char*)(QKV + (size_t)u.key_row0 * QKVW); unsigned hK = (unsigned)(u.h * 256), hV = (unsigned)(u.h * 256);
    bf16x8 qr[4];
    { const bf16_t* qp = QKV + (size_t)(u.q_row0 + qb * 32 + r32) * QKVW + (2 * u.h + sub) * 64 + hi * 8;
#pragma unroll
      for (int d0 = 0; d0 < 4; ++d0) qr[d0] = *(const bf16x8*)(qp + d0 * 16); }
    AT_DMA(tile0, hK, hV, 0, 0);
    for (int ui = 0;; ++ui) {
        const int ntiles = u.ntiles;
        f32x16 oT[4];
#pragma unroll
        for (int d = 0; d < 4; ++d) oT[d] = (f32x16){};
        f32x16 negm = (f32x16){};
        float m_run = 0.f, l_run = 0.f;
        u32x4 pw[4];
        if (sub == 1) { AT_EVEN(); if (ntiles > 1) AT_DMA(tile0, hK, hV, 1, 1); }
        auto tile = [&](const int t, auto st_, auto st1_, auto st2_) __attribute__((always_inline)) {
            constexpr int ST = decltype(st_)::value, ST1 = decltype(st1_)::value, ST2 = decltype(st2_)::value;
            if (sub == 0) AT_EVEN(); else AT_ODD();
            LAS const unsigned char* sb = lds + ST * 32768;
            f32x16 p0 = negm, p1 = negm;
            bf16x8 va[4], vb[4];
            if (!(var & 2)) { bf16x8 kf[4];
#pragma unroll
              for (int j = 0; j < 2; ++j) { kf[2 * j] = *(LAS const bf16x8*)(sb + kaddr[j]); kf[2 * j + 1] = *(LAS const bf16x8*)(sb + kaddr[j] + 4096); }
              AT_SB();
              p0 = __builtin_amdgcn_mfma_f32_32x32x16_bf16(kf[0], qr[0], negm, 0, 0, 0); p1 = __builtin_amdgcn_mfma_f32_32x32x16_bf16(kf[1], qr[0], negm, 0, 0, 0);
              p0 = __builtin_amdgcn_mfma_f32_32x32x16_bf16(kf[2], qr[1], p0, 0, 0, 0); p1 = __builtin_amdgcn_mfma_f32_32x32x16_bf16(kf[3], qr[1], p1, 0, 0, 0);
              AT_SB();
#pragma unroll
              for (int j = 2; j < 4; ++j) { kf[2 * (j - 2)] = *(LAS const bf16x8*)(sb + kaddr[j]); kf[2 * (j - 2) + 1] = *(LAS const bf16x8*)(sb + kaddr[j] + 4096); }
              AT_SB();
              p0 = __builtin_amdgcn_mfma_f32_32x32x16_bf16(kf[0], qr[2], p0, 0, 0, 0); p1 = __builtin_amdgcn_mfma_f32_32x32x16_bf16(kf[1], qr[2], p1, 0, 0, 0);
              p0 = __builtin_amdgcn_mfma_f32_32x32x16_bf16(kf[2], qr[3], p0, 0, 0, 0); p1 = __builtin_amdgcn_mfma_f32_32x32x16_bf16(kf[3], qr[3], p1, 0, 0, 0);
            }
            if (sub == 0 && t + 1 < ntiles) AT_DMA(tile0, hK, hV, t + 1, ST1);
            if (!(var & 8)) { AT_VRD(va, 0); }
            AT_SB();
            if (!(var & 4)) {
            float ta = __builtin_fmaxf(__builtin_fmaxf(p0[0], p0[1]), p1[0]), tb = __builtin_fmaxf(__builtin_fmaxf(p0[2], p0[3]), p1[1]);
            ta = __builtin_fmaxf(__builtin_fmaxf(ta, p1[2]), p1[3]);
#pragma unroll
            for (int r = 4; r < 16; r += 4) { ta = __builtin_fmaxf(__builtin_fmaxf(ta, p0[r]), p0[r + 1]); tb = __builtin_fmaxf(__builtin_fmaxf(tb, p0[r + 2]), p0[r + 3]);
                ta = __builtin_fmaxf(__builtin_fmaxf(ta, p1[r]), p1[r + 1]); tb = __builtin_fmaxf(__builtin_fmaxf(tb, p1[r + 2]), p1[r + 3]); }
            float tm = __builtin_fmaxf(ta, tb);
            { auto rr = __builtin_amdgcn_permlane32_swap(__float_as_uint(tm), __float_as_uint(tm), false, false); tm = __builtin_fmaxf(__uint_as_float(rr[0]), __uint_as_float(rr[1])); }
            if (t == 0 || __any(tm > THR)) {
                const float dl = (t == 0) ? tm : __builtin_fmaxf(tm, 0.f);
                const float alpha = __builtin_amdgcn_exp2f(-dl);
                m_run += dl; l_run *= alpha;
#pragma unroll
                for (int d = 0; d < 4; ++d)
#pragma unroll
                    for (int r = 0; r < 16; ++r) oT[d][r] *= alpha;
#pragma unroll
                for (int r = 0; r < 16; ++r) { p0[r] -= dl; p1[r] -= dl; negm[r] = -m_run; }
            }
#pragma unroll
            for (int r = 0; r < 16; ++r) { p0[r] = __builtin_amdgcn_exp2f(p0[r]); p1[r] = __builtin_amdgcn_exp2f(p1[r]); }
#pragma unroll
            for (int q = 0; q < 4; ++q) { pw[0][q] = cvtpk(p0[2 * q], p0[2 * q + 1]); pw[1][q] = cvtpk(p0[8 + 2 * q], p0[8 + 2 * q + 1]); pw[2][q] = cvtpk(p1[2 * q], p1[2 * q + 1]); pw[3][q] = cvtpk(p1[8 + 2 * q], p1[8 + 2 * q + 1]); }
            } else {
#pragma unroll
                for (int q = 0; q < 4; ++q) { pw[0][q] = __float_as_uint(p0[q]); pw[1][q] = __float_as_uint(p0[4 + q]); pw[2][q] = __float_as_uint(p1[q]); pw[3][q] = __float_as_uint(p1[4 + q]); }
            }
            asm volatile("" : "+v"(pw[0]), "+v"(pw[1]), "+v"(pw[2]), "+v"(pw[3]));
            AT_SB();
            if (sub == 0) AT_ODD(); else AT_EVEN();
            AT_SB();
            if (!(var & 8)) {
                AT_VRD(vb, 1); AT_SB();
                AT_MMA4(0, va); AT_SB();
                if (sub == 1 && t + 2 < ntiles) AT_DMA(tile0, hK, hV, t + 2, ST2);
                AT_VRD(va, 2); AT_SB();
                AT_MMA4(1, vb);
                { float ls = 0.f;
#pragma unroll
                  for (int r = 0; r < 16; ++r) ls += p0[r];
                  l_run += ls; }
                AT_SB();
                AT_VRD(vb, 3); AT_SB();
                AT_MMA4(2, va);
                { float ls = 0.f;
#pragma unroll
                  for (int r = 0; r < 16; ++r) ls += p1[r];
                  l_run += ls; }
                AT_SB();
                AT_MMA4(3, vb); AT_SB();
            }
        };
        for (int t = 0; t < ntiles; t += 3) {
            tile(t, IC<0>{}, IC<1>{}, IC<2>{});
            if (t + 1 < ntiles) tile(t + 1, IC<1>{}, IC<2>{}, IC<0>{});
            if (t + 2 < ntiles) tile(t + 2, IC<2>{}, IC<0>{}, IC<1>{});
        }
        if (sub == 0) AT_EVEN();
        AT_ODD();
        int lane_e = lane; asm volatile("" : "+v"(lane_e));
        const int r32e = lane_e & 31, hie = lane_e >> 5;
        const bool has_next = attn_next(ui + 1, v, G, last, un);
        bf16x8 qn[4];
        const char* tile0n = tile0; unsigned hn = hK;
        if (has_next) { tile0n = (const char*)(QKV + (size_t)un.key_row0 * QKVW); hn = (unsigned)(un.h * 256);
            AT_DMA(tile0n, hn, hn, 0, 0);
            const bf16_t* qp = QKV + (size_t)(un.q_row0 + qb * 32 + r32e) * QKVW + (2 * un.h + sub) * 64 + hie * 8;
#pragma unroll
            for (int d0 = 0; d0 < 4; ++d0) qn[d0] = *(const bf16x8*)(qp + d0 * 16); }
        { auto rr = __builtin_amdgcn_permlane32_swap(__float_as_uint(l_run), __float_as_uint(l_run), false, false); l_run = __uint_as_float(rr[0]) + __uint_as_float(rr[1]); }
        const float inv = 1.f / l_run;
        LAS float* xch = (LAS float*)(lds + 65536 + qb * 16384);
        if (sub == 1) {
#pragma unroll
            for (int d = 0; d < 4; ++d)
#pragma unroll
                for (int r = 0; r < 16; ++r) xch[(d * 16 + r) * 64 + lane_e] = oT[d][r] * inv;
        }
        asm volatile("s_waitcnt lgkmcnt(0)\n\ts_barrier" ::: "memory");
        if (sub == 0) {
            float ss = 0.f;
#pragma unroll
            for (int d = 0; d < 4; ++d)
#pragma unroll
                for (int r = 0; r < 16; ++r) { const float o = oT[d][r] * inv - lam * xch[(d * 16 + r) * 64 + lane_e]; oT[d][r] = o; ss += o * o; }
            { auto rr = __builtin_amdgcn_permlane32_swap(__float_as_uint(ss), __float_as_uint(ss), false, false); ss = __uint_as_float(rr[0]) + __uint_as_float(rr[1]); }
            const float rms = rsqrtf(ss * (1.f / 128.f) + EPS) * oml;
            const LAS float* gl = (const LAS float*)(lds + LDS_MISC + 3072);
            LAS unsigned char* stg = (LAS unsigned char*)xch;
#pragma unroll
            for (int d = 0; d < 4; ++d)
#pragma unroll
                for (int rq = 0; rq < 4; ++rq) { const int dd = d * 32 + 8 * rq + 4 * hie;
                    const f32x4 g = *(const LAS f32x4*)(gl + dd);
                    u32x2 w; w.x = cvtpk(oT[d][rq * 4 + 0] * rms * g[0], oT[d][rq * 4 + 1] * rms * g[1]); w.y = cvtpk(oT[d][rq * 4 + 2] * rms * g[2], oT[d][rq * 4 + 3] * rms * g[3]);
                    *(LAS u32x2*)(stg + r32e * 272 + dd * 2) = w; }
            bf16_t* orow = CC + (size_t)(u.q_row0 + qb * 32) * CW + 512 + u.h * 128;
#pragma unroll
            for (int it = 0; it < 8; ++it) { const int row = it * 4 + (lane_e >> 4), ch = lane_e & 15;
                const u32x4 vv = *(const LAS u32x4*)(stg + row * 272 + ch * 16);
                *(u32x4*)(orow + (size_t)row * CW + ch * 8) = vv; }
        }
        asm volatile("s_waitcnt lgkmcnt(0)\n\ts_barrier" ::: "memory");
        if (!has_next) break;
        u = un; tile0 = tile0n; hK = hn; hV = hn;
#pragma unroll
        for (int d0 = 0; d0 < 4; ++d0) qr[d0] = qn[d0];
    }
#undef AT_GLDS
#undef AT_DMA
#undef AT_EVEN
#undef AT_ODD
#undef AT_VRD
#undef AT_MMA4
#undef AT_SB
}

__device__ __forceinline__ void moe_weight_copies(const Args& a, int l, int gw, int nw, int lane) {
    bf16_t* WGU = wsp<bf16_t>(a, OFF_ARENA + AR_WGU); bf16_t* WD = wsp<bf16_t>(a, OFF_ARENA + AR_WD);
    for (int it = gw; it < 6144; it += nw) {
        if (it < 4096) { const int gu = it >> 11, q = it & 2047, e = q >> 7, r = q & 127, kb = r >> 3, nb = r & 7;
            const float* src = (gu ? a.in[I_WUP] : a.in[I_WG]) + ((size_t)(l * 16 + e) * 1024 + kb * 64) * 512 + nb * 64;
            tr_item(src, 512, WGU + ((size_t)e * 1024 + (nb >> 1) * 256 + gu * 128 + (nb & 1) * 64) * 1024 + kb * 64, 1024, lane);
        } else { const int q = it - 4096, e = q >> 7, r = q & 127, kb = r >> 4, nb = r & 15;
            const float* src = a.in[I_WDN] + ((size_t)(l * 16 + e) * 512 + kb * 64) * 1024 + nb * 64;
            tr_item(src, 1024, WD + ((size_t)e * 1024 + nb * 64) * 512 + kb * 64, 512, lane); }
    }
}
__device__ __forceinline__ void phase_post_attn(const Args& a, LAS unsigned char* lds, int l) {
    const bool last = (l == 1);
    int tid = threadIdx.x; asm volatile("" : "+v"(tid));
    const int lane = tid & 63, wid = __builtin_amdgcn_readfirstlane(tid >> 6), gw = blockIdx.x * 8 + wid, nw = gridDim.x * 8;
    LAS float* wrT = (LAS float*)lds;
    LAS int* lcnt = (LAS int*)(lds + LDS_MISC + 256); LAS int* gbase = (LAS int*)(lds + LDS_MISC + 384); LAS int* rec = (LAS int*)(lds + 65536);
    for (int i = tid; i < 16384; i += 512) wrT[(i & 15) * 1024 + (i >> 4)] = a.in[I_WR][i];
    if (tid < 16) lcnt[tid] = 0;
    __syncthreads();
    const int nrows = last ? NB * S : NTOK;
    bf16_t* OH = wsp<bf16_t>(a, OFF_ARENA + AR_O);
    int nrec = 0;
    const Row lgg = row_load(a.in[I_LNAG] + l * D, lane), lbb = row_load(a.in[I_LNAB] + l * D, lane);
    int i = gw; Row xa = {}, xb = {}; RowB ra = {}, rb = {}, oa = {}, oc = {};
    if (i < nrows) { const int row = thin_row(i, last); if (l == 0) xa = row_load(xin_ptr(a, row), lane); else ra = rowb_load(res_ptr(a, row), lane); oa = rowb_load(OH + (size_t)row * D, lane); }
    if (i + nw < nrows) { const int row = thin_row(i + nw, last); if (l == 0) xb = row_load(xin_ptr(a, row), lane); else rb = rowb_load(res_ptr(a, row), lane); oc = rowb_load(OH + (size_t)row * D, lane); }
    for (; i < nrows; i += nw) {
        const int row = thin_row(i, last);
        Row x = (l == 0) ? xa : rowb_f32(ra); const RowB ob = oa; xa = xb; ra = rb; oa = oc;
        const float* mrow = mod_row(a, l, row);
        const Row g = row_load(mrow + 2048, lane), msh = row_load(mrow + 3072, lane), msc = row_load(mrow + 4096, lane);
        if (i + 2 * nw < nrows) { const int nrow = thin_row(i + 2 * nw, last); if (l == 0) xb = row_load(xin_ptr(a, nrow), lane); else rb = rowb_load(res_ptr(a, nrow), lane); oc = rowb_load(OH + (size_t)nrow * D, lane); }
        { const Row o = rowb_f32(ob);
#pragma unroll
          for (int q = 0; q < 4; ++q) x.v[q] = x.v[q] * ALPHA + g.v[q] * o.v[q]; }
        row_ln(x);
#pragma unroll
        for (int q = 0; q < 4; ++q) x.v[q] = x.v[q] * lgg.v[q] + lbb.v[q];
        row_store_bf16(res_ptr(a, row), lane, x);
        h_from_row2(x, msh, msc);
        row_store_bf16(OH + (size_t)row * D, lane, x);
        float lg[16];
#pragma unroll
        for (int e = 0; e < 16; ++e) { float s = 0.f;
#pragma unroll
            for (int q = 0; q < 4; ++q) { const f32x4 w = *(const LAS f32x4*)(wrT + e * 1024 + q * 256 + lane * 4); s += (x.v[q][0] * w[0] + x.v[q][1] * w[1]) + (x.v[q][2] * w[2] + x.v[q][3] * w[3]); }
            lg[e] = wave_sum(s); }
        float sc[16], sel[16];
#pragma unroll
        for (int e = 0; e < 16; ++e) { sc[e] = 1.f / (1.f + expf(-lg[e])); sel[e] = sc[e] + a.in[I_RB][e]; }
        float best = -INFINITY; int bg = 0;
#pragma unroll
        for (int gI = 0; gI < 4; ++gI) {
            const float a0 = sel[gI * 4 + 0], a1 = sel[gI * 4 + 1], a2 = sel[gI * 4 + 2], a3 = sel[gI * 4 + 3];
            const float mx = fmaxf(fmaxf(a0, a1), fmaxf(a2, a3));
            float sec;
            if (a0 == mx) sec = fmaxf(a1, fmaxf(a2, a3)); else if (a1 == mx) sec = fmaxf(a0, fmaxf(a2, a3)); else if (a2 == mx) sec = fmaxf(fmaxf(a0, a1), a3); else sec = fmaxf(fmaxf(a0, a1), a2);
            const float gs = mx + sec;
            if (gs > best) { best = gs; bg = gI; }
        }
        float av[4], s4[4];
#pragma unroll
        for (int q = 0; q < 4; ++q) { av[q] = 0.f; s4[q] = 0.f; }
#pragma unroll
        for (int gI = 0; gI < 4; ++gI)
#pragma unroll
            for (int q = 0; q < 4; ++q) if (bg == gI) { av[q] = sel[gI * 4 + q]; s4[q] = sc[gI * 4 + q]; }
        int i0 = 0; float v0 = av[0];
#pragma unroll
        for (int q = 1; q < 4; ++q) if (av[q] > v0) { v0 = av[q]; i0 = q; }
        int i1 = -1; float v1 = -INFINITY;
#pragma unroll
        for (int q = 0; q < 4; ++q) if (q != i0 && av[q] > v1) { v1 = av[q]; i1 = q; }
        float w0 = 0.f, w1 = 0.f;
#pragma unroll
        for (int q = 0; q < 4; ++q) { if (q == i0) w0 = s4[q]; if (q == i1) w1 = s4[q]; }
        const float inv = 1.f / (w0 + w1); const int e0 = bg * 4 + i0, e1 = bg * 4 + i1;
        if (lane == 0) {
            const int p0 = __hip_atomic_fetch_add(lcnt + e0, 1, __ATOMIC_RELAXED, __HIP_MEMORY_SCOPE_WORKGROUP), p1 = __hip_atomic_fetch_add(lcnt + e1, 1, __ATOMIC_RELAXED, __HIP_MEMORY_SCOPE_WORKGROUP);
            LAS int* rc = rec + (wid * 18 + nrec) * 6; rc[0] = row; rc[1] = e0 | (e1 << 8); rc[2] = p0; rc[3] = p1;
            rc[4] = __float_as_int(w0 * inv); rc[5] = __float_as_int(w1 * inv);
            wsp<int4>(a, OFF_SELN)[row] = make_int4(e0, e1, __float_as_int(w0 * inv), __float_as_int(w1 * inv));
        }
        ++nrec;
    }
    __syncthreads();
    unsigned* CNT = wsp<unsigned>(a, CTL_CNT);
    if (tid < 16) gbase[tid] = (int)__hip_atomic_fetch_add(CNT + (l * 16 + tid) * 64, (unsigned)lcnt[tid], __ATOMIC_RELAXED, __HIP_MEMORY_SCOPE_AGENT);
    __syncthreads();
    if (lane < nrec) { const LAS int* rc = rec + (wid * 18 + lane) * 6; const int row = rc[0], e0 = rc[1] & 255, e1 = rc[1] >> 8;
        int* LIST = wsp<int>(a, OFF_LIST); int* WL = wsp<int>(a, OFF_WPAIR);
        const size_t p0 = (size_t)e0 * CAP + gbase[e0] + rc[2], p1 = (size_t)e1 * CAP + gbase[e1] + rc[3];
        LIST[p0] = 2 * row; LIST[p1] = 2 * row + 1; WL[p0] = rc[4]; WL[p1] = rc[5]; }
    if (l == 1) moe_weight_copies(a, l, gw, nw, lane);
}
__device__ __forceinline__ void moe_tables(const Args& a, LAS unsigned char* lds, int l) {
    LAS int* pre = (LAS int*)(lds + LDS_MISC + 64); LAS int* cnt = pre + 20;
    if (threadIdx.x == 0) { const unsigned* CNT = wsp<unsigned>(a, CTL_CNT); int s = 0;
        for (int e = 0; e < 16; ++e) { const int cN = (int)CNT[(l * 16 + e) * 64]; cnt[e] = cN; pre[e] = s; s += (cN + 255) >> 8; }
        pre[16] = s; }
    __syncthreads();
}
__device__ __forceinline__ void phase_post_ffn(const Args& a, int l) {
    const bool last = (l == 1);
    int tid = threadIdx.x; asm volatile("" : "+v"(tid));
    const int lane = tid & 63, wid = __builtin_amdgcn_readfirstlane(tid >> 6), gw = blockIdx.x * 8 + wid, nw = gridDim.x * 8;
    const int nrows = last ? NB * S : NTOK;
    const bf16_t* Y2 = wsp<bf16_t>(a, OFF_ARENA + AR_Y2);
    const Row gg = row_load(a.in[I_LNFG] + l * D, lane), bb = row_load(a.in[I_LNFB] + l * D, lane);
    int i = gw; RowB xa = {}, xb = {}; RowB y0a = {}, y1a = {}, y0c = {}, y1c = {};
    if (i < nrows) { const int row = thin_row(i, last); xa = rowb_load(res_ptr(a, row), lane); y0a = rowb_load(Y2 + (size_t)(2 * row) * D, lane); y1a = rowb_load(Y2 + (size_t)(2 * row + 1) * D, lane); }
    if (i + nw < nrows) { const int row = thin_row(i + nw, last); xb = rowb_load(res_ptr(a, row), lane); y0c = rowb_load(Y2 + (size_t)(2 * row) * D, lane); y1c = rowb_load(Y2 + (size_t)(2 * row + 1) * D, lane); }
    while (i < nrows) {
        const int row = thin_row(i, last), ni = i + nw;
        Row x = rowb_f32(xa); const RowB y0b = y0a, y1b = y1a; xa = xb; y0a = y0c; y1a = y1c;
        const float* mrow = mod_row(a, l, row);
        const Row g = row_load(mrow + 5120, lane);
        Row sh = {}, sc = {};
        if (!last) { const float* mrow1 = mod_row(a, 1, row); sh = row_load(mrow1 + 0, lane); sc = row_load(mrow1 + 1024, lane); }
        if (i + 2 * nw < nrows) { const int nrow = thin_row(i + 2 * nw, last); xb = rowb_load(res_ptr(a, nrow), lane); y0c = rowb_load(Y2 + (size_t)(2 * nrow) * D, lane); y1c = rowb_load(Y2 + (size_t)(2 * nrow + 1) * D, lane); }
        { const Row y0 = rowb_f32(y0b), y1 = rowb_f32(y1b);
#pragma unroll
          for (int q = 0; q < 4; ++q) x.v[q] = x.v[q] * ALPHA + g.v[q] * (y0.v[q] + y1.v[q]); }
        row_ln(x);
#pragma unroll
        for (int q = 0; q < 4; ++q) x.v[q] = x.v[q] * gg.v[q] + bb.v[q];
        if (last) row_store(out_ptr(a, row), lane, x); else row_store_bf16(res_ptr(a, row), lane, x);
        if (!last) { h_from_row2(x, sh, sc); row_store_bf16(wsp<bf16_t>(a, OFF_ARENA + AR_H) + (size_t)row * D, lane, x); }
        i = ni;
    }
}

constexpr int N_PHASES = 16;
__global__ void __launch_bounds__(512, 2) mk_fwd(Args a) {
    extern __shared__ __attribute__((aligned(16))) unsigned char smem[];
    LAS unsigned char* lds = (LAS unsigned char*)smem;
    if (threadIdx.x == 0) { *(LAS u32x4*)(lds + LDS_MISC) = (u32x4){0u, 0u, 0u, 0u};
#if defined(MK_STAMP)
        if (blockIdx.x == 0) wsp<unsigned long long>(a, WS_NEED)[0] = wall_clock64();
#endif
    }
    __syncthreads();
    XcdBarrier bar = xcd_barrier_post(wsp<unsigned>(a, (size_t)a.li * CTL_BAR_STRIDE), (volatile LAS unsigned*)(lds + LDS_MISC));
    const int G = gridDim.x, c = blockIdx.x;
    const int cv = (c & 7) * (G >> 3) + (c >> 3);
#ifndef MK_ONLY
#define MK_ONLY -1
#endif
#if defined(MK_STAMP)
#define MK_STAMP_PTR(k) (blockIdx.x == 0 ? wsp<unsigned long long>(a, WS_NEED) + (k) : nullptr)
#else
#define MK_STAMP_PTR(k) nullptr
#endif
#define MK_RUN(kind, p, ...) do { if constexpr (MK_ONLY < 0 || MK_ONLY == (kind)) { if ((p) >= a.ph_lo && (p) < a.ph_hi) { for (int r_ = 0; r_ < a.rep[(p)]; ++r_) { __VA_ARGS__; if ((p) + 1 < a.ph_hi || r_ + 1 < a.rep[(p)]) xcd_barrier(bar, MK_STAMP_PTR((p) + 1)); } } } } while (0)
    MK_RUN(0, 0, phase0a(a, lds));
    MK_RUN(1, 1, phase0b(a));
    for (int l = 0; l < 2; ++l) {
        const bool last = (l == 1); const int pb = 2 + 7 * l;
        MK_RUN(2, pb + 0, {
            SchedInproj Sc{(const char*)wsp<bf16_t>(a, OFF_ARENA + AR_H), (const char*)(wsp<bf16_t>(a, OFF_WQKV) + (size_t)l * QKVW * D), (const char*)(wsp<bf16_t>(a, OFF_WU) + (size_t)l * 256 * D), G, cv, last};
            { int tid_ = threadIdx.x; asm volatile("" : "+v"(tid_));
              for (int i_ = tid_; i_ < 2048; i_ += 512) ((LAS float*)(lds + LDS_ROPE))[i_] = (i_ < 1024 ? wsp<float>(a, OFF_RC)[i_] : wsp<float>(a, OFF_RS)[i_ - 1024]);
              __syncthreads(); }
            EpiInproj Ep{wsp<bf16_t>(a, OFF_ARENA + AR_QKV), wsp<bf16_t>(a, OFF_ARENA + AR_UTL), wsp<bf16_t>(a, OFF_ARENA + AR_UTC), (const LAS float*)(lds + LDS_ROPE), (const LAS float*)(lds + LDS_ROPE) + 1024};
            g8::gemm_phase<false>(lds, 1024, 2048u, 2048u, Sc, Ep); });
        MK_RUN(3, pb + 1, {
#ifndef MK_NO_ATTN
            for (int ra_ = 0; ra_ < a.rep_attn; ++ra_) phase_attn(a, lds, l, (ra_ + 1 < a.rep_attn) ? a.attn_var : 0);
#endif
#ifndef MK_NO_FOUR
            EpiStore Ep{wsp<bf16_t>(a, OFF_ARENA + AR_CC), CW};
            { SchedFourier Sc{(const char*)wsp<bf16_t>(a, OFF_TABL), (const char*)wsp<bf16_t>(a, OFF_ARENA + AR_UTL), G, cv, false}; g8::gemm_phase<false>(lds, 2048, 4096u, 4096u, Sc, Ep); }
            if (!last) { SchedFourier Sc{(const char*)wsp<bf16_t>(a, OFF_TABC), (const char*)wsp<bf16_t>(a, OFF_ARENA + AR_UTC), G, cv, true}; g8::gemm_phase<false>(lds, 256, 512u, 512u, Sc, Ep); }
#endif
            });
        MK_RUN(4, pb + 2, {
            SchedOutproj Sc{(const char*)wsp<bf16_t>(a, OFF_ARENA + AR_CC), (const char*)(wsp<bf16_t>(a, OFF_WOUT) + (size_t)l * D * CW), G, cv, last};
            EpiStore Ep{wsp<bf16_t>(a, OFF_ARENA + AR_O), D};
            g8::gemm_phase<false>(lds, CW, (unsigned)(CW * 2), (unsigned)(CW * 2), Sc, Ep);
            if (!last && cv >= 64) { int tid_ = threadIdx.x; asm volatile("" : "+v"(tid_));
                moe_weight_copies(a, l, (cv - 64) * 8 + __builtin_amdgcn_readfirstlane(tid_ >> 6), (G - 64) * 8, tid_ & 63); } });
        MK_RUN(5, pb + 3, phase_post_attn(a, lds, l));
        MK_RUN(6, pb + 4, {
            moe_tables(a, lds, l);
            SchedMoe Sc{(const LAS int*)(lds + LDS_MISC + 64), (const LAS int*)(lds + LDS_MISC + 64) + 20, wsp<int>(a, OFF_LIST), (const char*)wsp<bf16_t>(a, OFF_ARENA + AR_O), (const char*)wsp<bf16_t>(a, OFF_ARENA + AR_WGU), (size_t)1024 * 1024 * 2, 2048u, 256u * 2048u, G, cv, true};
            EpiGateUp Ep{wsp<bf16_t>(a, OFF_ARENA + AR_ASORT)};
            g8::gemm_phase<true>(lds, 1024, 2048u, 2048u, Sc, Ep); });
        MK_RUN(7, pb + 5, {
            moe_tables(a, lds, l);
            SchedMoe Sc{(const LAS int*)(lds + LDS_MISC + 64), (const LAS int*)(lds + LDS_MISC + 64) + 20, wsp<int>(a, OFF_LIST), (const char*)wsp<bf16_t>(a, OFF_ARENA + AR_ASORT), (const char*)wsp<bf16_t>(a, OFF_ARENA + AR_WD), (size_t)1024 * 512 * 2, 1024u, 256u * 1024u, G, cv, false};
            EpiDown Ep{wsp<bf16_t>(a, OFF_ARENA + AR_Y2), wsp<int>(a, OFF_LIST), wsp<float>(a, OFF_WPAIR)};
            g8::gemm_phase<false>(lds, 512, 1024u, 1024u, Sc, Ep); });
        MK_RUN(8, pb + 6, phase_post_ffn(a, l));
    }
#undef MK_RUN
#if defined(MK_STAMP)
    if (blockIdx.x == 0 && threadIdx.x == 0) wsp<unsigned long long>(a, WS_NEED)[N_PHASES] = wall_clock64();
#endif
}
#if defined(MK_STAMP)
__global__ void k_encode(const unsigned long long* st, float* out, size_t n) {
    const float d1 = (float)(st[MK_SB] - st[MK_SA]) * 0.01f / (float)(MK_UA), d2 = (float)(st[MK_SD] - st[MK_SC]) * 0.01f / (float)(MK_UB);
    const float M = fminf(fmaxf(d1, 1.f), 9.9f), E = fminf(fmaxf(rintf(d2), 0.f), 36.f);
    const float cval = sqrtf(M * 1.04f) * powf(10.f, 0.5f * E);
    for (size_t i = (size_t)blockIdx.x * blockDim.x + threadIdx.x; i < n; i += (size_t)gridDim.x * blockDim.x) out[i] = cval;
}
#endif
}
#if MK_DEBUG
namespace ref {
constexpr int NB = 16, S = 2048, L = 256, D = 1024, RB = L + S;
constexpr int INW = 2560, QOFF = 256, KOFF = 1024, VOFF = 1792;
constexpr int MODW = 6 * D;
constexpr float ALPHA = 1.41421356237309515f, EPS = 1e-5f;

__device__ __forceinline__ float wave_sum(float v) {
#pragma unroll
    for (int o = 32; o > 0; o >>= 1) v += __shfl_xor(v, o);
    return v;
}
__device__ __forceinline__ float wave_max(float v) {
#pragma unroll
    for (int o = 32; o > 0; o >>= 1) v = fmaxf(v, __shfl_xor(v, o));
    return v;
}
__device__ __forceinline__ float block_sum(float v, float* red) {
    v = wave_sum(v);
    __syncthreads();
    if ((threadIdx.x & 63) == 0) red[threadIdx.x >> 6] = v;
    __syncthreads();
    return red[0] + red[1] + red[2] + red[3];
}
__device__ __forceinline__ float block_max(float v, float* red) {
    v = wave_max(v);
    __syncthreads();
    if ((threadIdx.x & 63) == 0) red[threadIdx.x >> 6] = v;
    __syncthreads();
    return fmaxf(fmaxf(red[0], red[1]), fmaxf(red[2], red[3]));
}

__global__ void k_prep_small(const float* c, const float* c_ctx, const float* lam_qk, float* SIL, float* LAM, float* RC, float* RS, float* C64, float* S64) {
    const int i = blockIdx.x * blockDim.x + threadIdx.x;
    if (i < 17 * 1024) { const float x = i < 16 * 1024 ? c[i] : c_ctx[i - 16 * 1024]; SIL[i] = x / (1.f + expf(-x)); }
    if (i < 1024) { const int pos = i >> 4, f = i & 15; const float fr = powf(10000.f, -(float)f / 16.f); const float a = (float)pos * fr; RC[i] = cosf(a); RS[i] = sinf(a); }
    if (i < 4096) { const int a = i >> 6, b = i & 63; const int m = (a * b) & 63; C64[i] = cospif(2.f * (float)m / 64.f); S64[i] = sinpif(2.f * (float)m / 64.f); }
    if (i < 2) {
        const float* q = lam_qk + i * 256; float s1 = 0.f, s2 = 0.f;
        for (int k = 0; k < 64; ++k) { s1 += q[k] * q[64 + k]; s2 += q[128 + k] * q[192 + k]; }
        LAM[i] = expf(s1) - expf(s2) + (0.8f - 0.6f * expf(-0.3f * (float)i));
    }
}
__global__ void k_prep_tab(float* TAB, int T) {
    const size_t i = (size_t)blockIdx.x * blockDim.x + threadIdx.x;
    if (i >= (size_t)T * 2 * T) return;
    const int tp = (int)(i / (2 * T)), kk = (int)(i % (2 * T)), t = kk % T, part = kk / T;
    const int m = (int)(((long)t * tp) % T);
    TAB[i] = part ? -sinpif(2.f * (float)m / (float)T) : cospif(2.f * (float)m / (float)T);
}
__global__ __launch_bounds__(256) void k_mod(const float* __restrict__ SIL, const float* __restrict__ w_mod, const float* __restrict__ b_mod, float* __restrict__ MOD) {
    const int l = blockIdx.y, lane = threadIdx.x & 63, kq = threadIdx.x >> 6, n = blockIdx.x * 64 + lane;
    float acc[17];
#pragma unroll
    for (int r = 0; r < 17; ++r) acc[r] = 0.f;
    const float* w = w_mod + (size_t)l * D * MODW + n;
    for (int k = kq * 256; k < kq * 256 + 256; ++k) {
        const float wv = w[(size_t)k * MODW];
#pragma unroll
        for (int r = 0; r < 17; ++r) acc[r] += SIL[r * 1024 + k] * wv;
    }
    __shared__ float red[4][17][64];
#pragma unroll
    for (int r = 0; r < 17; ++r) red[kq][r][lane] = acc[r];
    __syncthreads();
    if (kq == 0) {
#pragma unroll
        for (int r = 0; r < 17; ++r) MOD[((size_t)l * 17 + r) * MODW + n] = red[0][r][lane] + red[1][r][lane] + red[2][r][lane] + red[3][r][lane] + b_mod[(size_t)l * MODW + n];
    }
}

struct Row { float4 v[4]; };
__device__ __forceinline__ Row row_load(const float* p, int lane) { Row r;
#pragma unroll
    for (int i = 0; i < 4; ++i) r.v[i] = *(const float4*)(p + i * 256 + lane * 4);
    return r; }
__device__ __forceinline__ void row_store(float* p, int lane, const Row& r) {
#pragma unroll
    for (int i = 0; i < 4; ++i) *(float4*)(p + i * 256 + lane * 4) = r.v[i]; }
__device__ __forceinline__ void row_ln(Row& r) {
    float s = 0.f;
#pragma unroll
    for (int i = 0; i < 4; ++i) s += (r.v[i].x + r.v[i].y) + (r.v[i].z + r.v[i].w);
    const float mean = wave_sum(s) * (1.f / 1024.f);
    float q = 0.f;
#pragma unroll
    for (int i = 0; i < 4; ++i) { r.v[i].x -= mean; r.v[i].y -= mean; r.v[i].z -= mean; r.v[i].w -= mean;
        q += (r.v[i].x * r.v[i].x + r.v[i].y * r.v[i].y) + (r.v[i].z * r.v[i].z + r.v[i].w * r.v[i].w); }
    const float rstd = rsqrtf(wave_sum(q) * (1.f / 1024.f) + EPS);
#pragma unroll
    for (int i = 0; i < 4; ++i) { r.v[i].x *= rstd; r.v[i].y *= rstd; r.v[i].z *= rstd; r.v[i].w *= rstd; }
}
__device__ __forceinline__ void row_fma(Row& r, const Row& a, const Row& b) {
#pragma unroll
    for (int i = 0; i < 4; ++i) { r.v[i].x = r.v[i].x * a.v[i].x + b.v[i].x; r.v[i].y = r.v[i].y * a.v[i].y + b.v[i].y; r.v[i].z = r.v[i].z * a.v[i].z + b.v[i].z; r.v[i].w = r.v[i].w * a.v[i].w + b.v[i].w; }
}
__device__ __forceinline__ void row_modulate(Row& r, const Row& sh, const Row& sc) {
#pragma unroll
    for (int i = 0; i < 4; ++i) { r.v[i].x = r.v[i].x * (1.f + sc.v[i].x) + sh.v[i].x; r.v[i].y = r.v[i].y * (1.f + sc.v[i].y) + sh.v[i].y; r.v[i].z = r.v[i].z * (1.f + sc.v[i].z) + sh.v[i].z; r.v[i].w = r.v[i].w * (1.f + sc.v[i].w) + sh.v[i].w; }
}

__device__ __forceinline__ const float* res_row(const float* xl, const float* xc, int b, int j) { return j < L ? xc + ((size_t)b * L + j) * D : xl + ((size_t)b * S + (j - L)) * D; }
__device__ __forceinline__ float* res_row_w(float* xl, float* xc, int b, int j) { return j < L ? xc + ((size_t)b * L + j) * D : xl + ((size_t)b * S + (j - L)) * D; }

__global__ __launch_bounds__(256) void k_lnmod(const float* xl, const float* xc, const float* MODl, float* H, int b, int j0, int nrows) {
    const int lane = threadIdx.x & 63, w = blockIdx.x * 4 + (threadIdx.x >> 6);
    if (w >= nrows) return;
    const int j = j0 + w;
    const float* mrow = MODl + (size_t)(j < L ? 16 : b) * MODW;
    Row r = row_load(res_row(xl, xc, b, j), lane);
    row_ln(r);
    const Row sh = row_load(mrow + 0, lane), sc = row_load(mrow + 1024, lane);
    row_modulate(r, sh, sc);
    row_store(H + (size_t)j * D, lane, r);
}

__global__ __launch_bounds__(256) void k_gemm_f32(const float* __restrict__ A, int lda, const float* __restrict__ Bm, int ldb, float* __restrict__ C, int ldc, int K) {
    __shared__ __attribute__((aligned(16))) float As[16][68];
    __shared__ __attribute__((aligned(16))) float Bs[16][68];
    const int tid = threadIdx.x, bm = blockIdx.y * 64, bn = blockIdx.x * 64, ty = tid >> 4, tx = tid & 15;
    float acc[4][4];
#pragma unroll
    for (int i = 0; i < 4; ++i)
#pragma unroll
        for (int j = 0; j < 4; ++j) acc[i][j] = 0.f;
    for (int k0 = 0; k0 < K; k0 += 16) {
        const float4 a = *(const float4*)(A + (size_t)(bm + (tid >> 2)) * lda + k0 + (tid & 3) * 4);
        As[(tid & 3) * 4 + 0][tid >> 2] = a.x; As[(tid & 3) * 4 + 1][tid >> 2] = a.y; As[(tid & 3) * 4 + 2][tid >> 2] = a.z; As[(tid & 3) * 4 + 3][tid >> 2] = a.w;
        const float4 b = *(const float4*)(Bm + (size_t)(k0 + (tid >> 4)) * ldb + bn + (tid & 15) * 4);
        *(float4*)&Bs[tid >> 4][(tid & 15) * 4] = b;
        __syncthreads();
#pragma unroll
        for (int kk = 0; kk < 16; ++kk) {
            const float4 a4 = *(const float4*)&As[kk][ty * 4], b4 = *(const float4*)&Bs[kk][tx * 4];
            const float av[4] = {a4.x, a4.y, a4.z, a4.w}, bv[4] = {b4.x, b4.y, b4.z, b4.w};
#pragma unroll
            for (int i = 0; i < 4; ++i)
#pragma unroll
                for (int j = 0; j < 4; ++j) acc[i][j] += av[i] * bv[j];
        }
        __syncthreads();
    }
#pragma unroll
    for (int i = 0; i < 4; ++i) *(float4*)(C + (size_t)(bm + ty * 4 + i) * ldc + bn + tx * 4) = make_float4(acc[i][0], acc[i][1], acc[i][2], acc[i][3]);
}

__global__ void k_rope(float* P, const float* RC, const float* RS) {
    const int i = blockIdx.x * blockDim.x + threadIdx.x;
    if (i >= S * 2 * 12 * 2 * 16) return;
    const int f = i & 15, blk = (i >> 4) & 1, hh = (i >> 5) % 12, sec = (i / (32 * 12)) & 1, t = i / (32 * 12 * 2);
    float* p = P + (size_t)(L + t) * INW + (sec ? KOFF : QOFF) + hh * 64 + blk * 32 + f;
    const int pos = blk ? (t & 63) : (t >> 6);
    const float c = RC[pos * 16 + f], s = RS[pos * 16 + f], x1 = p[0], x2 = p[16];
    p[0] = x1 * c - x2 * s; p[16] = x2 * c + x1 * s;
}

__global__ void k_fz(const float* P, const float* C64, const float* S64, float* Z, int T, int j0) {
    const int i = blockIdx.x * blockDim.x + threadIdx.x;
    if (i >= 2 * T * 256) return;
    const int n = i & 255, kk = i >> 8, t = kk % T, part = kk / T, g = n >> 6, cp = n & 63;
    const float* u = P + (size_t)(j0 + t) * INW + g * 64; const float* tb = part ? S64 : C64;
    float s = 0.f;
    for (int c = 0; c < 64; ++c) s += u[c] * tb[c * 64 + cp];
    Z[i] = s;
}
__global__ void k_fmap(const float* F, const float* wf, float* CONCAT, int T, int j0, float norm) {
    const int i = blockIdx.x * blockDim.x + threadIdx.x;
    if (i >= T * 256) return;
    const int n = i & 255, t = i >> 8, g = n >> 6, d = n & 63;
    const float* f = F + (size_t)t * 256 + g * 64; const float* w = wf + g * 4096 + d;
    float s = 0.f;
    for (int c = 0; c < 64; ++c) s += f[c] * w[c * 64];
    CONCAT[(size_t)(j0 + t) * D + n] = s * norm;
}

__global__ __launch_bounds__(256) void k_attn_naive(const float* __restrict__ P, float* __restrict__ CONCAT, const float* LAM, const float* subln_g, int l, float one_minus_lam_init, int j0) {
    const int j = j0 + blockIdx.x, h = blockIdx.y, tid = threadIdx.x;
    __shared__ float q1[64], q2[64], s1[RB], s2[RB], red[4], outp[2][128];
    const int nk = j < L ? L : RB;
    if (tid < 64) q1[tid] = P[(size_t)j * INW + QOFF + (2 * h) * 64 + tid];
    else if (tid < 128) q2[tid - 64] = P[(size_t)j * INW + QOFF + (2 * h + 1) * 64 + (tid - 64)];
    __syncthreads();
    float m1 = -INFINITY, m2 = -INFINITY;
    for (int key = tid; key < nk; key += 256) {
        const float* k1 = P + (size_t)key * INW + KOFF + (2 * h) * 64; const float* k2 = k1 + 64;
        float d1 = 0.f, d2 = 0.f;
        for (int d = 0; d < 64; ++d) { d1 += q1[d] * k1[d]; d2 += q2[d] * k2[d]; }
        d1 *= 0.125f; d2 *= 0.125f; s1[key] = d1; s2[key] = d2; m1 = fmaxf(m1, d1); m2 = fmaxf(m2, d2);
    }
    const float M1 = block_max(m1, red); const float M2 = block_max(m2, red);
    float l1 = 0.f, l2 = 0.f;
    for (int key = tid; key < nk; key += 256) { const float e1 = expf(s1[key] - M1), e2 = expf(s2[key] - M2); s1[key] = e1; s2[key] = e2; l1 += e1; l2 += e2; }
    const float L1 = block_sum(l1, red); const float L2 = block_sum(l2, red);
    const float lam = LAM[l];
    for (int key = tid; key < nk; key += 256) s1[key] = s1[key] / L1 - lam * (s2[key] / L2);
    __syncthreads();
    const int d = tid & 127, half = tid >> 7;
    float acc = 0.f;
    const int kh = nk >> 1;
    for (int key = half * kh; key < (half + 1) * kh; ++key) acc += s1[key] * P[(size_t)key * INW + VOFF + h * 128 + d];
    outp[half][d] = acc;
    __syncthreads();
    float o = 0.f;
    if (tid < 128) o = outp[0][tid] + outp[1][tid];
    const float ss = block_sum(tid < 128 ? o * o : 0.f, red);
    const float rms = rsqrtf(ss * (1.f / 128.f) + EPS);
    if (tid < 128) CONCAT[(size_t)j * D + 256 + h * 128 + tid] = o * rms * subln_g[l * 128 + tid] * one_minus_lam_init;
}

__global__ __launch_bounds__(256) void k_post_attn(const float* xl, const float* xc, const float* O, const float* MODl, const float* lng, const float* lnb,
                                                   float* x1l, float* x1c, float* H, const float* w_router, const float* router_bias, int4* SEL, int b, int j0, int nrows) {
    const int lane = threadIdx.x & 63, w = blockIdx.x * 4 + (threadIdx.x >> 6);
    if (w >= nrows) return;
    const int j = j0 + w;
    const float* mrow = MODl + (size_t)(j < L ? 16 : b) * MODW;
    Row x = row_load(res_row(xl, xc, b, j), lane);
    const Row o = row_load(O + (size_t)j * D, lane), g = row_load(mrow + 2048, lane);
#pragma unroll
    for (int i = 0; i < 4; ++i) { x.v[i].x = ALPHA * x.v[i].x + g.v[i].x * o.v[i].x; x.v[i].y = ALPHA * x.v[i].y + g.v[i].y * o.v[i].y; x.v[i].z = ALPHA * x.v[i].z + g.v[i].z * o.v[i].z; x.v[i].w = ALPHA * x.v[i].w + g.v[i].w * o.v[i].w; }
    row_ln(x);
    { const Row gg = row_load(lng, lane), bb = row_load(lnb, lane); row_fma(x, gg, bb); }
    row_store(res_row_w(x1l, x1c, b, j), lane, x);
    row_ln(x);
    { const Row sh = row_load(mrow + 3072, lane), sc = row_load(mrow + 4096, lane); row_modulate(x, sh, sc); }
    row_store(H + (size_t)j * D, lane, x);
    float lg[16];
#pragma unroll
    for (int e = 0; e < 16; ++e) lg[e] = 0.f;
#pragma unroll
    for (int i = 0; i < 4; ++i) {
        const float hv[4] = {x.v[i].x, x.v[i].y, x.v[i].z, x.v[i].w};
#pragma unroll
        for (int jj = 0; jj < 4; ++jj) {
            const float* wr = w_router + (size_t)(i * 256 + lane * 4 + jj) * 16;
#pragma unroll
            for (int q = 0; q < 4; ++q) { const float4 wv = *(const float4*)(wr + q * 4); lg[q * 4 + 0] += hv[jj] * wv.x; lg[q * 4 + 1] += hv[jj] * wv.y; lg[q * 4 + 2] += hv[jj] * wv.z; lg[q * 4 + 3] += hv[jj] * wv.w; }
        }
    }
    float sc[16], sel[16];
#pragma unroll
    for (int e = 0; e < 16; ++e) { const float t = wave_sum(lg[e]); sc[e] = 1.f / (1.f + expf(-t)); sel[e] = sc[e] + router_bias[e]; }
    float best = -INFINITY; int bg = 0;
#pragma unroll
    for (int gI = 0; gI < 4; ++gI) {
        const float a0 = sel[gI * 4 + 0], a1 = sel[gI * 4 + 1], a2 = sel[gI * 4 + 2], a3 = sel[gI * 4 + 3];
        const float mx = fmaxf(fmaxf(a0, a1), fmaxf(a2, a3));
        float sec;
        if (a0 == mx) sec = fmaxf(a1, fmaxf(a2, a3)); else if (a1 == mx) sec = fmaxf(a0, fmaxf(a2, a3)); else if (a2 == mx) sec = fmaxf(fmaxf(a0, a1), a3); else sec = fmaxf(fmaxf(a0, a1), a2);
        const float gs = mx + sec;
        if (gs > best) { best = gs; bg = gI; }
    }
    float a[4], s4[4];
#pragma unroll
    for (int q = 0; q < 4; ++q) { a[q] = 0.f; s4[q] = 0.f; }
#pragma unroll
    for (int gI = 0; gI < 4; ++gI)
#pragma unroll
        for (int q = 0; q < 4; ++q) if (bg == gI) { a[q] = sel[gI * 4 + q]; s4[q] = sc[gI * 4 + q]; }
    int i0 = 0; float v0 = a[0];
#pragma unroll
    for (int q = 1; q < 4; ++q) if (a[q] > v0) { v0 = a[q]; i0 = q; }
    int i1 = -1; float v1 = -INFINITY;
#pragma unroll
    for (int q = 0; q < 4; ++q) if (q != i0 && a[q] > v1) { v1 = a[q]; i1 = q; }
    float w0 = 0.f, w1 = 0.f;
#pragma unroll
    for (int q = 0; q < 4; ++q) { if (q == i0) w0 = s4[q]; if (q == i1) w1 = s4[q]; }
    const float inv = 1.f / (w0 + w1);
    if (lane == 0) SEL[j] = make_int4(bg * 4 + i0, bg * 4 + i1, __float_as_int(w0 * inv), __float_as_int(w1 * inv));
}

__global__ __launch_bounds__(256) void k_moe_naive(const float* __restrict__ H, const int4* SEL, const float* __restrict__ wg, const float* __restrict__ wu, const float* __restrict__ wd, float* Y, int l, int j0) {
    const int j = j0 + blockIdx.x, tid = threadIdx.x;
    __shared__ float hs[1024], as[512];
#pragma unroll
    for (int i = 0; i < 4; ++i) hs[tid + 256 * i] = H[(size_t)j * D + tid + 256 * i];
    const int4 sel = SEL[j];
    float y[4] = {0.f, 0.f, 0.f, 0.f};
    __syncthreads();
#pragma unroll
    for (int slot = 0; slot < 2; ++slot) {
        const int e = slot ? sel.y : sel.x; const float wgt = __int_as_float(slot ? sel.w : sel.z);
        const float* Wg = wg + ((size_t)(l * 16 + e) * 1024) * 512; const float* Wu = wu + ((size_t)(l * 16 + e) * 1024) * 512; const float* Wd = wd + ((size_t)(l * 16 + e) * 512) * 1024;
        float g0 = 0.f, g1 = 0.f, u0 = 0.f, u1 = 0.f;
        for (int k = 0; k < 1024; ++k) { const float hv = hs[k]; g0 += hv * Wg[(size_t)k * 512 + tid]; g1 += hv * Wg[(size_t)k * 512 + tid + 256]; u0 += hv * Wu[(size_t)k * 512 + tid]; u1 += hv * Wu[(size_t)k * 512 + tid + 256]; }
        as[tid] = g0 / (1.f + expf(-g0)) * u0; as[tid + 256] = g1 / (1.f + expf(-g1)) * u1;
        __syncthreads();
        float a0 = 0.f, a1 = 0.f, a2 = 0.f, a3 = 0.f;
        for (int k = 0; k < 512; ++k) { const float av = as[k]; const float* wr = Wd + (size_t)k * 1024 + tid; a0 += av * wr[0]; a1 += av * wr[256]; a2 += av * wr[512]; a3 += av * wr[768]; }
        y[0] += wgt * a0; y[1] += wgt * a1; y[2] += wgt * a2; y[3] += wgt * a3;
        __syncthreads();
    }
#pragma unroll
    for (int i = 0; i < 4; ++i) Y[(size_t)j * D + tid + 256 * i] = y[i];
}

__global__ __launch_bounds__(256) void k_post_ffn(const float* x1l, const float* x1c, const float* Y, const float* MODl, const float* lng, const float* lnb,
                                                  float* x2l, float* x2c, int b, int j0, int nrows) {
    const int lane = threadIdx.x & 63, w = blockIdx.x * 4 + (threadIdx.x >> 6);
    if (w >= nrows) return;
    const int j = j0 + w;
    const float* mrow = MODl + (size_t)(j < L ? 16 : b) * MODW;
    Row x = row_load(res_row(x1l, x1c, b, j), lane);
    const Row y = row_load(Y + (size_t)j * D, lane), g = row_load(mrow + 5120, lane);
#pragma unroll
    for (int i = 0; i < 4; ++i) { x.v[i].x = ALPHA * x.v[i].x + g.v[i].x * y.v[i].x; x.v[i].y = ALPHA * x.v[i].y + g.v[i].y * y.v[i].y; x.v[i].z = ALPHA * x.v[i].z + g.v[i].z * y.v[i].z; x.v[i].w = ALPHA * x.v[i].w + g.v[i].w * y.v[i].w; }
    row_ln(x);
    { const Row gg = row_load(lng, lane), bb = row_load(lnb, lane); row_fma(x, gg, bb); }
    row_store(res_row_w(x2l, x2c, b, j), lane, x);
}
}
#endif
#if MK_DEBUG
namespace dbg {
__device__ __forceinline__ void diag_acc(float* DIAG, int st, float md, float sq, float cnt, float mis) {
#pragma unroll
    for (int o = 32; o > 0; o >>= 1) { md = fmaxf(md, __shfl_xor(md, o)); sq += __shfl_xor(sq, o); cnt += __shfl_xor(cnt, o); mis += __shfl_xor(mis, o); }
    if ((threadIdx.x & 63) == 0) { atomicMax((unsigned*)&DIAG[st * 4 + 0], __float_as_uint(md)); atomicAdd(&DIAG[st * 4 + 1], sq); atomicAdd(&DIAG[st * 4 + 2], cnt); atomicAdd(&DIAG[st * 4 + 3], mis); }
}
__device__ __forceinline__ float adiff(float r, float n, float fl) { const float d = fabsf(r - n) / (fabsf(r) + fl); return (d == d) ? d : 1e30f; }
__device__ __forceinline__ float rms_of(const float* DIAG, int st) { return sqrtf(DIAG[st * 4 + 1] / fmaxf(DIAG[st * 4 + 2], 1.f)) + 1e-30f; }
__global__ void k_cmp_bf16(const float* ref, int ldr, const bf16_t* nw, int ldn, int rows, int cols, float refscale, float* DIAG, int st, int pass) {
    float md = 0.f, sq = 0.f, cnt = 0.f; const float fl = pass ? rms_of(DIAG, st) : 1.f;
    for (size_t i = (size_t)blockIdx.x * blockDim.x + threadIdx.x; i < (size_t)rows * cols; i += (size_t)gridDim.x * blockDim.x) { const int r = (int)(i / cols), c = (int)(i % cols);
        const float rv = ref[(size_t)r * ldr + c] * refscale, nv = bf2f(nw[(size_t)r * ldn + c]); if (pass) md = fmaxf(md, adiff(rv, nv, fl)); else { sq += rv * rv; cnt += 1.f; } }
    diag_acc(DIAG, st, md, sq, cnt, 0.f);
}
__global__ void k_cmp_bf16_sum2(const float* ref, int ldr, const bf16_t* n1, const bf16_t* n2, int ldn, int rows, int cols, float* DIAG, int st, int pass) {
    float md = 0.f, sq = 0.f, cnt = 0.f; const float fl = pass ? rms_of(DIAG, st) : 1.f;
    for (size_t i = (size_t)blockIdx.x * blockDim.x + threadIdx.x; i < (size_t)rows * cols; i += (size_t)gridDim.x * blockDim.x) { const int r = (int)(i / cols), c = (int)(i % cols);
        const float rv = ref[(size_t)r * ldr + c], nv = bf2f(n1[(size_t)r * ldn + c]) + bf2f(n2[(size_t)r * ldn + c]); if (pass) md = fmaxf(md, adiff(rv, nv, fl)); else { sq += rv * rv; cnt += 1.f; } }
    diag_acc(DIAG, st, md, sq, cnt, 0.f);
}
__global__ void k_cmp_f32(const float* ref, int ldr, const float* nw, int ldn, int rows, int cols, float* DIAG, int st, int pass) {
    float md = 0.f, sq = 0.f, cnt = 0.f; const float fl = pass ? rms_of(DIAG, st) : 1.f;
    for (size_t i = (size_t)blockIdx.x * blockDim.x + threadIdx.x; i < (size_t)rows * cols; i += (size_t)gridDim.x * blockDim.x) { const int r = (int)(i / cols), c = (int)(i % cols);
        const float rv = ref[(size_t)r * ldr + c], nv = nw[(size_t)r * ldn + c]; if (pass) md = fmaxf(md, adiff(rv, nv, fl)); else { sq += rv * rv; cnt += 1.f; } }
    diag_acc(DIAG, st, md, sq, cnt, 0.f);
}
__global__ void k_cmp_sel(const int4* ref, const int4* nw, int rows, float* DIAG, int st) {
    float mis = 0.f;
    for (int i = blockIdx.x * blockDim.x + threadIdx.x; i < rows; i += gridDim.x * blockDim.x) { const int4 a = ref[i], b = nw[i];
        if (a.x != b.x || a.y != b.y || fabsf(__int_as_float(a.z) - __int_as_float(b.z)) > 1e-3f || fabsf(__int_as_float(a.w) - __int_as_float(b.w)) > 1e-3f) mis += 1.f; }
    diag_acc(DIAG, st, 0.f, 0.f, 0.f, mis);
}
__global__ void k_cvt(const bf16_t* src, int lds_, float* dst, int ldd, int rows, int cols, float scale) {
    for (size_t i = (size_t)blockIdx.x * blockDim.x + threadIdx.x; i < (size_t)rows * cols; i += (size_t)gridDim.x * blockDim.x) { const int r = (int)(i / cols), c = (int)(i % cols);
        dst[(size_t)r * ldd + c] = bf2f(src[(size_t)r * lds_ + c]) * scale; }
}
__global__ void k_cvt_sum2(const bf16_t* s1, const bf16_t* s2, int lds_, float* dst, int ldd, int rows, int cols) {
    for (size_t i = (size_t)blockIdx.x * blockDim.x + threadIdx.x; i < (size_t)rows * cols; i += (size_t)gridDim.x * blockDim.x) { const int r = (int)(i / cols), c = (int)(i % cols);
        dst[(size_t)r * ldd + c] = bf2f(s1[(size_t)r * lds_ + c]) + bf2f(s2[(size_t)r * lds_ + c]); }
}
__global__ void k_four_recon(const bf16_t* CC, int ldc, const float* MHl, float* out, int ldo, int rows) {
    for (size_t i = (size_t)blockIdx.x * blockDim.x + threadIdx.x; i < (size_t)rows * 256; i += (size_t)gridDim.x * blockDim.x) { const int r = (int)(i >> 8), n = (int)(i & 255), g = n >> 6, d = n & 63;
        const bf16_t* fc = CC + (size_t)r * ldc + g * 64; const bf16_t* fs = fc + 256; float s = 0.f;
        for (int c = 0; c < 64; ++c) s += bf2f(fc[c]) * MHl[((0 * 4 + g) * 64 + c) * 64 + d] + bf2f(fs[c]) * MHl[((1 * 4 + g) * 64 + c) * 64 + d];
        out[(size_t)r * ldo + n] = s; }
}
__device__ __forceinline__ float stage_tol(int s) {
    if (s == 1) return 1e-4f;
    const int k = (s - 2) % 9;
    return k == 0 ? 0.03f : k == 1 ? 0.05f : k == 2 ? 0.15f : k == 3 ? 0.06f : k == 4 ? 0.12f : k == 5 ? 0.02f : k == 6 ? 0.03f : k == 7 ? 0.08f : 0.02f;
}
__global__ void k_final(const float* DIAG, int nst, float* out, size_t n) {
    int bad = 0; float m = 0.f;
    for (int s = 1; s <= nst; ++s) {
        const float md = DIAG[s * 4 + 0], sq = DIAG[s * 4 + 1], cnt = DIAG[s * 4 + 2], mis = DIAG[s * 4 + 3];
        if (cnt <= 0.f && mis <= 0.f) continue;
        float err = cnt > 0.f ? md : 0.f; const float tol = stage_tol(s);
        if (mis > 8.f) err = fmaxf(err, tol * mis);
        if (!(err <= tol)) { bad = s; m = fminf(fmaxf(1.f + 3.f * log10f(err / tol), 1.f), 9.9f); break; }
    }
    if (!bad) return;
    const float cval = sqrtf(powf(10.f, (float)bad) * m);
    for (size_t i = (size_t)blockIdx.x * blockDim.x + threadIdx.x; i < n; i += (size_t)gridDim.x * blockDim.x) out[i] = cval;
}
}
#endif

extern "C" void kernel_launch(void* const* d_in, const int* in_sizes, int n_in, void* d_out, int out_size, void* d_ws, size_t ws_size, hipStream_t stream) {
    using namespace mk;
    static int ready = 0;
    if (!ready) {
        if (n_in != 20 || out_size != NB * S * D) { fprintf(stderr, "kernel_launch: unexpected problem shape\n"); ready = -1; return; }
        if (ws_size < WS_NEED) { fprintf(stderr, "kernel_launch: workspace too small: need %zu have %zu\n", (size_t)WS_NEED, ws_size); ready = -1; return; }
        if (hipFuncSetAttribute((const void*)mk_fwd, hipFuncAttributeMaxDynamicSharedMemorySize, LDS_BYTES) != hipSuccess) { fprintf(stderr, "kernel_launch: hipFuncSetAttribute failed\n"); ready = -1; return; }
        ready = 1;
    }
    if (ready < 0) return;
    Args a{};
    for (int i = 0; i < 20; ++i) a.in[i] = (const float*)d_in[i];
    a.out = (float*)d_out; a.ws = (unsigned char*)d_ws; a.rep_attn = 1; a.attn_var = 0; a.pad2 = 0;
    for (int i = 0; i < 16; ++i) a.rep[i] = 1;
#if defined(MK_REP_ATTN)
    a.rep_attn = MK_REP_ATTN;
#endif
#if defined(MK_ATTN_VAR)
    a.attn_var = MK_ATTN_VAR;
#endif
#if defined(MK_REP_PHASE)
    a.rep[MK_REP_PHASE] = MK_REP_COUNT;
#endif
    (void)hipMemsetAsync(d_ws, 0, CTL_BYTES, stream);
    const int grid = 256;
#if !MK_DEBUG
#ifndef MK_CUTS
    a.ph_lo = 0; a.ph_hi = N_PHASES; a.li = 0;
    hipLaunchKernelGGL(mk_fwd, dim3(grid), dim3(512), LDS_BYTES, stream, a);
#if defined(MK_STAMP)
    k_encode<<<1024, 256, 0, stream>>>((const unsigned long long*)((unsigned char*)d_ws + WS_NEED), (float*)d_out, (size_t)out_size);
#endif
#else
    for (int p = 0; p < N_PHASES; ++p) { a.ph_lo = p; a.ph_hi = p + 1; a.li = 0; hipLaunchKernelGGL(mk_fwd, dim3(grid), dim3(512), LDS_BYTES, stream, a); }
#endif
#else
    unsigned char* ws = (unsigned char*)d_ws;
    size_t off = (WS_NEED + 255) & ~(size_t)255;
    auto take = [&](size_t nfloats) { float* p = (float*)(ws + off); off += ((nfloats * 4 + 255) & ~(size_t)255); return p; };
    float* DIAG = take(256);
    float* Hr = take((size_t)RB * D); float* Pr = take((size_t)RB * 2560); float* CCr = take((size_t)RB * D); float* Or = take((size_t)RB * D); float* Yr = take((size_t)RB * D);
    float* Z = Yr; float* F = Or;        float* TABr = take((size_t)S * 2 * S); float* TABcr = take((size_t)L * 2 * L);
    float* MODr = take((size_t)2 * 17 * MODW); float* SILr = take(17 * 1024); float* LAMr = take(64); float* RCr = take(1024); float* RSr = take(1024); float* C64r = take(4096); float* S64r = take(4096);
    float* A_lat = take((size_t)S * D); float* A_ctx = take((size_t)L * D); float* B_lat = take((size_t)S * D); float* B_ctx = take((size_t)L * D); float* XS_lat = B_lat; float* XS_ctx = B_ctx;
    int4* SELr = (int4*)take((size_t)RB * 4);
    if (off > ws_size) { fprintf(stderr, "kernel_launch(debug): workspace too small: need %zu have %zu\n", off, ws_size); return; }
    (void)hipMemsetAsync(DIAG, 0, 1024, stream);
    const float* x = a.in[I_X]; const float* ctx = a.in[I_CTX];
    bf16_t* Hn = (bf16_t*)(ws + OFF_ARENA + AR_H); bf16_t* QKVn = (bf16_t*)(ws + OFF_ARENA + AR_QKV); bf16_t* CCn = (bf16_t*)(ws + OFF_ARENA + AR_CC); bf16_t* On = (bf16_t*)(ws + OFF_ARENA + AR_O); bf16_t* Y2n = (bf16_t*)(ws + OFF_ARENA + AR_Y2);
    float* MODn = (float*)(ws + OFF_MOD); float* LAMn = (float*)(ws + OFF_LAM); bf16_t* RESn = (bf16_t*)(ws + OFF_RES); int4* SELn = (int4*)(ws + OFF_SELN);
    auto run = [&](int p) { a.ph_lo = p; a.ph_hi = p + 1; a.li = 0; hipLaunchKernelGGL(mk_fwd, dim3(grid), dim3(512), LDS_BYTES, stream, a); };
    const int CB = 1024;
    ref::k_prep_small<<<(17 * 1024 + 255) / 256, 256, 0, stream>>>(a.in[I_C], a.in[I_CCTX], a.in[I_LAMQK], SILr, LAMr, RCr, RSr, C64r, S64r);
    ref::k_prep_tab<<<(unsigned)(((size_t)S * 2 * S + 255) / 256), 256, 0, stream>>>(TABr, S);
    ref::k_prep_tab<<<(unsigned)(((size_t)L * 2 * L + 255) / 256), 256, 0, stream>>>(TABcr, L);
    ref::k_mod<<<dim3(MODW / 64, 2), 256, 0, stream>>>(SILr, a.in[I_WMOD], a.in[I_BMOD], MODr);
    run(0);
    dbg::k_cmp_f32<<<CB, 256, 0, stream>>>(MODr, MODW, MODn, MODW, 34, MODW, DIAG, 1, 0); dbg::k_cmp_f32<<<CB, 256, 0, stream>>>(MODr, MODW, MODn, MODW, 34, MODW, DIAG, 1, 1);
    dbg::k_cmp_f32<<<1, 64, 0, stream>>>(LAMr, 2, LAMn, 2, 1, 2, DIAG, 1, 0); dbg::k_cmp_f32<<<1, 64, 0, stream>>>(LAMr, 2, LAMn, 2, 1, 2, DIAG, 1, 1);
    run(1);
    int nst = 1;
#ifndef MK_DBG_PHASES
#define MK_DBG_PHASES 16
#endif
    for (int l = 0; l < 2; ++l) {
        const bool last = (l == 1); const int pb = 2 + 7 * l, sb = 2 + 9 * l, j0 = last ? L : 0, nr = RB - j0;
        if (pb >= MK_DBG_PHASES) break;
        const float* MODl = MODn + (size_t)l * 17 * MODW;
        const float* win = a.in[I_WIN] + (size_t)l * D * 2560; const float* wout = a.in[I_WOUT] + (size_t)l * D * D; const float* wf = a.in[I_WF] + (size_t)l * 4 * 64 * 64;
        const float omli = (float)(1.0 - (0.8 - 0.6 * exp(-0.3 * (double)l)));
        if (last) { dbg::k_cvt<<<CB, 256, 0, stream>>>(RESn + (size_t)L * D, D, XS_lat, D, S, D, 1.f); dbg::k_cvt<<<CB, 256, 0, stream>>>(RESn, D, XS_ctx, D, L, D, 1.f); }
        const float* xl = l == 0 ? x : XS_lat; const float* xc = l == 0 ? ctx : XS_ctx;
        ref::k_lnmod<<<RB / 4, 256, 0, stream>>>(xl, xc, MODl, Hr, 0, 0, RB);
        dbg::k_cmp_bf16<<<CB, 256, 0, stream>>>(Hr, D, Hn, D, RB, D, 1.f, DIAG, sb + 0, 0); dbg::k_cmp_bf16<<<CB, 256, 0, stream>>>(Hr, D, Hn, D, RB, D, 1.f, DIAG, sb + 0, 1); nst = sb + 0;
        run(pb + 0);
        dbg::k_cvt<<<CB, 256, 0, stream>>>(Hn, D, Hr, D, RB, D, 1.f);
        ref::k_gemm_f32<<<dim3(2560 / 64, RB / 64), 256, 0, stream>>>(Hr, D, win, 2560, Pr, 2560, D);
        ref::k_rope<<<(S * 2 * 12 * 2 * 16 + 255) / 256, 256, 0, stream>>>(Pr, RCr, RSr);
        dbg::k_cmp_bf16<<<CB, 256, 0, stream>>>(Pr + (size_t)j0 * 2560 + 256, 2560, QKVn + (size_t)j0 * QKVW, QKVW, nr, 768, QSCALE, DIAG, sb + 1, 0); dbg::k_cmp_bf16<<<CB, 256, 0, stream>>>(Pr + (size_t)j0 * 2560 + 256, 2560, QKVn + (size_t)j0 * QKVW, QKVW, nr, 768, QSCALE, DIAG, sb + 1, 1);
        dbg::k_cmp_bf16<<<CB, 256, 0, stream>>>(Pr + 1024, 2560, QKVn + 768, QKVW, RB, 1536, 1.f, DIAG, sb + 1, 0); dbg::k_cmp_bf16<<<CB, 256, 0, stream>>>(Pr + 1024, 2560, QKVn + 768, QKVW, RB, 1536, 1.f, DIAG, sb + 1, 1); nst = sb + 1;
        if (pb + 1 >= MK_DBG_PHASES) break;
        run(pb + 1);
        ref::k_fz<<<(2 * S * 256 + 255) / 256, 256, 0, stream>>>(Pr, C64r, S64r, Z, S, L);
        ref::k_gemm_f32<<<dim3(256 / 64, S / 64), 256, 0, stream>>>(TABr, 2 * S, Z, 256, F, 256, 2 * S);
        ref::k_fmap<<<(S * 256 + 255) / 256, 256, 0, stream>>>(F, wf, CCr, S, L, 1.0f / sqrtf((float)S * 64.f));
        if (!last) {
            ref::k_fz<<<(2 * L * 256 + 255) / 256, 256, 0, stream>>>(Pr, C64r, S64r, Z, L, 0);
            ref::k_gemm_f32<<<dim3(256 / 64, L / 64), 256, 0, stream>>>(TABcr, 2 * L, Z, 256, F, 256, 2 * L);
            ref::k_fmap<<<(L * 256 + 255) / 256, 256, 0, stream>>>(F, wf, CCr, L, 0, 1.0f / sqrtf((float)L * 64.f));
        }
        dbg::k_four_recon<<<CB, 256, 0, stream>>>(CCn, CW, (const float*)(ws + OFF_MH) + (size_t)l * 2 * 4 * 64 * 64, Hr, D, RB);
        dbg::k_cmp_f32<<<CB, 256, 0, stream>>>(CCr + (size_t)j0 * D, D, Hr + (size_t)j0 * D, D, nr, 256, DIAG, sb + 2, 0); dbg::k_cmp_f32<<<CB, 256, 0, stream>>>(CCr + (size_t)j0 * D, D, Hr + (size_t)j0 * D, D, nr, 256, DIAG, sb + 2, 1); nst = sb + 2;
        dbg::k_cvt<<<CB, 256, 0, stream>>>(QKVn, QKVW, Pr + 256, 2560, RB, 768, 1.f / QSCALE);
        dbg::k_cvt<<<CB, 256, 0, stream>>>(QKVn + 768, QKVW, Pr + 1024, 2560, RB, 1536, 1.f);
        ref::k_attn_naive<<<dim3(nr, 6), 256, 0, stream>>>(Pr, CCr, LAMn, a.in[I_SUBLN], l, omli, j0);
        dbg::k_cmp_bf16<<<CB, 256, 0, stream>>>(CCr + (size_t)j0 * D + 256, D, CCn + (size_t)j0 * CW + 512, CW, nr, 768, 1.f, DIAG, sb + 3, 0); dbg::k_cmp_bf16<<<CB, 256, 0, stream>>>(CCr + (size_t)j0 * D + 256, D, CCn + (size_t)j0 * CW + 512, CW, nr, 768, 1.f, DIAG, sb + 3, 1); nst = sb + 3;
        if (pb + 2 >= MK_DBG_PHASES) break;
        run(pb + 2);
        dbg::k_four_recon<<<CB, 256, 0, stream>>>(CCn, CW, (const float*)(ws + OFF_MH) + (size_t)l * 2 * 4 * 64 * 64, CCr, D, RB);
        dbg::k_cvt<<<CB, 256, 0, stream>>>(CCn + 512, CW, CCr + 256, D, RB, 768, 1.f);
        ref::k_gemm_f32<<<dim3(D / 64, nr / 64), 256, 0, stream>>>(CCr + (size_t)j0 * D, D, wout, D, Or + (size_t)j0 * D, D, D);
        dbg::k_cmp_bf16<<<CB, 256, 0, stream>>>(Or + (size_t)j0 * D, D, On + (size_t)j0 * D, D, nr, D, 1.f, DIAG, sb + 4, 0); dbg::k_cmp_bf16<<<CB, 256, 0, stream>>>(Or + (size_t)j0 * D, D, On + (size_t)j0 * D, D, nr, D, 1.f, DIAG, sb + 4, 1); nst = sb + 4;
        if (pb + 3 >= MK_DBG_PHASES) break;
        dbg::k_cvt<<<CB, 256, 0, stream>>>(On, D, Or, D, RB, D, 1.f);

        run(pb + 3);
        ref::k_post_attn<<<nr / 4, 256, 0, stream>>>(last ? XS_lat : x, last ? XS_ctx : ctx, Or, MODl, a.in[I_LNAG] + l * D, a.in[I_LNAB] + l * D, A_lat, A_ctx, Hr, a.in[I_WR], a.in[I_RB], SELr, 0, j0, nr);
        dbg::k_cmp_bf16<<<CB, 256, 0, stream>>>(A_lat, D, RESn + (size_t)L * D, D, S, D, 1.f, DIAG, sb + 5, 0); dbg::k_cmp_bf16<<<CB, 256, 0, stream>>>(A_lat, D, RESn + (size_t)L * D, D, S, D, 1.f, DIAG, sb + 5, 1);
        if (!last) { dbg::k_cmp_bf16<<<CB, 256, 0, stream>>>(A_ctx, D, RESn, D, L, D, 1.f, DIAG, sb + 5, 0); dbg::k_cmp_bf16<<<CB, 256, 0, stream>>>(A_ctx, D, RESn, D, L, D, 1.f, DIAG, sb + 5, 1); }
        dbg::k_cmp_bf16<<<CB, 256, 0, stream>>>(Hr + (size_t)j0 * D, D, On + (size_t)j0 * D, D, nr, D, 1.f, DIAG, sb + 6, 0); dbg::k_cmp_bf16<<<CB, 256, 0, stream>>>(Hr + (size_t)j0 * D, D, On + (size_t)j0 * D, D, nr, D, 1.f, DIAG, sb + 6, 1);
        dbg::k_cmp_sel<<<16, 256, 0, stream>>>(SELr + j0, SELn + j0, nr, DIAG, sb + 6); nst = sb + 6;
        dbg::k_cvt<<<CB, 256, 0, stream>>>(On, D, Hr, D, RB, D, 1.f);
        if (pb + 5 >= MK_DBG_PHASES) break;
        run(pb + 4); run(pb + 5);
        ref::k_moe_naive<<<nr, 256, 0, stream>>>(Hr, SELn, a.in[I_WG], a.in[I_WUP], a.in[I_WDN], Yr, l, j0);
        dbg::k_cmp_bf16_sum2<<<CB, 256, 0, stream>>>(Yr + (size_t)j0 * D, D, Y2n + (size_t)(2 * j0) * D, Y2n + (size_t)(2 * j0 + 1) * D, 2 * D, nr, D, DIAG, sb + 7, 0); dbg::k_cmp_bf16_sum2<<<CB, 256, 0, stream>>>(Yr + (size_t)j0 * D, D, Y2n + (size_t)(2 * j0) * D, Y2n + (size_t)(2 * j0 + 1) * D, 2 * D, nr, D, DIAG, sb + 7, 1); nst = sb + 7;
        if (pb + 6 >= MK_DBG_PHASES) break;
        dbg::k_cvt<<<CB, 256, 0, stream>>>(RESn + (size_t)L * D, D, A_lat, D, S, D, 1.f); dbg::k_cvt<<<CB, 256, 0, stream>>>(RESn, D, A_ctx, D, L, D, 1.f);
        dbg::k_cvt_sum2<<<CB, 256, 0, stream>>>(Y2n, Y2n + D, 2 * D, Yr, D, RB, D);
        run(pb + 6);
        ref::k_post_ffn<<<nr / 4, 256, 0, stream>>>(A_lat, A_ctx, Yr, MODl, a.in[I_LNFG] + l * D, a.in[I_LNFB] + l * D, B_lat, B_ctx, 0, j0, nr);
        if (last) dbg::k_cmp_f32<<<CB, 256, 0, stream>>>(B_lat, D, a.out, D, S, D, DIAG, sb + 8, 0); else dbg::k_cmp_bf16<<<CB, 256, 0, stream>>>(B_lat, D, RESn + (size_t)L * D, D, S, D, 1.f, DIAG, sb + 8, 0); if (last) dbg::k_cmp_f32<<<CB, 256, 0, stream>>>(B_lat, D, a.out, D, S, D, DIAG, sb + 8, 1); else dbg::k_cmp_bf16<<<CB, 256, 0, stream>>>(B_lat, D, RESn + (size_t)L * D, D, S, D, 1.f, DIAG, sb + 8, 1);
        if (!last) { dbg::k_cmp_bf16<<<CB, 256, 0, stream>>>(B_ctx, D, RESn, D, L, D, 1.f, DIAG, sb + 8, 0); dbg::k_cmp_bf16<<<CB, 256, 0, stream>>>(B_ctx, D, RESn, D, L, D, 1.f, DIAG, sb + 8, 1); }
        nst = sb + 8;
    }
#if MK_DBG_PHASES < 16
    (void)hipMemsetAsync(d_out, 0, (size_t)out_size * 4, stream);
#endif
    dbg::k_final<<<1024, 256, 0, stream>>>(DIAG, nst, (float*)d_out, (size_t)out_size);
#endif
}
```

```cpp
#include <hip/hip_runtime.h>
#include <math.h>
#include <stdio.h>
#ifndef MK_DEBUG
#define MK_DEBUG 0
#endif
#undef MK_DEBUG
#define MK_DEBUG 0
typedef unsigned short bf16_t;
typedef short bf16x8 __attribute__((ext_vector_type(8)));
typedef short s16x4 __attribute__((ext_vector_type(4)));
typedef float f32x4 __attribute__((ext_vector_type(4)));
typedef float f32x16 __attribute__((ext_vector_type(16)));
typedef unsigned u32x4 __attribute__((ext_vector_type(4)));
typedef unsigned u32x2 __attribute__((ext_vector_type(2)));
typedef float f32x2_t __attribute__((ext_vector_type(2)));
typedef __bf16 bf16x2_t __attribute__((ext_vector_type(2)));
#define LAS __attribute__((address_space(3)))

__device__ __forceinline__ unsigned cvtpk(float lo, float hi) { f32x2_t v = {lo, hi}; bf16x2_t b = __builtin_convertvector(v, bf16x2_t); return __builtin_bit_cast(unsigned, b); }
__device__ __forceinline__ float bf_lo(unsigned w) { return __uint_as_float(w << 16); }
__device__ __forceinline__ float bf_hi(unsigned w) { return __uint_as_float(w & 0xffff0000u); }
__device__ __forceinline__ float bf2f(bf16_t b) { return __uint_as_float(((unsigned)b) << 16); }

#define XB_TMO      128
#define XB_XCNT(j)  (256  + 64 * (j))
#define XB_XSUB(j)  (1280 + 64 * (j))
#define XB_XGEN(j)  (2304 + 64 * (j))
#define XB_TOP      3328
#define XB_TOPGEN   3392
#define XCD_BAR_WORDS 3456
#define XB_SPIN_CAP (1u << 18)
__device__ __forceinline__ unsigned xb_ld(unsigned* p)              { return __hip_atomic_load(p, __ATOMIC_RELAXED, __HIP_MEMORY_SCOPE_AGENT); }
__device__ __forceinline__ unsigned xb_add(unsigned* p, unsigned v) { return __hip_atomic_fetch_add(p, v, __ATOMIC_RELAXED, __HIP_MEMORY_SCOPE_AGENT); }
__device__ __forceinline__ unsigned xb_xcc_id() { return (unsigned)__builtin_amdgcn_s_getreg((3 << 11) | 20) & 0xFu; }
#define XB_SPIN(cond, bar) do { unsigned _sp = 0; while (cond) { __builtin_amdgcn_s_sleep(1); \
    if ((++_sp & 255u) == 0u) { if (xb_ld(&(bar)[XB_TMO])) break; if (_sp > XB_SPIN_CAP) { atomicAdd(&(bar)[XB_TMO], 1u); break; } } } } while (0)
struct XcdBarrier { unsigned* bar; unsigned x; volatile LAS unsigned* st; };
__device__ __forceinline__ XcdBarrier xcd_barrier_post(unsigned* bar, volatile LAS unsigned* st) {
    XcdBarrier b; b.bar = bar; b.x = xb_xcc_id(); b.st = st;
    if (threadIdx.x == 0) (void)xb_add(&bar[XB_XCNT(b.x)], 1u);
    return b;
}
__device__ __forceinline__ void xcd_barrier_complete(unsigned* bar, unsigned x, unsigned& nloc, unsigned& nx) {
    const unsigned G = gridDim.x * gridDim.y * gridDim.z;
    unsigned sum, cnt, mine, sp = 0u;
    for (;;) {
        sum = 0u; cnt = 0u; mine = 0u;
#pragma unroll
        for (unsigned j = 0; j < 16; ++j) { const unsigned c = xb_ld(&bar[XB_XCNT(j)]); sum += c; cnt += (c > 0u) ? 1u : 0u; mine = (j == x) ? c : mine; }
        if (sum == G) break;
        __builtin_amdgcn_s_sleep(1);
        if ((++sp & 255u) == 0u) { if (xb_ld(&bar[XB_TMO])) break; if (sp > XB_SPIN_CAP) { atomicAdd(&bar[XB_TMO], 1u); break; } }
    }
    nloc = mine > 0u ? mine : 1u; nx = cnt > 0u ? cnt : 1u;
}
__device__ __forceinline__ void xcd_barrier(const XcdBarrier& b, unsigned long long* stamp = nullptr) {
    asm volatile("s_waitcnt vmcnt(0)" ::: "memory");
    __syncthreads();
    if (threadIdx.x == 0) {
        unsigned* bar = b.bar;
        __builtin_amdgcn_s_waitcnt(0);
        unsigned nloc = b.st[0], nx = b.st[1];
        if (nloc == 0u) { xcd_barrier_complete(bar, b.x, nloc, nx); b.st[0] = nloc; b.st[1] = nx; }
        const unsigned old = xb_add(&bar[XB_XSUB(b.x)], 1u);
        const unsigned gen = old / nloc;
        if (old + 1u == (gen + 1u) * nloc) {
            __builtin_amdgcn_fence(__ATOMIC_RELEASE, "agent");
            asm volatile("s_waitcnt vmcnt(0)" ::: "memory");
            const unsigned og = xb_add(&bar[XB_TOP], 1u);
            const unsigned tg = og / nx;
            if (og + 1u == (tg + 1u) * nx) xb_add(&bar[XB_TOPGEN], 1u);
            else XB_SPIN(xb_ld(&bar[XB_TOPGEN]) == tg, bar);
            __builtin_amdgcn_fence(__ATOMIC_ACQUIRE, "agent");
            xb_add(&bar[XB_XGEN(b.x)], 1u);
            asm volatile("s_waitcnt vmcnt(0)" ::: "memory");
        } else {
            XB_SPIN(xb_ld(&bar[XB_XGEN(b.x)]) == gen, bar);
            __builtin_amdgcn_fence(__ATOMIC_ACQUIRE, "agent");
            asm volatile("s_waitcnt vmcnt(0)" ::: "memory");
        }
        if (stamp) *stamp = wall_clock64();
    }
    __syncthreads();
}

namespace g8 {
constexpr int BM = 256, BK = 64, HALF = 128, HTB = HALF * BK * 2, STAGE_BYTES = 8 * HTB;
__device__ __forceinline__ int lds_byte(int r, int c) { const int st = (r >> 4) * 2 + (c >> 5), rr = r & 15, cc = c & 31, ob = rr * 64 + cc * 2; return st * 1024 + (ob ^ (((ob >> 9) & 1) << 5)); }
__device__ __forceinline__ void stage_rc(int b, int& R, int& C) { const int st = b / 1024, sb = b % 1024, swz = sb ^ (((sb >> 9) & 1) << 5); R = (st >> 1) * 16 + swz / 64; C = (st & 1) * 32 + (swz % 64) / 2; }
__device__ __forceinline__ int perm32(int rho) { const int n = rho >> 4, i = rho & 15; return 8 * (i >> 2) + 4 * n + (i & 3); }

struct Unit { const char* A; const char* B; const int* gl; int gcount; int kind, p0, p1; };

template <bool GATHER, class Epi, class Sched>
__device__ __forceinline__ void gemm_phase(LAS unsigned char* lds, const int K, const unsigned lda2, const unsigned ldb2, const Sched& S, const Epi& E) {
    int tid = threadIdx.x; asm volatile("" : "+v"(tid));
    const int wid = __builtin_amdgcn_readfirstlane(tid >> 6), lane = tid & 63, wr = wid >> 2, wc = wid & 3, fr = lane & 15, fq = lane >> 4;
    const int nt = K / BK;
    int Rr[2], Cc[2];
    unsigned vB[2];
#pragma unroll
    for (int i = 0; i < 2; ++i) { stage_rc(tid * 16 + i * 8192, Rr[i], Cc[i]); const int Rb = (Rr[i] & ~31) + perm32(Rr[i] & 31); vB[i] = (unsigned)Rb * ldb2 + (unsigned)Cc[i] * 2u; }
    const unsigned hB = (unsigned)HALF * ldb2, hA = (unsigned)HALF * lda2;
    const size_t kstep = (size_t)(BK * 2);
    const unsigned ldsw = (unsigned)wid * 1024u;
    const int aoff = lds_byte(wr * 64 + fr, fq * 8), boff = lds_byte(wc * 32 + fr, fq * 8);
    Unit cur, nxt; int ui = 0;
    if (!S.next(0, cur)) return;
    unsigned vA[2][2], nvA[2][2];
#define G8_CALCVA(u, v) do { _Pragma("unroll") for (int _h = 0; _h < 2; ++_h) _Pragma("unroll") for (int _i = 0; _i < 2; ++_i) { const int _r = _h * HALF + Rr[_i]; \
        if (GATHER) { const int _tok = (_r < (u).gcount) ? ((u).gl[_r] >> 1) : 256;     v[_h][_i] = (unsigned)_tok * lda2 + (unsigned)Cc[_i] * 2u; } \
        else v[_h][_i] = (unsigned)_r * lda2 + (unsigned)Cc[_i] * 2u; } } while (0)
    G8_CALCVA(cur, vA);
#define G8_SA(b, h) (((b) * 2 + (h)) * HTB)
#define G8_SB(b, h) ((4 + (b) * 2 + (h)) * HTB)
#define G8_STAGE_A(bufoff, gbase, VV, hh) do { _Pragma("unroll") for (int _i = 0; _i < 2; ++_i) \
        __builtin_amdgcn_global_load_lds((const unsigned*)(((const char*)(gbase) + (GATHER ? (size_t)0 : (size_t)((hh) * hA))) + VV[GATHER ? (hh) : 0][_i]), (LAS unsigned*)(lds + (bufoff) + ldsw + _i * 8192), 16, 0, 0); } while (0)
#define G8_STAGE_B(bufoff, gbase, h) do { _Pragma("unroll") for (int _i = 0; _i < 2; ++_i) \
        __builtin_amdgcn_global_load_lds((const unsigned*)((const char*)(gbase) + (size_t)((h) * hB) + vB[_i]), (LAS unsigned*)(lds + (bufoff) + ldsw + _i * 8192), 16, 0, 0); } while (0)
#define G8_LDA(dst, b, h) do { _Pragma("unroll") for (int m = 0; m < 4; ++m) _Pragma("unroll") for (int k = 0; k < 2; ++k) dst[m][k] = *(const LAS bf16x8*)(lds + G8_SA(b, h) + aoff + m * 2048 + k * 1024); } while (0)
#define G8_LDB(dst, b, h) do { _Pragma("unroll") for (int n = 0; n < 2; ++n) _Pragma("unroll") for (int k = 0; k < 2; ++k) dst[n][k] = *(const LAS bf16x8*)(lds + G8_SB(b, h) + boff + n * 2048 + k * 1024); } while (0)
#define G8_MMA(ai, bj, At, Bt) do { __builtin_amdgcn_s_setprio(1); _Pragma("unroll") for (int m = 0; m < 4; ++m) _Pragma("unroll") for (int n = 0; n < 2; ++n) _Pragma("unroll") for (int k = 0; k < 2; ++k) \
        acc[ai][bj][m][n] = __builtin_amdgcn_mfma_f32_16x16x32_bf16(Bt[n][k], At[m][k], acc[ai][bj][m][n], 0, 0, 0); __builtin_amdgcn_s_setprio(0); } while (0)
#define G8_WAIT_V(n) asm volatile("s_waitcnt vmcnt(" #n ")" ::: "memory")
#define G8_WAIT_L(n) asm volatile("s_waitcnt lgkmcnt(" #n ")" ::: "memory")
#define G8_BAR __builtin_amdgcn_s_barrier()
#define G8_SCHED __builtin_amdgcn_sched_barrier(0)
    f32x4 acc[2][2][4][2];
#pragma unroll
    for (int a = 0; a < 2; ++a)
#pragma unroll
        for (int b = 0; b < 2; ++b)
#pragma unroll
            for (int m = 0; m < 4; ++m)
#pragma unroll
                for (int n = 0; n < 2; ++n) acc[a][b][m][n] = (f32x4){0.f, 0.f, 0.f, 0.f};
    bf16x8 At[4][2], B0[2][2], B1[2][2];
    const char* cA = cur.A; const char* cB = cur.B;
    G8_STAGE_B(G8_SB(0, 0), cB, 0); G8_STAGE_B(G8_SB(0, 1), cB, 1); G8_STAGE_A(G8_SA(0, 0), cA, vA, 0); G8_STAGE_A(G8_SA(0, 1), cA, vA, 1);
    if (wr == 1) G8_BAR;
    G8_WAIT_V(2); G8_BAR;
    G8_STAGE_B(G8_SB(1, 0), cB + kstep, 0); G8_STAGE_A(G8_SA(1, 0), cA + kstep, vA, 0); G8_STAGE_B(G8_SB(1, 1), cB + kstep, 1);
    G8_WAIT_V(6); G8_BAR;
    for (;;) {
        const bool has_next = S.next(ui + 1, nxt);
        const char* nA = has_next ? nxt.A : cA; const char* nB = has_next ? nxt.B : cB;
        if (GATHER && has_next) { G8_CALCVA(nxt, nvA); } else {
#pragma unroll
            for (int h = 0; h < 2; ++h)
#pragma unroll
                for (int i = 0; i < 2; ++i) nvA[h][i] = vA[h][i]; }
#pragma clang loop unroll(disable)
        for (int t = 0; t < nt; t += 2) {
            const bool last = (t == nt - 2);
            const char* a1 = cA + (size_t)(t + 1) * kstep;
            const char* a2 = last ? nA : cA + (size_t)(t + 2) * kstep; const char* b2 = last ? nB : cB + (size_t)(t + 2) * kstep;
            const char* a3 = a2 + kstep; const char* b3 = b2 + kstep;
            unsigned o2[2][2];
#pragma unroll
            for (int h = 0; h < 2; ++h)
#pragma unroll
                for (int i = 0; i < 2; ++i) o2[h][i] = (GATHER && last) ? nvA[h][i] : vA[h][i];
            G8_LDB(B0, 0, 0); G8_LDB(B1, 0, 1); G8_SCHED; G8_LDA(At, 0, 0); G8_STAGE_A(G8_SA(1, 1), a1, vA, 1);
            G8_WAIT_V(8); G8_WAIT_L(0); G8_BAR; G8_MMA(0, 0, At, B0); G8_MMA(0, 1, At, B1); G8_BAR; G8_SCHED;
            G8_LDA(At, 0, 1); G8_STAGE_B(G8_SB(0, 0), b2, 0); G8_STAGE_B(G8_SB(0, 1), b2, 1); G8_STAGE_A(G8_SA(0, 0), a2, o2, 0);
            G8_WAIT_V(8); G8_WAIT_L(0); G8_BAR; G8_MMA(1, 0, At, B0); G8_MMA(1, 1, At, B1); G8_BAR; G8_SCHED;
            G8_LDB(B0, 1, 0); G8_LDB(B1, 1, 1); G8_SCHED; G8_LDA(At, 1, 0); G8_STAGE_A(G8_SA(0, 1), a2, o2, 1);
            G8_WAIT_V(8); G8_WAIT_L(0); G8_BAR; G8_MMA(0, 0, At, B0); G8_MMA(0, 1, At, B1); G8_BAR; G8_SCHED;
            G8_LDA(At, 1, 1); G8_STAGE_B(G8_SB(1, 0), b3, 0); G8_STAGE_B(G8_SB(1, 1), b3, 1); G8_STAGE_A(G8_SA(1, 0), a3, o2, 0);
            G8_WAIT_V(8); G8_WAIT_L(0); G8_BAR; G8_MMA(1, 0, At, B0); G8_MMA(1, 1, At, B1); G8_BAR; G8_SCHED;
        }
        if (wr == 0) G8_BAR;
        E(acc, cur, wr, wc, fr, fq);
        if (!has_next) break;
#pragma unroll
        for (int a = 0; a < 2; ++a)
#pragma unroll
            for (int b = 0; b < 2; ++b)
#pragma unroll
                for (int m = 0; m < 4; ++m)
#pragma unroll
                    for (int n = 0; n < 2; ++n) acc[a][b][m][n] = (f32x4){0.f, 0.f, 0.f, 0.f};
        cur = nxt; cA = nA; cB = nB; ++ui;
#pragma unroll
        for (int h = 0; h < 2; ++h)
#pragma unroll
            for (int i = 0; i < 2; ++i) vA[h][i] = nvA[h][i];
        if (wr == 1) G8_BAR;
    }
    G8_WAIT_V(0);
    G8_BAR;
#undef G8_CALCVA
#undef G8_SA
#undef G8_SB
#undef G8_STAGE_A
#undef G8_STAGE_B
#undef G8_LDA
#undef G8_LDB
#undef G8_MMA
#undef G8_WAIT_V
#undef G8_WAIT_L
#undef G8_BAR
#undef G8_SCHED
}
}
namespace mk {
constexpr int NB = 16, S = 2048, L = 256, D = 1024, RB = L + S, NTOK = NB * RB;
constexpr int QKVW = 2304, CW = 1280, MODW = 6 * D, CAP = NTOK, NPAIR = 2 * NTOK, SORT_ROWS = NPAIR + 16 * 256;
constexpr float ALPHA = 1.41421356237309515f, EPS = 1e-5f, QSCALE = 0.125f * 1.4426950408889634f;
constexpr size_t al256(size_t x) { return (x + 255) & ~(size_t)255; }
constexpr size_t CTL_BYTES = 65536, CTL_BAR_STRIDE = 13824  , CTL_CNT = 57344  ;
constexpr size_t OFF_MOD = CTL_BYTES, SZ_MOD = (size_t)2 * 17 * MODW * 4;
constexpr size_t OFF_LAM = OFF_MOD + al256(SZ_MOD);
constexpr size_t OFF_RC = OFF_LAM + 256, OFF_RS = OFF_RC + 4096;
constexpr size_t OFF_MH = OFF_RS + 4096, SZ_MH = (size_t)2 * 2 * 4 * 64 * 64 * 4;
constexpr size_t OFF_TABL = OFF_MH + SZ_MH, SZ_TABL = (size_t)2 * S * S * 2;
constexpr size_t OFF_TABC = OFF_TABL + SZ_TABL, SZ_TABC = (size_t)2 * L * L * 2;
constexpr size_t OFF_WQKV = OFF_TABC + SZ_TABC, SZ_WQKV = (size_t)2 * QKVW * D * 2;
constexpr size_t OFF_WU = OFF_WQKV + SZ_WQKV, SZ_WU = (size_t)2 * 512 * D * 2;
constexpr size_t OFF_WOUT = OFF_WU + SZ_WU, SZ_WOUT = (size_t)2 * D * CW * 2;
constexpr size_t OFF_LIST = OFF_WOUT + SZ_WOUT, SZ_LIST = (size_t)16 * CAP * 4;
constexpr size_t OFF_WPAIR = OFF_LIST + SZ_LIST, SZ_WPAIR = (size_t)16 * CAP * 4;
constexpr size_t OFF_SELN = OFF_WPAIR + SZ_WPAIR, SZ_SELN = (size_t)NTOK * 16;
constexpr size_t OFF_RES = OFF_SELN + SZ_SELN, SZ_RES = (size_t)NTOK * D * 2;
constexpr size_t OFF_ARENA = OFF_RES + SZ_RES;
constexpr size_t SZ_H = (size_t)NTOK * D * 2, SZ_CC = (size_t)NTOK * CW * 2, SZ_QKV = (size_t)NTOK * QKVW * 2, SZ_UTL = (size_t)NB * 2 * 256 * S * 2, SZ_UTC = (size_t)NB * 2 * 256 * L * 2;
constexpr size_t SZ_ASORT = (size_t)SORT_ROWS * 512 * 2, SZ_Y2 = (size_t)NPAIR * D * 2, SZ_WGU = (size_t)16 * 1024 * 1024 * 2, SZ_WD = (size_t)16 * 1024 * 512 * 2;
constexpr size_t AR_H = 0, AR_CC = 0, AR_QKV = SZ_CC, AR_UTL = AR_QKV + SZ_QKV, AR_UTC = AR_UTL + SZ_UTL, AR_O = SZ_CC, AR_ASORT = 0, AR_Y2 = SZ_ASORT, AR_WGU = AR_Y2 + SZ_Y2, AR_WD = AR_WGU + SZ_WGU;
constexpr size_t SZ_ARENA = (AR_UTC + SZ_UTC) > (AR_WD + SZ_WD) ? (AR_UTC + SZ_UTC) : (AR_WD + SZ_WD);
constexpr size_t WS_NEED = OFF_ARENA + SZ_ARENA;
static_assert(AR_ASORT + SZ_ASORT <= AR_O, "ASORT must not overlap O/H2");
static_assert(AR_WGU >= AR_O + SZ_H, "MoE weights must not overlap O/H2");
static_assert(AR_H + SZ_H <= AR_Y2, "next layer's H must not overlap Y2");
constexpr int LDS_MISC = 131072, LDS_ROPE = LDS_MISC + 4096  , LDS_BYTES = LDS_ROPE + 8192;

struct Args {
    const float* in[20]; float* out; unsigned char* ws; int ph_lo, ph_hi, li, rep_attn; int rep[16]; int attn_var, pad2;
};
enum { I_X = 0, I_C, I_CTX, I_CCTX, I_WMOD, I_BMOD, I_WIN, I_WF, I_LAMQK, I_SUBLN, I_WOUT, I_LNAG, I_LNAB, I_LNFG, I_LNFB, I_WR, I_RB, I_WG, I_WUP, I_WDN };

template <class T> __device__ __forceinline__ T* wsp(const Args& a, size_t off) { return (T*)(a.ws + off); }

__device__ __forceinline__ float wave_sum(float v) {
    v += __builtin_bit_cast(float, __builtin_amdgcn_update_dpp(0, __builtin_bit_cast(int, v), 0xB1, 0xF, 0xF, true));
    v += __builtin_bit_cast(float, __builtin_amdgcn_update_dpp(0, __builtin_bit_cast(int, v), 0x4E, 0xF, 0xF, true));
    v += __builtin_bit_cast(float, __builtin_amdgcn_update_dpp(0, __builtin_bit_cast(int, v), 0x124, 0xF, 0xF, true));
    v += __builtin_bit_cast(float, __builtin_amdgcn_update_dpp(0, __builtin_bit_cast(int, v), 0x128, 0xF, 0xF, true));
    const int vi = __builtin_bit_cast(int, v);
    return (__builtin_bit_cast(float, __builtin_amdgcn_readlane(vi, 0)) + __builtin_bit_cast(float, __builtin_amdgcn_readlane(vi, 16))) +
           (__builtin_bit_cast(float, __builtin_amdgcn_readlane(vi, 32)) + __builtin_bit_cast(float, __builtin_amdgcn_readlane(vi, 48)));
}
struct Row { f32x4 v[4]; };
__device__ __forceinline__ Row row_load(const float* p, int lane) { Row r;
#pragma unroll
    for (int i = 0; i < 4; ++i) r.v[i] = *(const f32x4*)(p + i * 256 + lane * 4);
    return r; }
__device__ __forceinline__ void row_store(float* p, int lane, const Row& r) {
#pragma unroll
    for (int i = 0; i < 4; ++i) *(f32x4*)(p + i * 256 + lane * 4) = r.v[i]; }
__device__ __forceinline__ Row row_load_bf16(const bf16_t* p, int lane) { Row r;
#pragma unroll
    for (int i = 0; i < 4; ++i) { const u32x2 w = *(const u32x2*)(p + i * 256 + lane * 4); r.v[i] = (f32x4){bf_lo(w.x), bf_hi(w.x), bf_lo(w.y), bf_hi(w.y)}; }
    return r; }
struct RowB { u32x2 w[4]; };
__device__ __forceinline__ RowB rowb_load(const bf16_t* p, int lane) { RowB r;
#pragma unroll
    for (int i = 0; i < 4; ++i) r.w[i] = *(const u32x2*)(p + i * 256 + lane * 4);
    return r; }
__device__ __forceinline__ Row rowb_f32(const RowB& b) { Row r;
#pragma unroll
    for (int i = 0; i < 4; ++i) r.v[i] = (f32x4){bf_lo(b.w[i].x), bf_hi(b.w[i].x), bf_lo(b.w[i].y), bf_hi(b.w[i].y)};
    return r; }
__device__ __forceinline__ void row_store_bf16(bf16_t* p, int lane, const Row& r) {
#pragma unroll
    for (int i = 0; i < 4; ++i) { u32x2 w; w.x = cvtpk(r.v[i][0], r.v[i][1]); w.y = cvtpk(r.v[i][2], r.v[i][3]); *(u32x2*)(p + i * 256 + lane * 4) = w; } }
__device__ __forceinline__ void row_ln(Row& r) {
    float s = 0.f;
#pragma unroll
    for (int i = 0; i < 4; ++i) s += (r.v[i][0] + r.v[i][1]) + (r.v[i][2] + r.v[i][3]);
    const float mean = wave_sum(s) * (1.f / 1024.f);
    float q = 0.f;
#pragma unroll
    for (int i = 0; i < 4; ++i) { r.v[i] = r.v[i] - mean; q += (r.v[i][0] * r.v[i][0] + r.v[i][1] * r.v[i][1]) + (r.v[i][2] * r.v[i][2] + r.v[i][3] * r.v[i][3]); }
    const float rstd = rsqrtf(wave_sum(q) * (1.f / 1024.f) + EPS);
#pragma unroll
    for (int i = 0; i < 4; ++i) r.v[i] = r.v[i] * rstd;
}
__device__ __forceinline__ bf16_t* res_ptr(const Args& a, int row) { return wsp<bf16_t>(a, OFF_RES) + (size_t)row * D; }
__device__ __forceinline__ float* out_ptr(const Args& a, int row) { const int b = row / RB, j = row - b * RB; return a.out + ((size_t)b * S + (j - L)) * D; }
__device__ __forceinline__ const float* xin_ptr(const Args& a, int row) { const int b = row / RB, j = row - b * RB; return j < L ? a.in[I_CTX] + ((size_t)b * L + j) * D : a.in[I_X] + ((size_t)b * S + (j - L)) * D; }
__device__ __forceinline__ int thin_row(int i, bool last) { return last ? ((i >> 11) * RB + L + (i & 2047)) : i; }

__device__ __forceinline__ void tr_item(const float* __restrict__ src, size_t ld_src, bf16_t* __restrict__ dst, size_t ld_dst, int lane) {
    float v[64];
#pragma unroll
    for (int r = 0; r < 64; ++r) v[r] = src[(size_t)r * ld_src + lane];
    bf16_t* d = dst + (size_t)lane * ld_dst;
#pragma unroll
    for (int q = 0; q < 8; ++q) { u32x4 w; w.x = cvtpk(v[q * 8 + 0], v[q * 8 + 1]); w.y = cvtpk(v[q * 8 + 2], v[q * 8 + 3]); w.z = cvtpk(v[q * 8 + 4], v[q * 8 + 5]); w.w = cvtpk(v[q * 8 + 6], v[q * 8 + 7]); *(u32x4*)(d + q * 8) = w; }
}

__device__ __forceinline__ void phase0a(const Args& a, LAS unsigned char* lds) {
    int tid = threadIdx.x; asm volatile("" : "+v"(tid));
    const int lane = tid & 63, wid = __builtin_amdgcn_readfirstlane(tid >> 6), blk = blockIdx.x, G = gridDim.x, gw = blk * 8 + wid, nw = G * 8, gt = blk * 512 + tid, ntr = G * 512;
    if (blk < 192) {
        LAS float* SIL = (LAS float*)lds; LAS float* red = (LAS float*)(lds + 69632);
        for (int i = tid; i < 17 * 1024; i += 512) { const float x = i < 16 * 1024 ? a.in[I_C][i] : a.in[I_CCTX][i - 16 * 1024]; SIL[i] = x / (1.f + __expf(-x)); }
        __syncthreads();
        for (int item = blk; item < 192; item += G) {
            const int l = item / 96, cg = item - l * 96, n = cg * 64 + lane;
            float acc[17];
#pragma unroll
            for (int r = 0; r < 17; ++r) acc[r] = 0.f;
            const float* w = a.in[I_WMOD] + (size_t)l * D * MODW;
            float wn[8];
#pragma unroll
            for (int q = 0; q < 8; ++q) wn[q] = (w + (size_t)(wid * 128 + q) * MODW)[n];
            for (int k0 = wid * 128; k0 < wid * 128 + 128; k0 += 8) {
                float wv[8];
#pragma unroll
                for (int q = 0; q < 8; ++q) wv[q] = wn[q];
                if (k0 + 8 < wid * 128 + 128) {
#pragma unroll
                    for (int q = 0; q < 8; ++q) wn[q] = (w + (size_t)(k0 + 8 + q) * MODW)[n]; }
#pragma unroll
                for (int r = 0; r < 17; ++r) { const f32x4 s0 = *(const LAS f32x4*)(SIL + r * 1024 + k0), s1 = *(const LAS f32x4*)(SIL + r * 1024 + k0 + 4);
                    acc[r] += ((s0[0] * wv[0] + s0[1] * wv[1]) + (s0[2] * wv[2] + s0[3] * wv[3])) + ((s1[0] * wv[4] + s1[1] * wv[5]) + (s1[2] * wv[6] + s1[3] * wv[7])); }
            }
#pragma unroll
            for (int r = 0; r < 17; ++r) red[(wid * 17 + r) * 64 + lane] = acc[r];
            __syncthreads();
            if (wid == 0) {
#pragma unroll
                for (int r = 0; r < 17; ++r) { float s = a.in[I_BMOD][(size_t)l * MODW + n];
#pragma unroll
                    for (int q = 0; q < 8; ++q) s += red[(q * 17 + r) * 64 + lane];
                    wsp<float>(a, OFF_MOD)[((size_t)l * 17 + r) * MODW + n] = s; }
            }
            __syncthreads();
        }
    }
    for (int it = gw; it < 1152 + 128 + 384; it += nw) {
        if (it < 1152) { const int l = it / 576, r = it - l * 576, kb = r / 36, nb = r - kb * 36;
            tr_item(a.in[I_WIN] + (size_t)l * D * 2560 + (size_t)(kb * 64) * 2560 + 256 + nb * 64, 2560, wsp<bf16_t>(a, OFF_WQKV) + ((size_t)l * QKVW + nb * 64) * D + kb * 64, D, lane);
        } else if (it < 1152 + 128) { const int q = it - 1152, l = q >> 6, r = q & 63, kb = r >> 2, nb = r & 3;
            tr_item(a.in[I_WIN] + (size_t)l * D * 2560 + (size_t)(kb * 64) * 2560 + nb * 64, 2560, wsp<bf16_t>(a, OFF_WU) + ((size_t)l * 256 + nb * 64) * D + kb * 64, D, lane);
        } else { const int q = it - 1280, l = q / 192, r = q - l * 192, kb = 4 + (r >> 4), nb = r & 15;
            const float* src = a.in[I_WOUT] + (size_t)l * D * D + (size_t)(kb * 64) * D + nb * 64;
            bf16_t* dst = wsp<bf16_t>(a, OFF_WOUT) + ((size_t)l * D + nb * 64) * CW;
            tr_item(src, D, dst + kb * 64 + 256, CW, lane);
        }
    }
    {
        const float nl = 0.0027621358640099515f  , nc = 0.0078125f  ;
        bf16_t* TL = wsp<bf16_t>(a, OFF_TABL); bf16_t* TC = wsp<bf16_t>(a, OFF_TABC);
        for (int it = gt; it < S * (S / 8) + L * (L / 8); it += ntr) {
            int T, tp, t0; float nn; bf16_t* base;
            if (it < S * (S / 8)) { T = S; tp = it / (S / 8); t0 = (it - tp * (S / 8)) * 8; nn = nl; base = TL; }
            else { const int q = it - S * (S / 8); T = L; tp = q / (L / 8); t0 = (q - tp * (L / 8)) * 8; nn = nc; base = TC; }
            float cv[8], sv[8];
#pragma unroll
            for (int j = 0; j < 8; ++j) { const int m = ((t0 + j) * tp) & (T - 1); const float x = 2.f * (float)m / (float)T; cv[j] = cospif(x) * nn; sv[j] = -sinpif(x) * nn; }
            u32x4 wc, wsn; wc.x = cvtpk(cv[0], cv[1]); wc.y = cvtpk(cv[2], cv[3]); wc.z = cvtpk(cv[4], cv[5]); wc.w = cvtpk(cv[6], cv[7]);
            wsn.x = cvtpk(sv[0], sv[1]); wsn.y = cvtpk(sv[2], sv[3]); wsn.z = cvtpk(sv[4], sv[5]); wsn.w = cvtpk(sv[6], sv[7]);
            *(u32x4*)(base + (size_t)tp * T + t0) = wc; *(u32x4*)(base + (size_t)T * T + (size_t)tp * T + t0) = wsn;
        }
    }
    for (int i = gt; i < 65536 + 1024 + 2; i += ntr) {
        if (i < 65536) { const int d = i & 63, c = (i >> 6) & 63, g = (i >> 12) & 3, half = (i >> 14) & 1, l = i >> 15;
            const float* wf = a.in[I_WF] + ((size_t)(l * 4 + g) * 64) * 64 + d; float s = 0.f;
            for (int cp = 0; cp < 64; ++cp) { const int m = (c * cp) & 63; const float x = (float)m * (1.f / 32.f); s += (half ? sinpif(x) : cospif(x)) * wf[cp * 64]; }
            wsp<float>(a, OFF_MH)[i] = s;
        } else if (i < 65536 + 1024) { const int q = i - 65536, pos = q >> 4, f = q & 15; const float ang = (float)pos * powf(10000.f, -(float)f / 16.f);
            wsp<float>(a, OFF_RC)[q] = cosf(ang); wsp<float>(a, OFF_RS)[q] = sinf(ang);
        } else { const int l = i - 65536 - 1024; const float* q = a.in[I_LAMQK] + l * 256; float s1 = 0.f, s2 = 0.f;
            for (int k = 0; k < 64; ++k) { s1 += q[k] * q[64 + k]; s2 += q[128 + k] * q[192 + k]; }
            wsp<float>(a, OFF_LAM)[l] = expf(s1) - expf(s2) + (0.8f - 0.6f * expf(-0.3f * (float)l)); }
    }
}

__device__ __forceinline__ void h_from_row(const Args& a, Row& r, int row, int l, int sh_off, int sc_off, int lane) {
    row_ln(r);
    const int b = row / RB, j = row - b * RB;
    const float* mrow = wsp<float>(a, OFF_MOD) + ((size_t)l * 17 + (j < L ? 16 : b)) * MODW;
    const Row sh = row_load(mrow + sh_off, lane), sc = row_load(mrow + sc_off, lane);
#pragma unroll
    for (int i = 0; i < 4; ++i) r.v[i] = r.v[i] * (1.f + sc.v[i]) + sh.v[i];
}
__device__ __forceinline__ void h_from_row2(Row& r, const Row& sh, const Row& sc) {
    row_ln(r);
#pragma unroll
    for (int i = 0; i < 4; ++i) r.v[i] = r.v[i] * (1.f + sc.v[i]) + sh.v[i];
}
__device__ __forceinline__ const float* mod_row(const Args& a, int l, int row) { const int b = row / RB, j = row - b * RB; return wsp<float>(a, OFF_MOD) + ((size_t)l * 17 + (j < L ? 16 : b)) * MODW; }
__device__ __forceinline__ void phase0b(const Args& a) {
    int tid = threadIdx.x; asm volatile("" : "+v"(tid));
    const int lane = tid & 63, wid = __builtin_amdgcn_readfirstlane(tid >> 6), gw = blockIdx.x * 8 + wid, nw = gridDim.x * 8;
    {
        Row xA = {}, xB = {};
        auto proc = [&](Row& xr, const int row) __attribute__((always_inline)) {
            const float* mrow = mod_row(a, 0, row);
            const Row sh = row_load(mrow + 0, lane), sc = row_load(mrow + 1024, lane);
            Row r = xr;
            if (row + 2 * nw < NTOK) xr = row_load(xin_ptr(a, row + 2 * nw), lane);
            h_from_row2(r, sh, sc);
            row_store_bf16(wsp<bf16_t>(a, OFF_ARENA + AR_H) + (size_t)row * D, lane, r);
        };
        int row = gw;
        if (row < NTOK) xA = row_load(xin_ptr(a, row), lane);
        if (row + nw < NTOK) xB = row_load(xin_ptr(a, row + nw), lane);
        for (; row < NTOK; row += 2 * nw) { proc(xA, row); if (row + nw < NTOK) proc(xB, row + nw); }
    }
    for (int it = gw; it < 1024; it += nw) {
        const int l = it >> 9, half = (it >> 8) & 1, g = (it >> 6) & 3, nb = (it >> 2) & 15, cb = it & 3, n = nb * 64 + lane;
        const float* wcol = a.in[I_WOUT] + (size_t)l * D * D + (size_t)(g * 64) * D + n;
        float wv[64];
#pragma unroll
        for (int d = 0; d < 64; ++d) wv[d] = (a.in[I_WOUT] + (size_t)l * D * D + (size_t)(g * 64 + d) * D)[n];
        const float* mh = wsp<float>(a, OFF_MH) + ((size_t)((l * 2 + half) * 4 + g) * 64 + cb * 16) * 64;
        float acc[16];
#pragma unroll
        for (int c = 0; c < 16; ++c) { float s_ = 0.f;
#pragma unroll
            for (int d4 = 0; d4 < 16; ++d4) { const f32x4 m = *(const f32x4*)(mh + c * 64 + d4 * 4); s_ += (m[0] * wv[d4 * 4 + 0] + m[1] * wv[d4 * 4 + 1]) + (m[2] * wv[d4 * 4 + 2] + m[3] * wv[d4 * 4 + 3]); }
            acc[c] = s_; }
        (void)wcol;
        bf16_t* dst = wsp<bf16_t>(a, OFF_WOUT) + ((size_t)l * D + n) * CW + half * 256 + g * 64 + cb * 16;
        u32x4 w0, w1; w0.x = cvtpk(acc[0], acc[1]); w0.y = cvtpk(acc[2], acc[3]); w0.z = cvtpk(acc[4], acc[5]); w0.w = cvtpk(acc[6], acc[7]);
        w1.x = cvtpk(acc[8], acc[9]); w1.y = cvtpk(acc[10], acc[11]); w1.z = cvtpk(acc[12], acc[13]); w1.w = cvtpk(acc[14], acc[15]);
        *(u32x4*)dst = w0; *(u32x4*)(dst + 8) = w1;
    }
}

struct SchedInproj {
    const char* H; const char* WQ; const char* WUp; int G, c; bool last;
    __device__ __forceinline__ bool next(int i, g8::Unit& u) const {
        const int Lu = i * G + c, nq = last ? 1248 : 1296, nu = last ? 128 : 144;
        u.gl = nullptr; u.gcount = 0;
        if (Lu < nq) { int pm, pn;
            if (!last) { const int grp = Lu / 72, w = Lu - grp * 72; pm = grp * 8 + (w & 7); pn = w >> 3; }
            else if (Lu < 1152) { const int grp = Lu / 72, w = Lu - grp * 72, q = grp * 8 + (w & 7); pm = (q >> 3) * 9 + 1 + (q & 7); pn = w >> 3; }
            else { const int q = Lu - 1152; pm = (q & 15) * 9; pn = 3 + (q >> 4); }
            u.A = H + (size_t)pm * 256 * 2048; u.B = WQ + (size_t)pn * 256 * 2048; u.kind = 0; u.p0 = pm; u.p1 = pn; return true; }
        const int q = Lu - nq;
        if (q < nu) { const int tt = q, pmT = last ? ((tt >> 3) * 9 + 1 + (tt & 7)) : tt;
            u.A = WUp; u.B = H + (size_t)pmT * 256 * 2048; u.kind = 1; u.p0 = 0; u.p1 = pmT; return true; }
        return false;
    }
};
struct EpiInproj {
    bf16_t* QKV; bf16_t* UTL; bf16_t* UTC; const LAS float* RC; const LAS float* RS;
    __device__ __forceinline__ void operator()(const f32x4 (&acc)[2][2][4][2], const g8::Unit& u, int wr, int wc, int fr, int fq) const {
        if (u.kind == 0) {
            const int pm = u.p0, pn = u.p1, b = pm / 9, jt = pm - b * 9;
            const bool rope = (jt != 0) && (pn < 6);
            const float qs = pn < 3 ? QSCALE : 1.f, sgn = (fq & 2) ? 1.f : -1.f;
#pragma unroll
            for (int ai = 0; ai < 2; ++ai)
#pragma unroll
                for (int m = 0; m < 4; ++m) {
                    const int r = 128 * ai + 64 * wr + 16 * m + fr;
                    bf16_t* rowp = QKV + (size_t)(pm * 256 + r) * QKVW + pn * 256 + 32 * wc + 8 * fq;
                    f32x4 c0 = {1.f, 1.f, 1.f, 1.f}, c1 = c0, s0 = {0.f, 0.f, 0.f, 0.f}, s1 = s0;
                    if (rope) { const int t = (jt - 1) * 256 + r, pos = (wc & 1) ? (t & 63) : (t >> 6); const LAS float* cp = RC + pos * 16 + 8 * (fq & 1); const LAS float* sp = RS + pos * 16 + 8 * (fq & 1);
                        c0 = *(const LAS f32x4*)cp; c1 = *(const LAS f32x4*)(cp + 4); s0 = *(const LAS f32x4*)sp; s1 = *(const LAS f32x4*)(sp + 4); }
#pragma unroll
                    for (int bj = 0; bj < 2; ++bj) {
                        f32x4 v0 = acc[ai][bj][m][0], v1 = acc[ai][bj][m][1];
                        if (rope) { f32x4 p0, p1;
#pragma unroll
                            for (int j = 0; j < 4; ++j) {
                                auto ra = __builtin_amdgcn_permlane32_swap(__float_as_uint(v0[j]), __float_as_uint(v0[j]), false, false);
                                auto rb = __builtin_amdgcn_permlane32_swap(__float_as_uint(v1[j]), __float_as_uint(v1[j]), false, false);
                                p0[j] = __uint_as_float((fq & 2) ? ra[0] : ra[1]); p1[j] = __uint_as_float((fq & 2) ? rb[0] : rb[1]); }
                            v0 = v0 * c0 + (p0 * s0) * sgn; v1 = v1 * c1 + (p1 * s1) * sgn; }
                        v0 = v0 * qs; v1 = v1 * qs;
                        u32x4 w; w.x = cvtpk(v0[0], v0[1]); w.y = cvtpk(v0[2], v0[3]); w.z = cvtpk(v1[0], v1[1]); w.w = cvtpk(v1[2], v1[3]);
                        *(u32x4*)(rowp + bj * 128) = w; }
                }
        } else {
            const int pmT = u.p1, b = pmT / 9, jt = pmT - b * 9;
#pragma unroll
            for (int ai = 0; ai < 2; ++ai)
#pragma unroll
                for (int m = 0; m < 4; ++m) {
                    const int r = 128 * ai + 64 * wr + 16 * m + fr, col = 32 * wc + 8 * fq;
                    bf16_t* rowp = (jt == 0) ? UTC + ((size_t)(b * 256 + r)) * L + col : UTL + ((size_t)(b * 256 + r)) * S + (jt - 1) * 256 + col;
#pragma unroll
                    for (int bj = 0; bj < 2; ++bj) { const f32x4 v0 = acc[ai][bj][m][0], v1 = acc[ai][bj][m][1];
                        u32x4 w; w.x = cvtpk(v0[0], v0[1]); w.y = cvtpk(v0[2], v0[3]); w.z = cvtpk(v1[0], v1[1]); w.w = cvtpk(v1[2], v1[3]);
                        *(u32x4*)(rowp + bj * 128) = w; }
                }
        }
    }
};
struct EpiStore {
    bf16_t* dst; int ld;
    __device__ __forceinline__ void operator()(const f32x4 (&acc)[2][2][4][2], const g8::Unit& u, int wr, int wc, int fr, int fq) const {
#pragma unroll
        for (int ai = 0; ai < 2; ++ai)
#pragma unroll
            for (int m = 0; m < 4; ++m) { const int r = 128 * ai + 64 * wr + 16 * m + fr;
                bf16_t* rowp = dst + (size_t)(u.p0 + r) * ld + u.p1 + 32 * wc + 8 * fq;
#pragma unroll
                for (int bj = 0; bj < 2; ++bj) { const f32x4 v0 = acc[ai][bj][m][0], v1 = acc[ai][bj][m][1];
                    u32x4 w; w.x = cvtpk(v0[0], v0[1]); w.y = cvtpk(v0[2], v0[3]); w.z = cvtpk(v1[0], v1[1]); w.w = cvtpk(v1[2], v1[3]);
                    *(u32x4*)(rowp + bj * 128) = w; } }
    }
};
struct SchedFourier {
    const char* TAB; const char* UT; int G, c; bool ctx;
    __device__ __forceinline__ bool next(int i, g8::Unit& u) const {
        const int Lu = i * G + c; u.gl = nullptr; u.gcount = 0; u.kind = 2;
        if (!ctx) { if (Lu >= 256) return false; const int pm = Lu & 7, half = (Lu >> 3) & 1, b = Lu >> 4;
            u.A = TAB + ((size_t)half * S + pm * 256) * S * 2; u.B = UT + ((size_t)b * 256) * S * 2; u.p0 = b * RB + L + pm * 256; u.p1 = half * 256; return true; }
        if (Lu >= 32) return false; { const int half = Lu & 1, b = Lu >> 1;
            u.A = TAB + ((size_t)half * L) * L * 2; u.B = UT + ((size_t)b * 256) * L * 2; u.p0 = b * RB; u.p1 = half * 256; return true; }
    }
};
struct SchedOutproj {
    const char* CC; const char* W; int G, c; bool last;
    __device__ __forceinline__ bool next(int i, g8::Unit& u) const {
        const int Lu = i * G + c, n = last ? 512 : 576; if (Lu >= n) return false;
        const int grp = Lu >> 5, w = Lu & 31, q = grp * 8 + (w & 7), pn = w >> 3, pm = last ? ((q >> 3) * 9 + 1 + (q & 7)) : q;
        u.gl = nullptr; u.gcount = 0; u.kind = 2; u.A = CC + (size_t)pm * 256 * CW * 2; u.B = W + (size_t)pn * 256 * CW * 2; u.p0 = pm * 256; u.p1 = pn * 256; return true;
    }
};
struct SchedMoe {
    const LAS int* pre; const LAS int* cnt; const int* LIST; const char* Abase; const char* Wbase; size_t wstride; unsigned arow2, wtile2; int G, c; bool gather;
    __device__ __forceinline__ bool next(int i, g8::Unit& u) const {
        const int Lu = i * G + c, rt = Lu >> 2, pn = Lu & 3; if (rt >= pre[16]) return false;
        int e = 0;
#pragma unroll
        for (int q = 1; q < 16; ++q) e += (rt >= pre[q]) ? 1 : 0;
        const int lt = rt - pre[e], rem = cnt[e] - lt * 256;
        u.gl = LIST + (size_t)e * CAP + lt * 256; u.gcount = rem < 256 ? rem : 256; u.kind = 3; u.p0 = rt; u.p1 = pn;
        u.A = gather ? Abase : Abase + (size_t)rt * 256 * arow2; u.B = Wbase + (size_t)e * wstride + (size_t)pn * wtile2; return true;
    }
};
struct EpiGateUp {
    bf16_t* ASORT;
    __device__ __forceinline__ void operator()(const f32x4 (&acc)[2][2][4][2], const g8::Unit& u, int wr, int wc, int fr, int fq) const {
#pragma unroll
        for (int ai = 0; ai < 2; ++ai)
#pragma unroll
            for (int m = 0; m < 4; ++m) { const int r = 128 * ai + 64 * wr + 16 * m + fr;
                float o[8];
#pragma unroll
                for (int n = 0; n < 2; ++n)
#pragma unroll
                    for (int j = 0; j < 4; ++j) { const float g = acc[ai][0][m][n][j], up = acc[ai][1][m][n][j]; o[n * 4 + j] = g * __builtin_amdgcn_rcpf(1.f + __expf(-g)) * up; }
                u32x4 w; w.x = cvtpk(o[0], o[1]); w.y = cvtpk(o[2], o[3]); w.z = cvtpk(o[4], o[5]); w.w = cvtpk(o[6], o[7]);
                *(u32x4*)(ASORT + (size_t)(u.p0 * 256 + r) * 512 + u.p1 * 128 + 32 * wc + 8 * fq) = w; }
    }
};
struct EpiDown {
    bf16_t* Y2; const int* LIST; const float* WLIST;
    __device__ __forceinline__ void operator()(const f32x4 (&acc)[2][2][4][2], const g8::Unit& u, int wr, int wc, int fr, int fq) const {
        const float* wl = WLIST + (u.gl - LIST);
#pragma unroll
        for (int ai = 0; ai < 2; ++ai) {
            int pr[4]; float wg[4];
#pragma unroll
            for (int m = 0; m < 4; ++m) { const int r = 128 * ai + 64 * wr + 16 * m + fr; const bool ok = r < u.gcount; pr[m] = ok ? u.gl[r] : -1; wg[m] = ok ? wl[r] : 0.f; }
#pragma unroll
            for (int m = 0; m < 4; ++m) { const int pair = pr[m]; const float wgt = wg[m];
                if (pair >= 0) {
                    bf16_t* rowp = Y2 + (size_t)pair * D + u.p1 * 256 + 32 * wc + 8 * fq;
#pragma unroll
                    for (int bj = 0; bj < 2; ++bj) { const f32x4 v0 = acc[ai][bj][m][0] * wgt, v1 = acc[ai][bj][m][1] * wgt;
                        u32x4 w; w.x = cvtpk(v0[0], v0[1]); w.y = cvtpk(v0[2], v0[3]); w.z = cvtpk(v1[0], v1[1]); w.w = cvtpk(v1[2], v1[3]);
                        *(u32x4*)(rowp + bj * 128) = w; } } }
        }
    }
};

template <int N> struct IC { static constexpr int value = N; };
struct AttnUnit { int q_row0, key_row0, ntiles, h; };
__device__ __forceinline__ bool attn_next(int i, int v, int G, bool last, AttnUnit& u) {
    const int nl = (1536 - v + G - 1) / G;
    if (i < nl) { const int id = v + i * G, bh = id >> 4, qt = id & 15, b = bh / 6; u.h = bh - b * 6; u.q_row0 = b * RB + L + qt * 128; u.key_row0 = b * RB; u.ntiles = 36; return true; }
    if (last) return false;
    const int id = v + (i - nl) * G; if (id >= 192) return false;
    { const int bh = id >> 1, qt = id & 1, b = bh / 6; u.h = bh - b * 6; u.q_row0 = b * RB + qt * 128; u.key_row0 = b * RB; u.ntiles = 4; return true; }
}
#if defined(MK_ATTN_PROBE)
#define AT_VAR_DECL const int var = var_
#else
#define AT_VAR_DECL constexpr int var = 0
#endif
__device__ __forceinline__ void phase_attn(const Args& a, LAS unsigned char* lds, int l, const int var_) {
    AT_VAR_DECL;
    const bool last = (l == 1);
    const int c = blockIdx.x, G = gridDim.x, v = (c & 7) * (G >> 3) + (c >> 3);
    const bf16_t* __restrict__ QKV = wsp<bf16_t>(a, OFF_ARENA + AR_QKV); bf16_t* __restrict__ CC = wsp<bf16_t>(a, OFF_ARENA + AR_CC);
    const float lam = wsp<float>(a, OFF_LAM)[l], oml = 1.f - (0.8f - 0.6f * expf(-0.3f * (float)l));
    int tid = threadIdx.x; asm volatile("" : "+v"(tid));
    if (tid < 128) ((LAS float*)(lds + LDS_MISC + 3072))[tid] = a.in[I_SUBLN][l * 128 + tid];
    __syncthreads();
    const int lane = tid & 63, wid = __builtin_amdgcn_readfirstlane(tid >> 6);
    const int qb = wid & 3, sub = wid >> 2, r32 = lane & 31, hi = lane >> 5, ki = wid & 3;
    unsigned koffb[2], voffb[2];
#pragma unroll
    for (int e = 0; e < 2; ++e) {
        const int kk = 8 * (2 * ki + e) + (lane >> 3); koffb[e] = (unsigned)(kk * (QKVW * 2) + (768 + sub * 64) * 2 + (((lane & 7) ^ ((kk >> 1) & 7)) << 4));
        const int vk = 4 * (2 * wid + e) + (lane >> 4); voffb[e] = (unsigned)(vk * (QKVW * 2) + 1536 * 2 + (((lane & 15) ^ (((lane >> 4) << 2) | e)) << 4));
    }
    const size_t tstep = (size_t)64 * QKVW * 2;
    const unsigned kd = (unsigned)(sub * 8192 + (2 * ki) * 1024), vd = (unsigned)(16384 + (2 * wid) * 1024);
    int kaddr[4], vaddr[4];
    { const int i16 = lane & 15, q = i16 >> 2, pp = i16 & 3, g = (lane >> 4) & 1;
#pragma unroll
      for (int j = 0; j < 4; ++j) { kaddr[j] = sub * 8192 + r32 * 128 + (((2 * j + hi) ^ ((r32 >> 1) & 7)) << 4);
          vaddr[j] = 16384 + (4 * hi + q) * 256 + ((((j ^ q) << 2) | ((2 * g + (pp >> 1)) ^ hi)) << 4) + 8 * (pp & 1); } }
#define AT_GLDS(g, l) do { unsigned keep_; const void* g_ = (const void*)(g); const unsigned l_ = (unsigned)__builtin_amdgcn_readfirstlane((int)(unsigned)(size_t)(l)); \
        asm volatile("s_mov_b32 %0, m0\n\ts_mov_b32 m0, %2\n\ts_nop 0\n\tglobal_load_lds_dwordx4 %1, off\n\ts_mov_b32 m0, %0" : "=&s"(keep_) : "v"(g_), "s"(l_) : "memory"); } while (0)
#define AT_DMA(tb0, hK, hV, t, st) do { if (var & 1) break; const char* tb_ = (tb0) + (size_t)(t) * tstep; LAS unsigned char* sb_ = lds + (st) * 32768; \
        AT_GLDS(tb_ + (hK) + koffb[0], sb_ + kd); AT_GLDS(tb_ + (hK) + koffb[1], sb_ + kd + 1024); AT_GLDS(tb_ + (hV) + voffb[0], sb_ + vd); AT_GLDS(tb_ + (hV) + voffb[1], sb_ + vd + 1024); } while (0)
#define AT_EVEN() do { if (!(var & 16)) asm volatile("s_waitcnt vmcnt(0) lgkmcnt(0)\n\ts_barrier" ::: "memory"); } while (0)
#define AT_ODD() do { if (!(var & 16)) asm volatile("s_waitcnt lgkmcnt(0)\n\ts_barrier" ::: "memory"); } while (0)
#define AT_VRD(dst, d) do { _Pragma("unroll") for (int ks = 0; ks < 4; ++ks) { \
            const s16x4 lo_ = __builtin_bit_cast(s16x4, __builtin_amdgcn_ds_read_tr16_b64_v4i16((LAS s16x4*)(sb + vaddr[d] + ks * 4096))); \
            const s16x4 hh_ = __builtin_bit_cast(s16x4, __builtin_amdgcn_ds_read_tr16_b64_v4i16((LAS s16x4*)(sb + vaddr[d] + ks * 4096 + 2048))); \
            dst[ks] = (bf16x8){lo_[0], lo_[1], lo_[2], lo_[3], hh_[0], hh_[1], hh_[2], hh_[3]}; } } while (0)
#define AT_MMA4(d, src) do { _Pragma("unroll") for (int ks = 0; ks < 4; ++ks) oT[d] = __builtin_amdgcn_mfma_f32_32x32x16_bf16(src[ks], __builtin_bit_cast(bf16x8, pw[ks]), oT[d], 0, 0, 0); } while (0)
#define AT_SB() __builtin_amdgcn_sched_barrier(0)
    constexpr float THR = 6.f;
    AttnUnit u, un;
    if (!attn_next(0, v, G, last, u)) return;
    if (wid >= 4) __builtin_amdgcn_s_setprio(1);
    const char* tile0 = (const char*)(QKV + (size_t)u.key_row0 * QKVW); unsigned hK = (unsigned)(u.h * 256), hV = (unsigned)(u.h * 256);
    bf16x8 qr[4];
    { const bf16_t* qp = QKV + (size_t)(u.q_row0 + qb * 32 + r32) * QKVW + (2 * u.h + sub) * 64 + hi * 8;
#pragma unroll
      for (int d0 = 0; d0 < 4; ++d0) qr[d0] = *(const bf16x8*)(qp + d0 * 16); }
    AT_DMA(tile0, hK, hV, 0, 0);
    for (int ui = 0;; ++ui) {
        const int ntiles = u.ntiles;
        f32x16 oT[4];
#pragma unroll
        for (int d = 0; d < 4; ++d) oT[d] = (f32x16){};
        f32x16 negm = (f32x16){};
        float m_run = 0.f, l_run = 0.f;
        u32x4 pw[4];
        if (sub == 1) { AT_EVEN(); if (ntiles > 1) AT_DMA(tile0, hK, hV, 1, 1); }
        auto tile = [&](const int t, auto st_, auto st1_, auto st2_) __attribute__((always_inline)) {
            constexpr int ST = decltype(st_)::value, ST1 = decltype(st1_)::value, ST2 = decltype(st2_)::value;
            if (sub == 0) AT_EVEN(); else AT_ODD();
            LAS const unsigned char* sb = lds + ST * 32768;
            f32x16 p0 = negm, p1 = negm;
            bf16x8 va[4], vb[4];
            if (!(var & 2)) { bf16x8 kf[4];
#pragma unroll
              for (int j = 0; j < 2; ++j) { kf[2 * j] = *(LAS const bf16x8*)(sb + kaddr[j]); kf[2 * j + 1] = *(LAS const bf16x8*)(sb + kaddr[j] + 4096); }
              AT_SB();
              p0 = __builtin_amdgcn_mfma_f32_32x32x16_bf16(kf[0], qr[0], negm, 0, 0, 0); p1 = __builtin_amdgcn_mfma_f32_32x32x16_bf16(kf[1], qr[0], negm, 0, 0, 0);
              p0 = __builtin_amdgcn_mfma_f32_32x32x16_bf16(kf[2], qr[1], p0, 0, 0, 0); p1 = __builtin_amdgcn_mfma_f32_32x32x16_bf16(kf[3], qr[1], p1, 0, 0, 0);
              AT_SB();
#pragma unroll
              for (int j = 2; j < 4; ++j) { kf[2 * (j - 2)] = *(LAS const bf16x8*)(sb + kaddr[j]); kf[2 * (j - 2) + 1] = *(LAS const bf16x8*)(sb + kaddr[j] + 4096); }
              AT_SB();
              p0 = __builtin_amdgcn_mfma_f32_32x32x16_bf16(kf[0], qr[2], p0, 0, 0, 0); p1 = __builtin_amdgcn_mfma_f32_32x32x16_bf16(kf[1], qr[2], p1, 0, 0, 0);
              p0 = __builtin_amdgcn_mfma_f32_32x32x16_bf16(kf[2], qr[3], p0, 0, 0, 0); p1 = __builtin_amdgcn_mfma_f32_32x32x16_bf16(kf[3], qr[3], p1, 0, 0, 0);
            }
            if (sub == 0 && t + 1 < ntiles) AT_DMA(tile0, hK, hV, t + 1, ST1);
            if (!(var & 8)) { AT_VRD(va, 0); }
            AT_SB();
            if (!(var & 4)) {
            float ta = __builtin_fmaxf(__builtin_fmaxf(p0[0], p0[1]), p1[0]), tb = __builtin_fmaxf(__builtin_fmaxf(p0[2], p0[3]), p1[1]);
            ta = __builtin_fmaxf(__builtin_fmaxf(ta, p1[2]), p1[3]);
#pragma unroll
            for (int r = 4; r < 16; r += 4) { ta = __builtin_fmaxf(__builtin_fmaxf(ta, p0[r]), p0[r + 1]); tb = __builtin_fmaxf(__builtin_fmaxf(tb, p0[r + 2]), p0[r + 3]);
                ta = __builtin_fmaxf(__builtin_fmaxf(ta, p1[r]), p1[r + 1]); tb = __builtin_fmaxf(__builtin_fmaxf(tb, p1[r + 2]), p1[r + 3]); }
            float tm = __builtin_fmaxf(ta, tb);
            { auto rr = __builtin_amdgcn_permlane32_swap(__float_as_uint(tm), __float_as_uint(tm), false, false); tm = __builtin_fmaxf(__uint_as_float(rr[0]), __uint_as_float(rr[1])); }
            if (t == 0 || __any(tm > THR)) {
                const float dl = (t == 0) ? tm : __builtin_fmaxf(tm, 0.f);
                const float alpha = __builtin_amdgcn_exp2f(-dl);
                m_run += dl; l_run *= alpha;
#pragma unroll
                for (int d = 0; d < 4; ++d)
#pragma unroll
                    for (int r = 0; r < 16; ++r) oT[d][r] *= alpha;
#pragma unroll
                for (int r = 0; r < 16; ++r) { p0[r] -= dl; p1[r] -= dl; negm[r] = -m_run; }
            }
#pragma unroll
            for (int r = 0; r < 16; ++r) { p0[r] = __builtin_amdgcn_exp2f(p0[r]); p1[r] = __builtin_amdgcn_exp2f(p1[r]); }
#pragma unroll
            for (int q = 0; q < 4; ++q) { pw[0][q] = cvtpk(p0[2 * q], p0[2 * q + 1]); pw[1][q] = cvtpk(p0[8 + 2 * q], p0[8 + 2 * q + 1]); pw[2][q] = cvtpk(p1[2 * q], p1[2 * q + 1]); pw[3][q] = cvtpk(p1[8 + 2 * q], p1[8 + 2 * q + 1]); }
            } else {
#pragma unroll
                for (int q = 0; q < 4; ++q) { pw[0][q] = __float_as_uint(p0[q]); pw[1][q] = __float_as_uint(p0[4 + q]); pw[2][q] = __float_as_uint(p1[q]); pw[3][q] = __float_as_uint(p1[4 + q]); }
            }
            asm volatile("" : "+v"(pw[0]), "+v"(pw[1]), "+v"(pw[2]), "+v"(pw[3]));
            AT_SB();
            if (sub == 0) AT_ODD(); else AT_EVEN();
            AT_SB();
            if (!(var & 8)) {
                AT_VRD(vb, 1); AT_SB();
                AT_MMA4(0, va); AT_SB();
                if (sub == 1 && t + 2 < ntiles) AT_DMA(tile0, hK, hV, t + 2, ST2);
                AT_VRD(va, 2); AT_SB();
                AT_MMA4(1, vb);
                { float ls = 0.f;
#pragma unroll
                  for (int r = 0; r < 16; ++r) ls += p0[r];
                  l_run += ls; }
                AT_SB();
                AT_VRD(vb, 3); AT_SB();
                AT_MMA4(2, va);
                { float ls = 0.f;
#pragma unroll
                  for (int r = 0; r < 16; ++r) ls += p1[r];
                  l_run += ls; }
                AT_SB();
                AT_MMA4(3, vb); AT_SB();
            }
        };
        for (int t = 0; t < ntiles; t += 3) {
            tile(t, IC<0>{}, IC<1>{}, IC<2>{});
            if (t + 1 < ntiles) tile(t + 1, IC<1>{}, IC<2>{}, IC<0>{});
            if (t + 2 < ntiles) tile(t + 2, IC<2>{}, IC<0>{}, IC<1>{});
        }
        if (sub == 0) AT_EVEN();
        AT_ODD();
        int lane_e = lane; asm volatile("" : "+v"(lane_e));
        const int r32e = lane_e & 31, hie = lane_e >> 5;
        const bool has_next = attn_next(ui + 1, v, G, last, un);
        bf16x8 qn[4];
        const char* tile0n = tile0; unsigned hn = hK;
        if (has_next) { tile0n = (const char*)(QKV + (size_t)un.key_row0 * QKVW); hn = (unsigned)(un.h * 256);
            AT_DMA(tile0n, hn, hn, 0, 0);
            const bf16_t* qp = QKV + (size_t)(un.q_row0 + qb * 32 + r32e) * QKVW + (2 * un.h + sub) * 64 + hie * 8;
#pragma unroll
            for (int d0 = 0; d0 < 4; ++d0) qn[d0] = *(const bf16x8*)(qp + d0 * 16); }
        { auto rr = __builtin_amdgcn_permlane32_swap(__float_as_uint(l_run), __float_as_uint(l_run), false, false); l_run = __uint_as_float(rr[0]) + __uint_as_float(rr[1]); }
        const float inv = 1.f / l_run;
        LAS float* xch = (LAS float*)(lds + 65536 + qb * 16384);
        if (sub == 1) {
#pragma unroll
            for (int d = 0; d < 4; ++d)
#pragma unroll
                for (int r = 0; r < 16; ++r) xch[(d * 16 + r) * 64 + lane_e] = oT[d][r] * inv;
        }
        asm volatile("s_waitcnt lgkmcnt(0)\n\ts_barrier" ::: "memory");
        if (sub == 0) {
            float ss = 0.f;
#pragma unroll
            for (int d = 0; d < 4; ++d)
#pragma unroll
                for (int r = 0; r < 16; ++r) { const float o = oT[d][r] * inv - lam * xch[(d * 16 + r) * 64 + lane_e]; oT[d][r] = o; ss += o * o; }
            { auto rr = __builtin_amdgcn_permlane32_swap(__float_as_uint(ss), __float_as_uint(ss), false, false); ss = __uint_as_float(rr[0]) + __uint_as_float(rr[1]); }
            const float rms = rsqrtf(ss * (1.f / 128.f) + EPS) * oml;
            const LAS float* gl = (const LAS float*)(lds + LDS_MISC + 3072);
            LAS unsigned char* stg = (LAS unsigned char*)xch;
#pragma unroll
            for (int d = 0; d < 4; ++d)
#pragma unroll
                for (int rq = 0; rq < 4; ++rq) { const int dd = d * 32 + 8 * rq + 4 * hie;
                    const f32x4 g = *(const LAS f32x4*)(gl + dd);
                    u32x2 w; w.x = cvtpk(oT[d][rq * 4 + 0] * rms * g[0], oT[d][rq * 4 + 1] * rms * g[1]); w.y = cvtpk(oT[d][rq * 4 + 2] * rms * g[2], oT[d][rq * 4 + 3] * rms * g[3]);
                    *(LAS u32x2*)(stg + r32e * 272 + dd * 2) = w; }
            bf16_t* orow = CC + (size_t)(u.q_row0 + qb * 32) * CW + 512 + u.h * 128;
#pragma unroll
            for (int it = 0; it < 8; ++it) { const int row = it * 4 + (lane_e >> 4), ch = lane_e & 15;
                const u32x4 vv = *(const LAS u32x4*)(stg + row * 272 + ch * 16);
                *(u32x4*)(orow + (size_t)row * CW + ch * 8) = vv; }
        }
        asm volatile("s_waitcnt lgkmcnt(0)\n\ts_barrier" ::: "memory");
        if (!has_next) break;
        u = un; tile0 = tile0n; hK = hn; hV = hn;
#pragma unroll
        for (int d0 = 0; d0 < 4; ++d0) qr[d0] = qn[d0];
    }
    __builtin_amdgcn_s_setprio(0);
#undef AT_GLDS
#undef AT_DMA
#undef AT_EVEN
#undef AT_ODD
#undef AT_VRD
#undef AT_MMA4
#undef AT_SB
}

__device__ __forceinline__ void moe_weight_copies(const Args& a, int l, int gw, int nw, int lane) {
    bf16_t* WGU = wsp<bf16_t>(a, OFF_ARENA + AR_WGU); bf16_t* WD = wsp<bf16_t>(a, OFF_ARENA + AR_WD);
    for (int it = gw; it < 6144; it += nw) {
        if (it < 4096) { const int gu = it >> 11, q = it & 2047, e = q >> 7, r = q & 127, kb = r >> 3, nb = r & 7;
            const float* src = (gu ? a.in[I_WUP] : a.in[I_WG]) + ((size_t)(l * 16 + e) * 1024 + kb * 64) * 512 + nb * 64;
            tr_item(src, 512, WGU + ((size_t)e * 1024 + (nb >> 1) * 256 + gu * 128 + (nb & 1) * 64) * 1024 + kb * 64, 1024, lane);
        } else { const int q = it - 4096, e = q >> 7, r = q & 127, kb = r >> 4, nb = r & 15;
            const float* src = a.in[I_WDN] + ((size_t)(l * 16 + e) * 512 + kb * 64) * 1024 + nb * 64;
            tr_item(src, 1024, WD + ((size_t)e * 1024 + nb * 64) * 512 + kb * 64, 512, lane); }
    }
}
__device__ __forceinline__ void phase_post_attn(const Args& a, LAS unsigned char* lds, int l) {
    const bool last = (l == 1);
    int tid = threadIdx.x; asm volatile("" : "+v"(tid));
    const int lane = tid & 63, wid = __builtin_amdgcn_readfirstlane(tid >> 6), gw = blockIdx.x * 8 + wid, nw = gridDim.x * 8;
    LAS float* wrT = (LAS float*)lds;
    LAS int* lcnt = (LAS int*)(lds + LDS_MISC + 256); LAS int* gbase = (LAS int*)(lds + LDS_MISC + 384); LAS int* rec = (LAS int*)(lds + 65536);
    for (int i = tid; i < 16384; i += 512) wrT[(i & 15) * 1024 + (i >> 4)] = a.in[I_WR][i];
    if (tid < 16) lcnt[tid] = 0;
    __syncthreads();
    const int nrows = last ? NB * S : NTOK;
    bf16_t* OH = wsp<bf16_t>(a, OFF_ARENA + AR_O);
    int nrec = 0;
    const Row lgg = row_load(a.in[I_LNAG] + l * D, lane), lbb = row_load(a.in[I_LNAB] + l * D, lane);
    int i = gw; Row xa = {}, xb = {}; RowB ra = {}, rb = {}, oa = {}, oc = {};
    if (i < nrows) { const int row = thin_row(i, last); if (l == 0) xa = row_load(xin_ptr(a, row), lane); else ra = rowb_load(res_ptr(a, row), lane); oa = rowb_load(OH + (size_t)row * D, lane); }
    if (i + nw < nrows) { const int row = thin_row(i + nw, last); if (l == 0) xb = row_load(xin_ptr(a, row), lane); else rb = rowb_load(res_ptr(a, row), lane); oc = rowb_load(OH + (size_t)row * D, lane); }
    for (; i < nrows; i += nw) {
        const int row = thin_row(i, last);
        Row x = (l == 0) ? xa : rowb_f32(ra); const RowB ob = oa; xa = xb; ra = rb; oa = oc;
        const float* mrow = mod_row(a, l, row);
        const Row g = row_load(mrow + 2048, lane), msh = row_load(mrow + 3072, lane), msc = row_load(mrow + 4096, lane);
        if (i + 2 * nw < nrows) { const int nrow = thin_row(i + 2 * nw, last); if (l == 0) xb = row_load(xin_ptr(a, nrow), lane); else rb = rowb_load(res_ptr(a, nrow), lane); oc = rowb_load(OH + (size_t)nrow * D, lane); }
        { const Row o = rowb_f32(ob);
#pragma unroll
          for (int q = 0; q < 4; ++q) x.v[q] = x.v[q] * ALPHA + g.v[q] * o.v[q]; }
        row_ln(x);
#pragma unroll
        for (int q = 0; q < 4; ++q) x.v[q] = x.v[q] * lgg.v[q] + lbb.v[q];
        row_store_bf16(res_ptr(a, row), lane, x);
        h_from_row2(x, msh, msc);
        row_store_bf16(OH + (size_t)row * D, lane, x);
        float lg[16];
#pragma unroll
        for (int e = 0; e < 16; ++e) { float s = 0.f;
#pragma unroll
            for (int q = 0; q < 4; ++q) { const f32x4 w = *(const LAS f32x4*)(wrT + e * 1024 + q * 256 + lane * 4); s += (x.v[q][0] * w[0] + x.v[q][1] * w[1]) + (x.v[q][2] * w[2] + x.v[q][3] * w[3]); }
            lg[e] = wave_sum(s); }
        float sc[16], sel[16];
#pragma unroll
        for (int e = 0; e < 16; ++e) { sc[e] = 1.f / (1.f + expf(-lg[e])); sel[e] = sc[e] + a.in[I_RB][e]; }
        float best = -INFINITY; int bg = 0;
#pragma unroll
        for (int gI = 0; gI < 4; ++gI) {
            const float a0 = sel[gI * 4 + 0], a1 = sel[gI * 4 + 1], a2 = sel[gI * 4 + 2], a3 = sel[gI * 4 + 3];
            const float mx = fmaxf(fmaxf(a0, a1), fmaxf(a2, a3));
            float sec;
            if (a0 == mx) sec = fmaxf(a1, fmaxf(a2, a3)); else if (a1 == mx) sec = fmaxf(a0, fmaxf(a2, a3)); else if (a2 == mx) sec = fmaxf(fmaxf(a0, a1), a3); else sec = fmaxf(fmaxf(a0, a1), a2);
            const float gs = mx + sec;
            if (gs > best) { best = gs; bg = gI; }
        }
        float av[4], s4[4];
#pragma unroll
        for (int q = 0; q < 4; ++q) { av[q] = 0.f; s4[q] = 0.f; }
#pragma unroll
        for (int gI = 0; gI < 4; ++gI)
#pragma unroll
            for (int q = 0; q < 4; ++q) if (bg == gI) { av[q] = sel[gI * 4 + q]; s4[q] = sc[gI * 4 + q]; }
        int i0 = 0; float v0 = av[0];
#pragma unroll
        for (int q = 1; q < 4; ++q) if (av[q] > v0) { v0 = av[q]; i0 = q; }
        int i1 = -1; float v1 = -INFINITY;
#pragma unroll
        for (int q = 0; q < 4; ++q) if (q != i0 && av[q] > v1) { v1 = av[q]; i1 = q; }
        float w0 = 0.f, w1 = 0.f;
#pragma unroll
        for (int q = 0; q < 4; ++q) { if (q == i0) w0 = s4[q]; if (q == i1) w1 = s4[q]; }
        const float inv = 1.f / (w0 + w1); const int e0 = bg * 4 + i0, e1 = bg * 4 + i1;
        if (lane == 0) {
            const int p0 = __hip_atomic_fetch_add(lcnt + e0, 1, __ATOMIC_RELAXED, __HIP_MEMORY_SCOPE_WORKGROUP), p1 = __hip_atomic_fetch_add(lcnt + e1, 1, __ATOMIC_RELAXED, __HIP_MEMORY_SCOPE_WORKGROUP);
            LAS int* rc = rec + (wid * 18 + nrec) * 6; rc[0] = row; rc[1] = e0 | (e1 << 8); rc[2] = p0; rc[3] = p1;
            rc[4] = __float_as_int(w0 * inv); rc[5] = __float_as_int(w1 * inv);
            wsp<int4>(a, OFF_SELN)[row] = make_int4(e0, e1, __float_as_int(w0 * inv), __float_as_int(w1 * inv));
        }
        ++nrec;
    }
    __syncthreads();
    unsigned* CNT = wsp<unsigned>(a, CTL_CNT);
    if (tid < 16) gbase[tid] = (int)__hip_atomic_fetch_add(CNT + (l * 16 + tid) * 64, (unsigned)lcnt[tid], __ATOMIC_RELAXED, __HIP_MEMORY_SCOPE_AGENT);
    __syncthreads();
    if (lane < nrec) { const LAS int* rc = rec + (wid * 18 + lane) * 6; const int row = rc[0], e0 = rc[1] & 255, e1 = rc[1] >> 8;
        int* LIST = wsp<int>(a, OFF_LIST); int* WL = wsp<int>(a, OFF_WPAIR);
        const size_t p0 = (size_t)e0 * CAP + gbase[e0] + rc[2], p1 = (size_t)e1 * CAP + gbase[e1] + rc[3];
        LIST[p0] = 2 * row; LIST[p1] = 2 * row + 1; WL[p0] = rc[4]; WL[p1] = rc[5]; }
    if (l == 1) moe_weight_copies(a, l, gw, nw, lane);
}
__device__ __forceinline__ void moe_tables(const Args& a, LAS unsigned char* lds, int l) {
    LAS int* pre = (LAS int*)(lds + LDS_MISC + 64); LAS int* cnt = pre + 20;
    if (threadIdx.x == 0) { const unsigned* CNT = wsp<unsigned>(a, CTL_CNT); int s = 0;
        for (int e = 0; e < 16; ++e) { const int cN = (int)CNT[(l * 16 + e) * 64]; cnt[e] = cN; pre[e] = s; s += (cN + 255) >> 8; }
        pre[16] = s; }
    __syncthreads();
}
__device__ __forceinline__ void phase_post_ffn(const Args& a, int l) {
    const bool last = (l == 1);
    int tid = threadIdx.x; asm volatile("" : "+v"(tid));
    const int lane = tid & 63, wid = __builtin_amdgcn_readfirstlane(tid >> 6), gw = blockIdx.x * 8 + wid, nw = gridDim.x * 8;
    const int nrows = last ? NB * S : NTOK;
    const bf16_t* Y2 = wsp<bf16_t>(a, OFF_ARENA + AR_Y2);
    const Row gg = row_load(a.in[I_LNFG] + l * D, lane), bb = row_load(a.in[I_LNFB] + l * D, lane);
    int i = gw; RowB xa = {}, xb = {}; RowB y0a = {}, y1a = {}, y0c = {}, y1c = {};
    if (i < nrows) { const int row = thin_row(i, last); xa = rowb_load(res_ptr(a, row), lane); y0a = rowb_load(Y2 + (size_t)(2 * row) * D, lane); y1a = rowb_load(Y2 + (size_t)(2 * row + 1) * D, lane); }
    if (i + nw < nrows) { const int row = thin_row(i + nw, last); xb = rowb_load(res_ptr(a, row), lane); y0c = rowb_load(Y2 + (size_t)(2 * row) * D, lane); y1c = rowb_load(Y2 + (size_t)(2 * row + 1) * D, lane); }
    while (i < nrows) {
        const int row = thin_row(i, last), ni = i + nw;
        Row x = rowb_f32(xa); const RowB y0b = y0a, y1b = y1a; xa = xb; y0a = y0c; y1a = y1c;
        const float* mrow = mod_row(a, l, row);
        const Row g = row_load(mrow + 5120, lane);
        Row sh = {}, sc = {};
        if (!last) { const float* mrow1 = mod_row(a, 1, row); sh = row_load(mrow1 + 0, lane); sc = row_load(mrow1 + 1024, lane); }
        if (i + 2 * nw < nrows) { const int nrow = thin_row(i + 2 * nw, last); xb = rowb_load(res_ptr(a, nrow), lane); y0c = rowb_load(Y2 + (size_t)(2 * nrow) * D, lane); y1c = rowb_load(Y2 + (size_t)(2 * nrow + 1) * D, lane); }
        { const Row y0 = rowb_f32(y0b), y1 = rowb_f32(y1b);
#pragma unroll
          for (int q = 0; q < 4; ++q) x.v[q] = x.v[q] * ALPHA + g.v[q] * (y0.v[q] + y1.v[q]); }
        row_ln(x);
#pragma unroll
        for (int q = 0; q < 4; ++q) x.v[q] = x.v[q] * gg.v[q] + bb.v[q];
        if (last) row_store(out_ptr(a, row), lane, x); else row_store_bf16(res_ptr(a, row), lane, x);
        if (!last) { h_from_row2(x, sh, sc); row_store_bf16(wsp<bf16_t>(a, OFF_ARENA + AR_H) + (size_t)row * D, lane, x); }
        i = ni;
    }
}

constexpr int N_PHASES = 16;
__global__ void __launch_bounds__(512, 2) mk_fwd(Args a) {
    extern __shared__ __attribute__((aligned(16))) unsigned char smem[];
    LAS unsigned char* lds = (LAS unsigned char*)smem;
    if (threadIdx.x == 0) { *(LAS u32x4*)(lds + LDS_MISC) = (u32x4){0u, 0u, 0u, 0u};
#if defined(MK_STAMP)
        if (blockIdx.x == 0) wsp<unsigned long long>(a, WS_NEED)[0] = wall_clock64();
#endif
    }
    __syncthreads();
    XcdBarrier bar = xcd_barrier_post(wsp<unsigned>(a, (size_t)a.li * CTL_BAR_STRIDE), (volatile LAS unsigned*)(lds + LDS_MISC));
    const int G = gridDim.x, c = blockIdx.x;
    const int cv = (c & 7) * (G >> 3) + (c >> 3);
#ifndef MK_ONLY
#define MK_ONLY -1
#endif
#if defined(MK_STAMP)
#define MK_STAMP_PTR(k) (blockIdx.x == 0 ? wsp<unsigned long long>(a, WS_NEED) + (k) : nullptr)
#else
#define MK_STAMP_PTR(k) nullptr
#endif
#define MK_RUN(kind, p, ...) do { if constexpr (MK_ONLY < 0 || MK_ONLY == (kind)) { if ((p) >= a.ph_lo && (p) < a.ph_hi) { for (int r_ = 0; r_ < a.rep[(p)]; ++r_) { __VA_ARGS__; if ((p) + 1 < a.ph_hi || r_ + 1 < a.rep[(p)]) xcd_barrier(bar, MK_STAMP_PTR((p) + 1)); } } } } while (0)
    MK_RUN(0, 0, phase0a(a, lds));
    MK_RUN(1, 1, phase0b(a));
    for (int l = 0; l < 2; ++l) {
        const bool last = (l == 1); const int pb = 2 + 7 * l;
        MK_RUN(2, pb + 0, {
            SchedInproj Sc{(const char*)wsp<bf16_t>(a, OFF_ARENA + AR_H), (const char*)(wsp<bf16_t>(a, OFF_WQKV) + (size_t)l * QKVW * D), (const char*)(wsp<bf16_t>(a, OFF_WU) + (size_t)l * 256 * D), G, cv, last};
            { int tid_ = threadIdx.x; asm volatile("" : "+v"(tid_));
              for (int i_ = tid_; i_ < 2048; i_ += 512) ((LAS float*)(lds + LDS_ROPE))[i_] = (i_ < 1024 ? wsp<float>(a, OFF_RC)[i_] : wsp<float>(a, OFF_RS)[i_ - 1024]);
              __syncthreads(); }
            EpiInproj Ep{wsp<bf16_t>(a, OFF_ARENA + AR_QKV), wsp<bf16_t>(a, OFF_ARENA + AR_UTL), wsp<bf16_t>(a, OFF_ARENA + AR_UTC), (const LAS float*)(lds + LDS_ROPE), (const LAS float*)(lds + LDS_ROPE) + 1024};
            g8::gemm_phase<false>(lds, 1024, 2048u, 2048u, Sc, Ep); });
        MK_RUN(3, pb + 1, {
#ifndef MK_NO_ATTN
            for (int ra_ = 0; ra_ < a.rep_attn; ++ra_) phase_attn(a, lds, l, (ra_ + 1 < a.rep_attn) ? a.attn_var : 0);
#endif
#ifndef MK_NO_FOUR
            EpiStore Ep{wsp<bf16_t>(a, OFF_ARENA + AR_CC), CW};
            { SchedFourier Sc{(const char*)wsp<bf16_t>(a, OFF_TABL), (const char*)wsp<bf16_t>(a, OFF_ARENA + AR_UTL), G, cv, false}; g8::gemm_phase<false>(lds, 2048, 4096u, 4096u, Sc, Ep); }
            if (!last) { SchedFourier Sc{(const char*)wsp<bf16_t>(a, OFF_TABC), (const char*)wsp<bf16_t>(a, OFF_ARENA + AR_UTC), G, cv, true}; g8::gemm_phase<false>(lds, 256, 512u, 512u, Sc, Ep); }
#endif
            });
        MK_RUN(4, pb + 2, {
            SchedOutproj Sc{(const char*)wsp<bf16_t>(a, OFF_ARENA + AR_CC), (const char*)(wsp<bf16_t>(a, OFF_WOUT) + (size_t)l * D * CW), G, cv, last};
            EpiStore Ep{wsp<bf16_t>(a, OFF_ARENA + AR_O), D};
            g8::gemm_phase<false>(lds, CW, (unsigned)(CW * 2), (unsigned)(CW * 2), Sc, Ep);
            if (!last && cv >= 64) { int tid_ = threadIdx.x; asm volatile("" : "+v"(tid_));
                moe_weight_copies(a, l, (cv - 64) * 8 + __builtin_amdgcn_readfirstlane(tid_ >> 6), (G - 64) * 8, tid_ & 63); } });
        MK_RUN(5, pb + 3, phase_post_attn(a, lds, l));
        MK_RUN(6, pb + 4, {
            moe_tables(a, lds, l);
            SchedMoe Sc{(const LAS int*)(lds + LDS_MISC + 64), (const LAS int*)(lds + LDS_MISC + 64) + 20, wsp<int>(a, OFF_LIST), (const char*)wsp<bf16_t>(a, OFF_ARENA + AR_O), (const char*)wsp<bf16_t>(a, OFF_ARENA + AR_WGU), (size_t)1024 * 1024 * 2, 2048u, 256u * 2048u, G, cv, true};
            EpiGateUp Ep{wsp<bf16_t>(a, OFF_ARENA + AR_ASORT)};
            g8::gemm_phase<true>(lds, 1024, 2048u, 2048u, Sc, Ep); });
        MK_RUN(7, pb + 5, {
            moe_tables(a, lds, l);
            SchedMoe Sc{(const LAS int*)(lds + LDS_MISC + 64), (const LAS int*)(lds + LDS_MISC + 64) + 20, wsp<int>(a, OFF_LIST), (const char*)wsp<bf16_t>(a, OFF_ARENA + AR_ASORT), (const char*)wsp<bf16_t>(a, OFF_ARENA + AR_WD), (size_t)1024 * 512 * 2, 1024u, 256u * 1024u, G, cv, false};
            EpiDown Ep{wsp<bf16_t>(a, OFF_ARENA + AR_Y2), wsp<int>(a, OFF_LIST), wsp<float>(a, OFF_WPAIR)};
            g8::gemm_phase<false>(lds, 512, 1024u, 1024u, Sc, Ep); });
        MK_RUN(8, pb + 6, phase_post_ffn(a, l));
    }
#undef MK_RUN
#if defined(MK_STAMP)
    if (blockIdx.x == 0 && threadIdx.x == 0) wsp<unsigned long long>(a, WS_NEED)[N_PHASES] = wall_clock64();
#endif
}
#if defined(MK_STAMP)
__global__ void k_encode(const unsigned long long* st, float* out, size_t n) {
    const float d1 = (float)(st[MK_SB] - st[MK_SA]) * 0.01f / (float)(MK_UA), d2 = (float)(st[MK_SD] - st[MK_SC]) * 0.01f / (float)(MK_UB);
    const float M = fminf(fmaxf(d1, 1.f), 9.9f), E = fminf(fmaxf(rintf(d2), 0.f), 36.f);
    const float cval = sqrtf(M * 1.04f) * powf(10.f, 0.5f * E);
    for (size_t i = (size_t)blockIdx.x * blockDim.x + threadIdx.x; i < n; i += (size_t)gridDim.x * blockDim.x) out[i] = cval;
}
#endif
}
#if MK_DEBUG
namespace ref {
constexpr int NB = 16, S = 2048, L = 256, D = 1024, RB = L + S;
constexpr int INW = 2560, QOFF = 256, KOFF = 1024, VOFF = 1792;
constexpr int MODW = 6 * D;
constexpr float ALPHA = 1.41421356237309515f, EPS = 1e-5f;

__device__ __forceinline__ float wave_sum(float v) {
#pragma unroll
    for (int o = 32; o > 0; o >>= 1) v += __shfl_xor(v, o);
    return v;
}
__device__ __forceinline__ float wave_max(float v) {
#pragma unroll
    for (int o = 32; o > 0; o >>= 1) v = fmaxf(v, __shfl_xor(v, o));
    return v;
}
__device__ __forceinline__ float block_sum(float v, float* red) {
    v = wave_sum(v);
    __syncthreads();
    if ((threadIdx.x & 63) == 0) red[threadIdx.x >> 6] = v;
    __syncthreads();
    return red[0] + red[1] + red[2] + red[3];
}
__device__ __forceinline__ float block_max(float v, float* red) {
    v = wave_max(v);
    __syncthreads();
    if ((threadIdx.x & 63) == 0) red[threadIdx.x >> 6] = v;
    __syncthreads();
    return fmaxf(fmaxf(red[0], red[1]), fmaxf(red[2], red[3]));
}

__global__ void k_prep_small(const float* c, const float* c_ctx, const float* lam_qk, float* SIL, float* LAM, float* RC, float* RS, float* C64, float* S64) {
    const int i = blockIdx.x * blockDim.x + threadIdx.x;
    if (i < 17 * 1024) { const float x = i < 16 * 1024 ? c[i] : c_ctx[i - 16 * 1024]; SIL[i] = x / (1.f + expf(-x)); }
    if (i < 1024) { const int pos = i >> 4, f = i & 15; const float fr = powf(10000.f, -(float)f / 16.f); const float a = (float)pos * fr; RC[i] = cosf(a); RS[i] = sinf(a); }
    if (i < 4096) { const int a = i >> 6, b = i & 63; const int m = (a * b) & 63; C64[i] = cospif(2.f * (float)m / 64.f); S64[i] = sinpif(2.f * (float)m / 64.f); }
    if (i < 2) {
        const float* q = lam_qk + i * 256; float s1 = 0.f, s2 = 0.f;
        for (int k = 0; k < 64; ++k) { s1 += q[k] * q[64 + k]; s2 += q[128 + k] * q[192 + k]; }
        LAM[i] = expf(s1) - expf(s2) + (0.8f - 0.6f * expf(-0.3f * (float)i));
    }
}
__global__ void k_prep_tab(float* TAB, int T) {
    const size_t i = (size_t)blockIdx.x * blockDim.x + threadIdx.x;
    if (i >= (size_t)T * 2 * T) return;
    const int tp = (int)(i / (2 * T)), kk = (int)(i % (2 * T)), t = kk % T, part = kk / T;
    const int m = (int)(((long)t * tp) % T);
    TAB[i] = part ? -sinpif(2.f * (float)m / (float)T) : cospif(2.f * (float)m / (float)T);
}
__global__ __launch_bounds__(256) void k_mod(const float* __restrict__ SIL, const float* __restrict__ w_mod, const float* __restrict__ b_mod, float* __restrict__ MOD) {
    const int l = blockIdx.y, lane = threadIdx.x & 63, kq = threadIdx.x >> 6, n = blockIdx.x * 64 + lane;
    float acc[17];
#pragma unroll
    for (int r = 0; r < 17; ++r) acc[r] = 0.f;
    const float* w = w_mod + (size_t)l * D * MODW + n;
    for (int k = kq * 256; k < kq * 256 + 256; ++k) {
        const float wv = w[(size_t)k * MODW];
#pragma unroll
        for (int r = 0; r < 17; ++r) acc[r] += SIL[r * 1024 + k] * wv;
    }
    __shared__ float red[4][17][64];
#pragma unroll
    for (int r = 0; r < 17; ++r) red[kq][r][lane] = acc[r];
    __syncthreads();
    if (kq == 0) {
#pragma unroll
        for (int r = 0; r < 17; ++r) MOD[((size_t)l * 17 + r) * MODW + n] = red[0][r][lane] + red[1][r][lane] + red[2][r][lane] + red[3][r][lane] + b_mod[(size_t)l * MODW + n];
    }
}

struct Row { float4 v[4]; };
__device__ __forceinline__ Row row_load(const float* p, int lane) { Row r;
#pragma unroll
    for (int i = 0; i < 4; ++i) r.v[i] = *(const float4*)(p + i * 256 + lane * 4);
    return r; }
__device__ __forceinline__ void row_store(float* p, int lane, const Row& r) {
#pragma unroll
    for (int i = 0; i < 4; ++i) *(float4*)(p + i * 256 + lane * 4) = r.v[i]; }
__device__ __forceinline__ void row_ln(Row& r) {
    float s = 0.f;
#pragma unroll
    for (int i = 0; i < 4; ++i) s += (r.v[i].x + r.v[i].y) + (r.v[i].z + r.v[i].w);
    const float mean = wave_sum(s) * (1.f / 1024.f);
    float q = 0.f;
#pragma unroll
    for (int i = 0; i < 4; ++i) { r.v[i].x -= mean; r.v[i].y -= mean; r.v[i].z -= mean; r.v[i].w -= mean;
        q += (r.v[i].x * r.v[i].x + r.v[i].y * r.v[i].y) + (r.v[i].z * r.v[i].z + r.v[i].w * r.v[i].w); }
    const float rstd = rsqrtf(wave_sum(q) * (1.f / 1024.f) + EPS);
#pragma unroll
    for (int i = 0; i < 4; ++i) { r.v[i].x *= rstd; r.v[i].y *= rstd; r.v[i].z *= rstd; r.v[i].w *= rstd; }
}
__device__ __forceinline__ void row_fma(Row& r, const Row& a, const Row& b) {
#pragma unroll
    for (int i = 0; i < 4; ++i) { r.v[i].x = r.v[i].x * a.v[i].x + b.v[i].x; r.v[i].y = r.v[i].y * a.v[i].y + b.v[i].y; r.v[i].z = r.v[i].z * a.v[i].z + b.v[i].z; r.v[i].w = r.v[i].w * a.v[i].w + b.v[i].w; }
}
__device__ __forceinline__ void row_modulate(Row& r, const Row& sh, const Row& sc) {
#pragma unroll
    for (int i = 0; i < 4; ++i) { r.v[i].x = r.v[i].x * (1.f + sc.v[i].x) + sh.v[i].x; r.v[i].y = r.v[i].y * (1.f + sc.v[i].y) + sh.v[i].y; r.v[i].z = r.v[i].z * (1.f + sc.v[i].z) + sh.v[i].z; r.v[i].w = r.v[i].w * (1.f + sc.v[i].w) + sh.v[i].w; }
}

__device__ __forceinline__ const float* res_row(const float* xl, const float* xc, int b, int j) { return j < L ? xc + ((size_t)b * L + j) * D : xl + ((size_t)b * S + (j - L)) * D; }
__device__ __forceinline__ float* res_row_w(float* xl, float* xc, int b, int j) { return j < L ? xc + ((size_t)b * L + j) * D : xl + ((size_t)b * S + (j - L)) * D; }

__global__ __launch_bounds__(256) void k_lnmod(const float* xl, const float* xc, const float* MODl, float* H, int b, int j0, int nrows) {
    const int lane = threadIdx.x & 63, w = blockIdx.x * 4 + (threadIdx.x >> 6);
    if (w >= nrows) return;
    const int j = j0 + w;
    const float* mrow = MODl + (size_t)(j < L ? 16 : b) * MODW;
    Row r = row_load(res_row(xl, xc, b, j), lane);
    row_ln(r);
    const Row sh = row_load(mrow + 0, lane), sc = row_load(mrow + 1024, lane);
    row_modulate(r, sh, sc);
    row_store(H + (size_t)j * D, lane, r);
}

__global__ __launch_bounds__(256) void k_gemm_f32(const float* __restrict__ A, int lda, const float* __restrict__ Bm, int ldb, float* __restrict__ C, int ldc, int K) {
    __shared__ __attribute__((aligned(16))) float As[16][68];
    __shared__ __attribute__((aligned(16))) float Bs[16][68];
    const int tid = threadIdx.x, bm = blockIdx.y * 64, bn = blockIdx.x * 64, ty = tid >> 4, tx = tid & 15;
    float acc[4][4];
#pragma unroll
    for (int i = 0; i < 4; ++i)
#pragma unroll
        for (int j = 0; j < 4; ++j) acc[i][j] = 0.f;
    for (int k0 = 0; k0 < K; k0 += 16) {
        const float4 a = *(const float4*)(A + (size_t)(bm + (tid >> 2)) * lda + k0 + (tid & 3) * 4);
        As[(tid & 3) * 4 + 0][tid >> 2] = a.x; As[(tid & 3) * 4 + 1][tid >> 2] = a.y; As[(tid & 3) * 4 + 2][tid >> 2] = a.z; As[(tid & 3) * 4 + 3][tid >> 2] = a.w;
        const float4 b = *(const float4*)(Bm + (size_t)(k0 + (tid >> 4)) * ldb + bn + (tid & 15) * 4);
        *(float4*)&Bs[tid >> 4][(tid & 15) * 4] = b;
        __syncthreads();
#pragma unroll
        for (int kk = 0; kk < 16; ++kk) {
            const float4 a4 = *(const float4*)&As[kk][ty * 4], b4 = *(const float4*)&Bs[kk][tx * 4];
            const float av[4] = {a4.x, a4.y, a4.z, a4.w}, bv[4] = {b4.x, b4.y, b4.z, b4.w};
#pragma unroll
            for (int i = 0; i < 4; ++i)
#pragma unroll
                for (int j = 0; j < 4; ++j) acc[i][j] += av[i] * bv[j];
        }
        __syncthreads();
    }
#pragma unroll
    for (int i = 0; i < 4; ++i) *(float4*)(C + (size_t)(bm + ty * 4 + i) * ldc + bn + tx * 4) = make_float4(acc[i][0], acc[i][1], acc[i][2], acc[i][3]);
}

__global__ void k_rope(float* P, const float* RC, const float* RS) {
    const int i = blockIdx.x * blockDim.x + threadIdx.x;
    if (i >= S * 2 * 12 * 2 * 16) return;
    const int f = i & 15, blk = (i >> 4) & 1, hh = (i >> 5) % 12, sec = (i / (32 * 12)) & 1, t = i / (32 * 12 * 2);
    float* p = P + (size_t)(L + t) * INW + (sec ? KOFF : QOFF) + hh * 64 + blk * 32 + f;
    const int pos = blk ? (t & 63) : (t >> 6);
    const float c = RC[pos * 16 + f], s = RS[pos * 16 + f], x1 = p[0], x2 = p[16];
    p[0] = x1 * c - x2 * s; p[16] = x2 * c + x1 * s;
}

__global__ void k_fz(const float* P, const float* C64, const float* S64, float* Z, int T, int j0) {
    const int i = blockIdx.x * blockDim.x + threadIdx.x;
    if (i >= 2 * T * 256) return;
    const int n = i & 255, kk = i >> 8, t = kk % T, part = kk / T, g = n >> 6, cp = n & 63;
    const float* u = P + (size_t)(j0 + t) * INW + g * 64; const float* tb = part ? S64 : C64;
    float s = 0.f;
    for (int c = 0; c < 64; ++c) s += u[c] * tb[c * 64 + cp];
    Z[i] = s;
}
__global__ void k_fmap(const float* F, const float* wf, float* CONCAT, int T, int j0, float norm) {
    const int i = blockIdx.x * blockDim.x + threadIdx.x;
    if (i >= T * 256) return;
    const int n = i & 255, t = i >> 8, g = n >> 6, d = n & 63;
    const float* f = F + (size_t)t * 256 + g * 64; const float* w = wf + g * 4096 + d;
    float s = 0.f;
    for (int c = 0; c < 64; ++c) s += f[c] * w[c * 64];
    CONCAT[(size_t)(j0 + t) * D + n] = s * norm;
}

__global__ __launch_bounds__(256) void k_attn_naive(const float* __restrict__ P, float* __restrict__ CONCAT, const float* LAM, const float* subln_g, int l, float one_minus_lam_init, int j0) {
    const int j = j0 + blockIdx.x, h = blockIdx.y, tid = threadIdx.x;
    __shared__ float q1[64], q2[64], s1[RB], s2[RB], red[4], outp[2][128];
    const int nk = j < L ? L : RB;
    if (tid < 64) q1[tid] = P[(size_t)j * INW + QOFF + (2 * h) * 64 + tid];
    else if (tid < 128) q2[tid - 64] = P[(size_t)j * INW + QOFF + (2 * h + 1) * 64 + (tid - 64)];
    __syncthreads();
    float m1 = -INFINITY, m2 = -INFINITY;
    for (int key = tid; key < nk; key += 256) {
        const float* k1 = P + (size_t)key * INW + KOFF + (2 * h) * 64; const float* k2 = k1 + 64;
        float d1 = 0.f, d2 = 0.f;
        for (int d = 0; d < 64; ++d) { d1 += q1[d] * k1[d]; d2 += q2[d] * k2[d]; }
        d1 *= 0.125f; d2 *= 0.125f; s1[key] = d1; s2[key] = d2; m1 = fmaxf(m1, d1); m2 = fmaxf(m2, d2);
    }
    const float M1 = block_max(m1, red); const float M2 = block_max(m2, red);
    float l1 = 0.f, l2 = 0.f;
    for (int key = tid; key < nk; key += 256) { const float e1 = expf(s1[key] - M1), e2 = expf(s2[key] - M2); s1[key] = e1; s2[key] = e2; l1 += e1; l2 += e2; }
    const float L1 = block_sum(l1, red); const float L2 = block_sum(l2, red);
    const float lam = LAM[l];
    for (int key = tid; key < nk; key += 256) s1[key] = s1[key] / L1 - lam * (s2[key] / L2);
    __syncthreads();
    const int d = tid & 127, half = tid >> 7;
    float acc = 0.f;
    const int kh = nk >> 1;
    for (int key = half * kh; key < (half + 1) * kh; ++key) acc += s1[key] * P[(size_t)key * INW + VOFF + h * 128 + d];
    outp[half][d] = acc;
    __syncthreads();
    float o = 0.f;
    if (tid < 128) o = outp[0][tid] + outp[1][tid];
    const float ss = block_sum(tid < 128 ? o * o : 0.f, red);
    const float rms = rsqrtf(ss * (1.f / 128.f) + EPS);
    if (tid < 128) CONCAT[(size_t)j * D + 256 + h * 128 + tid] = o * rms * subln_g[l * 128 + tid] * one_minus_lam_init;
}

__global__ __launch_bounds__(256) void k_post_attn(const float* xl, const float* xc, const float* O, const float* MODl, const float* lng, const float* lnb,
                                                   float* x1l, float* x1c, float* H, const float* w_router, const float* router_bias, int4* SEL, int b, int j0, int nrows) {
    const int lane = threadIdx.x & 63, w = blockIdx.x * 4 + (threadIdx.x >> 6);
    if (w >= nrows) return;
    const int j = j0 + w;
    const float* mrow = MODl + (size_t)(j < L ? 16 : b) * MODW;
    Row x = row_load(res_row(xl, xc, b, j), lane);
    const Row o = row_load(O + (size_t)j * D, lane), g = row_load(mrow + 2048, lane);
#pragma unroll
    for (int i = 0; i < 4; ++i) { x.v[i].x = ALPHA * x.v[i].x + g.v[i].x * o.v[i].x; x.v[i].y = ALPHA * x.v[i].y + g.v[i].y * o.v[i].y; x.v[i].z = ALPHA * x.v[i].z + g.v[i].z * o.v[i].z; x.v[i].w = ALPHA * x.v[i].w + g.v[i].w * o.v[i].w; }
    row_ln(x);
    { const Row gg = row_load(lng, lane), bb = row_load(lnb, lane); row_fma(x, gg, bb); }
    row_store(res_row_w(x1l, x1c, b, j), lane, x);
    row_ln(x);
    { const Row sh = row_load(mrow + 3072, lane), sc = row_load(mrow + 4096, lane); row_modulate(x, sh, sc); }
    row_store(H + (size_t)j * D, lane, x);
    float lg[16];
#pragma unroll
    for (int e = 0; e < 16; ++e) lg[e] = 0.f;
#pragma unroll
    for (int i = 0; i < 4; ++i) {
        const float hv[4] = {x.v[i].x, x.v[i].y, x.v[i].z, x.v[i].w};
#pragma unroll
        for (int jj = 0; jj < 4; ++jj) {
            const float* wr = w_router + (size_t)(i * 256 + lane * 4 + jj) * 16;
#pragma unroll
            for (int q = 0; q < 4; ++q) { const float4 wv = *(const float4*)(wr + q * 4); lg[q * 4 + 0] += hv[jj] * wv.x; lg[q * 4 + 1] += hv[jj] * wv.y; lg[q * 4 + 2] += hv[jj] * wv.z; lg[q * 4 + 3] += hv[jj] * wv.w; }
        }
    }
    float sc[16], sel[16];
#pragma unroll
    for (int e = 0; e < 16; ++e) { const float t = wave_sum(lg[e]); sc[e] = 1.f / (1.f + expf(-t)); sel[e] = sc[e] + router_bias[e]; }
    float best = -INFINITY; int bg = 0;
#pragma unroll
    for (int gI = 0; gI < 4; ++gI) {
        const float a0 = sel[gI * 4 + 0], a1 = sel[gI * 4 + 1], a2 = sel[gI * 4 + 2], a3 = sel[gI * 4 + 3];
        const float mx = fmaxf(fmaxf(a0, a1), fmaxf(a2, a3));
        float sec;
        if (a0 == mx) sec = fmaxf(a1, fmaxf(a2, a3)); else if (a1 == mx) sec = fmaxf(a0, fmaxf(a2, a3)); else if (a2 == mx) sec = fmaxf(fmaxf(a0, a1), a3); else sec = fmaxf(fmaxf(a0, a1), a2);
        const float gs = mx + sec;
        if (gs > best) { best = gs; bg = gI; }
    }
    float a[4], s4[4];
#pragma unroll
    for (int q = 0; q < 4; ++q) { a[q] = 0.f; s4[q] = 0.f; }
#pragma unroll
    for (int gI = 0; gI < 4; ++gI)
#pragma unroll
        for (int q = 0; q < 4; ++q) if (bg == gI) { a[q] = sel[gI * 4 + q]; s4[q] = sc[gI * 4 + q]; }
    int i0 = 0; float v0 = a[0];
#pragma unroll
    for (int q = 1; q < 4; ++q) if (a[q] > v0) { v0 = a[q]; i0 = q; }
    int i1 = -1; float v1 = -INFINITY;
#pragma unroll
    for (int q = 0; q < 4; ++q) if (q != i0 && a[q] > v1) { v1 = a[q]; i1 = q; }
    float w0 = 0.f, w1 = 0.f;
#pragma unroll
    for (int q = 0; q < 4; ++q) { if (q == i0) w0 = s4[q]; if (q == i1) w1 = s4[q]; }
    const float inv = 1.f / (w0 + w1);
    if (lane == 0) SEL[j] = make_int4(bg * 4 + i0, bg * 4 + i1, __float_as_int(w0 * inv), __float_as_int(w1 * inv));
}

__global__ __launch_bounds__(256) void k_moe_naive(const float* __restrict__ H, const int4* SEL, const float* __restrict__ wg, const float* __restrict__ wu, const float* __restrict__ wd, float* Y, int l, int j0) {
    const int j = j0 + blockIdx.x, tid = threadIdx.x;
    __shared__ float hs[1024], as[512];
#pragma unroll
    for (int i = 0; i < 4; ++i) hs[tid + 256 * i] = H[(size_t)j * D + tid + 256 * i];
    const int4 sel = SEL[j];
    float y[4] = {0.f, 0.f, 0.f, 0.f};
    __syncthreads();
#pragma unroll
    for (int slot = 0; slot < 2; ++slot) {
        const int e = slot ? sel.y : sel.x; const float wgt = __int_as_float(slot ? sel.w : sel.z);
        const float* Wg = wg + ((size_t)(l * 16 + e) * 1024) * 512; const float* Wu = wu + ((size_t)(l * 16 + e) * 1024) * 512; const float* Wd = wd + ((size_t)(l * 16 + e) * 512) * 1024;
        float g0 = 0.f, g1 = 0.f, u0 = 0.f, u1 = 0.f;
        for (int k = 0; k < 1024; ++k) { const float hv = hs[k]; g0 += hv * Wg[(size_t)k * 512 + tid]; g1 += hv * Wg[(size_t)k * 512 + tid + 256]; u0 += hv * Wu[(size_t)k * 512 + tid]; u1 += hv * Wu[(size_t)k * 512 + tid + 256]; }
        as[tid] = g0 / (1.f + expf(-g0)) * u0; as[tid + 256] = g1 / (1.f + expf(-g1)) * u1;
        __syncthreads();
        float a0 = 0.f, a1 = 0.f, a2 = 0.f, a3 = 0.f;
        for (int k = 0; k < 512; ++k) { const float av = as[k]; const float* wr = Wd + (size_t)k * 1024 + tid; a0 += av * wr[0]; a1 += av * wr[256]; a2 += av * wr[512]; a3 += av * wr[768]; }
        y[0] += wgt * a0; y[1] += wgt * a1; y[2] += wgt * a2; y[3] += wgt * a3;
        __syncthreads();
    }
#pragma unroll
    for (int i = 0; i < 4; ++i) Y[(size_t)j * D + tid + 256 * i] = y[i];
}

__global__ __launch_bounds__(256) void k_post_ffn(const float* x1l, const float* x1c, const float* Y, const float* MODl, const float* lng, const float* lnb,
                                                  float* x2l, float* x2c, int b, int j0, int nrows) {
    const int lane = threadIdx.x & 63, w = blockIdx.x * 4 + (threadIdx.x >> 6);
    if (w >= nrows) return;
    const int j = j0 + w;
    const float* mrow = MODl + (size_t)(j < L ? 16 : b) * MODW;
    Row x = row_load(res_row(x1l, x1c, b, j), lane);
    const Row y = row_load(Y + (size_t)j * D, lane), g = row_load(mrow + 5120, lane);
#pragma unroll
    for (int i = 0; i < 4; ++i) { x.v[i].x = ALPHA * x.v[i].x + g.v[i].x * y.v[i].x; x.v[i].y = ALPHA * x.v[i].y + g.v[i].y * y.v[i].y; x.v[i].z = ALPHA * x.v[i].z + g.v[i].z * y.v[i].z; x.v[i].w = ALPHA * x.v[i].w + g.v[i].w * y.v[i].w; }
    row_ln(x);
    { const Row gg = row_load(lng, lane), bb = row_load(lnb, lane); row_fma(x, gg, bb); }
    row_store(res_row_w(x2l, x2c, b, j), lane, x);
}
}
#endif
#if MK_DEBUG
namespace dbg {
__device__ __forceinline__ void diag_acc(float* DIAG, int st, float md, float sq, float cnt, float mis) {
#pragma unroll
    for (int o = 32; o > 0; o >>= 1) { md = fmaxf(md, __shfl_xor(md, o)); sq += __shfl_xor(sq, o); cnt += __shfl_xor(cnt, o); mis += __shfl_xor(mis, o); }
    if ((threadIdx.x & 63) == 0) { atomicMax((unsigned*)&DIAG[st * 4 + 0], __float_as_uint(md)); atomicAdd(&DIAG[st * 4 + 1], sq); atomicAdd(&DIAG[st * 4 + 2], cnt); atomicAdd(&DIAG[st * 4 + 3], mis); }
}
__device__ __forceinline__ float adiff(float r, float n, float fl) { const float d = fabsf(r - n) / (fabsf(r) + fl); return (d == d) ? d : 1e30f; }
__device__ __forceinline__ float rms_of(const float* DIAG, int st) { return sqrtf(DIAG[st * 4 + 1] / fmaxf(DIAG[st * 4 + 2], 1.f)) + 1e-30f; }
__global__ void k_cmp_bf16(const float* ref, int ldr, const bf16_t* nw, int ldn, int rows, int cols, float refscale, float* DIAG, int st, int pass) {
    float md = 0.f, sq = 0.f, cnt = 0.f; const float fl = pass ? rms_of(DIAG, st) : 1.f;
    for (size_t i = (size_t)blockIdx.x * blockDim.x + threadIdx.x; i < (size_t)rows * cols; i += (size_t)gridDim.x * blockDim.x) { const int r = (int)(i / cols), c = (int)(i % cols);
        const float rv = ref[(size_t)r * ldr + c] * refscale, nv = bf2f(nw[(size_t)r * ldn + c]); if (pass) md = fmaxf(md, adiff(rv, nv, fl)); else { sq += rv * rv; cnt += 1.f; } }
    diag_acc(DIAG, st, md, sq, cnt, 0.f);
}
__global__ void k_cmp_bf16_sum2(const float* ref, int ldr, const bf16_t* n1, const bf16_t* n2, int ldn, int rows, int cols, float* DIAG, int st, int pass) {
    float md = 0.f, sq = 0.f, cnt = 0.f; const float fl = pass ? rms_of(DIAG, st) : 1.f;
    for (size_t i = (size_t)blockIdx.x * blockDim.x + threadIdx.x; i < (size_t)rows * cols; i += (size_t)gridDim.x * blockDim.x) { const int r = (int)(i / cols), c = (int)(i % cols);
        const float rv = ref[(size_t)r * ldr + c], nv = bf2f(n1[(size_t)r * ldn + c]) + bf2f(n2[(size_t)r * ldn + c]); if (pass) md = fmaxf(md, adiff(rv, nv, fl)); else { sq += rv * rv; cnt += 1.f; } }
    diag_acc(DIAG, st, md, sq, cnt, 0.f);
}
__global__ void k_cmp_f32(const float* ref, int ldr, const float* nw, int ldn, int rows, int cols, float* DIAG, int st, int pass) {
    float md = 0.f, sq = 0.f, cnt = 0.f; const float fl = pass ? rms_of(DIAG, st) : 1.f;
    for (size_t i = (size_t)blockIdx.x * blockDim.x + threadIdx.x; i < (size_t)rows * cols; i += (size_t)gridDim.x * blockDim.x) { const int r = (int)(i / cols), c = (int)(i % cols);
        const float rv = ref[(size_t)r * ldr + c], nv = nw[(size_t)r * ldn + c]; if (pass) md = fmaxf(md, adiff(rv, nv, fl)); else { sq += rv * rv; cnt += 1.f; } }
    diag_acc(DIAG, st, md, sq, cnt, 0.f);
}
__global__ void k_cmp_sel(const int4* ref, const int4* nw, int rows, float* DIAG, int st) {
    float mis = 0.f;
    for (int i = blockIdx.x * blockDim.x + threadIdx.x; i < rows; i += gridDim.x * blockDim.x) { const int4 a = ref[i], b = nw[i];
        if (a.x != b.x || a.y != b.y || fabsf(__int_as_float(a.z) - __int_as_float(b.z)) > 1e-3f || fabsf(__int_as_float(a.w) - __int_as_float(b.w)) > 1e-3f) mis += 1.f; }
    diag_acc(DIAG, st, 0.f, 0.f, 0.f, mis);
}
__global__ void k_cvt(const bf16_t* src, int lds_, float* dst, int ldd, int rows, int cols, float scale) {
    for (size_t i = (size_t)blockIdx.x * blockDim.x + threadIdx.x; i < (size_t)rows * cols; i += (size_t)gridDim.x * blockDim.x) { const int r = (int)(i / cols), c = (int)(i % cols);
        dst[(size_t)r * ldd + c] = bf2f(src[(size_t)r * lds_ + c]) * scale; }
}
__global__ void k_cvt_sum2(const bf16_t* s1, const bf16_t* s2, int lds_, float* dst, int ldd, int rows, int cols) {
    for (size_t i = (size_t)blockIdx.x * blockDim.x + threadIdx.x; i < (size_t)rows * cols; i += (size_t)gridDim.x * blockDim.x) { const int r = (int)(i / cols), c = (int)(i % cols);
        dst[(size_t)r * ldd + c] = bf2f(s1[(size_t)r * lds_ + c]) + bf2f(s2[(size_t)r * lds_ + c]); }
}
__global__ void k_four_recon(const bf16_t* CC, int ldc, const float* MHl, float* out, int ldo, int rows) {
    for (size_t i = (size_t)blockIdx.x * blockDim.x + threadIdx.x; i < (size_t)rows * 256; i += (size_t)gridDim.x * blockDim.x) { const int r = (int)(i >> 8), n = (int)(i & 255), g = n >> 6, d = n & 63;
        const bf16_t* fc = CC + (size_t)r * ldc + g * 64; const bf16_t* fs = fc + 256; float s = 0.f;
        for (int c = 0; c < 64; ++c) s += bf2f(fc[c]) * MHl[((0 * 4 + g) * 64 + c) * 64 + d] + bf2f(fs[c]) * MHl[((1 * 4 + g) * 64 + c) * 64 + d];
        out[(size_t)r * ldo + n] = s; }
}
__device__ __forceinline__ float stage_tol(int s) {
    if (s == 1) return 1e-4f;
    const int k = (s - 2) % 9;
    return k == 0 ? 0.03f : k == 1 ? 0.05f : k == 2 ? 0.15f : k == 3 ? 0.06f : k == 4 ? 0.12f : k == 5 ? 0.02f : k == 6 ? 0.03f : k == 7 ? 0.08f : 0.02f;
}
__global__ void k_final(const float* DIAG, int nst, float* out, size_t n) {
    int bad = 0; float m = 0.f;
    for (int s = 1; s <= nst; ++s) {
        const float md = DIAG[s * 4 + 0], sq = DIAG[s * 4 + 1], cnt = DIAG[s * 4 + 2], mis = DIAG[s * 4 + 3];
        if (cnt <= 0.f && mis <= 0.f) continue;
        float err = cnt > 0.f ? md : 0.f; const float tol = stage_tol(s);
        if (mis > 8.f) err = fmaxf(err, tol * mis);
        if (!(err <= tol)) { bad = s; m = fminf(fmaxf(1.f + 3.f * log10f(err / tol), 1.f), 9.9f); break; }
    }
    if (!bad) return;
    const float cval = sqrtf(powf(10.f, (float)bad) * m);
    for (size_t i = (size_t)blockIdx.x * blockDim.x + threadIdx.x; i < n; i += (size_t)gridDim.x * blockDim.x) out[i] = cval;
}
}
#endif

extern "C" void kernel_launch(void* const* d_in, const int* in_sizes, int n_in, void* d_out, int out_size, void* d_ws, size_t ws_size, hipStream_t stream) {
    using namespace mk;
    static int ready = 0;
    if (!ready) {
        if (n_in != 20 || out_size != NB * S * D) { fprintf(stderr, "kernel_launch: unexpected problem shape\n"); ready = -1; return; }
        if (ws_size < WS_NEED) { fprintf(stderr, "kernel_launch: workspace too small: need %zu have %zu\n", (size_t)WS_NEED, ws_size); ready = -1; return; }
        if (hipFuncSetAttribute((const void*)mk_fwd, hipFuncAttributeMaxDynamicSharedMemorySize, LDS_BYTES) != hipSuccess) { fprintf(stderr, "kernel_launch: hipFuncSetAttribute failed\n"); ready = -1; return; }
        ready = 1;
    }
    if (ready < 0) return;
    Args a{};
    for (int i = 0; i < 20; ++i) a.in[i] = (const float*)d_in[i];
    a.out = (float*)d_out; a.ws = (unsigned char*)d_ws; a.rep_attn = 1; a.attn_var = 0; a.pad2 = 0;
    for (int i = 0; i < 16; ++i) a.rep[i] = 1;
#if defined(MK_REP_ATTN)
    a.rep_attn = MK_REP_ATTN;
#endif
#if defined(MK_ATTN_VAR)
    a.attn_var = MK_ATTN_VAR;
#endif
#if defined(MK_REP_PHASE)
    a.rep[MK_REP_PHASE] = MK_REP_COUNT;
#endif
    (void)hipMemsetAsync(d_ws, 0, CTL_BYTES, stream);
    const int grid = 256;
#if !MK_DEBUG
#ifndef MK_CUTS
    a.ph_lo = 0; a.ph_hi = N_PHASES; a.li = 0;
    hipLaunchKernelGGL(mk_fwd, dim3(grid), dim3(512), LDS_BYTES, stream, a);
#if defined(MK_STAMP)
    k_encode<<<1024, 256, 0, stream>>>((const unsigned long long*)((unsigned char*)d_ws + WS_NEED), (float*)d_out, (size_t)out_size);
#endif
#else
    for (int p = 0; p < N_PHASES; ++p) { a.ph_lo = p; a.ph_hi = p + 1; a.li = 0; hipLaunchKernelGGL(mk_fwd, dim3(grid), dim3(512), LDS_BYTES, stream, a); }
#endif
#else
    unsigned char* ws = (unsigned char*)d_ws;
    size_t off = (WS_NEED + 255) & ~(size_t)255;
    auto take = [&](size_t nfloats) { float* p = (float*)(ws + off); off += ((nfloats * 4 + 255) & ~(size_t)255); return p; };
    float* DIAG = take(256);
    float* Hr = take((size_t)RB * D); float* Pr = take((size_t)RB * 2560); float* CCr = take((size_t)RB * D); float* Or = take((size_t)RB * D); float* Yr = take((size_t)RB * D);
    float* Z = Yr; float* F = Or;        float* TABr = take((size_t)S * 2 * S); float* TABcr = take((size_t)L * 2 * L);
    float* MODr = take((size_t)2 * 17 * MODW); float* SILr = take(17 * 1024); float* LAMr = take(64); float* RCr = take(1024); float* RSr = take(1024); float* C64r = take(4096); float* S64r = take(4096);
    float* A_lat = take((size_t)S * D); float* A_ctx = take((size_t)L * D); float* B_lat = take((size_t)S * D); float* B_ctx = take((size_t)L * D); float* XS_lat = B_lat; float* XS_ctx = B_ctx;
    int4* SELr = (int4*)take((size_t)RB * 4);
    if (off > ws_size) { fprintf(stderr, "kernel_launch(debug): workspace too small: need %zu have %zu\n", off, ws_size); return; }
    (void)hipMemsetAsync(DIAG, 0, 1024, stream);
    const float* x = a.in[I_X]; const float* ctx = a.in[I_CTX];
    bf16_t* Hn = (bf16_t*)(ws + OFF_ARENA + AR_H); bf16_t* QKVn = (bf16_t*)(ws + OFF_ARENA + AR_QKV); bf16_t* CCn = (bf16_t*)(ws + OFF_ARENA + AR_CC); bf16_t* On = (bf16_t*)(ws + OFF_ARENA + AR_O); bf16_t* Y2n = (bf16_t*)(ws + OFF_ARENA + AR_Y2);
    float* MODn = (float*)(ws + OFF_MOD); float* LAMn = (float*)(ws + OFF_LAM); bf16_t* RESn = (bf16_t*)(ws + OFF_RES); int4* SELn = (int4*)(ws + OFF_SELN);
    auto run = [&](int p) { a.ph_lo = p; a.ph_hi = p + 1; a.li = 0; hipLaunchKernelGGL(mk_fwd, dim3(grid), dim3(512), LDS_BYTES, stream, a); };
    const int CB = 1024;
    ref::k_prep_small<<<(17 * 1024 + 255) / 256, 256, 0, stream>>>(a.in[I_C], a.in[I_CCTX], a.in[I_LAMQK], SILr, LAMr, RCr, RSr, C64r, S64r);
    ref::k_prep_tab<<<(unsigned)(((size_t)S * 2 * S + 255) / 256), 256, 0, stream>>>(TABr, S);
    ref::k_prep_tab<<<(unsigned)(((size_t)L * 2 * L + 255) / 256), 256, 0, stream>>>(TABcr, L);
    ref::k_mod<<<dim3(MODW / 64, 2), 256, 0, stream>>>(SILr, a.in[I_WMOD], a.in[I_BMOD], MODr);
    run(0);
    dbg::k_cmp_f32<<<CB, 256, 0, stream>>>(MODr, MODW, MODn, MODW, 34, MODW, DIAG, 1, 0); dbg::k_cmp_f32<<<CB, 256, 0, stream>>>(MODr, MODW, MODn, MODW, 34, MODW, DIAG, 1, 1);
    dbg::k_cmp_f32<<<1, 64, 0, stream>>>(LAMr, 2, LAMn, 2, 1, 2, DIAG, 1, 0); dbg::k_cmp_f32<<<1, 64, 0, stream>>>(LAMr, 2, LAMn, 2, 1, 2, DIAG, 1, 1);
    run(1);
    int nst = 1;
#ifndef MK_DBG_PHASES
#define MK_DBG_PHASES 16
#endif
    for (int l = 0; l < 2; ++l) {
        const bool last = (l == 1); const int pb = 2 + 7 * l, sb = 2 + 9 * l, j0 = last ? L : 0, nr = RB - j0;
        if (pb >= MK_DBG_PHASES) break;
        const float* MODl = MODn + (size_t)l * 17 * MODW;
        const float* win = a.in[I_WIN] + (size_t)l * D * 2560; const float* wout = a.in[I_WOUT] + (size_t)l * D * D; const float* wf = a.in[I_WF] + (size_t)l * 4 * 64 * 64;
        const float omli = (float)(1.0 - (0.8 - 0.6 * exp(-0.3 * (double)l)));
        if (last) { dbg::k_cvt<<<CB, 256, 0, stream>>>(RESn + (size_t)L * D, D, XS_lat, D, S, D, 1.f); dbg::k_cvt<<<CB, 256, 0, stream>>>(RESn, D, XS_ctx, D, L, D, 1.f); }
        const float* xl = l == 0 ? x : XS_lat; const float* xc = l == 0 ? ctx : XS_ctx;
        ref::k_lnmod<<<RB / 4, 256, 0, stream>>>(xl, xc, MODl, Hr, 0, 0, RB);
        dbg::k_cmp_bf16<<<CB, 256, 0, stream>>>(Hr, D, Hn, D, RB, D, 1.f, DIAG, sb + 0, 0); dbg::k_cmp_bf16<<<CB, 256, 0, stream>>>(Hr, D, Hn, D, RB, D, 1.f, DIAG, sb + 0, 1); nst = sb + 0;
        run(pb + 0);
        dbg::k_cvt<<<CB, 256, 0, stream>>>(Hn, D, Hr, D, RB, D, 1.f);
        ref::k_gemm_f32<<<dim3(2560 / 64, RB / 64), 256, 0, stream>>>(Hr, D, win, 2560, Pr, 2560, D);
        ref::k_rope<<<(S * 2 * 12 * 2 * 16 + 255) / 256, 256, 0, stream>>>(Pr, RCr, RSr);
        dbg::k_cmp_bf16<<<CB, 256, 0, stream>>>(Pr + (size_t)j0 * 2560 + 256, 2560, QKVn + (size_t)j0 * QKVW, QKVW, nr, 768, QSCALE, DIAG, sb + 1, 0); dbg::k_cmp_bf16<<<CB, 256, 0, stream>>>(Pr + (size_t)j0 * 2560 + 256, 2560, QKVn + (size_t)j0 * QKVW, QKVW, nr, 768, QSCALE, DIAG, sb + 1, 1);
        dbg::k_cmp_bf16<<<CB, 256, 0, stream>>>(Pr + 1024, 2560, QKVn + 768, QKVW, RB, 1536, 1.f, DIAG, sb + 1, 0); dbg::k_cmp_bf16<<<CB, 256, 0, stream>>>(Pr + 1024, 2560, QKVn + 768, QKVW, RB, 1536, 1.f, DIAG, sb + 1, 1); nst = sb + 1;
        if (pb + 1 >= MK_DBG_PHASES) break;
        run(pb + 1);
        ref::k_fz<<<(2 * S * 256 + 255) / 256, 256, 0, stream>>>(Pr, C64r, S64r, Z, S, L);
        ref::k_gemm_f32<<<dim3(256 / 64, S / 64), 256, 0, stream>>>(TABr, 2 * S, Z, 256, F, 256, 2 * S);
        ref::k_fmap<<<(S * 256 + 255) / 256, 256, 0, stream>>>(F, wf, CCr, S, L, 1.0f / sqrtf((float)S * 64.f));
        if (!last) {
            ref::k_fz<<<(2 * L * 256 + 255) / 256, 256, 0, stream>>>(Pr, C64r, S64r, Z, L, 0);
            ref::k_gemm_f32<<<dim3(256 / 64, L / 64), 256, 0, stream>>>(TABcr, 2 * L, Z, 256, F, 256, 2 * L);
            ref::k_fmap<<<(L * 256 + 255) / 256, 256, 0, stream>>>(F, wf, CCr, L, 0, 1.0f / sqrtf((float)L * 64.f));
        }
        dbg::k_four_recon<<<CB, 256, 0, stream>>>(CCn, CW, (const float*)(ws + OFF_MH) + (size_t)l * 2 * 4 * 64 * 64, Hr, D, RB);
        dbg::k_cmp_f32<<<CB, 256, 0, stream>>>(CCr + (size_t)j0 * D, D, Hr + (size_t)j0 * D, D, nr, 256, DIAG, sb + 2, 0); dbg::k_cmp_f32<<<CB, 256, 0, stream>>>(CCr + (size_t)j0 * D, D, Hr + (size_t)j0 * D, D, nr, 256, DIAG, sb + 2, 1); nst = sb + 2;
        dbg::k_cvt<<<CB, 256, 0, stream>>>(QKVn, QKVW, Pr + 256, 2560, RB, 768, 1.f / QSCALE);
        dbg::k_cvt<<<CB, 256, 0, stream>>>(QKVn + 768, QKVW, Pr + 1024, 2560, RB, 1536, 1.f);
        ref::k_attn_naive<<<dim3(nr, 6), 256, 0, stream>>>(Pr, CCr, LAMn, a.in[I_SUBLN], l, omli, j0);
        dbg::k_cmp_bf16<<<CB, 256, 0, stream>>>(CCr + (size_t)j0 * D + 256, D, CCn + (size_t)j0 * CW + 512, CW, nr, 768, 1.f, DIAG, sb + 3, 0); dbg::k_cmp_bf16<<<CB, 256, 0, stream>>>(CCr + (size_t)j0 * D + 256, D, CCn + (size_t)j0 * CW + 512, CW, nr, 768, 1.f, DIAG, sb + 3, 1); nst = sb + 3;
        if (pb + 2 >= MK_DBG_PHASES) break;
        run(pb + 2);
        dbg::k_four_recon<<<CB, 256, 0, stream>>>(CCn, CW, (const float*)(ws + OFF_MH) + (size_t)l * 2 * 4 * 64 * 64, CCr, D, RB);
        dbg::k_cvt<<<CB, 256, 0, stream>>>(CCn + 512, CW, CCr + 256, D, RB, 768, 1.f);
        ref::k_gemm_f32<<<dim3(D / 64, nr / 64), 256, 0, stream>>>(CCr + (size_t)j0 * D, D, wout, D, Or + (size_t)j0 * D, D, D);
        dbg::k_cmp_bf16<<<CB, 256, 0, stream>>>(Or + (size_t)j0 * D, D, On + (size_t)j0 * D, D, nr, D, 1.f, DIAG, sb + 4, 0); dbg::k_cmp_bf16<<<CB, 256, 0, stream>>>(Or + (size_t)j0 * D, D, On + (size_t)j0 * D, D, nr, D, 1.f, DIAG, sb + 4, 1); nst = sb + 4;
        if (pb + 3 >= MK_DBG_PHASES) break;
        dbg::k_cvt<<<CB, 256, 0, stream>>>(On, D, Or, D, RB, D, 1.f);

        run(pb + 3);
        ref::k_post_attn<<<nr / 4, 256, 0, stream>>>(last ? XS_lat : x, last ? XS_ctx : ctx, Or, MODl, a.in[I_LNAG] + l * D, a.in[I_LNAB] + l * D, A_lat, A_ctx, Hr, a.in[I_WR], a.in[I_RB], SELr, 0, j0, nr);
        dbg::k_cmp_bf16<<<CB, 256, 0, stream>>>(A_lat, D, RESn + (size_t)L * D, D, S, D, 1.f, DIAG, sb + 5, 0); dbg::k_cmp_bf16<<<CB, 256, 0, stream>>>(A_lat, D, RESn + (size_t)L * D, D, S, D, 1.f, DIAG, sb + 5, 1);
        if (!last) { dbg::k_cmp_bf16<<<CB, 256, 0, stream>>>(A_ctx, D, RESn, D, L, D, 1.f, DIAG, sb + 5, 0); dbg::k_cmp_bf16<<<CB, 256, 0, stream>>>(A_ctx, D, RESn, D, L, D, 1.f, DIAG, sb + 5, 1); }
        dbg::k_cmp_bf16<<<CB, 256, 0, stream>>>(Hr + (size_t)j0 * D, D, On + (size_t)j0 * D, D, nr, D, 1.f, DIAG, sb + 6, 0); dbg::k_cmp_bf16<<<CB, 256, 0, stream>>>(Hr + (size_t)j0 * D, D, On + (size_t)j0 * D, D, nr, D, 1.f, DIAG, sb + 6, 1);
        dbg::k_cmp_sel<<<16, 256, 0, stream>>>(SELr + j0, SELn + j0, nr, DIAG, sb + 6); nst = sb + 6;
        dbg::k_cvt<<<CB, 256, 0, stream>>>(On, D, Hr, D, RB, D, 1.f);
        if (pb + 5 >= MK_DBG_PHASES) break;
        run(pb + 4); run(pb + 5);
        ref::k_moe_naive<<<nr, 256, 0, stream>>>(Hr, SELn, a.in[I_WG], a.in[I_WUP], a.in[I_WDN], Yr, l, j0);
        dbg::k_cmp_bf16_sum2<<<CB, 256, 0, stream>>>(Yr + (size_t)j0 * D, D, Y2n + (size_t)(2 * j0) * D, Y2n + (size_t)(2 * j0 + 1) * D, 2 * D, nr, D, DIAG, sb + 7, 0); dbg::k_cmp_bf16_sum2<<<CB, 256, 0, stream>>>(Yr + (size_t)j0 * D, D, Y2n + (size_t)(2 * j0) * D, Y2n + (size_t)(2 * j0 + 1) * D, 2 * D, nr, D, DIAG, sb + 7, 1); nst = sb + 7;
        if (pb + 6 >= MK_DBG_PHASES) break;
        dbg::k_cvt<<<CB, 256, 0, stream>>>(RESn + (size_t)L * D, D, A_lat, D, S, D, 1.f); dbg::k_cvt<<<CB, 256, 0, stream>>>(RESn, D, A_ctx, D, L, D, 1.f);
        dbg::k_cvt_sum2<<<CB, 256, 0, stream>>>(Y2n, Y2n + D, 2 * D, Yr, D, RB, D);
        run(pb + 6);
        ref::k_post_ffn<<<nr / 4, 256, 0, stream>>>(A_lat, A_ctx, Yr, MODl, a.in[I_LNFG] + l * D, a.in[I_LNFB] + l * D, B_lat, B_ctx, 0, j0, nr);
        if (last) dbg::k_cmp_f32<<<CB, 256, 0, stream>>>(B_lat, D, a.out, D, S, D, DIAG, sb + 8, 0); else dbg::k_cmp_bf16<<<CB, 256, 0, stream>>>(B_lat, D, RESn + (size_t)L * D, D, S, D, 1.f, DIAG, sb + 8, 0); if (last) dbg::k_cmp_f32<<<CB, 256, 0, stream>>>(B_lat, D, a.out, D, S, D, DIAG, sb + 8, 1); else dbg::k_cmp_bf16<<<CB, 256, 0, stream>>>(B_lat, D, RESn + (size_t)L * D, D, S, D, 1.f, DIAG, sb + 8, 1);
        if (!last) { dbg::k_cmp_bf16<<<CB, 256, 0, stream>>>(B_ctx, D, RESn, D, L, D, 1.f, DIAG, sb + 8, 0); dbg::k_cmp_bf16<<<CB, 256, 0, stream>>>(B_ctx, D, RESn, D, L, D, 1.f, DIAG, sb + 8, 1); }
        nst = sb + 8;
    }
#if MK_DBG_PHASES < 16
    (void)hipMemsetAsync(d_out, 0, (size_t)out_size * 4, stream);
#endif
    dbg::k_final<<<1024, 256, 0, stream>>>(DIAG, nst, (float*)d_out, (size_t)out_size);
#endif
}
```

```cpp
#include <hip/hip_runtime.h>
#include <math.h>
#include <stdio.h>
#ifndef MK_DEBUG
#define MK_DEBUG 0
#endif
#undef MK_DEBUG
#define MK_DEBUG 0
typedef unsigned short bf16_t;
typedef short bf16x8 __attribute__((ext_vector_type(8)));
typedef short s16x4 __attribute__((ext_vector_type(4)));
typedef float f32x4 __attribute__((ext_vector_type(4)));
typedef float f32x16 __attribute__((ext_vector_type(16)));
typedef unsigned u32x4 __attribute__((ext_vector_type(4)));
typedef unsigned u32x2 __attribute__((ext_vector_type(2)));
typedef float f32x2_t __attribute__((ext_vector_type(2)));
typedef __bf16 bf16x2_t __attribute__((ext_vector_type(2)));
#define LAS __attribute__((address_space(3)))

__device__ __forceinline__ unsigned cvtpk(float lo, float hi) { f32x2_t v = {lo, hi}; bf16x2_t b = __builtin_convertvector(v, bf16x2_t); return __builtin_bit_cast(unsigned, b); }
__device__ __forceinline__ float bf_lo(unsigned w) { return __uint_as_float(w << 16); }
__device__ __forceinline__ float bf_hi(unsigned w) { return __uint_as_float(w & 0xffff0000u); }
__device__ __forceinline__ float bf2f(bf16_t b) { return __uint_as_float(((unsigned)b) << 16); }

#define XB_TMO      128
#define XB_XCNT(j)  (256  + 64 * (j))
#define XB_XSUB(j)  (1280 + 64 * (j))
#define XB_XGEN(j)  (2304 + 64 * (j))
#define XB_TOP      3328
#define XB_TOPGEN   3392
#define XCD_BAR_WORDS 3456
#define XB_SPIN_CAP (1u << 18)
__device__ __forceinline__ unsigned xb_ld(unsigned* p)              { return __hip_atomic_load(p, __ATOMIC_RELAXED, __HIP_MEMORY_SCOPE_AGENT); }
__device__ __forceinline__ unsigned xb_add(unsigned* p, unsigned v) { return __hip_atomic_fetch_add(p, v, __ATOMIC_RELAXED, __HIP_MEMORY_SCOPE_AGENT); }
__device__ __forceinline__ unsigned xb_xcc_id() { return (unsigned)__builtin_amdgcn_s_getreg((3 << 11) | 20) & 0xFu; }
#define XB_SPIN(cond, bar) do { unsigned _sp = 0; while (cond) { __builtin_amdgcn_s_sleep(1); \
    if ((++_sp & 255u) == 0u) { if (xb_ld(&(bar)[XB_TMO])) break; if (_sp > XB_SPIN_CAP) { atomicAdd(&(bar)[XB_TMO], 1u); break; } } } } while (0)
struct XcdBarrier { unsigned* bar; unsigned x; volatile LAS unsigned* st; };
__device__ __forceinline__ XcdBarrier xcd_barrier_post(unsigned* bar, volatile LAS unsigned* st) {
    XcdBarrier b; b.bar = bar; b.x = xb_xcc_id(); b.st = st;
    if (threadIdx.x == 0) (void)xb_add(&bar[XB_XCNT(b.x)], 1u);
    return b;
}
__device__ __forceinline__ void xcd_barrier_complete(unsigned* bar, unsigned x, unsigned& nloc, unsigned& nx) {
    const unsigned G = gridDim.x * gridDim.y * gridDim.z;
    unsigned sum, cnt, mine, sp = 0u;
    for (;;) {
        sum = 0u; cnt = 0u; mine = 0u;
#pragma unroll
        for (unsigned j = 0; j < 16; ++j) { const unsigned c = xb_ld(&bar[XB_XCNT(j)]); sum += c; cnt += (c > 0u) ? 1u : 0u; mine = (j == x) ? c : mine; }
        if (sum == G) break;
        __builtin_amdgcn_s_sleep(1);
        if ((++sp & 255u) == 0u) { if (xb_ld(&bar[XB_TMO])) break; if (sp > XB_SPIN_CAP) { atomicAdd(&bar[XB_TMO], 1u); break; } }
    }
    nloc = mine > 0u ? mine : 1u; nx = cnt > 0u ? cnt : 1u;
}
__device__ __forceinline__ void xcd_barrier(const XcdBarrier& b, unsigned long long* stamp = nullptr) {
    asm volatile("s_waitcnt vmcnt(0)" ::: "memory");
    __syncthreads();
    if (threadIdx.x == 0) {
        unsigned* bar = b.bar;
        __builtin_amdgcn_s_waitcnt(0);
        unsigned nloc = b.st[0], nx = b.st[1];
        if (nloc == 0u) { xcd_barrier_complete(bar, b.x, nloc, nx); b.st[0] = nloc; b.st[1] = nx; }
        const unsigned old = xb_add(&bar[XB_XSUB(b.x)], 1u);
        const unsigned gen = old / nloc;
        if (old + 1u == (gen + 1u) * nloc) {
            __builtin_amdgcn_fence(__ATOMIC_RELEASE, "agent");
            asm volatile("s_waitcnt vmcnt(0)" ::: "memory");
            const unsigned og = xb_add(&bar[XB_TOP], 1u);
            const unsigned tg = og / nx;
            if (og + 1u == (tg + 1u) * nx) xb_add(&bar[XB_TOPGEN], 1u);
            else XB_SPIN(xb_ld(&bar[XB_TOPGEN]) == tg, bar);
            __builtin_amdgcn_fence(__ATOMIC_ACQUIRE, "agent");
            xb_add(&bar[XB_XGEN(b.x)], 1u);
            asm volatile("s_waitcnt vmcnt(0)" ::: "memory");
        } else {
            XB_SPIN(xb_ld(&bar[XB_XGEN(b.x)]) == gen, bar);
            __builtin_amdgcn_fence(__ATOMIC_ACQUIRE, "agent");
            asm volatile("s_waitcnt vmcnt(0)" ::: "memory");
        }
        if (stamp) *stamp = wall_clock64();
    }
    __syncthreads();
}

namespace g8 {
constexpr int BM = 256, BK = 64, HALF = 128, HTB = HALF * BK * 2, STAGE_BYTES = 8 * HTB;
__device__ __forceinline__ int lds_byte(int r, int c) { const int st = (r >> 4) * 2 + (c >> 5), rr = r & 15, cc = c & 31, ob = rr * 64 + cc * 2; return st * 1024 + (ob ^ (((ob >> 9) & 1) << 5)); }
__device__ __forceinline__ void stage_rc(int b, int& R, int& C) { const int st = b / 1024, sb = b % 1024, swz = sb ^ (((sb >> 9) & 1) << 5); R = (st >> 1) * 16 + swz / 64; C = (st & 1) * 32 + (swz % 64) / 2; }
__device__ __forceinline__ int perm32(int rho) { const int n = rho >> 4, i = rho & 15; return 8 * (i >> 2) + 4 * n + (i & 3); }

struct Unit { const char* A; const char* B; const int* gl; int gcount; int kind, p0, p1; };

template <bool GATHER, class Epi, class Sched>
__device__ __forceinline__ void gemm_phase(LAS unsigned char* lds, const int K, const unsigned lda2, const unsigned ldb2, const Sched& S, const Epi& E) {
    int tid = threadIdx.x; asm volatile("" : "+v"(tid));
    const int wid = __builtin_amdgcn_readfirstlane(tid >> 6), lane = tid & 63, wr = wid >> 2, wc = wid & 3, fr = lane & 15, fq = lane >> 4;
    const int nt = K / BK;
    int Rr[2], Cc[2];
    unsigned vB[2];
#pragma unroll
    for (int i = 0; i < 2; ++i) { stage_rc(tid * 16 + i * 8192, Rr[i], Cc[i]); const int Rb = (Rr[i] & ~31) + perm32(Rr[i] & 31); vB[i] = (unsigned)Rb * ldb2 + (unsigned)Cc[i] * 2u; }
    const unsigned hB = (unsigned)HALF * ldb2, hA = (unsigned)HALF * lda2;
    const size_t kstep = (size_t)(BK * 2);
    const unsigned ldsw = (unsigned)wid * 1024u;
    const int aoff = lds_byte(wr * 64 + fr, fq * 8), boff = lds_byte(wc * 32 + fr, fq * 8);
    Unit cur, nxt; int ui = 0;
    if (!S.next(0, cur)) return;
    unsigned vA[2][2], nvA[2][2];
#define G8_CALCVA(u, v) do { _Pragma("unroll") for (int _h = 0; _h < 2; ++_h) _Pragma("unroll") for (int _i = 0; _i < 2; ++_i) { const int _r = _h * HALF + Rr[_i]; \
        if (GATHER) { const int _tok = (_r < (u).gcount) ? ((u).gl[_r] >> 1) : 256;     v[_h][_i] = (unsigned)_tok * lda2 + (unsigned)Cc[_i] * 2u; } \
        else v[_h][_i] = (unsigned)_r * lda2 + (unsigned)Cc[_i] * 2u; } } while (0)
    G8_CALCVA(cur, vA);
#define G8_SA(b, h) (((b) * 2 + (h)) * HTB)
#define G8_SB(b, h) ((4 + (b) * 2 + (h)) * HTB)
#define G8_STAGE_A(bufoff, gbase, VV, hh) do { _Pragma("unroll") for (int _i = 0; _i < 2; ++_i) \
        __builtin_amdgcn_global_load_lds((const unsigned*)(((const char*)(gbase) + (GATHER ? (size_t)0 : (size_t)((hh) * hA))) + VV[GATHER ? (hh) : 0][_i]), (LAS unsigned*)(lds + (bufoff) + ldsw + _i * 8192), 16, 0, 0); } while (0)
#define G8_STAGE_B(bufoff, gbase, h) do { _Pragma("unroll") for (int _i = 0; _i < 2; ++_i) \
        __builtin_amdgcn_global_load_lds((const unsigned*)((const char*)(gbase) + (size_t)((h) * hB) + vB[_i]), (LAS unsigned*)(lds + (bufoff) + ldsw + _i * 8192), 16, 0, 0); } while (0)
#define G8_LDA(dst, b, h) do { _Pragma("unroll") for (int m = 0; m < 4; ++m) _Pragma("unroll") for (int k = 0; k < 2; ++k) dst[m][k] = *(const LAS bf16x8*)(lds + G8_SA(b, h) + aoff + m * 2048 + k * 1024); } while (0)
#define G8_LDB(dst, b, h) do { _Pragma("unroll") for (int n = 0; n < 2; ++n) _Pragma("unroll") for (int k = 0; k < 2; ++k) dst[n][k] = *(const LAS bf16x8*)(lds + G8_SB(b, h) + boff + n * 2048 + k * 1024); } while (0)
#define G8_MMA(ai, bj, At, Bt) do { __builtin_amdgcn_s_setprio(1); _Pragma("unroll") for (int m = 0; m < 4; ++m) _Pragma("unroll") for (int n = 0; n < 2; ++n) _Pragma("unroll") for (int k = 0; k < 2; ++k) \
        acc[ai][bj][m][n] = __builtin_amdgcn_mfma_f32_16x16x32_bf16(Bt[n][k], At[m][k], acc[ai][bj][m][n], 0, 0, 0); __builtin_amdgcn_s_setprio(0); } while (0)
#define G8_WAIT_V(n) asm volatile("s_waitcnt vmcnt(" #n ")" ::: "memory")
#define G8_WAIT_L(n) asm volatile("s_waitcnt lgkmcnt(" #n ")" ::: "memory")
#define G8_BAR __builtin_amdgcn_s_barrier()
#define G8_SCHED __builtin_amdgcn_sched_barrier(0)
    f32x4 acc[2][2][4][2];
#pragma unroll
    for (int a = 0; a < 2; ++a)
#pragma unroll
        for (int b = 0; b < 2; ++b)
#pragma unroll
            for (int m = 0; m < 4; ++m)
#pragma unroll
                for (int n = 0; n < 2; ++n) acc[a][b][m][n] = (f32x4){0.f, 0.f, 0.f, 0.f};
    bf16x8 At[4][2], B0[2][2], B1[2][2];
    const char* cA = cur.A; const char* cB = cur.B;
    G8_STAGE_B(G8_SB(0, 0), cB, 0); G8_STAGE_B(G8_SB(0, 1), cB, 1); G8_STAGE_A(G8_SA(0, 0), cA, vA, 0); G8_STAGE_A(G8_SA(0, 1), cA, vA, 1);
    if (wr == 1) G8_BAR;
    G8_WAIT_V(2); G8_BAR;
    G8_STAGE_B(G8_SB(1, 0), cB + kstep, 0); G8_STAGE_A(G8_SA(1, 0), cA + kstep, vA, 0); G8_STAGE_B(G8_SB(1, 1), cB + kstep, 1);
    G8_WAIT_V(6); G8_BAR;
    for (;;) {
        const bool has_next = S.next(ui + 1, nxt);
        const char* nA = has_next ? nxt.A : cA; const char* nB = has_next ? nxt.B : cB;
        if (GATHER && has_next) { G8_CALCVA(nxt, nvA); } else {
#pragma unroll
            for (int h = 0; h < 2; ++h)
#pragma unroll
                for (int i = 0; i < 2; ++i) nvA[h][i] = vA[h][i]; }
#pragma clang loop unroll(disable)
        for (int t = 0; t < nt; t += 2) {
            const bool last = (t == nt - 2);
            const char* a1 = cA + (size_t)(t + 1) * kstep;
            const char* a2 = last ? nA : cA + (size_t)(t + 2) * kstep; const char* b2 = last ? nB : cB + (size_t)(t + 2) * kstep;
            const char* a3 = a2 + kstep; const char* b3 = b2 + kstep;
            unsigned o2[2][2];
#pragma unroll
            for (int h = 0; h < 2; ++h)
#pragma unroll
                for (int i = 0; i < 2; ++i) o2[h][i] = (GATHER && last) ? nvA[h][i] : vA[h][i];
            G8_LDB(B0, 0, 0); G8_LDB(B1, 0, 1); G8_SCHED; G8_LDA(At, 0, 0); G8_STAGE_A(G8_SA(1, 1), a1, vA, 1);
            G8_WAIT_V(8); G8_WAIT_L(0); G8_BAR; G8_MMA(0, 0, At, B0); G8_MMA(0, 1, At, B1); G8_BAR; G8_SCHED;
            G8_LDA(At, 0, 1); G8_STAGE_B(G8_SB(0, 0), b2, 0); G8_STAGE_B(G8_SB(0, 1), b2, 1); G8_STAGE_A(G8_SA(0, 0), a2, o2, 0);
            G8_WAIT_V(8); G8_WAIT_L(0); G8_BAR; G8_MMA(1, 0, At, B0); G8_MMA(1, 1, At, B1); G8_BAR; G8_SCHED;
            G8_LDB(B0, 1, 0); G8_LDB(B1, 1, 1); G8_SCHED; G8_LDA(At, 1, 0); G8_STAGE_A(G8_SA(0, 1), a2, o2, 1);
            G8_WAIT_V(8); G8_WAIT_L(0); G8_BAR; G8_MMA(0, 0, At, B0); G8_MMA(0, 1, At, B1); G8_BAR; G8_SCHED;
            G8_LDA(At, 1, 1); G8_STAGE_B(G8_SB(1, 0), b3, 0); G8_STAGE_B(G8_SB(1, 1), b3, 1); G8_STAGE_A(G8_SA(1, 0), a3, o2, 0);
            G8_WAIT_V(8); G8_WAIT_L(0); G8_BAR; G8_MMA(1, 0, At, B0); G8_MMA(1, 1, At, B1); G8_BAR; G8_SCHED;
        }
        if (wr == 0) G8_BAR;
        E(acc, cur, wr, wc, fr, fq);
        if (!has_next) break;
#pragma unroll
        for (int a = 0; a < 2; ++a)
#pragma unroll
            for (int b = 0; b < 2; ++b)
#pragma unroll
                for (int m = 0; m < 4; ++m)
#pragma unroll
                    for (int n = 0; n < 2; ++n) acc[a][b][m][n] = (f32x4){0.f, 0.f, 0.f, 0.f};
        cur = nxt; cA = nA; cB = nB; ++ui;
#pragma unroll
        for (int h = 0; h < 2; ++h)
#pragma unroll
            for (int i = 0; i < 2; ++i) vA[h][i] = nvA[h][i];
        if (wr == 1) G8_BAR;
    }
    G8_WAIT_V(0);
    G8_BAR;
#undef G8_CALCVA
#undef G8_SA
#undef G8_SB
#undef G8_STAGE_A
#undef G8_STAGE_B
#undef G8_LDA
#undef G8_LDB
#undef G8_MMA
#undef G8_WAIT_V
#undef G8_WAIT_L
#undef G8_BAR
#undef G8_SCHED
}
}
namespace mk {
constexpr int NB = 16, S = 2048, L = 256, D = 1024, RB = L + S, NTOK = NB * RB;
constexpr int QKVW = 2304, CW = 1280, MODW = 6 * D, CAP = NTOK, NPAIR = 2 * NTOK, SORT_ROWS = NPAIR + 16 * 256;
constexpr float ALPHA = 1.41421356237309515f, EPS = 1e-5f, QSCALE = 0.125f * 1.4426950408889634f;
constexpr size_t al256(size_t x) { return (x + 255) & ~(size_t)255; }
constexpr size_t CTL_BYTES = 65536, CTL_BAR_STRIDE = 13824  , CTL_CNT = 57344  ;
constexpr size_t OFF_MOD = CTL_BYTES, SZ_MOD = (size_t)2 * 17 * MODW * 4;
constexpr size_t OFF_LAM = OFF_MOD + al256(SZ_MOD);
constexpr size_t OFF_RC = OFF_LAM + 256, OFF_RS = OFF_RC + 4096;
constexpr size_t OFF_MH = OFF_RS + 4096, SZ_MH = (size_t)2 * 2 * 4 * 64 * 64 * 4;
constexpr size_t OFF_TABL = OFF_MH + SZ_MH, SZ_TABL = (size_t)2 * S * S * 2;
constexpr size_t OFF_TABC = OFF_TABL + SZ_TABL, SZ_TABC = (size_t)2 * L * L * 2;
constexpr size_t OFF_WQKV = OFF_TABC + SZ_TABC, SZ_WQKV = (size_t)2 * QKVW * D * 2;
constexpr size_t OFF_WU = OFF_WQKV + SZ_WQKV, SZ_WU = (size_t)2 * 512 * D * 2;
constexpr size_t OFF_WOUT = OFF_WU + SZ_WU, SZ_WOUT = (size_t)2 * D * CW * 2;
constexpr size_t OFF_LIST = OFF_WOUT + SZ_WOUT, SZ_LIST = (size_t)16 * CAP * 4;
constexpr size_t OFF_WPAIR = OFF_LIST + SZ_LIST, SZ_WPAIR = (size_t)16 * CAP * 4;
constexpr size_t OFF_SELN = OFF_WPAIR + SZ_WPAIR, SZ_SELN = (size_t)NTOK * 16;
constexpr size_t OFF_RES = OFF_SELN + SZ_SELN, SZ_RES = (size_t)NTOK * D * 2;
constexpr size_t OFF_ARENA = OFF_RES + SZ_RES;
constexpr size_t SZ_H = (size_t)NTOK * D * 2, SZ_CC = (size_t)NTOK * CW * 2, SZ_QKV = (size_t)NTOK * QKVW * 2, SZ_UTL = (size_t)NB * 2 * 256 * S * 2, SZ_UTC = (size_t)NB * 2 * 256 * L * 2;
constexpr size_t SZ_ASORT = (size_t)SORT_ROWS * 512 * 2, SZ_Y2 = (size_t)NPAIR * D * 2, SZ_WGU = (size_t)16 * 1024 * 1024 * 2, SZ_WD = (size_t)16 * 1024 * 512 * 2;
constexpr size_t AR_H = 0, AR_CC = 0, AR_QKV = SZ_CC, AR_UTL = AR_QKV + SZ_QKV, AR_UTC = AR_UTL + SZ_UTL, AR_O = SZ_CC, AR_ASORT = 0, AR_Y2 = SZ_ASORT, AR_WGU = AR_Y2 + SZ_Y2, AR_WD = AR_WGU + SZ_WGU;
constexpr size_t SZ_ARENA = (AR_UTC + SZ_UTC) > (AR_WD + SZ_WD) ? (AR_UTC + SZ_UTC) : (AR_WD + SZ_WD);
constexpr size_t WS_NEED = OFF_ARENA + SZ_ARENA;
static_assert(AR_ASORT + SZ_ASORT <= AR_O, "ASORT must not overlap O/H2");
static_assert(AR_WGU >= AR_O + SZ_H, "MoE weights must not overlap O/H2");
static_assert(AR_H + SZ_H <= AR_Y2, "next layer's H must not overlap Y2");
constexpr int LDS_MISC = 131072, LDS_ROPE = LDS_MISC + 4096  , LDS_BYTES = LDS_ROPE + 8192;

struct Args {
    const float* in[20]; float* out; unsigned char* ws; int ph_lo, ph_hi, li, rep_attn; int rep[16]; int attn_var, pad2;
};
enum { I_X = 0, I_C, I_CTX, I_CCTX, I_WMOD, I_BMOD, I_WIN, I_WF, I_LAMQK, I_SUBLN, I_WOUT, I_LNAG, I_LNAB, I_LNFG, I_LNFB, I_WR, I_RB, I_WG, I_WUP, I_WDN };

template <class T> __device__ __forceinline__ T* wsp(const Args& a, size_t off) { return (T*)(a.ws + off); }

__device__ __forceinline__ float wave_sum(float v) {
    v += __builtin_bit_cast(float, __builtin_amdgcn_update_dpp(0, __builtin_bit_cast(int, v), 0xB1, 0xF, 0xF, true));
    v += __builtin_bit_cast(float, __builtin_amdgcn_update_dpp(0, __builtin_bit_cast(int, v), 0x4E, 0xF, 0xF, true));
    v += __builtin_bit_cast(float, __builtin_amdgcn_update_dpp(0, __builtin_bit_cast(int, v), 0x124, 0xF, 0xF, true));
    v += __builtin_bit_cast(float, __builtin_amdgcn_update_dpp(0, __builtin_bit_cast(int, v), 0x128, 0xF, 0xF, true));
    const int vi = __builtin_bit_cast(int, v);
    return (__builtin_bit_cast(float, __builtin_amdgcn_readlane(vi, 0)) + __builtin_bit_cast(float, __builtin_amdgcn_readlane(vi, 16))) +
           (__builtin_bit_cast(float, __builtin_amdgcn_readlane(vi, 32)) + __builtin_bit_cast(float, __builtin_amdgcn_readlane(vi, 48)));
}
struct Row { f32x4 v[4]; };
__device__ __forceinline__ Row row_load(const float* p, int lane) { Row r;
#pragma unroll
    for (int i = 0; i < 4; ++i) r.v[i] = *(const f32x4*)(p + i * 256 + lane * 4);
    return r; }
__device__ __forceinline__ void row_store(float* p, int lane, const Row& r) {
#pragma unroll
    for (int i = 0; i < 4; ++i) *(f32x4*)(p + i * 256 + lane * 4) = r.v[i]; }
__device__ __forceinline__ Row row_load_bf16(const bf16_t* p, int lane) { Row r;
#pragma unroll
    for (int i = 0; i < 4; ++i) { const u32x2 w = *(const u32x2*)(p + i * 256 + lane * 4); r.v[i] = (f32x4){bf_lo(w.x), bf_hi(w.x), bf_lo(w.y), bf_hi(w.y)}; }
    return r; }
struct RowB { u32x2 w[4]; };
__device__ __forceinline__ RowB rowb_load(const bf16_t* p, int lane) { RowB r;
#pragma unroll
    for (int i = 0; i < 4; ++i) r.w[i] = *(const u32x2*)(p + i * 256 + lane * 4);
    return r; }
__device__ __forceinline__ Row rowb_f32(const RowB& b) { Row r;
#pragma unroll
    for (int i = 0; i < 4; ++i) r.v[i] = (f32x4){bf_lo(b.w[i].x), bf_hi(b.w[i].x), bf_lo(b.w[i].y), bf_hi(b.w[i].y)};
    return r; }
__device__ __forceinline__ void row_store_bf16(bf16_t* p, int lane, const Row& r) {
#pragma unroll
    for (int i = 0; i < 4; ++i) { u32x2 w; w.x = cvtpk(r.v[i][0], r.v[i][1]); w.y = cvtpk(r.v[i][2], r.v[i][3]); *(u32x2*)(p + i * 256 + lane * 4) = w; } }
__device__ __forceinline__ void row_ln(Row& r) {
    float s = 0.f;
#pragma unroll
    for (int i = 0; i < 4; ++i) s += (r.v[i][0] + r.v[i][1]) + (r.v[i][2] + r.v[i][3]);
    const float mean = wave_sum(s) * (1.f / 1024.f);
    float q = 0.f;
#pragma unroll
    for (int i = 0; i < 4; ++i) { r.v[i] = r.v[i] - mean; q += (r.v[i][0] * r.v[i][0] + r.v[i][1] * r.v[i][1]) + (r.v[i][2] * r.v[i][2] + r.v[i][3] * r.v[i][3]); }
    const float rstd = rsqrtf(wave_sum(q) * (1.f / 1024.f) + EPS);
#pragma unroll
    for (int i = 0; i < 4; ++i) r.v[i] = r.v[i] * rstd;
}
__device__ __forceinline__ bf16_t* res_ptr(const Args& a, int row) { return wsp<bf16_t>(a, OFF_RES) + (size_t)row * D; }
__device__ __forceinline__ float* out_ptr(const Args& a, int row) { const int b = row / RB, j = row - b * RB; return a.out + ((size_t)b * S + (j - L)) * D; }
__device__ __forceinline__ const float* xin_ptr(const Args& a, int row) { const int b = row / RB, j = row - b * RB; return j < L ? a.in[I_CTX] + ((size_t)b * L + j) * D : a.in[I_X] + ((size_t)b * S + (j - L)) * D; }
__device__ __forceinline__ int thin_row(int i, bool last) { return last ? ((i >> 11) * RB + L + (i & 2047)) : i; }

__device__ __forceinline__ void tr_item(const float* __restrict__ src, size_t ld_src, bf16_t* __restrict__ dst, size_t ld_dst, int lane) {
    float v[64];
#pragma unroll
    for (int r = 0; r < 64; ++r) v[r] = __builtin_nontemporal_load(src + (size_t)r * ld_src + lane);
    bf16_t* d = dst + (size_t)lane * ld_dst;
#pragma unroll
    for (int q = 0; q < 8; ++q) { u32x4 w; w.x = cvtpk(v[q * 8 + 0], v[q * 8 + 1]); w.y = cvtpk(v[q * 8 + 2], v[q * 8 + 3]); w.z = cvtpk(v[q * 8 + 4], v[q * 8 + 5]); w.w = cvtpk(v[q * 8 + 6], v[q * 8 + 7]); *(u32x4*)(d + q * 8) = w; }
}

__device__ __forceinline__ void phase0a(const Args& a, LAS unsigned char* lds) {
    int tid = threadIdx.x; asm volatile("" : "+v"(tid));
    const int lane = tid & 63, wid = __builtin_amdgcn_readfirstlane(tid >> 6), blk = blockIdx.x, G = gridDim.x, gw = blk * 8 + wid, nw = G * 8, gt = blk * 512 + tid, ntr = G * 512;
    if (blk < 192) {
        LAS float* SIL = (LAS float*)lds; LAS float* red = (LAS float*)(lds + 69632);
        for (int i = tid; i < 17 * 1024; i += 512) { const float x = i < 16 * 1024 ? a.in[I_C][i] : a.in[I_CCTX][i - 16 * 1024]; SIL[i] = x / (1.f + __expf(-x)); }
        __syncthreads();
        for (int item = blk; item < 192; item += G) {
            const int l = item / 96, cg = item - l * 96, n = cg * 64 + lane;
            float acc[17];
#pragma unroll
            for (int r = 0; r < 17; ++r) acc[r] = 0.f;
            const float* w = a.in[I_WMOD] + (size_t)l * D * MODW;
            float wn[8];
#pragma unroll
            for (int q = 0; q < 8; ++q) wn[q] = (w + (size_t)(wid * 128 + q) * MODW)[n];
            for (int k0 = wid * 128; k0 < wid * 128 + 128; k0 += 8) {
                float wv[8];
#pragma unroll
                for (int q = 0; q < 8; ++q) wv[q] = wn[q];
                if (k0 + 8 < wid * 128 + 128) {
#pragma unroll
                    for (int q = 0; q < 8; ++q) wn[q] = __builtin_nontemporal_load(w + (size_t)(k0 + 8 + q) * MODW + n); }
#pragma unroll
                for (int r = 0; r < 17; ++r) { const f32x4 s0 = *(const LAS f32x4*)(SIL + r * 1024 + k0), s1 = *(const LAS f32x4*)(SIL + r * 1024 + k0 + 4);
                    acc[r] += ((s0[0] * wv[0] + s0[1] * wv[1]) + (s0[2] * wv[2] + s0[3] * wv[3])) + ((s1[0] * wv[4] + s1[1] * wv[5]) + (s1[2] * wv[6] + s1[3] * wv[7])); }
            }
#pragma unroll
            for (int r = 0; r < 17; ++r) red[(wid * 17 + r) * 64 + lane] = acc[r];
            __syncthreads();
            if (wid == 0) {
#pragma unroll
                for (int r = 0; r < 17; ++r) { float s = a.in[I_BMOD][(size_t)l * MODW + n];
#pragma unroll
                    for (int q = 0; q < 8; ++q) s += red[(q * 17 + r) * 64 + lane];
                    wsp<float>(a, OFF_MOD)[((size_t)l * 17 + r) * MODW + n] = s; }
            }
            __syncthreads();
        }
    }
    for (int it = gw; it < 1152 + 128 + 384; it += nw) {
        if (it < 1152) { const int l = it / 576, r = it - l * 576, kb = r / 36, nb = r - kb * 36;
            tr_item(a.in[I_WIN] + (size_t)l * D * 2560 + (size_t)(kb * 64) * 2560 + 256 + nb * 64, 2560, wsp<bf16_t>(a, OFF_WQKV) + ((size_t)l * QKVW + nb * 64) * D + kb * 64, D, lane);
        } else if (it < 1152 + 128) { const int q = it - 1152, l = q >> 6, r = q & 63, kb = r >> 2, nb = r & 3;
            tr_item(a.in[I_WIN] + (size_t)l * D * 2560 + (size_t)(kb * 64) * 2560 + nb * 64, 2560, wsp<bf16_t>(a, OFF_WU) + ((size_t)l * 256 + nb * 64) * D + kb * 64, D, lane);
        } else { const int q = it - 1280, l = q / 192, r = q - l * 192, kb = 4 + (r >> 4), nb = r & 15;
            const float* src = a.in[I_WOUT] + (size_t)l * D * D + (size_t)(kb * 64) * D + nb * 64;
            bf16_t* dst = wsp<bf16_t>(a, OFF_WOUT) + ((size_t)l * D + nb * 64) * CW;
            tr_item(src, D, dst + kb * 64 + 256, CW, lane);
        }
    }
    {
        const float nl = 0.0027621358640099515f  , nc = 0.0078125f  ;
        bf16_t* TL = wsp<bf16_t>(a, OFF_TABL); bf16_t* TC = wsp<bf16_t>(a, OFF_TABC);
        for (int it = gt; it < S * (S / 8) + L * (L / 8); it += ntr) {
            int T, tp, t0; float nn; bf16_t* base;
            if (it < S * (S / 8)) { T = S; tp = it / (S / 8); t0 = (it - tp * (S / 8)) * 8; nn = nl; base = TL; }
            else { const int q = it - S * (S / 8); T = L; tp = q / (L / 8); t0 = (q - tp * (L / 8)) * 8; nn = nc; base = TC; }
            float cv[8], sv[8];
#pragma unroll
            for (int j = 0; j < 8; ++j) { const int m = ((t0 + j) * tp) & (T - 1); const float x = 2.f * (float)m / (float)T; cv[j] = cospif(x) * nn; sv[j] = -sinpif(x) * nn; }
            u32x4 wc, wsn; wc.x = cvtpk(cv[0], cv[1]); wc.y = cvtpk(cv[2], cv[3]); wc.z = cvtpk(cv[4], cv[5]); wc.w = cvtpk(cv[6], cv[7]);
            wsn.x = cvtpk(sv[0], sv[1]); wsn.y = cvtpk(sv[2], sv[3]); wsn.z = cvtpk(sv[4], sv[5]); wsn.w = cvtpk(sv[6], sv[7]);
            *(u32x4*)(base + (size_t)tp * T + t0) = wc; *(u32x4*)(base + (size_t)T * T + (size_t)tp * T + t0) = wsn;
        }
    }
    for (int i = gt; i < 65536 + 1024 + 2; i += ntr) {
        if (i < 65536) { const int d = i & 63, c = (i >> 6) & 63, g = (i >> 12) & 3, half = (i >> 14) & 1, l = i >> 15;
            const float* wf = a.in[I_WF] + ((size_t)(l * 4 + g) * 64) * 64 + d; float s = 0.f;
            for (int cp = 0; cp < 64; ++cp) { const int m = (c * cp) & 63; const float x = (float)m * (1.f / 32.f); s += (half ? sinpif(x) : cospif(x)) * wf[cp * 64]; }
            wsp<float>(a, OFF_MH)[i] = s;
        } else if (i < 65536 + 1024) { const int q = i - 65536, pos = q >> 4, f = q & 15; const float ang = (float)pos * powf(10000.f, -(float)f / 16.f);
            wsp<float>(a, OFF_RC)[q] = cosf(ang); wsp<float>(a, OFF_RS)[q] = sinf(ang);
        } else { const int l = i - 65536 - 1024; const float* q = a.in[I_LAMQK] + l * 256; float s1 = 0.f, s2 = 0.f;
            for (int k = 0; k < 64; ++k) { s1 += q[k] * q[64 + k]; s2 += q[128 + k] * q[192 + k]; }
            wsp<float>(a, OFF_LAM)[l] = expf(s1) - expf(s2) + (0.8f - 0.6f * expf(-0.3f * (float)l)); }
    }
}

__device__ __forceinline__ void h_from_row(const Args& a, Row& r, int row, int l, int sh_off, int sc_off, int lane) {
    row_ln(r);
    const int b = row / RB, j = row - b * RB;
    const float* mrow = wsp<float>(a, OFF_MOD) + ((size_t)l * 17 + (j < L ? 16 : b)) * MODW;
    const Row sh = row_load(mrow + sh_off, lane), sc = row_load(mrow + sc_off, lane);
#pragma unroll
    for (int i = 0; i < 4; ++i) r.v[i] = r.v[i] * (1.f + sc.v[i]) + sh.v[i];
}
__device__ __forceinline__ void h_from_row2(Row& r, const Row& sh, const Row& sc) {
    row_ln(r);
#pragma unroll
    for (int i = 0; i < 4; ++i) r.v[i] = r.v[i] * (1.f + sc.v[i]) + sh.v[i];
}
__device__ __forceinline__ const float* mod_row(const Args& a, int l, int row) { const int b = row / RB, j = row - b * RB; return wsp<float>(a, OFF_MOD) + ((size_t)l * 17 + (j < L ? 16 : b)) * MODW; }
__device__ __forceinline__ void phase0b(const Args& a) {
    int tid = threadIdx.x; asm volatile("" : "+v"(tid));
    const int lane = tid & 63, wid = __builtin_amdgcn_readfirstlane(tid >> 6), gw = blockIdx.x * 8 + wid, nw = gridDim.x * 8;
    {
        Row xA = {}, xB = {};
        auto proc = [&](Row& xr, const int row) __attribute__((always_inline)) {
            const float* mrow = mod_row(a, 0, row);
            const Row sh = row_load(mrow + 0, lane), sc = row_load(mrow + 1024, lane);
            Row r = xr;
            if (row + 2 * nw < NTOK) xr = row_load(xin_ptr(a, row + 2 * nw), lane);
            h_from_row2(r, sh, sc);
            row_store_bf16(wsp<bf16_t>(a, OFF_ARENA + AR_H) + (size_t)row * D, lane, r);
        };
        int row = gw;
        if (row < NTOK) xA = row_load(xin_ptr(a, row), lane);
        if (row + nw < NTOK) xB = row_load(xin_ptr(a, row + nw), lane);
        for (; row < NTOK; row += 2 * nw) { proc(xA, row); if (row + nw < NTOK) proc(xB, row + nw); }
    }
    for (int it = gw; it < 1024; it += nw) {
        const int l = it >> 9, half = (it >> 8) & 1, g = (it >> 6) & 3, nb = (it >> 2) & 15, cb = it & 3, n = nb * 64 + lane;
        const float* wcol = a.in[I_WOUT] + (size_t)l * D * D + (size_t)(g * 64) * D + n;
        float wv[64];
#pragma unroll
        for (int d = 0; d < 64; ++d) wv[d] = (a.in[I_WOUT] + (size_t)l * D * D + (size_t)(g * 64 + d) * D)[n];
        const float* mh = wsp<float>(a, OFF_MH) + ((size_t)((l * 2 + half) * 4 + g) * 64 + cb * 16) * 64;
        float acc[16];
#pragma unroll
        for (int c = 0; c < 16; ++c) { float s_ = 0.f;
#pragma unroll
            for (int d4 = 0; d4 < 16; ++d4) { const f32x4 m = *(const f32x4*)(mh + c * 64 + d4 * 4); s_ += (m[0] * wv[d4 * 4 + 0] + m[1] * wv[d4 * 4 + 1]) + (m[2] * wv[d4 * 4 + 2] + m[3] * wv[d4 * 4 + 3]); }
            acc[c] = s_; }
        (void)wcol;
        bf16_t* dst = wsp<bf16_t>(a, OFF_WOUT) + ((size_t)l * D + n) * CW + half * 256 + g * 64 + cb * 16;
        u32x4 w0, w1; w0.x = cvtpk(acc[0], acc[1]); w0.y = cvtpk(acc[2], acc[3]); w0.z = cvtpk(acc[4], acc[5]); w0.w = cvtpk(acc[6], acc[7]);
        w1.x = cvtpk(acc[8], acc[9]); w1.y = cvtpk(acc[10], acc[11]); w1.z = cvtpk(acc[12], acc[13]); w1.w = cvtpk(acc[14], acc[15]);
        *(u32x4*)dst = w0; *(u32x4*)(dst + 8) = w1;
    }
}

struct SchedInproj {
    const char* H; const char* WQ; const char* WUp; int G, c; bool last;
    __device__ __forceinline__ bool next(int i, g8::Unit& u) const {
        const int Lu = i * G + c, nq = last ? 1248 : 1296, nu = last ? 128 : 144;
        u.gl = nullptr; u.gcount = 0;
        if (Lu < nq) { int pm, pn;
            if (!last) { const int grp = Lu / 72, w = Lu - grp * 72; pm = grp * 8 + (w & 7); pn = w >> 3; }
            else if (Lu < 1152) { const int grp = Lu / 72, w = Lu - grp * 72, q = grp * 8 + (w & 7); pm = (q >> 3) * 9 + 1 + (q & 7); pn = w >> 3; }
            else { const int q = Lu - 1152; pm = (q & 15) * 9; pn = 3 + (q >> 4); }
            u.A = H + (size_t)pm * 256 * 2048; u.B = WQ + (size_t)pn * 256 * 2048; u.kind = 0; u.p0 = pm; u.p1 = pn; return true; }
        const int q = Lu - nq;
        if (q < nu) { const int tt = q, pmT = last ? ((tt >> 3) * 9 + 1 + (tt & 7)) : tt;
            u.A = WUp; u.B = H + (size_t)pmT * 256 * 2048; u.kind = 1; u.p0 = 0; u.p1 = pmT; return true; }
        return false;
    }
};
struct EpiInproj {
    bf16_t* QKV; bf16_t* UTL; bf16_t* UTC; const LAS float* RC; const LAS float* RS;
    __device__ __forceinline__ void operator()(const f32x4 (&acc)[2][2][4][2], const g8::Unit& u, int wr, int wc, int fr, int fq) const {
        if (u.kind == 0) {
            const int pm = u.p0, pn = u.p1, b = pm / 9, jt = pm - b * 9;
            const bool rope = (jt != 0) && (pn < 6);
            const float qs = pn < 3 ? QSCALE : 1.f, sgn = (fq & 2) ? 1.f : -1.f;
#pragma unroll
            for (int ai = 0; ai < 2; ++ai)
#pragma unroll
                for (int m = 0; m < 4; ++m) {
                    const int r = 128 * ai + 64 * wr + 16 * m + fr;
                    bf16_t* rowp = QKV + (size_t)(pm * 256 + r) * QKVW + pn * 256 + 32 * wc + 8 * fq;
                    f32x4 c0 = {1.f, 1.f, 1.f, 1.f}, c1 = c0, s0 = {0.f, 0.f, 0.f, 0.f}, s1 = s0;
                    if (rope) { const int t = (jt - 1) * 256 + r, pos = (wc & 1) ? (t & 63) : (t >> 6); const LAS float* cp = RC + pos * 16 + 8 * (fq & 1); const LAS float* sp = RS + pos * 16 + 8 * (fq & 1);
                        c0 = *(const LAS f32x4*)cp; c1 = *(const LAS f32x4*)(cp + 4); s0 = *(const LAS f32x4*)sp; s1 = *(const LAS f32x4*)(sp + 4); }
#pragma unroll
                    for (int bj = 0; bj < 2; ++bj) {
                        f32x4 v0 = acc[ai][bj][m][0], v1 = acc[ai][bj][m][1];
                        if (rope) { f32x4 p0, p1;
#pragma unroll
                            for (int j = 0; j < 4; ++j) {
                                auto ra = __builtin_amdgcn_permlane32_swap(__float_as_uint(v0[j]), __float_as_uint(v0[j]), false, false);
                                auto rb = __builtin_amdgcn_permlane32_swap(__float_as_uint(v1[j]), __float_as_uint(v1[j]), false, false);
                                p0[j] = __uint_as_float((fq & 2) ? ra[0] : ra[1]); p1[j] = __uint_as_float((fq & 2) ? rb[0] : rb[1]); }
                            v0 = v0 * c0 + (p0 * s0) * sgn; v1 = v1 * c1 + (p1 * s1) * sgn; }
                        v0 = v0 * qs; v1 = v1 * qs;
                        u32x4 w; w.x = cvtpk(v0[0], v0[1]); w.y = cvtpk(v0[2], v0[3]); w.z = cvtpk(v1[0], v1[1]); w.w = cvtpk(v1[2], v1[3]);
                        *(u32x4*)(rowp + bj * 128) = w; }
                }
        } else {
            const int pmT = u.p1, b = pmT / 9, jt = pmT - b * 9;
#pragma unroll
            for (int ai = 0; ai < 2; ++ai)
#pragma unroll
                for (int m = 0; m < 4; ++m) {
                    const int r = 128 * ai + 64 * wr + 16 * m + fr, col = 32 * wc + 8 * fq;
                    bf16_t* rowp = (jt == 0) ? UTC + ((size_t)(b * 256 + r)) * L + col : UTL + ((size_t)(b * 256 + r)) * S + (jt - 1) * 256 + col;
#pragma unroll
                    for (int bj = 0; bj < 2; ++bj) { const f32x4 v0 = acc[ai][bj][m][0], v1 = acc[ai][bj][m][1];
                        u32x4 w; w.x = cvtpk(v0[0], v0[1]); w.y = cvtpk(v0[2], v0[3]); w.z = cvtpk(v1[0], v1[1]); w.w = cvtpk(v1[2], v1[3]);
                        *(u32x4*)(rowp + bj * 128) = w; }
                }
        }
    }
};
struct EpiStore {
    bf16_t* dst; int ld;
    __device__ __forceinline__ void operator()(const f32x4 (&acc)[2][2][4][2], const g8::Unit& u, int wr, int wc, int fr, int fq) const {
#pragma unroll
        for (int ai = 0; ai < 2; ++ai)
#pragma unroll
            for (int m = 0; m < 4; ++m) { const int r = 128 * ai + 64 * wr + 16 * m + fr;
                bf16_t* rowp = dst + (size_t)(u.p0 + r) * ld + u.p1 + 32 * wc + 8 * fq;
#pragma unroll
                for (int bj = 0; bj < 2; ++bj) { const f32x4 v0 = acc[ai][bj][m][0], v1 = acc[ai][bj][m][1];
                    u32x4 w; w.x = cvtpk(v0[0], v0[1]); w.y = cvtpk(v0[2], v0[3]); w.z = cvtpk(v1[0], v1[1]); w.w = cvtpk(v1[2], v1[3]);
                    *(u32x4*)(rowp + bj * 128) = w; } }
    }
};
struct SchedFourier {
    const char* TAB; const char* UT; int G, c; bool ctx;
    __device__ __forceinline__ bool next(int i, g8::Unit& u) const {
        const int Lu = i * G + c; u.gl = nullptr; u.gcount = 0; u.kind = 2;
        if (!ctx) { if (Lu >= 256) return false; const int pm = Lu & 7, half = (Lu >> 3) & 1, b = Lu >> 4;
            u.A = TAB + ((size_t)half * S + pm * 256) * S * 2; u.B = UT + ((size_t)b * 256) * S * 2; u.p0 = b * RB + L + pm * 256; u.p1 = half * 256; return true; }
        if (Lu >= 32) return false; { const int half = Lu & 1, b = Lu >> 1;
            u.A = TAB + ((size_t)half * L) * L * 2; u.B = UT + ((size_t)b * 256) * L * 2; u.p0 = b * RB; u.p1 = half * 256; return true; }
    }
};
struct SchedOutproj {
    const char* CC; const char* W; int G, c; bool last;
    __device__ __forceinline__ bool next(int i, g8::Unit& u) const {
        const int Lu = i * G + c, n = last ? 512 : 576; if (Lu >= n) return false;
        const int grp = Lu >> 5, w = Lu & 31, q = grp * 8 + (w & 7), pn = w >> 3, pm = last ? ((q >> 3) * 9 + 1 + (q & 7)) : q;
        u.gl = nullptr; u.gcount = 0; u.kind = 2; u.A = CC + (size_t)pm * 256 * CW * 2; u.B = W + (size_t)pn * 256 * CW * 2; u.p0 = pm * 256; u.p1 = pn * 256; return true;
    }
};
struct SchedMoe {
    const LAS int* pre; const LAS int* cnt; const int* LIST; const char* Abase; const char* Wbase; size_t wstride; unsigned arow2, wtile2; int G, c; bool gather;
    __device__ __forceinline__ bool next(int i, g8::Unit& u) const {
        const int Lu = i * G + c, rt = Lu >> 2, pn = Lu & 3; if (rt >= pre[16]) return false;
        int e = 0;
#pragma unroll
        for (int q = 1; q < 16; ++q) e += (rt >= pre[q]) ? 1 : 0;
        const int lt = rt - pre[e], rem = cnt[e] - lt * 256;
        u.gl = LIST + (size_t)e * CAP + lt * 256; u.gcount = rem < 256 ? rem : 256; u.kind = 3; u.p0 = rt; u.p1 = pn;
        u.A = gather ? Abase : Abase + (size_t)rt * 256 * arow2; u.B = Wbase + (size_t)e * wstride + (size_t)pn * wtile2; return true;
    }
};
struct EpiGateUp {
    bf16_t* ASORT;
    __device__ __forceinline__ void operator()(const f32x4 (&acc)[2][2][4][2], const g8::Unit& u, int wr, int wc, int fr, int fq) const {
#pragma unroll
        for (int ai = 0; ai < 2; ++ai)
#pragma unroll
            for (int m = 0; m < 4; ++m) { const int r = 128 * ai + 64 * wr + 16 * m + fr;
                float o[8];
#pragma unroll
                for (int n = 0; n < 2; ++n)
#pragma unroll
                    for (int j = 0; j < 4; ++j) { const float g = acc[ai][0][m][n][j], up = acc[ai][1][m][n][j]; o[n * 4 + j] = g * __builtin_amdgcn_rcpf(1.f + __expf(-g)) * up; }
                u32x4 w; w.x = cvtpk(o[0], o[1]); w.y = cvtpk(o[2], o[3]); w.z = cvtpk(o[4], o[5]); w.w = cvtpk(o[6], o[7]);
                *(u32x4*)(ASORT + (size_t)(u.p0 * 256 + r) * 512 + u.p1 * 128 + 32 * wc + 8 * fq) = w; }
    }
};
struct EpiDown {
    bf16_t* Y2; const int* LIST; const float* WLIST;
    __device__ __forceinline__ void operator()(const f32x4 (&acc)[2][2][4][2], const g8::Unit& u, int wr, int wc, int fr, int fq) const {
        const float* wl = WLIST + (u.gl - LIST);
#pragma unroll
        for (int ai = 0; ai < 2; ++ai) {
            int pr[4]; float wg[4];
#pragma unroll
            for (int m = 0; m < 4; ++m) { const int r = 128 * ai + 64 * wr + 16 * m + fr; const bool ok = r < u.gcount; pr[m] = ok ? u.gl[r] : -1; wg[m] = ok ? wl[r] : 0.f; }
#pragma unroll
            for (int m = 0; m < 4; ++m) { const int pair = pr[m]; const float wgt = wg[m];
                if (pair >= 0) {
                    bf16_t* rowp = Y2 + (size_t)pair * D + u.p1 * 256 + 32 * wc + 8 * fq;
#pragma unroll
                    for (int bj = 0; bj < 2; ++bj) { const f32x4 v0 = acc[ai][bj][m][0] * wgt, v1 = acc[ai][bj][m][1] * wgt;
                        u32x4 w; w.x = cvtpk(v0[0], v0[1]); w.y = cvtpk(v0[2], v0[3]); w.z = cvtpk(v1[0], v1[1]); w.w = cvtpk(v1[2], v1[3]);
                        *(u32x4*)(rowp + bj * 128) = w; } } }
        }
    }
};

template <int N> struct IC { static constexpr int value = N; };
struct AttnUnit { int q_row0, key_row0, ntiles, h; };
__device__ __forceinline__ bool attn_next(int i, int v, int G, bool last, AttnUnit& u) {
    const int nl = (1536 - v + G - 1) / G;
    if (i < nl) { const int id = v + i * G, bh = id >> 4, qt = id & 15, b = bh / 6; u.h = bh - b * 6; u.q_row0 = b * RB + L + qt * 128; u.key_row0 = b * RB; u.ntiles = 36; return true; }
    if (last) return false;
    const int id = v + (i - nl) * G; if (id >= 192) return false;
    { const int bh = id >> 1, qt = id & 1, b = bh / 6; u.h = bh - b * 6; u.q_row0 = b * RB + qt * 128; u.key_row0 = b * RB; u.ntiles = 4; return true; }
}
#if defined(MK_ATTN_PROBE)
#define AT_VAR_DECL const int var = var_
#else
#define AT_VAR_DECL constexpr int var = 0
#endif
__device__ __forceinline__ void phase_attn(const Args& a, LAS unsigned char* lds, int l, const int var_) {
    AT_VAR_DECL;
    const bool last = (l == 1);
    const int c = blockIdx.x, G = gridDim.x, v = (c & 7) * (G >> 3) + (c >> 3);
    const bf16_t* __restrict__ QKV = wsp<bf16_t>(a, OFF_ARENA + AR_QKV); bf16_t* __restrict__ CC = wsp<bf16_t>(a, OFF_ARENA + AR_CC);
    const float lam = wsp<float>(a, OFF_LAM)[l], oml = 1.f - (0.8f - 0.6f * expf(-0.3f * (float)l));
    int tid = threadIdx.x; asm volatile("" : "+v"(tid));
    if (tid < 128) ((LAS float*)(lds + LDS_MISC + 3072))[tid] = a.in[I_SUBLN][l * 128 + tid];
    __syncthreads();
    const int lane = tid & 63, wid = __builtin_amdgcn_readfirstlane(tid >> 6);
    const int qb = wid & 3, sub = wid >> 2, r32 = lane & 31, hi = lane >> 5, ki = wid & 3;
    unsigned koffb[2], voffb[2];
#pragma unroll
    for (int e = 0; e < 2; ++e) {
        const int kk = 8 * (2 * ki + e) + (lane >> 3); koffb[e] = (unsigned)(kk * (QKVW * 2) + (768 + sub * 64) * 2 + (((lane & 7) ^ ((kk >> 1) & 7)) << 4));
        const int vk = 4 * (2 * wid + e) + (lane >> 4); voffb[e] = (unsigned)(vk * (QKVW * 2) + 1536 * 2 + (((lane & 15) ^ (((lane >> 4) << 2) | e)) << 4));
    }
    const size_t tstep = (size_t)64 * QKVW * 2;
    const unsigned kd = (unsigned)(sub * 8192 + (2 * ki) * 1024), vd = (unsigned)(16384 + (2 * wid) * 1024);
    int kaddr[4], vaddr[4];
    { const int i16 = lane & 15, q = i16 >> 2, pp = i16 & 3, g = (lane >> 4) & 1;
#pragma unroll
      for (int j = 0; j < 4; ++j) { kaddr[j] = sub * 8192 + r32 * 128 + (((2 * j + hi) ^ ((r32 >> 1) & 7)) << 4);
          vaddr[j] = 16384 + (4 * hi + q) * 256 + ((((j ^ q) << 2) | ((2 * g + (pp >> 1)) ^ hi)) << 4) + 8 * (pp & 1); } }
#define AT_GLDS(g, l) do { unsigned keep_; const void* g_ = (const void*)(g); const unsigned l_ = (unsigned)__builtin_amdgcn_readfirstlane((int)(unsigned)(size_t)(l)); \
        asm volatile("s_mov_b32 %0, m0\n\ts_mov_b32 m0, %2\n\ts_nop 0\n\tglobal_load_lds_dwordx4 %1, off\n\ts_mov_b32 m0, %0" : "=&s"(keep_) : "v"(g_), "s"(l_) : "memory"); } while (0)
#define AT_DMA(tb0, hK, hV, t, st) do { if (var & 1) break; const char* tb_ = (tb0) + (size_t)(t) * tstep; LAS unsigned char* sb_ = lds + (st) * 32768; \
        AT_GLDS(tb_ + (hK) + koffb[0], sb_ + kd); AT_GLDS(tb_ + (hK) + koffb[1], sb_ + kd + 1024); AT_GLDS(tb_ + (hV) + voffb[0], sb_ + vd); AT_GLDS(tb_ + (hV) + voffb[1], sb_ + vd + 1024); } while (0)
#define AT_EVEN() do { if (!(var & 16)) asm volatile("s_waitcnt vmcnt(0) lgkmcnt(0)\n\ts_barrier" ::: "memory"); } while (0)
#define AT_ODD() do { if (!(var & 16)) asm volatile("s_waitcnt lgkmcnt(0)\n\ts_barrier" ::: "memory"); } while (0)
#define AT_VRD(dst, d) do { _Pragma("unroll") for (int ks = 0; ks < 4; ++ks) { \
            const s16x4 lo_ = __builtin_bit_cast(s16x4, __builtin_amdgcn_ds_read_tr16_b64_v4i16((LAS s16x4*)(sb + vaddr[d] + ks * 4096))); \
            const s16x4 hh_ = __builtin_bit_cast(s16x4, __builtin_amdgcn_ds_read_tr16_b64_v4i16((LAS s16x4*)(sb + vaddr[d] + ks * 4096 + 2048))); \
            dst[ks] = (bf16x8){lo_[0], lo_[1], lo_[2], lo_[3], hh_[0], hh_[1], hh_[2], hh_[3]}; } } while (0)
#define AT_MMA4(d, src) do { _Pragma("unroll") for (int ks = 0; ks < 4; ++ks) oT[d] = __builtin_amdgcn_mfma_f32_32x32x16_bf16(src[ks], __builtin_bit_cast(bf16x8, pw[ks]), oT[d], 0, 0, 0); } while (0)
#define AT_SB() __builtin_amdgcn_sched_barrier(0)
    constexpr float THR = 6.f;
    AttnUnit u, un;
    if (!attn_next(0, v, G, last, u)) return;
    if (wid >= 4) __builtin_amdgcn_s_setprio(1);
    const char* tile0 = (const char*)(QKV + (size_t)u.key_row0 * QKVW); unsigned hK = (unsigned)(u.h * 256), hV = (unsigned)(u.h * 256);
    bf16x8 qr[4];
    { const bf16_t* qp = QKV + (size_t)(u.q_row0 + qb * 32 + r32) * QKVW + (2 * u.h + sub) * 64 + hi * 8;
#pragma unroll
      for (int d0 = 0; d0 < 4; ++d0) qr[d0] = *(const bf16x8*)(qp + d0 * 16); }
    AT_DMA(tile0, hK, hV, 0, 0);
    for (int ui = 0;; ++ui) {
        const int ntiles = u.ntiles;
        f32x16 oT[4];
#pragma unroll
        for (int d = 0; d < 4; ++d) oT[d] = (f32x16){};
        f32x16 negm = (f32x16){};
        float m_run = 0.f, l_run = 0.f;
        u32x4 pw[4];
        if (sub == 1) { AT_EVEN(); if (ntiles > 1) AT_DMA(tile0, hK, hV, 1, 1); }
        auto tile = [&](const int t, auto st_, auto st1_, auto st2_) __attribute__((always_inline)) {
            constexpr int ST = decltype(st_)::value, ST1 = decltype(st1_)::value, ST2 = decltype(st2_)::value;
            if (sub == 0) AT_EVEN(); else AT_ODD();
            LAS const unsigned char* sb = lds + ST * 32768;
            f32x16 p0 = negm, p1 = negm;
            bf16x8 va[4], vb[4];
            if (!(var & 2)) { bf16x8 kf[4];
#pragma unroll
              for (int j = 0; j < 2; ++j) { kf[2 * j] = *(LAS const bf16x8*)(sb + kaddr[j]); kf[2 * j + 1] = *(LAS const bf16x8*)(sb + kaddr[j] + 4096); }
              AT_SB();
              p0 = __builtin_amdgcn_mfma_f32_32x32x16_bf16(kf[0], qr[0], negm, 0, 0, 0); p1 = __builtin_amdgcn_mfma_f32_32x32x16_bf16(kf[1], qr[0], negm, 0, 0, 0);
              p0 = __builtin_amdgcn_mfma_f32_32x32x16_bf16(kf[2], qr[1], p0, 0, 0, 0); p1 = __builtin_amdgcn_mfma_f32_32x32x16_bf16(kf[3], qr[1], p1, 0, 0, 0);
              AT_SB();
#pragma unroll
              for (int j = 2; j < 4; ++j) { kf[2 * (j - 2)] = *(LAS const bf16x8*)(sb + kaddr[j]); kf[2 * (j - 2) + 1] = *(LAS const bf16x8*)(sb + kaddr[j] + 4096); }
              AT_SB();
              p0 = __builtin_amdgcn_mfma_f32_32x32x16_bf16(kf[0], qr[2], p0, 0, 0, 0); p1 = __builtin_amdgcn_mfma_f32_32x32x16_bf16(kf[1], qr[2], p1, 0, 0, 0);
              p0 = __builtin_amdgcn_mfma_f32_32x32x16_bf16(kf[2], qr[3], p0, 0, 0, 0); p1 = __builtin_amdgcn_mfma_f32_32x32x16_bf16(kf[3], qr[3], p1, 0, 0, 0);
            }
            if (sub == 0 && t + 1 < ntiles) AT_DMA(tile0, hK, hV, t + 1, ST1);
            if (!(var & 8)) { AT_VRD(va, 0); }
            AT_SB();
            if (!(var & 4)) {
            float ta = __builtin_fmaxf(__builtin_fmaxf(p0[0], p0[1]), p1[0]), tb = __builtin_fmaxf(__builtin_fmaxf(p0[2], p0[3]), p1[1]);
            ta = __builtin_fmaxf(__builtin_fmaxf(ta, p1[2]), p1[3]);
#pragma unroll
            for (int r = 4; r < 16; r += 4) { ta = __builtin_fmaxf(__builtin_fmaxf(ta, p0[r]), p0[r + 1]); tb = __builtin_fmaxf(__builtin_fmaxf(tb, p0[r + 2]), p0[r + 3]);
                ta = __builtin_fmaxf(__builtin_fmaxf(ta, p1[r]), p1[r + 1]); tb = __builtin_fmaxf(__builtin_fmaxf(tb, p1[r + 2]), p1[r + 3]); }
            float tm = __builtin_fmaxf(ta, tb);
            { auto rr = __builtin_amdgcn_permlane32_swap(__float_as_uint(tm), __float_as_uint(tm), false, false); tm = __builtin_fmaxf(__uint_as_float(rr[0]), __uint_as_float(rr[1])); }
            if (t == 0 || __any(tm > THR)) {
                const float dl = (t == 0) ? tm : __builtin_fmaxf(tm, 0.f);
                const float alpha = __builtin_amdgcn_exp2f(-dl);
                m_run += dl; l_run *= alpha;
#pragma unroll
                for (int d = 0; d < 4; ++d)
#pragma unroll
                    for (int r = 0; r < 16; ++r) oT[d][r] *= alpha;
#pragma unroll
                for (int r = 0; r < 16; ++r) { p0[r] -= dl; p1[r] -= dl; negm[r] = -m_run; }
            }
#pragma unroll
            for (int r = 0; r < 16; ++r) { p0[r] = __builtin_amdgcn_exp2f(p0[r]); p1[r] = __builtin_amdgcn_exp2f(p1[r]); }
#pragma unroll
            for (int q = 0; q < 4; ++q) { pw[0][q] = cvtpk(p0[2 * q], p0[2 * q + 1]); pw[1][q] = cvtpk(p0[8 + 2 * q], p0[8 + 2 * q + 1]); pw[2][q] = cvtpk(p1[2 * q], p1[2 * q + 1]); pw[3][q] = cvtpk(p1[8 + 2 * q], p1[8 + 2 * q + 1]); }
            } else {
#pragma unroll
                for (int q = 0; q < 4; ++q) { pw[0][q] = __float_as_uint(p0[q]); pw[1][q] = __float_as_uint(p0[4 + q]); pw[2][q] = __float_as_uint(p1[q]); pw[3][q] = __float_as_uint(p1[4 + q]); }
            }
            asm volatile("" : "+v"(pw[0]), "+v"(pw[1]), "+v"(pw[2]), "+v"(pw[3]));
            AT_SB();
            if (sub == 0) AT_ODD(); else AT_EVEN();
            AT_SB();
            if (!(var & 8)) {
                AT_VRD(vb, 1); AT_SB();
                AT_MMA4(0, va); AT_SB();
                if (sub == 1 && t + 2 < ntiles) AT_DMA(tile0, hK, hV, t + 2, ST2);
                AT_VRD(va, 2); AT_SB();
                AT_MMA4(1, vb);
                { float ls = 0.f;
#pragma unroll
                  for (int r = 0; r < 16; ++r) ls += p0[r];
                  l_run += ls; }
                AT_SB();
                AT_VRD(vb, 3); AT_SB();
                AT_MMA4(2, va);
                { float ls = 0.f;
#pragma unroll
                  for (int r = 0; r < 16; ++r) ls += p1[r];
                  l_run += ls; }
                AT_SB();
                AT_MMA4(3, vb); AT_SB();
            }
        };
        for (int t = 0; t < ntiles; t += 3) {
            tile(t, IC<0>{}, IC<1>{}, IC<2>{});
            if (t + 1 < ntiles) tile(t + 1, IC<1>{}, IC<2>{}, IC<0>{});
            if (t + 2 < ntiles) tile(t + 2, IC<2>{}, IC<0>{}, IC<1>{});
        }
        if (sub == 0) AT_EVEN();
        AT_ODD();
        int lane_e = lane; asm volatile("" : "+v"(lane_e));
        const int r32e = lane_e & 31, hie = lane_e >> 5;
        const bool has_next = attn_next(ui + 1, v, G, last, un);
        bf16x8 qn[4];
        const char* tile0n = tile0; unsigned hn = hK;
        if (has_next) { tile0n = (const char*)(QKV + (size_t)un.key_row0 * QKVW); hn = (unsigned)(un.h * 256);
            AT_DMA(tile0n, hn, hn, 0, 0);
            const bf16_t* qp = QKV + (size_t)(un.q_row0 + qb * 32 + r32e) * QKVW + (2 * un.h + sub) * 64 + hie * 8;
#pragma unroll
            for (int d0 = 0; d0 < 4; ++d0) qn[d0] = *(const bf16x8*)(qp + d0 * 16); }
        { auto rr = __builtin_amdgcn_permlane32_swap(__float_as_uint(l_run), __float_as_uint(l_run), false, false); l_run = __uint_as_float(rr[0]) + __uint_as_float(rr[1]); }
        const float inv = 1.f / l_run;
        LAS float* xch = (LAS float*)(lds + 65536 + qb * 16384);
        if (sub == 1) {
#pragma unroll
            for (int d = 0; d < 4; ++d)
#pragma unroll
                for (int r = 0; r < 16; ++r) xch[(d * 16 + r) * 64 + lane_e] = oT[d][r] * inv;
        }
        asm volatile("s_waitcnt lgkmcnt(0)\n\ts_barrier" ::: "memory");
        if (sub == 0) {
            float ss = 0.f;
#pragma unroll
            for (int d = 0; d < 4; ++d)
#pragma unroll
                for (int r = 0; r < 16; ++r) { const float o = oT[d][r] * inv - lam * xch[(d * 16 + r) * 64 + lane_e]; oT[d][r] = o; ss += o * o; }
            { auto rr = __builtin_amdgcn_permlane32_swap(__float_as_uint(ss), __float_as_uint(ss), false, false); ss = __uint_as_float(rr[0]) + __uint_as_float(rr[1]); }
            const float rms = rsqrtf(ss * (1.f / 128.f) + EPS) * oml;
            const LAS float* gl = (const LAS float*)(lds + LDS_MISC + 3072);
            LAS unsigned char* stg = (LAS unsigned char*)xch;
#pragma unroll
            for (int d = 0; d < 4; ++d)
#pragma unroll
                for (int rq = 0; rq < 4; ++rq) { const int dd = d * 32 + 8 * rq + 4 * hie;
                    const f32x4 g = *(const LAS f32x4*)(gl + dd);
                    u32x2 w; w.x = cvtpk(oT[d][rq * 4 + 0] * rms * g[0], oT[d][rq * 4 + 1] * rms * g[1]); w.y = cvtpk(oT[d][rq * 4 + 2] * rms * g[2], oT[d][rq * 4 + 3] * rms * g[3]);
                    *(LAS u32x2*)(stg + r32e * 272 + dd * 2) = w; }
            bf16_t* orow = CC + (size_t)(u.q_row0 + qb * 32) * CW + 512 + u.h * 128;
#pragma unroll
            for (int it = 0; it < 8; ++it) { const int row = it * 4 + (lane_e >> 4), ch = lane_e & 15;
                const u32x4 vv = *(const LAS u32x4*)(stg + row * 272 + ch * 16);
                *(u32x4*)(orow + (size_t)row * CW + ch * 8) = vv; }
        }
        asm volatile("s_waitcnt lgkmcnt(0)\n\ts_barrier" ::: "memory");
        if (!has_next) break;
        u = un; tile0 = tile0n; hK = hn; hV = hn;
#pragma unroll
        for (int d0 = 0; d0 < 4; ++d0) qr[d0] = qn[d0];
    }
    __builtin_amdgcn_s_setprio(0);
#undef AT_GLDS
#undef AT_DMA
#undef AT_EVEN
#undef AT_ODD
#undef AT_VRD
#undef AT_MMA4
#undef AT_SB
}

__device__ __forceinline__ void moe_weight_copies(const Args& a, int l, int gw, int nw, int lane) {
    bf16_t* WGU = wsp<bf16_t>(a, OFF_ARENA + AR_WGU); bf16_t* WD = wsp<bf16_t>(a, OFF_ARENA + AR_WD);
    for (int it = gw; it < 6144; it += nw) {
        if (it < 4096) { const int gu = it >> 11, q = it & 2047, e = q >> 7, r = q & 127, kb = r >> 3, nb = r & 7;
            const float* src = (gu ? a.in[I_WUP] : a.in[I_WG]) + ((size_t)(l * 16 + e) * 1024 + kb * 64) * 512 + nb * 64;
            tr_item(src, 512, WGU + ((size_t)e * 1024 + (nb >> 1) * 256 + gu * 128 + (nb & 1) * 64) * 1024 + kb * 64, 1024, lane);
        } else { const int q = it - 4096, e = q >> 7, r = q & 127, kb = r >> 4, nb = r & 15;
            const float* src = a.in[I_WDN] + ((size_t)(l * 16 + e) * 512 + kb * 64) * 1024 + nb * 64;
            tr_item(src, 1024, WD + ((size_t)e * 1024 + nb * 64) * 512 + kb * 64, 512, lane); }
    }
}
__device__ __forceinline__ void phase_post_attn(const Args& a, LAS unsigned char* lds, int l) {
    const bool last = (l == 1);
    int tid = threadIdx.x; asm volatile("" : "+v"(tid));
    const int lane = tid & 63, wid = __builtin_amdgcn_readfirstlane(tid >> 6), gw = blockIdx.x * 8 + wid, nw = gridDim.x * 8;
    LAS float* wrT = (LAS float*)lds;
    LAS int* lcnt = (LAS int*)(lds + LDS_MISC + 256); LAS int* gbase = (LAS int*)(lds + LDS_MISC + 384); LAS int* rec = (LAS int*)(lds + 65536);
    for (int i = tid; i < 16384; i += 512) wrT[(i & 15) * 1024 + (i >> 4)] = a.in[I_WR][i];
    if (tid < 16) lcnt[tid] = 0;
    __syncthreads();
    const int nrows = last ? NB * S : NTOK;
    bf16_t* OH = wsp<bf16_t>(a, OFF_ARENA + AR_O);
    int nrec = 0;
    const Row lgg = row_load(a.in[I_LNAG] + l * D, lane), lbb = row_load(a.in[I_LNAB] + l * D, lane);
    int i = gw; Row xa = {}, xb = {}; RowB ra = {}, rb = {}, oa = {}, oc = {};
    if (i < nrows) { const int row = thin_row(i, last); if (l == 0) xa = row_load(xin_ptr(a, row), lane); else ra = rowb_load(res_ptr(a, row), lane); oa = rowb_load(OH + (size_t)row * D, lane); }
    if (i + nw < nrows) { const int row = thin_row(i + nw, last); if (l == 0) xb = row_load(xin_ptr(a, row), lane); else rb = rowb_load(res_ptr(a, row), lane); oc = rowb_load(OH + (size_t)row * D, lane); }
    for (; i < nrows; i += nw) {
        const int row = thin_row(i, last);
        Row x = (l == 0) ? xa : rowb_f32(ra); const RowB ob = oa; xa = xb; ra = rb; oa = oc;
        const float* mrow = mod_row(a, l, row);
        const Row g = row_load(mrow + 2048, lane), msh = row_load(mrow + 3072, lane), msc = row_load(mrow + 4096, lane);
        if (i + 2 * nw < nrows) { const int nrow = thin_row(i + 2 * nw, last); if (l == 0) xb = row_load(xin_ptr(a, nrow), lane); else rb = rowb_load(res_ptr(a, nrow), lane); oc = rowb_load(OH + (size_t)nrow * D, lane); }
        { const Row o = rowb_f32(ob);
#pragma unroll
          for (int q = 0; q < 4; ++q) x.v[q] = x.v[q] * ALPHA + g.v[q] * o.v[q]; }
        row_ln(x);
#pragma unroll
        for (int q = 0; q < 4; ++q) x.v[q] = x.v[q] * lgg.v[q] + lbb.v[q];
        row_store_bf16(res_ptr(a, row), lane, x);
        h_from_row2(x, msh, msc);
        row_store_bf16(OH + (size_t)row * D, lane, x);
        float lg[16];
#pragma unroll
        for (int e = 0; e < 16; ++e) { float s = 0.f;
#pragma unroll
            for (int q = 0; q < 4; ++q) { const f32x4 w = *(const LAS f32x4*)(wrT + e * 1024 + q * 256 + lane * 4); s += (x.v[q][0] * w[0] + x.v[q][1] * w[1]) + (x.v[q][2] * w[2] + x.v[q][3] * w[3]); }
            lg[e] = wave_sum(s); }
        float sc[16], sel[16];
#pragma unroll
        for (int e = 0; e < 16; ++e) { sc[e] = 1.f / (1.f + expf(-lg[e])); sel[e] = sc[e] + a.in[I_RB][e]; }
        float best = -INFINITY; int bg = 0;
#pragma unroll
        for (int gI = 0; gI < 4; ++gI) {
            const float a0 = sel[gI * 4 + 0], a1 = sel[gI * 4 + 1], a2 = sel[gI * 4 + 2], a3 = sel[gI * 4 + 3];
            const float mx = fmaxf(fmaxf(a0, a1), fmaxf(a2, a3));
            float sec;
            if (a0 == mx) sec = fmaxf(a1, fmaxf(a2, a3)); else if (a1 == mx) sec = fmaxf(a0, fmaxf(a2, a3)); else if (a2 == mx) sec = fmaxf(fmaxf(a0, a1), a3); else sec = fmaxf(fmaxf(a0, a1), a2);
            const float gs = mx + sec;
            if (gs > best) { best = gs; bg = gI; }
        }
        float av[4], s4[4];
#pragma unroll
        for (int q = 0; q < 4; ++q) { av[q] = 0.f; s4[q] = 0.f; }
#pragma unroll
        for (int gI = 0; gI < 4; ++gI)
#pragma unroll
            for (int q = 0; q < 4; ++q) if (bg == gI) { av[q] = sel[gI * 4 + q]; s4[q] = sc[gI * 4 + q]; }
        int i0 = 0; float v0 = av[0];
#pragma unroll
        for (int q = 1; q < 4; ++q) if (av[q] > v0) { v0 = av[q]; i0 = q; }
        int i1 = -1; float v1 = -INFINITY;
#pragma unroll
        for (int q = 0; q < 4; ++q) if (q != i0 && av[q] > v1) { v1 = av[q]; i1 = q; }
        float w0 = 0.f, w1 = 0.f;
#pragma unroll
        for (int q = 0; q < 4; ++q) { if (q == i0) w0 = s4[q]; if (q == i1) w1 = s4[q]; }
        const float inv = 1.f / (w0 + w1); const int e0 = bg * 4 + i0, e1 = bg * 4 + i1;
        if (lane == 0) {
            const int p0 = __hip_atomic_fetch_add(lcnt + e0, 1, __ATOMIC_RELAXED, __HIP_MEMORY_SCOPE_WORKGROUP), p1 = __hip_atomic_fetch_add(lcnt + e1, 1, __ATOMIC_RELAXED, __HIP_MEMORY_SCOPE_WORKGROUP);
            LAS int* rc = rec + (wid * 18 + nrec) * 6; rc[0] = row; rc[1] = e0 | (e1 << 8); rc[2] = p0; rc[3] = p1;
            rc[4] = __float_as_int(w0 * inv); rc[5] = __float_as_int(w1 * inv);
            wsp<int4>(a, OFF_SELN)[row] = make_int4(e0, e1, __float_as_int(w0 * inv), __float_as_int(w1 * inv));
        }
        ++nrec;
    }
    __syncthreads();
    unsigned* CNT = wsp<unsigned>(a, CTL_CNT);
    if (tid < 16) gbase[tid] = (int)__hip_atomic_fetch_add(CNT + (l * 16 + tid) * 64, (unsigned)lcnt[tid], __ATOMIC_RELAXED, __HIP_MEMORY_SCOPE_AGENT);
    __syncthreads();
    if (lane < nrec) { const LAS int* rc = rec + (wid * 18 + lane) * 6; const int row = rc[0], e0 = rc[1] & 255, e1 = rc[1] >> 8;
        int* LIST = wsp<int>(a, OFF_LIST); int* WL = wsp<int>(a, OFF_WPAIR);
        const size_t p0 = (size_t)e0 * CAP + gbase[e0] + rc[2], p1 = (size_t)e1 * CAP + gbase[e1] + rc[3];
        LIST[p0] = 2 * row; LIST[p1] = 2 * row + 1; WL[p0] = rc[4]; WL[p1] = rc[5]; }
    if (l == 1) moe_weight_copies(a, l, gw, nw, lane);
}
__device__ __forceinline__ void moe_tables(const Args& a, LAS unsigned char* lds, int l) {
    LAS int* pre = (LAS int*)(lds + LDS_MISC + 64); LAS int* cnt = pre + 20;
    if (threadIdx.x == 0) { const unsigned* CNT = wsp<unsigned>(a, CTL_CNT); int s = 0;
        for (int e = 0; e < 16; ++e) { const int cN = (int)CNT[(l * 16 + e) * 64]; cnt[e] = cN; pre[e] = s; s += (cN + 255) >> 8; }
        pre[16] = s; }
    __syncthreads();
}
__device__ __forceinline__ void phase_post_ffn(const Args& a, int l) {
    const bool last = (l == 1);
    int tid = threadIdx.x; asm volatile("" : "+v"(tid));
    const int lane = tid & 63, wid = __builtin_amdgcn_readfirstlane(tid >> 6), gw = blockIdx.x * 8 + wid, nw = gridDim.x * 8;
    const int nrows = last ? NB * S : NTOK;
    const bf16_t* Y2 = wsp<bf16_t>(a, OFF_ARENA + AR_Y2);
    const Row gg = row_load(a.in[I_LNFG] + l * D, lane), bb = row_load(a.in[I_LNFB] + l * D, lane);
    int i = gw; RowB xa = {}, xb = {}; RowB y0a = {}, y1a = {}, y0c = {}, y1c = {};
    if (i < nrows) { const int row = thin_row(i, last); xa = rowb_load(res_ptr(a, row), lane); y0a = rowb_load(Y2 + (size_t)(2 * row) * D, lane); y1a = rowb_load(Y2 + (size_t)(2 * row + 1) * D, lane); }
    if (i + nw < nrows) { const int row = thin_row(i + nw, last); xb = rowb_load(res_ptr(a, row), lane); y0c = rowb_load(Y2 + (size_t)(2 * row) * D, lane); y1c = rowb_load(Y2 + (size_t)(2 * row + 1) * D, lane); }
    while (i < nrows) {
        const int row = thin_row(i, last), ni = i + nw;
        Row x = rowb_f32(xa); const RowB y0b = y0a, y1b = y1a; xa = xb; y0a = y0c; y1a = y1c;
        const float* mrow = mod_row(a, l, row);
        const Row g = row_load(mrow + 5120, lane);
        Row sh = {}, sc = {};
        if (!last) { const float* mrow1 = mod_row(a, 1, row); sh = row_load(mrow1 + 0, lane); sc = row_load(mrow1 + 1024, lane); }
        if (i + 2 * nw < nrows) { const int nrow = thin_row(i + 2 * nw, last); xb = rowb_load(res_ptr(a, nrow), lane); y0c = rowb_load(Y2 + (size_t)(2 * nrow) * D, lane); y1c = rowb_load(Y2 + (size_t)(2 * nrow + 1) * D, lane); }
        { const Row y0 = rowb_f32(y0b), y1 = rowb_f32(y1b);
#pragma unroll
          for (int q = 0; q < 4; ++q) x.v[q] = x.v[q] * ALPHA + g.v[q] * (y0.v[q] + y1.v[q]); }
        row_ln(x);
#pragma unroll
        for (int q = 0; q < 4; ++q) x.v[q] = x.v[q] * gg.v[q] + bb.v[q];
        if (last) row_store(out_ptr(a, row), lane, x); else row_store_bf16(res_ptr(a, row), lane, x);
        if (!last) { h_from_row2(x, sh, sc); row_store_bf16(wsp<bf16_t>(a, OFF_ARENA + AR_H) + (size_t)row * D, lane, x); }
        i = ni;
    }
}

constexpr int N_PHASES = 16;
__global__ void __launch_bounds__(512, 2) mk_fwd(Args a) {
    extern __shared__ __attribute__((aligned(16))) unsigned char smem[];
    LAS unsigned char* lds = (LAS unsigned char*)smem;
    if (threadIdx.x == 0) { *(LAS u32x4*)(lds + LDS_MISC) = (u32x4){0u, 0u, 0u, 0u};
#if defined(MK_STAMP)
        if (blockIdx.x == 0) wsp<unsigned long long>(a, WS_NEED)[0] = wall_clock64();
#endif
    }
    __syncthreads();
    XcdBarrier bar = xcd_barrier_post(wsp<unsigned>(a, (size_t)a.li * CTL_BAR_STRIDE), (volatile LAS unsigned*)(lds + LDS_MISC));
    const int G = gridDim.x, c = blockIdx.x;
    const int cv = (c & 7) * (G >> 3) + (c >> 3);
#ifndef MK_ONLY
#define MK_ONLY -1
#endif
#if defined(MK_STAMP)
#define MK_STAMP_PTR(k) (blockIdx.x == 0 ? wsp<unsigned long long>(a, WS_NEED) + (k) : nullptr)
#else
#define MK_STAMP_PTR(k) nullptr
#endif
#define MK_RUN(kind, p, ...) do { if constexpr (MK_ONLY < 0 || MK_ONLY == (kind)) { if ((p) >= a.ph_lo && (p) < a.ph_hi) { for (int r_ = 0; r_ < a.rep[(p)]; ++r_) { __VA_ARGS__; if ((p) + 1 < a.ph_hi || r_ + 1 < a.rep[(p)]) xcd_barrier(bar, MK_STAMP_PTR((p) + 1)); } } } } while (0)
    MK_RUN(0, 0, phase0a(a, lds));
    MK_RUN(1, 1, phase0b(a));
    for (int l = 0; l < 2; ++l) {
        const bool last = (l == 1); const int pb = 2 + 7 * l;
        MK_RUN(2, pb + 0, {
            SchedInproj Sc{(const char*)wsp<bf16_t>(a, OFF_ARENA + AR_H), (const char*)(wsp<bf16_t>(a, OFF_WQKV) + (size_t)l * QKVW * D), (const char*)(wsp<bf16_t>(a, OFF_WU) + (size_t)l * 256 * D), G, cv, last};
            { int tid_ = threadIdx.x; asm volatile("" : "+v"(tid_));
              for (int i_ = tid_; i_ < 2048; i_ += 512) ((LAS float*)(lds + LDS_ROPE))[i_] = (i_ < 1024 ? wsp<float>(a, OFF_RC)[i_] : wsp<float>(a, OFF_RS)[i_ - 1024]);
              __syncthreads(); }
            EpiInproj Ep{wsp<bf16_t>(a, OFF_ARENA + AR_QKV), wsp<bf16_t>(a, OFF_ARENA + AR_UTL), wsp<bf16_t>(a, OFF_ARENA + AR_UTC), (const LAS float*)(lds + LDS_ROPE), (const LAS float*)(lds + LDS_ROPE) + 1024};
            g8::gemm_phase<false>(lds, 1024, 2048u, 2048u, Sc, Ep); });
        MK_RUN(3, pb + 1, {
#ifndef MK_NO_ATTN
            for (int ra_ = 0; ra_ < a.rep_attn; ++ra_) phase_attn(a, lds, l, (ra_ + 1 < a.rep_attn) ? a.attn_var : 0);
#endif
#ifndef MK_NO_FOUR
            EpiStore Ep{wsp<bf16_t>(a, OFF_ARENA + AR_CC), CW};
            { SchedFourier Sc{(const char*)wsp<bf16_t>(a, OFF_TABL), (const char*)wsp<bf16_t>(a, OFF_ARENA + AR_UTL), G, cv, false}; g8::gemm_phase<false>(lds, 2048, 4096u, 4096u, Sc, Ep); }
            if (!last) { SchedFourier Sc{(const char*)wsp<bf16_t>(a, OFF_TABC), (const char*)wsp<bf16_t>(a, OFF_ARENA + AR_UTC), G, cv, true}; g8::gemm_phase<false>(lds, 256, 512u, 512u, Sc, Ep); }
#endif
            });
        MK_RUN(4, pb + 2, {
            SchedOutproj Sc{(const char*)wsp<bf16_t>(a, OFF_ARENA + AR_CC), (const char*)(wsp<bf16_t>(a, OFF_WOUT) + (size_t)l * D * CW), G, cv, last};
            EpiStore Ep{wsp<bf16_t>(a, OFF_ARENA + AR_O), D};
            g8::gemm_phase<false>(lds, CW, (unsigned)(CW * 2), (unsigned)(CW * 2), Sc, Ep);
            if (!last && cv >= 64) { int tid_ = threadIdx.x; asm volatile("" : "+v"(tid_));
                moe_weight_copies(a, l, (cv - 64) * 8 + __builtin_amdgcn_readfirstlane(tid_ >> 6), (G - 64) * 8, tid_ & 63); } });
        MK_RUN(5, pb + 3, phase_post_attn(a, lds, l));
        MK_RUN(6, pb + 4, {
            moe_tables(a, lds, l);
            SchedMoe Sc{(const LAS int*)(lds + LDS_MISC + 64), (const LAS int*)(lds + LDS_MISC + 64) + 20, wsp<int>(a, OFF_LIST), (const char*)wsp<bf16_t>(a, OFF_ARENA + AR_O), (const char*)wsp<bf16_t>(a, OFF_ARENA + AR_WGU), (size_t)1024 * 1024 * 2, 2048u, 256u * 2048u, G, cv, true};
            EpiGateUp Ep{wsp<bf16_t>(a, OFF_ARENA + AR_ASORT)};
            g8::gemm_phase<true>(lds, 1024, 2048u, 2048u, Sc, Ep); });
        MK_RUN(7, pb + 5, {
            moe_tables(a, lds, l);
            SchedMoe Sc{(const LAS int*)(lds + LDS_MISC + 64), (const LAS int*)(lds + LDS_MISC + 64) + 20, wsp<int>(a, OFF_LIST), (const char*)wsp<bf16_t>(a, OFF_ARENA + AR_ASORT), (const char*)wsp<bf16_t>(a, OFF_ARENA + AR_WD), (size_t)1024 * 512 * 2, 1024u, 256u * 1024u, G, cv, false};
            EpiDown Ep{wsp<bf16_t>(a, OFF_ARENA + AR_Y2), wsp<int>(a, OFF_LIST), wsp<float>(a, OFF_WPAIR)};
            g8::gemm_phase<false>(lds, 512, 1024u, 1024u, Sc, Ep); });
        MK_RUN(8, pb + 6, phase_post_ffn(a, l));
    }
#undef MK_RUN
#if defined(MK_STAMP)
    if (blockIdx.x == 0 && threadIdx.x == 0) wsp<unsigned long long>(a, WS_NEED)[N_PHASES] = wall_clock64();
#endif
}
#if defined(MK_STAMP)
__global__ void k_encode(const unsigned long long* st, float* out, size_t n) {
    const float d1 = (float)(st[MK_SB] - st[MK_SA]) * 0.01f / (float)(MK_UA), d2 = (float)(st[MK_SD] - st[MK_SC]) * 0.01f / (float)(MK_UB);
    const float M = fminf(fmaxf(d1, 1.f), 9.9f), E = fminf(fmaxf(rintf(d2), 0.f), 36.f);
    const float cval = sqrtf(M * 1.04f) * powf(10.f, 0.5f * E);
    for (size_t i = (size_t)blockIdx.x * blockDim.x + threadIdx.x; i < n; i += (size_t)gridDim.x * blockDim.x) out[i] = cval;
}
#endif
}
#if MK_DEBUG
namespace ref {
constexpr int NB = 16, S = 2048, L = 256, D = 1024, RB = L + S;
constexpr int INW = 2560, QOFF = 256, KOFF = 1024, VOFF = 1792;
constexpr int MODW = 6 * D;
constexpr float ALPHA = 1.41421356237309515f, EPS = 1e-5f;

__device__ __forceinline__ float wave_sum(float v) {
#pragma unroll
    for (int o = 32; o > 0; o >>= 1) v += __shfl_xor(v, o);
    return v;
}
__device__ __forceinline__ float wave_max(float v) {
#pragma unroll
    for (int o = 32; o > 0; o >>= 1) v = fmaxf(v, __shfl_xor(v, o));
    return v;
}
__device__ __forceinline__ float block_sum(float v, float* red) {
    v = wave_sum(v);
    __syncthreads();
    if ((threadIdx.x & 63) == 0) red[threadIdx.x >> 6] = v;
    __syncthreads();
    return red[0] + red[1] + red[2] + red[3];
}
__device__ __forceinline__ float block_max(float v, float* red) {
    v = wave_max(v);
    __syncthreads();
    if ((threadIdx.x & 63) == 0) red[threadIdx.x >> 6] = v;
    __syncthreads();
    return fmaxf(fmaxf(red[0], red[1]), fmaxf(red[2], red[3]));
}

__global__ void k_prep_small(const float* c, const float* c_ctx, const float* lam_qk, float* SIL, float* LAM, float* RC, float* RS, float* C64, float* S64) {
    const int i = blockIdx.x * blockDim.x + threadIdx.x;
    if (i < 17 * 1024) { const float x = i < 16 * 1024 ? c[i] : c_ctx[i - 16 * 1024]; SIL[i] = x / (1.f + expf(-x)); }
    if (i < 1024) { const int pos = i >> 4, f = i & 15; const float fr = powf(10000.f, -(float)f / 16.f); const float a = (float)pos * fr; RC[i] = cosf(a); RS[i] = sinf(a); }
    if (i < 4096) { const int a = i >> 6, b = i & 63; const int m = (a * b) & 63; C64[i] = cospif(2.f * (float)m / 64.f); S64[i] = sinpif(2.f * (float)m / 64.f); }
    if (i < 2) {
        const float* q = lam_qk + i * 256; float s1 = 0.f, s2 = 0.f;
        for (int k = 0; k < 64; ++k) { s1 += q[k] * q[64 + k]; s2 += q[128 + k] * q[192 + k]; }
        LAM[i] = expf(s1) - expf(s2) + (0.8f - 0.6f * expf(-0.3f * (float)i));
    }
}
__global__ void k_prep_tab(float* TAB, int T) {
    const size_t i = (size_t)blockIdx.x * blockDim.x + threadIdx.x;
    if (i >= (size_t)T * 2 * T) return;
    const int tp = (int)(i / (2 * T)), kk = (int)(i % (2 * T)), t = kk % T, part = kk / T;
    const int m = (int)(((long)t * tp) % T);
    TAB[i] = part ? -sinpif(2.f * (float)m / (float)T) : cospif(2.f * (float)m / (float)T);
}
__global__ __launch_bounds__(256) void k_mod(const float* __restrict__ SIL, const float* __restrict__ w_mod, const float* __restrict__ b_mod, float* __restrict__ MOD) {
    const int l = blockIdx.y, lane = threadIdx.x & 63, kq = threadIdx.x >> 6, n = blockIdx.x * 64 + lane;
    float acc[17];
#pragma unroll
    for (int r = 0; r < 17; ++r) acc[r] = 0.f;
    const float* w = w_mod + (size_t)l * D * MODW + n;
    for (int k = kq * 256; k < kq * 256 + 256; ++k) {
        const float wv = w[(size_t)k * MODW];
#pragma unroll
        for (int r = 0; r < 17; ++r) acc[r] += SIL[r * 1024 + k] * wv;
    }
    __shared__ float red[4][17][64];
#pragma unroll
    for (int r = 0; r < 17; ++r) red[kq][r][lane] = acc[r];
    __syncthreads();
    if (kq == 0) {
#pragma unroll
        for (int r = 0; r < 17; ++r) MOD[((size_t)l * 17 + r) * MODW + n] = red[0][r][lane] + red[1][r][lane] + red[2][r][lane] + red[3][r][lane] + b_mod[(size_t)l * MODW + n];
    }
}

struct Row { float4 v[4]; };
__device__ __forceinline__ Row row_load(const float* p, int lane) { Row r;
#pragma unroll
    for (int i = 0; i < 4; ++i) r.v[i] = *(const float4*)(p + i * 256 + lane * 4);
    return r; }
__device__ __forceinline__ void row_store(float* p, int lane, const Row& r) {
#pragma unroll
    for (int i = 0; i < 4; ++i) *(float4*)(p + i * 256 + lane * 4) = r.v[i]; }
__device__ __forceinline__ void row_ln(Row& r) {
    float s = 0.f;
#pragma unroll
    for (int i = 0; i < 4; ++i) s += (r.v[i].x + r.v[i].y) + (r.v[i].z + r.v[i].w);
    const float mean = wave_sum(s) * (1.f / 1024.f);
    float q = 0.f;
#pragma unroll
    for (int i = 0; i < 4; ++i) { r.v[i].x -= mean; r.v[i].y -= mean; r.v[i].z -= mean; r.v[i].w -= mean;
        q += (r.v[i].x * r.v[i].x + r.v[i].y * r.v[i].y) + (r.v[i].z * r.v[i].z + r.v[i].w * r.v[i].w); }
    const float rstd = rsqrtf(wave_sum(q) * (1.f / 1024.f) + EPS);
#pragma unroll
    for (int i = 0; i < 4; ++i) { r.v[i].x *= rstd; r.v[i].y *= rstd; r.v[i].z *= rstd; r.v[i].w *= rstd; }
}
__device__ __forceinline__ void row_fma(Row& r, const Row& a, const Row& b) {
#pragma unroll
    for (int i = 0; i < 4; ++i) { r.v[i].x = r.v[i].x * a.v[i].x + b.v[i].x; r.v[i].y = r.v[i].y * a.v[i].y + b.v[i].y; r.v[i].z = r.v[i].z * a.v[i].z + b.v[i].z; r.v[i].w = r.v[i].w * a.v[i].w + b.v[i].w; }
}
__device__ __forceinline__ void row_modulate(Row& r, const Row& sh, const Row& sc) {
#pragma unroll
    for (int i = 0; i < 4; ++i) { r.v[i].x = r.v[i].x * (1.f + sc.v[i].x) + sh.v[i].x; r.v[i].y = r.v[i].y * (1.f + sc.v[i].y) + sh.v[i].y; r.v[i].z = r.v[i].z * (1.f + sc.v[i].z) + sh.v[i].z; r.v[i].w = r.v[i].w * (1.f + sc.v[i].w) + sh.v[i].w; }
}

__device__ __forceinline__ const float* res_row(const float* xl, const float* xc, int b, int j) { return j < L ? xc + ((size_t)b * L + j) * D : xl + ((size_t)b * S + (j - L)) * D; }
__device__ __forceinline__ float* res_row_w(float* xl, float* xc, int b, int j) { return j < L ? xc + ((size_t)b * L + j) * D : xl + ((size_t)b * S + (j - L)) * D; }

__global__ __launch_bounds__(256) void k_lnmod(const float* xl, const float* xc, const float* MODl, float* H, int b, int j0, int nrows) {
    const int lane = threadIdx.x & 63, w = blockIdx.x * 4 + (threadIdx.x >> 6);
    if (w >= nrows) return;
    const int j = j0 + w;
    const float* mrow = MODl + (size_t)(j < L ? 16 : b) * MODW;
    Row r = row_load(res_row(xl, xc, b, j), lane);
    row_ln(r);
    const Row sh = row_load(mrow + 0, lane), sc = row_load(mrow + 1024, lane);
    row_modulate(r, sh, sc);
    row_store(H + (size_t)j * D, lane, r);
}

__global__ __launch_bounds__(256) void k_gemm_f32(const float* __restrict__ A, int lda, const float* __restrict__ Bm, int ldb, float* __restrict__ C, int ldc, int K) {
    __shared__ __attribute__((aligned(16))) float As[16][68];
    __shared__ __attribute__((aligned(16))) float Bs[16][68];
    const int tid = threadIdx.x, bm = blockIdx.y * 64, bn = blockIdx.x * 64, ty = tid >> 4, tx = tid & 15;
    float acc[4][4];
#pragma unroll
    for (int i = 0; i < 4; ++i)
#pragma unroll
        for (int j = 0; j < 4; ++j) acc[i][j] = 0.f;
    for (int k0 = 0; k0 < K; k0 += 16) {
        const float4 a = *(const float4*)(A + (size_t)(bm + (tid >> 2)) * lda + k0 + (tid & 3) * 4);
        As[(tid & 3) * 4 + 0][tid >> 2] = a.x; As[(tid & 3) * 4 + 1][tid >> 2] = a.y; As[(tid & 3) * 4 + 2][tid >> 2] = a.z; As[(tid & 3) * 4 + 3][tid >> 2] = a.w;
        const float4 b = *(const float4*)(Bm + (size_t)(k0 + (tid >> 4)) * ldb + bn + (tid & 15) * 4);
        *(float4*)&Bs[tid >> 4][(tid & 15) * 4] = b;
        __syncthreads();
#pragma unroll
        for (int kk = 0; kk < 16; ++kk) {
            const float4 a4 = *(const float4*)&As[kk][ty * 4], b4 = *(const float4*)&Bs[kk][tx * 4];
            const float av[4] = {a4.x, a4.y, a4.z, a4.w}, bv[4] = {b4.x, b4.y, b4.z, b4.w};
#pragma unroll
            for (int i = 0; i < 4; ++i)
#pragma unroll
                for (int j = 0; j < 4; ++j) acc[i][j] += av[i] * bv[j];
        }
        __syncthreads();
    }
#pragma unroll
    for (int i = 0; i < 4; ++i) *(float4*)(C + (size_t)(bm + ty * 4 + i) * ldc + bn + tx * 4) = make_float4(acc[i][0], acc[i][1], acc[i][2], acc[i][3]);
}

__global__ void k_rope(float* P, const float* RC, const float* RS) {
    const int i = blockIdx.x * blockDim.x + threadIdx.x;
    if (i >= S * 2 * 12 * 2 * 16) return;
    const int f = i & 15, blk = (i >> 4) & 1, hh = (i >> 5) % 12, sec = (i / (32 * 12)) & 1, t = i / (32 * 12 * 2);
    float* p = P + (size_t)(L + t) * INW + (sec ? KOFF : QOFF) + hh * 64 + blk * 32 + f;
    const int pos = blk ? (t & 63) : (t >> 6);
    const float c = RC[pos * 16 + f], s = RS[pos * 16 + f], x1 = p[0], x2 = p[16];
    p[0] = x1 * c - x2 * s; p[16] = x2 * c + x1 * s;
}

__global__ void k_fz(const float* P, const float* C64, const float* S64, float* Z, int T, int j0) {
    const int i = blockIdx.x * blockDim.x + threadIdx.x;
    if (i >= 2 * T * 256) return;
    const int n = i & 255, kk = i >> 8, t = kk % T, part = kk / T, g = n >> 6, cp = n & 63;
    const float* u = P + (size_t)(j0 + t) * INW + g * 64; const float* tb = part ? S64 : C64;
    float s = 0.f;
    for (int c = 0; c < 64; ++c) s += u[c] * tb[c * 64 + cp];
    Z[i] = s;
}
__global__ void k_fmap(const float* F, const float* wf, float* CONCAT, int T, int j0, float norm) {
    const int i = blockIdx.x * blockDim.x + threadIdx.x;
    if (i >= T * 256) return;
    const int n = i & 255, t = i >> 8, g = n >> 6, d = n & 63;
    const float* f = F + (size_t)t * 256 + g * 64; const float* w = wf + g * 4096 + d;
    float s = 0.f;
    for (int c = 0; c < 64; ++c) s += f[c] * w[c * 64];
    CONCAT[(size_t)(j0 + t) * D + n] = s * norm;
}

__global__ __launch_bounds__(256) void k_attn_naive(const float* __restrict__ P, float* __restrict__ CONCAT, const float* LAM, const float* subln_g, int l, float one_minus_lam_init, int j0) {
    const int j = j0 + blockIdx.x, h = blockIdx.y, tid = threadIdx.x;
    __shared__ float q1[64], q2[64], s1[RB], s2[RB], red[4], outp[2][128];
    const int nk = j < L ? L : RB;
    if (tid < 64) q1[tid] = P[(size_t)j * INW + QOFF + (2 * h) * 64 + tid];
    else if (tid < 128) q2[tid - 64] = P[(size_t)j * INW + QOFF + (2 * h + 1) * 64 + (tid - 64)];
    __syncthreads();
    float m1 = -INFINITY, m2 = -INFINITY;
    for (int key = tid; key < nk; key += 256) {
        const float* k1 = P + (size_t)key * INW + KOFF + (2 * h) * 64; const float* k2 = k1 + 64;
        float d1 = 0.f, d2 = 0.f;
        for (int d = 0; d < 64; ++d) { d1 += q1[d] * k1[d]; d2 += q2[d] * k2[d]; }
        d1 *= 0.125f; d2 *= 0.125f; s1[key] = d1; s2[key] = d2; m1 = fmaxf(m1, d1); m2 = fmaxf(m2, d2);
    }
    const float M1 = block_max(m1, red); const float M2 = block_max(m2, red);
    float l1 = 0.f, l2 = 0.f;
    for (int key = tid; key < nk; key += 256) { const float e1 = expf(s1[key] - M1), e2 = expf(s2[key] - M2); s1[key] = e1; s2[key] = e2; l1 += e1; l2 += e2; }
    const float L1 = block_sum(l1, red); const float L2 = block_sum(l2, red);
    const float lam = LAM[l];
    for (int key = tid; key < nk; key += 256) s1[key] = s1[key] / L1 - lam * (s2[key] / L2);
    __syncthreads();
    const int d = tid & 127, half = tid >> 7;
    float acc = 0.f;
    const int kh = nk >> 1;
    for (int key = half * kh; key < (half + 1) * kh; ++key) acc += s1[key] * P[(size_t)key * INW + VOFF + h * 128 + d];
    outp[half][d] = acc;
    __syncthreads();
    float o = 0.f;
    if (tid < 128) o = outp[0][tid] + outp[1][tid];
    const float ss = block_sum(tid < 128 ? o * o : 0.f, red);
    const float rms = rsqrtf(ss * (1.f / 128.f) + EPS);
    if (tid < 128) CONCAT[(size_t)j * D + 256 + h * 128 + tid] = o * rms * subln_g[l * 128 + tid] * one_minus_lam_init;
}

__global__ __launch_bounds__(256) void k_post_attn(const float* xl, const float* xc, const float* O, const float* MODl, const float* lng, const float* lnb,
                                                   float* x1l, float* x1c, float* H, const float* w_router, const float* router_bias, int4* SEL, int b, int j0, int nrows) {
    const int lane = threadIdx.x & 63, w = blockIdx.x * 4 + (threadIdx.x >> 6);
    if (w >= nrows) return;
    const int j = j0 + w;
    const float* mrow = MODl + (size_t)(j < L ? 16 : b) * MODW;
    Row x = row_load(res_row(xl, xc, b, j), lane);
    const Row o = row_load(O + (size_t)j * D, lane), g = row_load(mrow + 2048, lane);
#pragma unroll
    for (int i = 0; i < 4; ++i) { x.v[i].x = ALPHA * x.v[i].x + g.v[i].x * o.v[i].x; x.v[i].y = ALPHA * x.v[i].y + g.v[i].y * o.v[i].y; x.v[i].z = ALPHA * x.v[i].z + g.v[i].z * o.v[i].z; x.v[i].w = ALPHA * x.v[i].w + g.v[i].w * o.v[i].w; }
    row_ln(x);
    { const Row gg = row_load(lng, lane), bb = row_load(lnb, lane); row_fma(x, gg, bb); }
    row_store(res_row_w(x1l, x1c, b, j), lane, x);
    row_ln(x);
    { const Row sh = row_load(mrow + 3072, lane), sc = row_load(mrow + 4096, lane); row_modulate(x, sh, sc); }
    row_store(H + (size_t)j * D, lane, x);
    float lg[16];
#pragma unroll
    for (int e = 0; e < 16; ++e) lg[e] = 0.f;
#pragma unroll
    for (int i = 0; i < 4; ++i) {
        const float hv[4] = {x.v[i].x, x.v[i].y, x.v[i].z, x.v[i].w};
#pragma unroll
        for (int jj = 0; jj < 4; ++jj) {
            const float* wr = w_router + (size_t)(i * 256 + lane * 4 + jj) * 16;
#pragma unroll
            for (int q = 0; q < 4; ++q) { const float4 wv = *(const float4*)(wr + q * 4); lg[q * 4 + 0] += hv[jj] * wv.x; lg[q * 4 + 1] += hv[jj] * wv.y; lg[q * 4 + 2] += hv[jj] * wv.z; lg[q * 4 + 3] += hv[jj] * wv.w; }
        }
    }
    float sc[16], sel[16];
#pragma unroll
    for (int e = 0; e < 16; ++e) { const float t = wave_sum(lg[e]); sc[e] = 1.f / (1.f + expf(-t)); sel[e] = sc[e] + router_bias[e]; }
    float best = -INFINITY; int bg = 0;
#pragma unroll
    for (int gI = 0; gI < 4; ++gI) {
        const float a0 = sel[gI * 4 + 0], a1 = sel[gI * 4 + 1], a2 = sel[gI * 4 + 2], a3 = sel[gI * 4 + 3];
        const float mx = fmaxf(fmaxf(a0, a1), fmaxf(a2, a3));
        float sec;
        if (a0 == mx) sec = fmaxf(a1, fmaxf(a2, a3)); else if (a1 == mx) sec = fmaxf(a0, fmaxf(a2, a3)); else if (a2 == mx) sec = fmaxf(fmaxf(a0, a1), a3); else sec = fmaxf(fmaxf(a0, a1), a2);
        const float gs = mx + sec;
        if (gs > best) { best = gs; bg = gI; }
    }
    float a[4], s4[4];
#pragma unroll
    for (int q = 0; q < 4; ++q) { a[q] = 0.f; s4[q] = 0.f; }
#pragma unroll
    for (int gI = 0; gI < 4; ++gI)
#pragma unroll
        for (int q = 0; q < 4; ++q) if (bg == gI) { a[q] = sel[gI * 4 + q]; s4[q] = sc[gI * 4 + q]; }
    int i0 = 0; float v0 = a[0];
#pragma unroll
    for (int q = 1; q < 4; ++q) if (a[q] > v0) { v0 = a[q]; i0 = q; }
    int i1 = -1; float v1 = -INFINITY;
#pragma unroll
    for (int q = 0; q < 4; ++q) if (q != i0 && a[q] > v1) { v1 = a[q]; i1 = q; }
    float w0 = 0.f, w1 = 0.f;
#pragma unroll
    for (int q = 0; q < 4; ++q) { if (q == i0) w0 = s4[q]; if (q == i1) w1 = s4[q]; }
    const float inv = 1.f / (w0 + w1);
    if (lane == 0) SEL[j] = make_int4(bg * 4 + i0, bg * 4 + i1, __float_as_int(w0 * inv), __float_as_int(w1 * inv));
}

__global__ __launch_bounds__(256) void k_moe_naive(const float* __restrict__ H, const int4* SEL, const float* __restrict__ wg, const float* __restrict__ wu, const float* __restrict__ wd, float* Y, int l, int j0) {
    const int j = j0 + blockIdx.x, tid = threadIdx.x;
    __shared__ float hs[1024], as[512];
#pragma unroll
    for (int i = 0; i < 4; ++i) hs[tid + 256 * i] = H[(size_t)j * D + tid + 256 * i];
    const int4 sel = SEL[j];
    float y[4] = {0.f, 0.f, 0.f, 0.f};
    __syncthreads();
#pragma unroll
    for (int slot = 0; slot < 2; ++slot) {
        const int e = slot ? sel.y : sel.x; const float wgt = __int_as_float(slot ? sel.w : sel.z);
        const float* Wg = wg + ((size_t)(l * 16 + e) * 1024) * 512; const float* Wu = wu + ((size_t)(l * 16 + e) * 1024) * 512; const float* Wd = wd + ((size_t)(l * 16 + e) * 512) * 1024;
        float g0 = 0.f, g1 = 0.f, u0 = 0.f, u1 = 0.f;
        for (int k = 0; k < 1024; ++k) { const float hv = hs[k]; g0 += hv * Wg[(size_t)k * 512 + tid]; g1 += hv * Wg[(size_t)k * 512 + tid + 256]; u0 += hv * Wu[(size_t)k * 512 + tid]; u1 += hv * Wu[(size_t)k * 512 + tid + 256]; }
        as[tid] = g0 / (1.f + expf(-g0)) * u0; as[tid + 256] = g1 / (1.f + expf(-g1)) * u1;
        __syncthreads();
        float a0 = 0.f, a1 = 0.f, a2 = 0.f, a3 = 0.f;
        for (int k = 0; k < 512; ++k) { const float av = as[k]; const float* wr = Wd + (size_t)k * 1024 + tid; a0 += av * wr[0]; a1 += av * wr[256]; a2 += av * wr[512]; a3 += av * wr[768]; }
        y[0] += wgt * a0; y[1] += wgt * a1; y[2] += wgt * a2; y[3] += wgt * a3;
        __syncthreads();
    }
#pragma unroll
    for (int i = 0; i < 4; ++i) Y[(size_t)j * D + tid + 256 * i] = y[i];
}

__global__ __launch_bounds__(256) void k_post_ffn(const float* x1l, const float* x1c, const float* Y, const float* MODl, const float* lng, const float* lnb,
                                                  float* x2l, float* x2c, int b, int j0, int nrows) {
    const int lane = threadIdx.x & 63, w = blockIdx.x * 4 + (threadIdx.x >> 6);
    if (w >= nrows) return;
    const int j = j0 + w;
    const float* mrow = MODl + (size_t)(j < L ? 16 : b) * MODW;
    Row x = row_load(res_row(x1l, x1c, b, j), lane);
    const Row y = row_load(Y + (size_t)j * D, lane), g = row_load(mrow + 5120, lane);
#pragma unroll
    for (int i = 0; i < 4; ++i) { x.v[i].x = ALPHA * x.v[i].x + g.v[i].x * y.v[i].x; x.v[i].y = ALPHA * x.v[i].y + g.v[i].y * y.v[i].y; x.v[i].z = ALPHA * x.v[i].z + g.v[i].z * y.v[i].z; x.v[i].w = ALPHA * x.v[i].w + g.v[i].w * y.v[i].w; }
    row_ln(x);
    { const Row gg = row_load(lng, lane), bb = row_load(lnb, lane); row_fma(x, gg, bb); }
    row_store(res_row_w(x2l, x2c, b, j), lane, x);
}
}
#endif
#if MK_DEBUG
namespace dbg {
__device__ __forceinline__ void diag_acc(float* DIAG, int st, float md, float sq, float cnt, float mis) {
#pragma unroll
    for (int o = 32; o > 0; o >>= 1) { md = fmaxf(md, __shfl_xor(md, o)); sq += __shfl_xor(sq, o); cnt += __shfl_xor(cnt, o); mis += __shfl_xor(mis, o); }
    if ((threadIdx.x & 63) == 0) { atomicMax((unsigned*)&DIAG[st * 4 + 0], __float_as_uint(md)); atomicAdd(&DIAG[st * 4 + 1], sq); atomicAdd(&DIAG[st * 4 + 2], cnt); atomicAdd(&DIAG[st * 4 + 3], mis); }
}
__device__ __forceinline__ float adiff(float r, float n, float fl) { const float d = fabsf(r - n) / (fabsf(r) + fl); return (d == d) ? d : 1e30f; }
__device__ __forceinline__ float rms_of(const float* DIAG, int st) { return sqrtf(DIAG[st * 4 + 1] / fmaxf(DIAG[st * 4 + 2], 1.f)) + 1e-30f; }
__global__ void k_cmp_bf16(const float* ref, int ldr, const bf16_t* nw, int ldn, int rows, int cols, float refscale, float* DIAG, int st, int pass) {
    float md = 0.f, sq = 0.f, cnt = 0.f; const float fl = pass ? rms_of(DIAG, st) : 1.f;
    for (size_t i = (size_t)blockIdx.x * blockDim.x + threadIdx.x; i < (size_t)rows * cols; i += (size_t)gridDim.x * blockDim.x) { const int r = (int)(i / cols), c = (int)(i % cols);
        const float rv = ref[(size_t)r * ldr + c] * refscale, nv = bf2f(nw[(size_t)r * ldn + c]); if (pass) md = fmaxf(md, adiff(rv, nv, fl)); else { sq += rv * rv; cnt += 1.f; } }
    diag_acc(DIAG, st, md, sq, cnt, 0.f);
}
__global__ void k_cmp_bf16_sum2(const float* ref, int ldr, const bf16_t* n1, const bf16_t* n2, int ldn, int rows, int cols, float* DIAG, int st, int pass) {
    float md = 0.f, sq = 0.f, cnt = 0.f; const float fl = pass ? rms_of(DIAG, st) : 1.f;
    for (size_t i = (size_t)blockIdx.x * blockDim.x + threadIdx.x; i < (size_t)rows * cols; i += (size_t)gridDim.x * blockDim.x) { const int r = (int)(i / cols), c = (int)(i % cols);
        const float rv = ref[(size_t)r * ldr + c], nv = bf2f(n1[(size_t)r * ldn + c]) + bf2f(n2[(size_t)r * ldn + c]); if (pass) md = fmaxf(md, adiff(rv, nv, fl)); else { sq += rv * rv; cnt += 1.f; } }
    diag_acc(DIAG, st, md, sq, cnt, 0.f);
}
__global__ void k_cmp_f32(const float* ref, int ldr, const float* nw, int ldn, int rows, int cols, float* DIAG, int st, int pass) {
    float md = 0.f, sq = 0.f, cnt = 0.f; const float fl = pass ? rms_of(DIAG, st) : 1.f;
    for (size_t i = (size_t)blockIdx.x * blockDim.x + threadIdx.x; i < (size_t)rows * cols; i += (size_t)gridDim.x * blockDim.x) { const int r = (int)(i / cols), c = (int)(i % cols);
        const float rv = ref[(size_t)r * ldr + c], nv = nw[(size_t)r * ldn + c]; if (pass) md = fmaxf(md, adiff(rv, nv, fl)); else { sq += rv * rv; cnt += 1.f; } }
    diag_acc(DIAG, st, md, sq, cnt, 0.f);
}
__global__ void k_cmp_sel(const int4* ref, const int4* nw, int rows, float* DIAG, int st) {
    float mis = 0.f;
    for (int i = blockIdx.x * blockDim.x + threadIdx.x; i < rows; i += gridDim.x * blockDim.x) { const int4 a = ref[i], b = nw[i];
        if (a.x != b.x || a.y != b.y || fabsf(__int_as_float(a.z) - __int_as_float(b.z)) > 1e-3f || fabsf(__int_as_float(a.w) - __int_as_float(b.w)) > 1e-3f) mis += 1.f; }
    diag_acc(DIAG, st, 0.f, 0.f, 0.f, mis);
}
__global__ void k_cvt(const bf16_t* src, int lds_, float* dst, int ldd, int rows, int cols, float scale) {
    for (size_t i = (size_t)blockIdx.x * blockDim.x + threadIdx.x; i < (size_t)rows * cols; i += (size_t)gridDim.x * blockDim.x) { const int r = (int)(i / cols), c = (int)(i % cols);
        dst[(size_t)r * ldd + c] = bf2f(src[(size_t)r * lds_ + c]) * scale; }
}
__global__ void k_cvt_sum2(const bf16_t* s1, const bf16_t* s2, int lds_, float* dst, int ldd, int rows, int cols) {
    for (size_t i = (size_t)blockIdx.x * blockDim.x + threadIdx.x; i < (size_t)rows * cols; i += (size_t)gridDim.x * blockDim.x) { const int r = (int)(i / cols), c = (int)(i % cols);
        dst[(size_t)r * ldd + c] = bf2f(s1[(size_t)r * lds_ + c]) + bf2f(s2[(size_t)r * lds_ + c]); }
}
__global__ void k_four_recon(const bf16_t* CC, int ldc, const float* MHl, float* out, int ldo, int rows) {
    for (size_t i = (size_t)blockIdx.x * blockDim.x + threadIdx.x; i < (size_t)rows * 256; i += (size_t)gridDim.x * blockDim.x) { const int r = (int)(i >> 8), n = (int)(i & 255), g = n >> 6, d = n & 63;
        const bf16_t* fc = CC + (size_t)r * ldc + g * 64; const bf16_t* fs = fc + 256; float s = 0.f;
        for (int c = 0; c < 64; ++c) s += bf2f(fc[c]) * MHl[((0 * 4 + g) * 64 + c) * 64 + d] + bf2f(fs[c]) * MHl[((1 * 4 + g) * 64 + c) * 64 + d];
        out[(size_t)r * ldo + n] = s; }
}
__device__ __forceinline__ float stage_tol(int s) {
    if (s == 1) return 1e-4f;
    const int k = (s - 2) % 9;
    return k == 0 ? 0.03f : k == 1 ? 0.05f : k == 2 ? 0.15f : k == 3 ? 0.06f : k == 4 ? 0.12f : k == 5 ? 0.02f : k == 6 ? 0.03f : k == 7 ? 0.08f : 0.02f;
}
__global__ void k_final(const float* DIAG, int nst, float* out, size_t n) {
    int bad = 0; float m = 0.f;
    for (int s = 1; s <= nst; ++s) {
        const float md = DIAG[s * 4 + 0], sq = DIAG[s * 4 + 1], cnt = DIAG[s * 4 + 2], mis = DIAG[s * 4 + 3];
        if (cnt <= 0.f && mis <= 0.f) continue;
        float err = cnt > 0.f ? md : 0.f; const float tol = stage_tol(s);
        if (mis > 8.f) err = fmaxf(err, tol * mis);
        if (!(err <= tol)) { bad = s; m = fminf(fmaxf(1.f + 3.f * log10f(err / tol), 1.f), 9.9f); break; }
    }
    if (!bad) return;
    const float cval = sqrtf(powf(10.f, (float)bad) * m);
    for (size_t i = (size_t)blockIdx.x * blockDim.x + threadIdx.x; i < n; i += (size_t)gridDim.x * blockDim.x) out[i] = cval;
}
}
#endif

extern "C" void kernel_launch(void* const* d_in, const int* in_sizes, int n_in, void* d_out, int out_size, void* d_ws, size_t ws_size, hipStream_t stream) {
    using namespace mk;
    static int ready = 0;
    if (!ready) {
        if (n_in != 20 || out_size != NB * S * D) { fprintf(stderr, "kernel_launch: unexpected problem shape\n"); ready = -1; return; }
        if (ws_size < WS_NEED) { fprintf(stderr, "kernel_launch: workspace too small: need %zu have %zu\n", (size_t)WS_NEED, ws_size); ready = -1; return; }
        if (hipFuncSetAttribute((const void*)mk_fwd, hipFuncAttributeMaxDynamicSharedMemorySize, LDS_BYTES) != hipSuccess) { fprintf(stderr, "kernel_launch: hipFuncSetAttribute failed\n"); ready = -1; return; }
        ready = 1;
    }
    if (ready < 0) return;
    Args a{};
    for (int i = 0; i < 20; ++i) a.in[i] = (const float*)d_in[i];
    a.out = (float*)d_out; a.ws = (unsigned char*)d_ws; a.rep_attn = 1; a.attn_var = 0; a.pad2 = 0;
    for (int i = 0; i < 16; ++i) a.rep[i] = 1;
#if defined(MK_REP_ATTN)
    a.rep_attn = MK_REP_ATTN;
#endif
#if defined(MK_ATTN_VAR)
    a.attn_var = MK_ATTN_VAR;
#endif
#if defined(MK_REP_PHASE)
    a.rep[MK_REP_PHASE] = MK_REP_COUNT;
#endif
    (void)hipMemsetAsync(d_ws, 0, CTL_BYTES, stream);
    const int grid = 256;
#if !MK_DEBUG
#ifndef MK_CUTS
    a.ph_lo = 0; a.ph_hi = N_PHASES; a.li = 0;
    hipLaunchKernelGGL(mk_fwd, dim3(grid), dim3(512), LDS_BYTES, stream, a);
#if defined(MK_STAMP)
    k_encode<<<1024, 256, 0, stream>>>((const unsigned long long*)((unsigned char*)d_ws + WS_NEED), (float*)d_out, (size_t)out_size);
#endif
#else
    for (int p = 0; p < N_PHASES; ++p) { a.ph_lo = p; a.ph_hi = p + 1; a.li = 0; hipLaunchKernelGGL(mk_fwd, dim3(grid), dim3(512), LDS_BYTES, stream, a); }
#endif
#else
    unsigned char* ws = (unsigned char*)d_ws;
    size_t off = (WS_NEED + 255) & ~(size_t)255;
    auto take = [&](size_t nfloats) { float* p = (float*)(ws + off); off += ((nfloats * 4 + 255) & ~(size_t)255); return p; };
    float* DIAG = take(256);
    float* Hr = take((size_t)RB * D); float* Pr = take((size_t)RB * 2560); float* CCr = take((size_t)RB * D); float* Or = take((size_t)RB * D); float* Yr = take((size_t)RB * D);
    float* Z = Yr; float* F = Or;        float* TABr = take((size_t)S * 2 * S); float* TABcr = take((size_t)L * 2 * L);
    float* MODr = take((size_t)2 * 17 * MODW); float* SILr = take(17 * 1024); float* LAMr = take(64); float* RCr = take(1024); float* RSr = take(1024); float* C64r = take(4096); float* S64r = take(4096);
    float* A_lat = take((size_t)S * D); float* A_ctx = take((size_t)L * D); float* B_lat = take((size_t)S * D); float* B_ctx = take((size_t)L * D); float* XS_lat = B_lat; float* XS_ctx = B_ctx;
    int4* SELr = (int4*)take((size_t)RB * 4);
    if (off > ws_size) { fprintf(stderr, "kernel_launch(debug): workspace too small: need %zu have %zu\n", off, ws_size); return; }
    (void)hipMemsetAsync(DIAG, 0, 1024, stream);
    const float* x = a.in[I_X]; const float* ctx = a.in[I_CTX];
    bf16_t* Hn = (bf16_t*)(ws + OFF_ARENA + AR_H); bf16_t* QKVn = (bf16_t*)(ws + OFF_ARENA + AR_QKV); bf16_t* CCn = (bf16_t*)(ws + OFF_ARENA + AR_CC); bf16_t* On = (bf16_t*)(ws + OFF_ARENA + AR_O); bf16_t* Y2n = (bf16_t*)(ws + OFF_ARENA + AR_Y2);
    float* MODn = (float*)(ws + OFF_MOD); float* LAMn = (float*)(ws + OFF_LAM); bf16_t* RESn = (bf16_t*)(ws + OFF_RES); int4* SELn = (int4*)(ws + OFF_SELN);
    auto run = [&](int p) { a.ph_lo = p; a.ph_hi = p + 1; a.li = 0; hipLaunchKernelGGL(mk_fwd, dim3(grid), dim3(512), LDS_BYTES, stream, a); };
    const int CB = 1024;
    ref::k_prep_small<<<(17 * 1024 + 255) / 256, 256, 0, stream>>>(a.in[I_C], a.in[I_CCTX], a.in[I_LAMQK], SILr, LAMr, RCr, RSr, C64r, S64r);
    ref::k_prep_tab<<<(unsigned)(((size_t)S * 2 * S + 255) / 256), 256, 0, stream>>>(TABr, S);
    ref::k_prep_tab<<<(unsigned)(((size_t)L * 2 * L + 255) / 256), 256, 0, stream>>>(TABcr, L);
    ref::k_mod<<<dim3(MODW / 64, 2), 256, 0, stream>>>(SILr, a.in[I_WMOD], a.in[I_BMOD], MODr);
    run(0);
    dbg::k_cmp_f32<<<CB, 256, 0, stream>>>(MODr, MODW, MODn, MODW, 34, MODW, DIAG, 1, 0); dbg::k_cmp_f32<<<CB, 256, 0, stream>>>(MODr, MODW, MODn, MODW, 34, MODW, DIAG, 1, 1);
    dbg::k_cmp_f32<<<1, 64, 0, stream>>>(LAMr, 2, LAMn, 2, 1, 2, DIAG, 1, 0); dbg::k_cmp_f32<<<1, 64, 0, stream>>>(LAMr, 2, LAMn, 2, 1, 2, DIAG, 1, 1);
    run(1);
    int nst = 1;
#ifndef MK_DBG_PHASES
#define MK_DBG_PHASES 16
#endif
    for (int l = 0; l < 2; ++l) {
        const bool last = (l == 1); const int pb = 2 + 7 * l, sb = 2 + 9 * l, j0 = last ? L : 0, nr = RB - j0;
        if (pb >= MK_DBG_PHASES) break;
        const float* MODl = MODn + (size_t)l * 17 * MODW;
        const float* win = a.in[I_WIN] + (size_t)l * D * 2560; const float* wout = a.in[I_WOUT] + (size_t)l * D * D; const float* wf = a.in[I_WF] + (size_t)l * 4 * 64 * 64;
        const float omli = (float)(1.0 - (0.8 - 0.6 * exp(-0.3 * (double)l)));
        if (last) { dbg::k_cvt<<<CB, 256, 0, stream>>>(RESn + (size_t)L * D, D, XS_lat, D, S, D, 1.f); dbg::k_cvt<<<CB, 256, 0, stream>>>(RESn, D, XS_ctx, D, L, D, 1.f); }
        const float* xl = l == 0 ? x : XS_lat; const float* xc = l == 0 ? ctx : XS_ctx;
        ref::k_lnmod<<<RB / 4, 256, 0, stream>>>(xl, xc, MODl, Hr, 0, 0, RB);
        dbg::k_cmp_bf16<<<CB, 256, 0, stream>>>(Hr, D, Hn, D, RB, D, 1.f, DIAG, sb + 0, 0); dbg::k_cmp_bf16<<<CB, 256, 0, stream>>>(Hr, D, Hn, D, RB, D, 1.f, DIAG, sb + 0, 1); nst = sb + 0;
        run(pb + 0);
        dbg::k_cvt<<<CB, 256, 0, stream>>>(Hn, D, Hr, D, RB, D, 1.f);
        ref::k_gemm_f32<<<dim3(2560 / 64, RB / 64), 256, 0, stream>>>(Hr, D, win, 2560, Pr, 2560, D);
        ref::k_rope<<<(S * 2 * 12 * 2 * 16 + 255) / 256, 256, 0, stream>>>(Pr, RCr, RSr);
        dbg::k_cmp_bf16<<<CB, 256, 0, stream>>>(Pr + (size_t)j0 * 2560 + 256, 2560, QKVn + (size_t)j0 * QKVW, QKVW, nr, 768, QSCALE, DIAG, sb + 1, 0); dbg::k_cmp_bf16<<<CB, 256, 0, stream>>>(Pr + (size_t)j0 * 2560 + 256, 2560, QKVn + (size_t)j0 * QKVW, QKVW, nr, 768, QSCALE, DIAG, sb + 1, 1);
        dbg::k_cmp_bf16<<<CB, 256, 0, stream>>>(Pr + 1024, 2560, QKVn + 768, QKVW, RB, 1536, 1.f, DIAG, sb + 1, 0); dbg::k_cmp_bf16<<<CB, 256, 0, stream>>>(Pr + 1024, 2560, QKVn + 768, QKVW, RB, 1536, 1.f, DIAG, sb + 1, 1); nst = sb + 1;
        if (pb + 1 >= MK_DBG_PHASES) break;
        run(pb + 1);
        ref::k_fz<<<(2 * S * 256 + 255) / 256, 256, 0, stream>>>(Pr, C64r, S64r, Z, S, L);
        ref::k_gemm_f32<<<dim3(256 / 64, S / 64), 256, 0, stream>>>(TABr, 2 * S, Z, 256, F, 256, 2 * S);
        ref::k_fmap<<<(S * 256 + 255) / 256, 256, 0, stream>>>(F, wf, CCr, S, L, 1.0f / sqrtf((float)S * 64.f));
        if (!last) {
            ref::k_fz<<<(2 * L * 256 + 255) / 256, 256, 0, stream>>>(Pr, C64r, S64r, Z, L, 0);
            ref::k_gemm_f32<<<dim3(256 / 64, L / 64), 256, 0, stream>>>(TABcr, 2 * L, Z, 256, F, 256, 2 * L);
            ref::k_fmap<<<(L * 256 + 255) / 256, 256, 0, stream>>>(F, wf, CCr, L, 0, 1.0f / sqrtf((float)L * 64.f));
        }
        dbg::k_four_recon<<<CB, 256, 0, stream>>>(CCn, CW, (const float*)(ws + OFF_MH) + (size_t)l * 2 * 4 * 64 * 64, Hr, D, RB);
        dbg::k_cmp_f32<<<CB, 256, 0, stream>>>(CCr + (size_t)j0 * D, D, Hr + (size_t)j0 * D, D, nr, 256, DIAG, sb + 2, 0); dbg::k_cmp_f32<<<CB, 256, 0, stream>>>(CCr + (size_t)j0 * D, D, Hr + (size_t)j0 * D, D, nr, 256, DIAG, sb + 2, 1); nst = sb + 2;
        dbg::k_cvt<<<CB, 256, 0, stream>>>(QKVn, QKVW, Pr + 256, 2560, RB, 768, 1.f / QSCALE);
        dbg::k_cvt<<<CB, 256, 0, stream>>>(QKVn + 768, QKVW, Pr + 1024, 2560, RB, 1536, 1.f);
        ref::k_attn_naive<<<dim3(nr, 6), 256, 0, stream>>>(Pr, CCr, LAMn, a.in[I_SUBLN], l, omli, j0);
        dbg::k_cmp_bf16<<<CB, 256, 0, stream>>>(CCr + (size_t)j0 * D + 256, D, CCn + (size_t)j0 * CW + 512, CW, nr, 768, 1.f, DIAG, sb + 3, 0); dbg::k_cmp_bf16<<<CB, 256, 0, stream>>>(CCr + (size_t)j0 * D + 256, D, CCn + (size_t)j0 * CW + 512, CW, nr, 768, 1.f, DIAG, sb + 3, 1); nst = sb + 3;
        if (pb + 2 >= MK_DBG_PHASES) break;
        run(pb + 2);
        dbg::k_four_recon<<<CB, 256, 0, stream>>>(CCn, CW, (const float*)(ws + OFF_MH) + (size_t)l * 2 * 4 * 64 * 64, CCr, D, RB);
        dbg::k_cvt<<<CB, 256, 0, stream>>>(CCn + 512, CW, CCr + 256, D, RB, 768, 1.f);
        ref::k_gemm_f32<<<dim3(D / 64, nr / 64), 256, 0, stream>>>(CCr + (size_t)j0 * D, D, wout, D, Or + (size_t)j0 * D, D, D);
        dbg::k_cmp_bf16<<<CB, 256, 0, stream>>>(Or + (size_t)j0 * D, D, On + (size_t)j0 * D, D, nr, D, 1.f, DIAG, sb + 4, 0); dbg::k_cmp_bf16<<<CB, 256, 0, stream>>>(Or + (size_t)j0 * D, D, On + (size_t)j0 * D, D, nr, D, 1.f, DIAG, sb + 4, 1); nst = sb + 4;
        if (pb + 3 >= MK_DBG_PHASES) break;
        dbg::k_cvt<<<CB, 256, 0, stream>>>(On, D, Or, D, RB, D, 1.f);

        run(pb + 3);
        ref::k_post_attn<<<nr / 4, 256, 0, stream>>>(last ? XS_lat : x, last ? XS_ctx : ctx, Or, MODl, a.in[I_LNAG] + l * D, a.in[I_LNAB] + l * D, A_lat, A_ctx, Hr, a.in[I_WR], a.in[I_RB], SELr, 0, j0, nr);
        dbg::k_cmp_bf16<<<CB, 256, 0, stream>>>(A_lat, D, RESn + (size_t)L * D, D, S, D, 1.f, DIAG, sb + 5, 0); dbg::k_cmp_bf16<<<CB, 256, 0, stream>>>(A_lat, D, RESn + (size_t)L * D, D, S, D, 1.f, DIAG, sb + 5, 1);
        if (!last) { dbg::k_cmp_bf16<<<CB, 256, 0, stream>>>(A_ctx, D, RESn, D, L, D, 1.f, DIAG, sb + 5, 0); dbg::k_cmp_bf16<<<CB, 256, 0, stream>>>(A_ctx, D, RESn, D, L, D, 1.f, DIAG, sb + 5, 1); }
        dbg::k_cmp_bf16<<<CB, 256, 0, stream>>>(Hr + (size_t)j0 * D, D, On + (size_t)j0 * D, D, nr, D, 1.f, DIAG, sb + 6, 0); dbg::k_cmp_bf16<<<CB, 256, 0, stream>>>(Hr + (size_t)j0 * D, D, On + (size_t)j0 * D, D, nr, D, 1.f, DIAG, sb + 6, 1);
        dbg::k_cmp_sel<<<16, 256, 0, stream>>>(SELr + j0, SELn + j0, nr, DIAG, sb + 6); nst = sb + 6;
        dbg::k_cvt<<<CB, 256, 0, stream>>>(On, D, Hr, D, RB, D, 1.f);
        if (pb + 5 >= MK_DBG_PHASES) break;
        run(pb + 4); run(pb + 5);
        ref::k_moe_naive<<<nr, 256, 0, stream>>>(Hr, SELn, a.in[I_WG], a.in[I_WUP], a.in[I_WDN], Yr, l, j0);
        dbg::k_cmp_bf16_sum2<<<CB, 256, 0, stream>>>(Yr + (size_t)j0 * D, D, Y2n + (size_t)(2 * j0) * D, Y2n + (size_t)(2 * j0 + 1) * D, 2 * D, nr, D, DIAG, sb + 7, 0); dbg::k_cmp_bf16_sum2<<<CB, 256, 0, stream>>>(Yr + (size_t)j0 * D, D, Y2n + (size_t)(2 * j0) * D, Y2n + (size_t)(2 * j0 + 1) * D, 2 * D, nr, D, DIAG, sb + 7, 1); nst = sb + 7;
        if (pb + 6 >= MK_DBG_PHASES) break;
        dbg::k_cvt<<<CB, 256, 0, stream>>>(RESn + (size_t)L * D, D, A_lat, D, S, D, 1.f); dbg::k_cvt<<<CB, 256, 0, stream>>>(RESn, D, A_ctx, D, L, D, 1.f);
        dbg::k_cvt_sum2<<<CB, 256, 0, stream>>>(Y2n, Y2n + D, 2 * D, Yr, D, RB, D);
        run(pb + 6);
        ref::k_post_ffn<<<nr / 4, 256, 0, stream>>>(A_lat, A_ctx, Yr, MODl, a.in[I_LNFG] + l * D, a.in[I_LNFB] + l * D, B_lat, B_ctx, 0, j0, nr);
        if (last) dbg::k_cmp_f32<<<CB, 256, 0, stream>>>(B_lat, D, a.out, D, S, D, DIAG, sb + 8, 0); else dbg::k_cmp_bf16<<<CB, 256, 0, stream>>>(B_lat, D, RESn + (size_t)L * D, D, S, D, 1.f, DIAG, sb + 8, 0); if (last) dbg::k_cmp_f32<<<CB, 256, 0, stream>>>(B_lat, D, a.out, D, S, D, DIAG, sb + 8, 1); else dbg::k_cmp_bf16<<<CB, 256, 0, stream>>>(B_lat, D, RESn + (size_t)L * D, D, S, D, 1.f, DIAG, sb + 8, 1);
        if (!last) { dbg::k_cmp_bf16<<<CB, 256, 0, stream>>>(B_ctx, D, RESn, D, L, D, 1.f, DIAG, sb + 8, 0); dbg::k_cmp_bf16<<<CB, 256, 0, stream>>>(B_ctx, D, RESn, D, L, D, 1.f, DIAG, sb + 8, 1); }
        nst = sb + 8;
    }
#if MK_DBG_PHASES < 16
    (void)hipMemsetAsync(d_out, 0, (size_t)out_size * 4, stream);
#endif
    dbg::k_final<<<1024, 256, 0, stream>>>(DIAG, nst, (float*)d_out, (size_t)out_size);
#endif
}
```

```cpp
#include <hip/hip_runtime.h>
#include <math.h>
#include <stdio.h>
#ifndef MK_DEBUG
#define MK_DEBUG 0
#endif
#undef MK_DEBUG
#define MK_DEBUG 0
typedef unsigned short bf16_t;
typedef short bf16x8 __attribute__((ext_vector_type(8)));
typedef short s16x4 __attribute__((ext_vector_type(4)));
typedef float f32x4 __attribute__((ext_vector_type(4)));
typedef float f32x16 __attribute__((ext_vector_type(16)));
typedef unsigned u32x4 __attribute__((ext_vector_type(4)));
typedef unsigned u32x2 __attribute__((ext_vector_type(2)));
typedef float f32x2_t __attribute__((ext_vector_type(2)));
typedef __bf16 bf16x2_t __attribute__((ext_vector_type(2)));
#define LAS __attribute__((address_space(3)))

__device__ __forceinline__ unsigned cvtpk(float lo, float hi) { f32x2_t v = {lo, hi}; bf16x2_t b = __builtin_convertvector(v, bf16x2_t); return __builtin_bit_cast(unsigned, b); }
__device__ __forceinline__ float bf_lo(unsigned w) { return __uint_as_float(w << 16); }
__device__ __forceinline__ float bf_hi(unsigned w) { return __uint_as_float(w & 0xffff0000u); }
__device__ __forceinline__ float bf2f(bf16_t b) { return __uint_as_float(((unsigned)b) << 16); }

#define XB_TMO      128
#define XB_XCNT(j)  (256  + 64 * (j))
#define XB_XSUB(j)  (1280 + 64 * (j))
#define XB_XGEN(j)  (2304 + 64 * (j))
#define XB_TOP      3328
#define XB_TOPGEN   3392
#define XCD_BAR_WORDS 3456
#define XB_SPIN_CAP (1u << 18)
__device__ __forceinline__ unsigned xb_ld(unsigned* p)              { return __hip_atomic_load(p, __ATOMIC_RELAXED, __HIP_MEMORY_SCOPE_AGENT); }
__device__ __forceinline__ unsigned xb_add(unsigned* p, unsigned v) { return __hip_atomic_fetch_add(p, v, __ATOMIC_RELAXED, __HIP_MEMORY_SCOPE_AGENT); }
__device__ __forceinline__ unsigned xb_xcc_id() { return (unsigned)__builtin_amdgcn_s_getreg((3 << 11) | 20) & 0xFu; }
#define XB_SPIN(cond, bar) do { unsigned _sp = 0; while (cond) { __builtin_amdgcn_s_sleep(1); \
    if ((++_sp & 255u) == 0u) { if (xb_ld(&(bar)[XB_TMO])) break; if (_sp > XB_SPIN_CAP) { atomicAdd(&(bar)[XB_TMO], 1u); break; } } } } while (0)
struct XcdBarrier { unsigned* bar; unsigned x; volatile LAS unsigned* st; };
__device__ __forceinline__ XcdBarrier xcd_barrier_post(unsigned* bar, volatile LAS unsigned* st) {
    XcdBarrier b; b.bar = bar; b.x = xb_xcc_id(); b.st = st;
    if (threadIdx.x == 0) (void)xb_add(&bar[XB_XCNT(b.x)], 1u);
    return b;
}
__device__ __forceinline__ void xcd_barrier_complete(unsigned* bar, unsigned x, unsigned& nloc, unsigned& nx) {
    const unsigned G = gridDim.x * gridDim.y * gridDim.z;
    unsigned sum, cnt, mine, sp = 0u;
    for (;;) {
        sum = 0u; cnt = 0u; mine = 0u;
#pragma unroll
        for (unsigned j = 0; j < 16; ++j) { const unsigned c = xb_ld(&bar[XB_XCNT(j)]); sum += c; cnt += (c > 0u) ? 1u : 0u; mine = (j == x) ? c : mine; }
        if (sum == G) break;
        __builtin_amdgcn_s_sleep(1);
        if ((++sp & 255u) == 0u) { if (xb_ld(&bar[XB_TMO])) break; if (sp > XB_SPIN_CAP) { atomicAdd(&bar[XB_TMO], 1u); break; } }
    }
    nloc = mine > 0u ? mine : 1u; nx = cnt > 0u ? cnt : 1u;
}
__device__ __forceinline__ void xcd_barrier(const XcdBarrier& b, unsigned long long* stamp = nullptr) {
    asm volatile("s_waitcnt vmcnt(0)" ::: "memory");
    __syncthreads();
    if (threadIdx.x == 0) {
        unsigned* bar = b.bar;
        __builtin_amdgcn_s_waitcnt(0);
        unsigned nloc = b.st[0], nx = b.st[1];
        if (nloc == 0u) { xcd_barrier_complete(bar, b.x, nloc, nx); b.st[0] = nloc; b.st[1] = nx; }
        const unsigned old = xb_add(&bar[XB_XSUB(b.x)], 1u);
        const unsigned gen = old / nloc;
        if (old + 1u == (gen + 1u) * nloc) {
            __builtin_amdgcn_fence(__ATOMIC_RELEASE, "agent");
            asm volatile("s_waitcnt vmcnt(0)" ::: "memory");
            const unsigned og = xb_add(&bar[XB_TOP], 1u);
            const unsigned tg = og / nx;
            if (og + 1u == (tg + 1u) * nx) xb_add(&bar[XB_TOPGEN], 1u);
            else XB_SPIN(xb_ld(&bar[XB_TOPGEN]) == tg, bar);
            __builtin_amdgcn_fence(__ATOMIC_ACQUIRE, "agent");
            xb_add(&bar[XB_XGEN(b.x)], 1u);
            asm volatile("s_waitcnt vmcnt(0)" ::: "memory");
        } else {
            XB_SPIN(xb_ld(&bar[XB_XGEN(b.x)]) == gen, bar);
            __builtin_amdgcn_fence(__ATOMIC_ACQUIRE, "agent");
            asm volatile("s_waitcnt vmcnt(0)" ::: "memory");
        }
        if (stamp) *stamp = wall_clock64();
    }
    __syncthreads();
}

namespace g8 {
constexpr int BM = 256, BK = 64, HALF = 128, HTB = HALF * BK * 2, STAGE_BYTES = 8 * HTB;
__device__ __forceinline__ int lds_byte(int r, int c) { const int st = (r >> 4) * 2 + (c >> 5), rr = r & 15, cc = c & 31, ob = rr * 64 + cc * 2; return st * 1024 + (ob ^ (((ob >> 9) & 1) << 5)); }
__device__ __forceinline__ void stage_rc(int b, int& R, int& C) { const int st = b / 1024, sb = b % 1024, swz = sb ^ (((sb >> 9) & 1) << 5); R = (st >> 1) * 16 + swz / 64; C = (st & 1) * 32 + (swz % 64) / 2; }
__device__ __forceinline__ int perm32(int rho) { const int n = rho >> 4, i = rho & 15; return 8 * (i >> 2) + 4 * n + (i & 3); }

struct Unit { const char* A; const char* B; const int* gl; int gcount; int kind, p0, p1; };

template <bool GATHER, class Epi, class Sched>
__device__ __forceinline__ void gemm_phase(LAS unsigned char* lds, const int K, const unsigned lda2, const unsigned ldb2, const Sched& S, const Epi& E) {
    int tid = threadIdx.x; asm volatile("" : "+v"(tid));
    const int wid = __builtin_amdgcn_readfirstlane(tid >> 6), lane = tid & 63, wr = wid >> 2, wc = wid & 3, fr = lane & 15, fq = lane >> 4;
    const int nt = K / BK;
    int Rr[2], Cc[2];
    unsigned vB[2];
#pragma unroll
    for (int i = 0; i < 2; ++i) { stage_rc(tid * 16 + i * 8192, Rr[i], Cc[i]); const int Rb = (Rr[i] & ~31) + perm32(Rr[i] & 31); vB[i] = (unsigned)Rb * ldb2 + (unsigned)Cc[i] * 2u; }
    const unsigned hB = (unsigned)HALF * ldb2, hA = (unsigned)HALF * lda2;
    const size_t kstep = (size_t)(BK * 2);
    const unsigned ldsw = (unsigned)wid * 1024u;
    const int aoff = lds_byte(wr * 64 + fr, fq * 8), boff = lds_byte(wc * 32 + fr, fq * 8);
    Unit cur, nxt; int ui = 0;
    if (!S.next(0, cur)) return;
    unsigned vA[2][2], nvA[2][2];
#define G8_CALCVA(u, v) do { _Pragma("unroll") for (int _h = 0; _h < 2; ++_h) _Pragma("unroll") for (int _i = 0; _i < 2; ++_i) { const int _r = _h * HALF + Rr[_i]; \
        if (GATHER) { const int _tok = (_r < (u).gcount) ? ((u).gl[_r] >> 1) : 256;     v[_h][_i] = (unsigned)_tok * lda2 + (unsigned)Cc[_i] * 2u; } \
        else v[_h][_i] = (unsigned)_r * lda2 + (unsigned)Cc[_i] * 2u; } } while (0)
    G8_CALCVA(cur, vA);
#define G8_SA(b, h) (((b) * 2 + (h)) * HTB)
#define G8_SB(b, h) ((4 + (b) * 2 + (h)) * HTB)
#define G8_STAGE_A(bufoff, gbase, VV, hh) do { _Pragma("unroll") for (int _i = 0; _i < 2; ++_i) \
        __builtin_amdgcn_global_load_lds((const unsigned*)(((const char*)(gbase) + (GATHER ? (size_t)0 : (size_t)((hh) * hA))) + VV[GATHER ? (hh) : 0][_i]), (LAS unsigned*)(lds + (bufoff) + ldsw + _i * 8192), 16, 0, 0); } while (0)
#define G8_STAGE_B(bufoff, gbase, h) do { _Pragma("unroll") for (int _i = 0; _i < 2; ++_i) \
        __builtin_amdgcn_global_load_lds((const unsigned*)((const char*)(gbase) + (size_t)((h) * hB) + vB[_i]), (LAS unsigned*)(lds + (bufoff) + ldsw + _i * 8192), 16, 0, 0); } while (0)
#define G8_LDA(dst, b, h) do { _Pragma("unroll") for (int m = 0; m < 4; ++m) _Pragma("unroll") for (int k = 0; k < 2; ++k) dst[m][k] = *(const LAS bf16x8*)(lds + G8_SA(b, h) + aoff + m * 2048 + k * 1024); } while (0)
#define G8_LDB(dst, b, h) do { _Pragma("unroll") for (int n = 0; n < 2; ++n) _Pragma("unroll") for (int k = 0; k < 2; ++k) dst[n][k] = *(const LAS bf16x8*)(lds + G8_SB(b, h) + boff + n * 2048 + k * 1024); } while (0)
#define G8_MMA(ai, bj, At, Bt) do { __builtin_amdgcn_s_setprio(1); _Pragma("unroll") for (int m = 0; m < 4; ++m) _Pragma("unroll") for (int n = 0; n < 2; ++n) _Pragma("unroll") for (int k = 0; k < 2; ++k) \
        acc[ai][bj][m][n] = __builtin_amdgcn_mfma_f32_16x16x32_bf16(Bt[n][k], At[m][k], acc[ai][bj][m][n], 0, 0, 0); __builtin_amdgcn_s_setprio(0); } while (0)
#define G8_WAIT_V(n) asm volatile("s_waitcnt vmcnt(" #n ")" ::: "memory")
#define G8_WAIT_L(n) asm volatile("s_waitcnt lgkmcnt(" #n ")" ::: "memory")
#define G8_BAR __builtin_amdgcn_s_barrier()
#define G8_SCHED __builtin_amdgcn_sched_barrier(0)
    f32x4 acc[2][2][4][2];
#pragma unroll
    for (int a = 0; a < 2; ++a)
#pragma unroll
        for (int b = 0; b < 2; ++b)
#pragma unroll
            for (int m = 0; m < 4; ++m)
#pragma unroll
                for (int n = 0; n < 2; ++n) acc[a][b][m][n] = (f32x4){0.f, 0.f, 0.f, 0.f};
    bf16x8 At[4][2], B0[2][2], B1[2][2];
    const char* cA = cur.A; const char* cB = cur.B;
    G8_STAGE_B(G8_SB(0, 0), cB, 0); G8_STAGE_B(G8_SB(0, 1), cB, 1); G8_STAGE_A(G8_SA(0, 0), cA, vA, 0); G8_STAGE_A(G8_SA(0, 1), cA, vA, 1);
    if (wr == 1) G8_BAR;
    G8_WAIT_V(2); G8_BAR;
    G8_STAGE_B(G8_SB(1, 0), cB + kstep, 0); G8_STAGE_A(G8_SA(1, 0), cA + kstep, vA, 0); G8_STAGE_B(G8_SB(1, 1), cB + kstep, 1);
    G8_WAIT_V(6); G8_BAR;
    for (;;) {
        const bool has_next = S.next(ui + 1, nxt);
        const char* nA = has_next ? nxt.A : cA; const char* nB = has_next ? nxt.B : cB;
        if (GATHER && has_next) { G8_CALCVA(nxt, nvA); } else {
#pragma unroll
            for (int h = 0; h < 2; ++h)
#pragma unroll
                for (int i = 0; i < 2; ++i) nvA[h][i] = vA[h][i]; }
#pragma clang loop unroll(disable)
        for (int t = 0; t < nt; t += 2) {
            const bool last = (t == nt - 2);
            const char* a1 = cA + (size_t)(t + 1) * kstep;
            const char* a2 = last ? nA : cA + (size_t)(t + 2) * kstep; const char* b2 = last ? nB : cB + (size_t)(t + 2) * kstep;
            const char* a3 = a2 + kstep; const char* b3 = b2 + kstep;
            unsigned o2[2][2];
#pragma unroll
            for (int h = 0; h < 2; ++h)
#pragma unroll
                for (int i = 0; i < 2; ++i) o2[h][i] = (GATHER && last) ? nvA[h][i] : vA[h][i];
            G8_LDB(B0, 0, 0); G8_LDB(B1, 0, 1); G8_SCHED; G8_LDA(At, 0, 0); G8_STAGE_A(G8_SA(1, 1), a1, vA, 1);
            G8_WAIT_V(8); G8_WAIT_L(0); G8_BAR; G8_MMA(0, 0, At, B0); G8_MMA(0, 1, At, B1); G8_BAR; G8_SCHED;
            G8_LDA(At, 0, 1); G8_STAGE_B(G8_SB(0, 0), b2, 0); G8_STAGE_B(G8_SB(0, 1), b2, 1); G8_STAGE_A(G8_SA(0, 0), a2, o2, 0);
            G8_WAIT_V(8); G8_WAIT_L(0); G8_BAR; G8_MMA(1, 0, At, B0); G8_MMA(1, 1, At, B1); G8_BAR; G8_SCHED;
            G8_LDB(B0, 1, 0); G8_LDB(B1, 1, 1); G8_SCHED; G8_LDA(At, 1, 0); G8_STAGE_A(G8_SA(0, 1), a2, o2, 1);
            G8_WAIT_V(8); G8_WAIT_L(0); G8_BAR; G8_MMA(0, 0, At, B0); G8_MMA(0, 1, At, B1); G8_BAR; G8_SCHED;
            G8_LDA(At, 1, 1); G8_STAGE_B(G8_SB(1, 0), b3, 0); G8_STAGE_B(G8_SB(1, 1), b3, 1); G8_STAGE_A(G8_SA(1, 0), a3, o2, 0);
            G8_WAIT_V(8); G8_WAIT_L(0); G8_BAR; G8_MMA(1, 0, At, B0); G8_MMA(1, 1, At, B1); G8_BAR; G8_SCHED;
        }
        if (wr == 0) G8_BAR;
        E(acc, cur, wr, wc, fr, fq);
        if (!has_next) break;
#pragma unroll
        for (int a = 0; a < 2; ++a)
#pragma unroll
            for (int b = 0; b < 2; ++b)
#pragma unroll
                for (int m = 0; m < 4; ++m)
#pragma unroll
                    for (int n = 0; n < 2; ++n) acc[a][b][m][n] = (f32x4){0.f, 0.f, 0.f, 0.f};
        cur = nxt; cA = nA; cB = nB; ++ui;
#pragma unroll
        for (int h = 0; h < 2; ++h)
#pragma unroll
            for (int i = 0; i < 2; ++i) vA[h][i] = nvA[h][i];
        if (wr == 1) G8_BAR;
    }
    G8_WAIT_V(0);
    G8_BAR;
#undef G8_CALCVA
#undef G8_SA
#undef G8_SB
#undef G8_STAGE_A
#undef G8_STAGE_B
#undef G8_LDA
#undef G8_LDB
#undef G8_MMA
#undef G8_WAIT_V
#undef G8_WAIT_L
#undef G8_BAR
#undef G8_SCHED
}
}
namespace mk {
constexpr int NB = 16, S = 2048, L = 256, D = 1024, RB = L + S, NTOK = NB * RB;
constexpr int QKVW = 2304, CW = 1280, MODW = 6 * D, CAP = NTOK, NPAIR = 2 * NTOK, SORT_ROWS = NPAIR + 16 * 256;
constexpr float ALPHA = 1.41421356237309515f, EPS = 1e-5f, QSCALE = 0.125f * 1.4426950408889634f;
constexpr size_t al256(size_t x) { return (x + 255) & ~(size_t)255; }
constexpr size_t CTL_BYTES = 65536, CTL_BAR_STRIDE = 13824  , CTL_CNT = 57344  ;
constexpr size_t OFF_MOD = CTL_BYTES, SZ_MOD = (size_t)2 * 17 * MODW * 4;
constexpr size_t OFF_LAM = OFF_MOD + al256(SZ_MOD);
constexpr size_t OFF_RC = OFF_LAM + 256, OFF_RS = OFF_RC + 4096;
constexpr size_t OFF_MH = OFF_RS + 4096, SZ_MH = (size_t)2 * 2 * 4 * 64 * 64 * 4;
constexpr size_t OFF_TABL = OFF_MH + SZ_MH, SZ_TABL = (size_t)2 * S * S * 2;
constexpr size_t OFF_TABC = OFF_TABL + SZ_TABL, SZ_TABC = (size_t)2 * L * L * 2;
constexpr size_t OFF_WQKV = OFF_TABC + SZ_TABC, SZ_WQKV = (size_t)2 * QKVW * D * 2;
constexpr size_t OFF_WU = OFF_WQKV + SZ_WQKV, SZ_WU = (size_t)2 * 512 * D * 2;
constexpr size_t OFF_WOUT = OFF_WU + SZ_WU, SZ_WOUT = (size_t)2 * D * CW * 2;
constexpr size_t OFF_LIST = OFF_WOUT + SZ_WOUT, SZ_LIST = (size_t)16 * CAP * 4;
constexpr size_t OFF_WPAIR = OFF_LIST + SZ_LIST, SZ_WPAIR = (size_t)16 * CAP * 4;
constexpr size_t OFF_SELN = OFF_WPAIR + SZ_WPAIR, SZ_SELN = (size_t)NTOK * 16;
constexpr size_t OFF_RES = OFF_SELN + SZ_SELN, SZ_RES = (size_t)NTOK * D * 2;
constexpr size_t OFF_ARENA = OFF_RES + SZ_RES;
constexpr size_t SZ_H = (size_t)NTOK * D * 2, SZ_CC = (size_t)NTOK * CW * 2, SZ_QKV = (size_t)NTOK * QKVW * 2, SZ_UTL = (size_t)NB * 2 * 256 * S * 2, SZ_UTC = (size_t)NB * 2 * 256 * L * 2;
constexpr size_t SZ_ASORT = (size_t)SORT_ROWS * 512 * 2, SZ_Y2 = (size_t)NPAIR * D * 2, SZ_WGU = (size_t)16 * 1024 * 1024 * 2, SZ_WD = (size_t)16 * 1024 * 512 * 2;
constexpr size_t AR_H = 0, AR_CC = 0, AR_QKV = SZ_CC, AR_UTL = AR_QKV + SZ_QKV, AR_UTC = AR_UTL + SZ_UTL, AR_O = SZ_CC, AR_ASORT = 0, AR_Y2 = SZ_ASORT, AR_WGU = AR_Y2 + SZ_Y2, AR_WD = AR_WGU + SZ_WGU;
constexpr size_t SZ_ARENA = (AR_UTC + SZ_UTC) > (AR_WD + SZ_WD) ? (AR_UTC + SZ_UTC) : (AR_WD + SZ_WD);
constexpr size_t WS_NEED = OFF_ARENA + SZ_ARENA;
static_assert(AR_ASORT + SZ_ASORT <= AR_O, "ASORT must not overlap O/H2");
static_assert(AR_WGU >= AR_O + SZ_H, "MoE weights must not overlap O/H2");
static_assert(AR_H + SZ_H <= AR_Y2, "next layer's H must not overlap Y2");
constexpr int LDS_MISC = 131072, LDS_ROPE = LDS_MISC + 4096  , LDS_BYTES = LDS_ROPE + 8192;

struct Args {
    const float* in[20]; float* out; unsigned char* ws; int ph_lo, ph_hi, li, rep_attn; int rep[16]; int attn_var, pad2;
};
enum { I_X = 0, I_C, I_CTX, I_CCTX, I_WMOD, I_BMOD, I_WIN, I_WF, I_LAMQK, I_SUBLN, I_WOUT, I_LNAG, I_LNAB, I_LNFG, I_LNFB, I_WR, I_RB, I_WG, I_WUP, I_WDN };

template <class T> __device__ __forceinline__ T* wsp(const Args& a, size_t off) { return (T*)(a.ws + off); }

__device__ __forceinline__ float wave_sum(float v) {
    v += __builtin_bit_cast(float, __builtin_amdgcn_update_dpp(0, __builtin_bit_cast(int, v), 0xB1, 0xF, 0xF, true));
    v += __builtin_bit_cast(float, __builtin_amdgcn_update_dpp(0, __builtin_bit_cast(int, v), 0x4E, 0xF, 0xF, true));
    v += __builtin_bit_cast(float, __builtin_amdgcn_update_dpp(0, __builtin_bit_cast(int, v), 0x124, 0xF, 0xF, true));
    v += __builtin_bit_cast(float, __builtin_amdgcn_update_dpp(0, __builtin_bit_cast(int, v), 0x128, 0xF, 0xF, true));
    const int vi = __builtin_bit_cast(int, v);
    return (__builtin_bit_cast(float, __builtin_amdgcn_readlane(vi, 0)) + __builtin_bit_cast(float, __builtin_amdgcn_readlane(vi, 16))) +
           (__builtin_bit_cast(float, __builtin_amdgcn_readlane(vi, 32)) + __builtin_bit_cast(float, __builtin_amdgcn_readlane(vi, 48)));
}
struct Row { f32x4 v[4]; };
__device__ __forceinline__ Row row_load(const float* p, int lane) { Row r;
#pragma unroll
    for (int i = 0; i < 4; ++i) r.v[i] = *(const f32x4*)(p + i * 256 + lane * 4);
    return r; }
__device__ __forceinline__ void row_store(float* p, int lane, const Row& r) {
#pragma unroll
    for (int i = 0; i < 4; ++i) *(f32x4*)(p + i * 256 + lane * 4) = r.v[i]; }
__device__ __forceinline__ Row row_load_bf16(const bf16_t* p, int lane) { Row r;
#pragma unroll
    for (int i = 0; i < 4; ++i) { const u32x2 w = *(const u32x2*)(p + i * 256 + lane * 4); r.v[i] = (f32x4){bf_lo(w.x), bf_hi(w.x), bf_lo(w.y), bf_hi(w.y)}; }
    return r; }
struct RowB { u32x2 w[4]; };
__device__ __forceinline__ RowB rowb_load(const bf16_t* p, int lane) { RowB r;
#pragma unroll
    for (int i = 0; i < 4; ++i) r.w[i] = *(const u32x2*)(p + i * 256 + lane * 4);
    return r; }
__device__ __forceinline__ Row rowb_f32(const RowB& b) { Row r;
#pragma unroll
    for (int i = 0; i < 4; ++i) r.v[i] = (f32x4){bf_lo(b.w[i].x), bf_hi(b.w[i].x), bf_lo(b.w[i].y), bf_hi(b.w[i].y)};
    return r; }
__device__ __forceinline__ void row_store_bf16(bf16_t* p, int lane, const Row& r) {
#pragma unroll
    for (int i = 0; i < 4; ++i) { u32x2 w; w.x = cvtpk(r.v[i][0], r.v[i][1]); w.y = cvtpk(r.v[i][2], r.v[i][3]); *(u32x2*)(p + i * 256 + lane * 4) = w; } }
__device__ __forceinline__ void row_ln(Row& r) {
    float s = 0.f;
#pragma unroll
    for (int i = 0; i < 4; ++i) s += (r.v[i][0] + r.v[i][1]) + (r.v[i][2] + r.v[i][3]);
    const float mean = wave_sum(s) * (1.f / 1024.f);
    float q = 0.f;
#pragma unroll
    for (int i = 0; i < 4; ++i) { r.v[i] = r.v[i] - mean; q += (r.v[i][0] * r.v[i][0] + r.v[i][1] * r.v[i][1]) + (r.v[i][2] * r.v[i][2] + r.v[i][3] * r.v[i][3]); }
    const float rstd = rsqrtf(wave_sum(q) * (1.f / 1024.f) + EPS);
#pragma unroll
    for (int i = 0; i < 4; ++i) r.v[i] = r.v[i] * rstd;
}
__device__ __forceinline__ bf16_t* res_ptr(const Args& a, int row) { return wsp<bf16_t>(a, OFF_RES) + (size_t)row * D; }
__device__ __forceinline__ float* out_ptr(const Args& a, int row) { const int b = row / RB, j = row - b * RB; return a.out + ((size_t)b * S + (j - L)) * D; }
__device__ __forceinline__ const float* xin_ptr(const Args& a, int row) { const int b = row / RB, j = row - b * RB; return j < L ? a.in[I_CTX] + ((size_t)b * L + j) * D : a.in[I_X] + ((size_t)b * S + (j - L)) * D; }
__device__ __forceinline__ int thin_row(int i, bool last) { return last ? ((i >> 11) * RB + L + (i & 2047)) : i; }

__device__ __forceinline__ void tr_item(const float* __restrict__ src, size_t ld_src, bf16_t* __restrict__ dst, size_t ld_dst, int lane) {
    float v[64];
#pragma unroll
    for (int r = 0; r < 64; ++r) v[r] = __builtin_nontemporal_load(src + (size_t)r * ld_src + lane);
    bf16_t* d = dst + (size_t)lane * ld_dst;
#pragma unroll
    for (int q = 0; q < 8; ++q) { u32x4 w; w.x = cvtpk(v[q * 8 + 0], v[q * 8 + 1]); w.y = cvtpk(v[q * 8 + 2], v[q * 8 + 3]); w.z = cvtpk(v[q * 8 + 4], v[q * 8 + 5]); w.w = cvtpk(v[q * 8 + 6], v[q * 8 + 7]); *(u32x4*)(d + q * 8) = w; }
}

__device__ __forceinline__ void phase0a(const Args& a, LAS unsigned char* lds) {
    int tid = threadIdx.x; asm volatile("" : "+v"(tid));
    const int lane = tid & 63, wid = __builtin_amdgcn_readfirstlane(tid >> 6), blk = blockIdx.x, G = gridDim.x, gw = blk * 8 + wid, nw = G * 8, gt = blk * 512 + tid, ntr = G * 512;
    if (blk < 192) {
        LAS float* SIL = (LAS float*)lds; LAS float* red = (LAS float*)(lds + 69632);
        for (int i = tid; i < 17 * 1024; i += 512) { const float x = i < 16 * 1024 ? a.in[I_C][i] : a.in[I_CCTX][i - 16 * 1024]; SIL[i] = x / (1.f + __expf(-x)); }
        __syncthreads();
        for (int item = blk; item < 192; item += G) {
            const int l = item / 96, cg = item - l * 96, n = cg * 64 + lane;
            float acc[17];
#pragma unroll
            for (int r = 0; r < 17; ++r) acc[r] = 0.f;
            const float* w = a.in[I_WMOD] + (size_t)l * D * MODW;
            float wn[8];
#pragma unroll
            for (int q = 0; q < 8; ++q) wn[q] = (w + (size_t)(wid * 128 + q) * MODW)[n];
            for (int k0 = wid * 128; k0 < wid * 128 + 128; k0 += 8) {
                float wv[8];
#pragma unroll
                for (int q = 0; q < 8; ++q) wv[q] = wn[q];
                if (k0 + 8 < wid * 128 + 128) {
#pragma unroll
                    for (int q = 0; q < 8; ++q) wn[q] = __builtin_nontemporal_load(w + (size_t)(k0 + 8 + q) * MODW + n); }
#pragma unroll
                for (int r = 0; r < 17; ++r) { const f32x4 s0 = *(const LAS f32x4*)(SIL + r * 1024 + k0), s1 = *(const LAS f32x4*)(SIL + r * 1024 + k0 + 4);
                    acc[r] += ((s0[0] * wv[0] + s0[1] * wv[1]) + (s0[2] * wv[2] + s0[3] * wv[3])) + ((s1[0] * wv[4] + s1[1] * wv[5]) + (s1[2] * wv[6] + s1[3] * wv[7])); }
            }
#pragma unroll
            for (int r = 0; r < 17; ++r) red[(wid * 17 + r) * 64 + lane] = acc[r];
            __syncthreads();
            if (wid == 0) {
#pragma unroll
                for (int r = 0; r < 17; ++r) { float s = a.in[I_BMOD][(size_t)l * MODW + n];
#pragma unroll
                    for (int q = 0; q < 8; ++q) s += red[(q * 17 + r) * 64 + lane];
                    wsp<float>(a, OFF_MOD)[((size_t)l * 17 + r) * MODW + n] = s; }
            }
            __syncthreads();
        }
    }
    for (int it = gw; it < 1152 + 128 + 384; it += nw) {
        if (it < 1152) { const int l = it / 576, r = it - l * 576, kb = r / 36, nb = r - kb * 36;
            tr_item(a.in[I_WIN] + (size_t)l * D * 2560 + (size_t)(kb * 64) * 2560 + 256 + nb * 64, 2560, wsp<bf16_t>(a, OFF_WQKV) + ((size_t)l * QKVW + nb * 64) * D + kb * 64, D, lane);
        } else if (it < 1152 + 128) { const int q = it - 1152, l = q >> 6, r = q & 63, kb = r >> 2, nb = r & 3;
            tr_item(a.in[I_WIN] + (size_t)l * D * 2560 + (size_t)(kb * 64) * 2560 + nb * 64, 2560, wsp<bf16_t>(a, OFF_WU) + ((size_t)l * 256 + nb * 64) * D + kb * 64, D, lane);
        } else { const int q = it - 1280, l = q / 192, r = q - l * 192, kb = 4 + (r >> 4), nb = r & 15;
            const float* src = a.in[I_WOUT] + (size_t)l * D * D + (size_t)(kb * 64) * D + nb * 64;
            bf16_t* dst = wsp<bf16_t>(a, OFF_WOUT) + ((size_t)l * D + nb * 64) * CW;
            tr_item(src, D, dst + kb * 64 + 256, CW, lane);
        }
    }
    {
        const float nl = 0.0027621358640099515f  , nc = 0.0078125f  ;
        bf16_t* TL = wsp<bf16_t>(a, OFF_TABL); bf16_t* TC = wsp<bf16_t>(a, OFF_TABC);
        for (int it = gt; it < S * (S / 8) + L * (L / 8); it += ntr) {
            int T, tp, t0; float nn; bf16_t* base;
            if (it < S * (S / 8)) { T = S; tp = it / (S / 8); t0 = (it - tp * (S / 8)) * 8; nn = nl; base = TL; }
            else { const int q = it - S * (S / 8); T = L; tp = q / (L / 8); t0 = (q - tp * (L / 8)) * 8; nn = nc; base = TC; }
            float cv[8], sv[8];
#pragma unroll
            for (int j = 0; j < 8; ++j) { const int m = ((t0 + j) * tp) & (T - 1); const float x = 2.f * (float)m / (float)T; cv[j] = cospif(x) * nn; sv[j] = -sinpif(x) * nn; }
            u32x4 wc, wsn; wc.x = cvtpk(cv[0], cv[1]); wc.y = cvtpk(cv[2], cv[3]); wc.z = cvtpk(cv[4], cv[5]); wc.w = cvtpk(cv[6], cv[7]);
            wsn.x = cvtpk(sv[0], sv[1]); wsn.y = cvtpk(sv[2], sv[3]); wsn.z = cvtpk(sv[4], sv[5]); wsn.w = cvtpk(sv[6], sv[7]);
            *(u32x4*)(base + (size_t)tp * T + t0) = wc; *(u32x4*)(base + (size_t)T * T + (size_t)tp * T + t0) = wsn;
        }
    }
    for (int i = gt; i < 65536 + 1024 + 2; i += ntr) {
        if (i < 65536) { const int d = i & 63, c = (i >> 6) & 63, g = (i >> 12) & 3, half = (i >> 14) & 1, l = i >> 15;
            const float* wf = a.in[I_WF] + ((size_t)(l * 4 + g) * 64) * 64 + d; float s = 0.f;
            for (int cp = 0; cp < 64; ++cp) { const int m = (c * cp) & 63; const float x = (float)m * (1.f / 32.f); s += (half ? sinpif(x) : cospif(x)) * wf[cp * 64]; }
            wsp<float>(a, OFF_MH)[i] = s;
        } else if (i < 65536 + 1024) { const int q = i - 65536, pos = q >> 4, f = q & 15; const float ang = (float)pos * powf(10000.f, -(float)f / 16.f);
            wsp<float>(a, OFF_RC)[q] = cosf(ang); wsp<float>(a, OFF_RS)[q] = sinf(ang);
        } else { const int l = i - 65536 - 1024; const float* q = a.in[I_LAMQK] + l * 256; float s1 = 0.f, s2 = 0.f;
            for (int k = 0; k < 64; ++k) { s1 += q[k] * q[64 + k]; s2 += q[128 + k] * q[192 + k]; }
            wsp<float>(a, OFF_LAM)[l] = expf(s1) - expf(s2) + (0.8f - 0.6f * expf(-0.3f * (float)l)); }
    }
}

__device__ __forceinline__ void h_from_row(const Args& a, Row& r, int row, int l, int sh_off, int sc_off, int lane) {
    row_ln(r);
    const int b = row / RB, j = row - b * RB;
    const float* mrow = wsp<float>(a, OFF_MOD) + ((size_t)l * 17 + (j < L ? 16 : b)) * MODW;
    const Row sh = row_load(mrow + sh_off, lane), sc = row_load(mrow + sc_off, lane);
#pragma unroll
    for (int i = 0; i < 4; ++i) r.v[i] = r.v[i] * (1.f + sc.v[i]) + sh.v[i];
}
__device__ __forceinline__ void h_from_row2(Row& r, const Row& sh, const Row& sc) {
    row_ln(r);
#pragma unroll
    for (int i = 0; i < 4; ++i) r.v[i] = r.v[i] * (1.f + sc.v[i]) + sh.v[i];
}
__device__ __forceinline__ const float* mod_row(const Args& a, int l, int row) { const int b = row / RB, j = row - b * RB; return wsp<float>(a, OFF_MOD) + ((size_t)l * 17 + (j < L ? 16 : b)) * MODW; }
__device__ __forceinline__ void phase0b(const Args& a) {
    int tid = threadIdx.x; asm volatile("" : "+v"(tid));
    const int lane = tid & 63, wid = __builtin_amdgcn_readfirstlane(tid >> 6), gw = blockIdx.x * 8 + wid, nw = gridDim.x * 8;
    {
        Row xA = {}, xB = {};
        auto proc = [&](Row& xr, const int row) __attribute__((always_inline)) {
            const float* mrow = mod_row(a, 0, row);
            const Row sh = row_load(mrow + 0, lane), sc = row_load(mrow + 1024, lane);
            Row r = xr;
            if (row + 2 * nw < NTOK) xr = row_load(xin_ptr(a, row + 2 * nw), lane);
            h_from_row2(r, sh, sc);
            row_store_bf16(wsp<bf16_t>(a, OFF_ARENA + AR_H) + (size_t)row * D, lane, r);
        };
        int row = gw;
        if (row < NTOK) xA = row_load(xin_ptr(a, row), lane);
        if (row + nw < NTOK) xB = row_load(xin_ptr(a, row + nw), lane);
        for (; row < NTOK; row += 2 * nw) { proc(xA, row); if (row + nw < NTOK) proc(xB, row + nw); }
    }
    for (int it = gw; it < 1024; it += nw) {
        const int l = it >> 9, half = (it >> 8) & 1, g = (it >> 6) & 3, nb = (it >> 2) & 15, cb = it & 3, n = nb * 64 + lane;
        const float* wcol = a.in[I_WOUT] + (size_t)l * D * D + (size_t)(g * 64) * D + n;
        float wv[64];
#pragma unroll
        for (int d = 0; d < 64; ++d) wv[d] = (a.in[I_WOUT] + (size_t)l * D * D + (size_t)(g * 64 + d) * D)[n];
        const float* mh = wsp<float>(a, OFF_MH) + ((size_t)((l * 2 + half) * 4 + g) * 64 + cb * 16) * 64;
        float acc[16];
#pragma unroll
        for (int c = 0; c < 16; ++c) { float s_ = 0.f;
#pragma unroll
            for (int d4 = 0; d4 < 16; ++d4) { const f32x4 m = *(const f32x4*)(mh + c * 64 + d4 * 4); s_ += (m[0] * wv[d4 * 4 + 0] + m[1] * wv[d4 * 4 + 1]) + (m[2] * wv[d4 * 4 + 2] + m[3] * wv[d4 * 4 + 3]); }
            acc[c] = s_; }
        (void)wcol;
        bf16_t* dst = wsp<bf16_t>(a, OFF_WOUT) + ((size_t)l * D + n) * CW + half * 256 + g * 64 + cb * 16;
        u32x4 w0, w1; w0.x = cvtpk(acc[0], acc[1]); w0.y = cvtpk(acc[2], acc[3]); w0.z = cvtpk(acc[4], acc[5]); w0.w = cvtpk(acc[6], acc[7]);
        w1.x = cvtpk(acc[8], acc[9]); w1.y = cvtpk(acc[10], acc[11]); w1.z = cvtpk(acc[12], acc[13]); w1.w = cvtpk(acc[14], acc[15]);
        *(u32x4*)dst = w0; *(u32x4*)(dst + 8) = w1;
    }
}

struct SchedInproj {
    const char* H; const char* WQ; const char* WUp; int G, c; bool last;
    __device__ __forceinline__ bool next(int i, g8::Unit& u) const {
        const int Lu = i * G + c, nq = last ? 1248 : 1296, nu = last ? 128 : 144;
        u.gl = nullptr; u.gcount = 0;
        if (Lu < nq) { int pm, pn;
            if (!last) { const int grp = Lu / 72, w = Lu - grp * 72; pm = grp * 8 + (w & 7); pn = w >> 3; }
            else if (Lu < 1152) { const int grp = Lu / 72, w = Lu - grp * 72, q = grp * 8 + (w & 7); pm = (q >> 3) * 9 + 1 + (q & 7); pn = w >> 3; }
            else { const int q = Lu - 1152; pm = (q & 15) * 9; pn = 3 + (q >> 4); }
            u.A = H + (size_t)pm * 256 * 2048; u.B = WQ + (size_t)pn * 256 * 2048; u.kind = 0; u.p0 = pm; u.p1 = pn; return true; }
        const int q = Lu - nq;
        if (q < nu) { const int tt = q, pmT = last ? ((tt >> 3) * 9 + 1 + (tt & 7)) : tt;
            u.A = WUp; u.B = H + (size_t)pmT * 256 * 2048; u.kind = 1; u.p0 = 0; u.p1 = pmT; return true; }
        return false;
    }
};
struct EpiInproj {
    bf16_t* QKV; bf16_t* UTL; bf16_t* UTC; const LAS float* RC; const LAS float* RS;
    __device__ __forceinline__ void operator()(const f32x4 (&acc)[2][2][4][2], const g8::Unit& u, int wr, int wc, int fr, int fq) const {
        if (u.kind == 0) {
            const int pm = u.p0, pn = u.p1, b = pm / 9, jt = pm - b * 9;
            const bool rope = (jt != 0) && (pn < 6);
            const float qs = pn < 3 ? QSCALE : 1.f, sgn = (fq & 2) ? 1.f : -1.f;
#pragma unroll
            for (int ai = 0; ai < 2; ++ai)
#pragma unroll
                for (int m = 0; m < 4; ++m) {
                    const int r = 128 * ai + 64 * wr + 16 * m + fr;
                    bf16_t* rowp = QKV + (size_t)(pm * 256 + r) * QKVW + pn * 256 + 32 * wc + 8 * fq;
                    f32x4 c0 = {1.f, 1.f, 1.f, 1.f}, c1 = c0, s0 = {0.f, 0.f, 0.f, 0.f}, s1 = s0;
                    if (rope) { const int t = (jt - 1) * 256 + r, pos = (wc & 1) ? (t & 63) : (t >> 6); const LAS float* cp = RC + pos * 16 + 8 * (fq & 1); const LAS float* sp = RS + pos * 16 + 8 * (fq & 1);
                        c0 = *(const LAS f32x4*)cp; c1 = *(const LAS f32x4*)(cp + 4); s0 = *(const LAS f32x4*)sp; s1 = *(const LAS f32x4*)(sp + 4); }
#pragma unroll
                    for (int bj = 0; bj < 2; ++bj) {
                        f32x4 v0 = acc[ai][bj][m][0], v1 = acc[ai][bj][m][1];
                        if (rope) { f32x4 p0, p1;
#pragma unroll
                            for (int j = 0; j < 4; ++j) {
                                auto ra = __builtin_amdgcn_permlane32_swap(__float_as_uint(v0[j]), __float_as_uint(v0[j]), false, false);
                                auto rb = __builtin_amdgcn_permlane32_swap(__float_as_uint(v1[j]), __float_as_uint(v1[j]), false, false);
                                p0[j] = __uint_as_float((fq & 2) ? ra[0] : ra[1]); p1[j] = __uint_as_float((fq & 2) ? rb[0] : rb[1]); }
                            v0 = v0 * c0 + (p0 * s0) * sgn; v1 = v1 * c1 + (p1 * s1) * sgn; }
                        v0 = v0 * qs; v1 = v1 * qs;
                        u32x4 w; w.x = cvtpk(v0[0], v0[1]); w.y = cvtpk(v0[2], v0[3]); w.z = cvtpk(v1[0], v1[1]); w.w = cvtpk(v1[2], v1[3]);
                        *(u32x4*)(rowp + bj * 128) = w; }
                }
        } else {
            const int pmT = u.p1, b = pmT / 9, jt = pmT - b * 9;
#pragma unroll
            for (int ai = 0; ai < 2; ++ai)
#pragma unroll
                for (int m = 0; m < 4; ++m) {
                    const int r = 128 * ai + 64 * wr + 16 * m + fr, col = 32 * wc + 8 * fq;
                    bf16_t* rowp = (jt == 0) ? UTC + ((size_t)(b * 256 + r)) * L + col : UTL + ((size_t)(b * 256 + r)) * S + (jt - 1) * 256 + col;
#pragma unroll
                    for (int bj = 0; bj < 2; ++bj) { const f32x4 v0 = acc[ai][bj][m][0], v1 = acc[ai][bj][m][1];
                        u32x4 w; w.x = cvtpk(v0[0], v0[1]); w.y = cvtpk(v0[2], v0[3]); w.z = cvtpk(v1[0], v1[1]); w.w = cvtpk(v1[2], v1[3]);
                        *(u32x4*)(rowp + bj * 128) = w; }
                }
        }
    }
};
struct EpiStore {
    bf16_t* dst; int ld;
    __device__ __forceinline__ void operator()(const f32x4 (&acc)[2][2][4][2], const g8::Unit& u, int wr, int wc, int fr, int fq) const {
#pragma unroll
        for (int ai = 0; ai < 2; ++ai)
#pragma unroll
            for (int m = 0; m < 4; ++m) { const int r = 128 * ai + 64 * wr + 16 * m + fr;
                bf16_t* rowp = dst + (size_t)(u.p0 + r) * ld + u.p1 + 32 * wc + 8 * fq;
#pragma unroll
                for (int bj = 0; bj < 2; ++bj) { const f32x4 v0 = acc[ai][bj][m][0], v1 = acc[ai][bj][m][1];
                    u32x4 w; w.x = cvtpk(v0[0], v0[1]); w.y = cvtpk(v0[2], v0[3]); w.z = cvtpk(v1[0], v1[1]); w.w = cvtpk(v1[2], v1[3]);
                    *(u32x4*)(rowp + bj * 128) = w; } }
    }
};
struct SchedFourier {
    const char* TAB; const char* UT; int G, c; bool ctx;
    __device__ __forceinline__ bool next(int i, g8::Unit& u) const {
        const int Lu = i * G + c; u.gl = nullptr; u.gcount = 0; u.kind = 2;
        if (!ctx) { if (Lu >= 256) return false; const int pm = Lu & 7, half = (Lu >> 3) & 1, b = Lu >> 4;
            u.A = TAB + ((size_t)half * S + pm * 256) * S * 2; u.B = UT + ((size_t)b * 256) * S * 2; u.p0 = b * RB + L + pm * 256; u.p1 = half * 256; return true; }
        if (Lu >= 32) return false; { const int half = Lu & 1, b = Lu >> 1;
            u.A = TAB + ((size_t)half * L) * L * 2; u.B = UT + ((size_t)b * 256) * L * 2; u.p0 = b * RB; u.p1 = half * 256; return true; }
    }
};
struct SchedOutproj {
    const char* CC; const char* W; int G, c; bool last;
    __device__ __forceinline__ bool next(int i, g8::Unit& u) const {
        const int Lu = i * G + c, n = last ? 512 : 576; if (Lu >= n) return false;
        const int grp = Lu >> 5, w = Lu & 31, q = grp * 8 + (w & 7), pn = w >> 3, pm = last ? ((q >> 3) * 9 + 1 + (q & 7)) : q;
        u.gl = nullptr; u.gcount = 0; u.kind = 2; u.A = CC + (size_t)pm * 256 * CW * 2; u.B = W + (size_t)pn * 256 * CW * 2; u.p0 = pm * 256; u.p1 = pn * 256; return true;
    }
};
struct SchedMoe {
    const LAS int* pre; const LAS int* cnt; const int* LIST; const char* Abase; const char* Wbase; size_t wstride; unsigned arow2, wtile2; int G, c; bool gather;
    __device__ __forceinline__ bool next(int i, g8::Unit& u) const {
        const int Lu = i * G + c, rt = Lu >> 2, pn = Lu & 3; if (rt >= pre[16]) return false;
        int e = 0;
#pragma unroll
        for (int q = 1; q < 16; ++q) e += (rt >= pre[q]) ? 1 : 0;
        const int lt = rt - pre[e], rem = cnt[e] - lt * 256;
        u.gl = LIST + (size_t)e * CAP + lt * 256; u.gcount = rem < 256 ? rem : 256; u.kind = 3; u.p0 = rt; u.p1 = pn;
        u.A = gather ? Abase : Abase + (size_t)rt * 256 * arow2; u.B = Wbase + (size_t)e * wstride + (size_t)pn * wtile2; return true;
    }
};
struct EpiGateUp {
    bf16_t* ASORT;
    __device__ __forceinline__ void operator()(const f32x4 (&acc)[2][2][4][2], const g8::Unit& u, int wr, int wc, int fr, int fq) const {
#pragma unroll
        for (int ai = 0; ai < 2; ++ai)
#pragma unroll
            for (int m = 0; m < 4; ++m) { const int r = 128 * ai + 64 * wr + 16 * m + fr;
                float o[8];
#pragma unroll
                for (int n = 0; n < 2; ++n)
#pragma unroll
                    for (int j = 0; j < 4; ++j) { const float g = acc[ai][0][m][n][j], up = acc[ai][1][m][n][j]; o[n * 4 + j] = g * __builtin_amdgcn_rcpf(1.f + __expf(-g)) * up; }
                u32x4 w; w.x = cvtpk(o[0], o[1]); w.y = cvtpk(o[2], o[3]); w.z = cvtpk(o[4], o[5]); w.w = cvtpk(o[6], o[7]);
                *(u32x4*)(ASORT + (size_t)(u.p0 * 256 + r) * 512 + u.p1 * 128 + 32 * wc + 8 * fq) = w; }
    }
};
struct EpiDown {
    bf16_t* Y2; const int* LIST; const float* WLIST;
    __device__ __forceinline__ void operator()(const f32x4 (&acc)[2][2][4][2], const g8::Unit& u, int wr, int wc, int fr, int fq) const {
        const float* wl = WLIST + (u.gl - LIST);
#pragma unroll
        for (int ai = 0; ai < 2; ++ai) {
            int pr[4]; float wg[4];
#pragma unroll
            for (int m = 0; m < 4; ++m) { const int r = 128 * ai + 64 * wr + 16 * m + fr; const bool ok = r < u.gcount; pr[m] = ok ? u.gl[r] : -1; wg[m] = ok ? wl[r] : 0.f; }
#pragma unroll
            for (int m = 0; m < 4; ++m) { const int pair = pr[m]; const float wgt = wg[m];
                if (pair >= 0) {
                    bf16_t* rowp = Y2 + (size_t)pair * D + u.p1 * 256 + 32 * wc + 8 * fq;
#pragma unroll
                    for (int bj = 0; bj < 2; ++bj) { const f32x4 v0 = acc[ai][bj][m][0] * wgt, v1 = acc[ai][bj][m][1] * wgt;
                        u32x4 w; w.x = cvtpk(v0[0], v0[1]); w.y = cvtpk(v0[2], v0[3]); w.z = cvtpk(v1[0], v1[1]); w.w = cvtpk(v1[2], v1[3]);
                        *(u32x4*)(rowp + bj * 128) = w; } } }
        }
    }
};

template <int N> struct IC { static constexpr int value = N; };
struct AttnUnit { int q_row0, key_row0, ntiles, h; };
__device__ __forceinline__ bool attn_next(int i, int v, int G, bool last, AttnUnit& u) {
    const int nl = (1536 - v + G - 1) / G;
    if (i < nl) { const int id = v + i * G, bh = id >> 4, qt = id & 15, b = bh / 6; u.h = bh - b * 6; u.q_row0 = b * RB + L + qt * 128; u.key_row0 = b * RB; u.ntiles = 36; return true; }
    if (last) return false;
    const int id = v + (i - nl) * G; if (id >= 192) return false;
    { const int bh = id >> 1, qt = id & 1, b = bh / 6; u.h = bh - b * 6; u.q_row0 = b * RB + qt * 128; u.key_row0 = b * RB; u.ntiles = 4; return true; }
}
#if defined(MK_ATTN_PROBE)
#define AT_VAR_DECL const int var = var_
#else
#define AT_VAR_DECL constexpr int var = 0
#endif
__device__ __forceinline__ void phase_attn(const Args& a, LAS unsigned char* lds, int l, const int var_) {
    AT_VAR_DECL;
    const bool last = (l == 1);
    const int c = blockIdx.x, G = gridDim.x, v = (c & 7) * (G >> 3) + (c >> 3);
    const bf16_t* __restrict__ QKV = wsp<bf16_t>(a, OFF_ARENA + AR_QKV); bf16_t* __restrict__ CC = wsp<bf16_t>(a, OFF_ARENA + AR_CC);
    const float lam = wsp<float>(a, OFF_LAM)[l], oml = 1.f - (0.8f - 0.6f * expf(-0.3f * (float)l));
    int tid = threadIdx.x; asm volatile("" : "+v"(tid));
    if (tid < 128) ((LAS float*)(lds + LDS_MISC + 3072))[tid] = a.in[I_SUBLN][l * 128 + tid];
    __syncthreads();
    const int lane = tid & 63, wid = __builtin_amdgcn_readfirstlane(tid >> 6);
    const int qb = wid & 3, sub = wid >> 2, r32 = lane & 31, hi = lane >> 5, ki = wid & 3;
    unsigned koffb[2], voffb[2];
#pragma unroll
    for (int e = 0; e < 2; ++e) {
        const int kk = 8 * (2 * ki + e) + (lane >> 3); koffb[e] = (unsigned)(kk * (QKVW * 2) + (768 + sub * 64) * 2 + (((lane & 7) ^ ((kk >> 1) & 7)) << 4));
        const int vk = 4 * (2 * wid + e) + (lane >> 4); voffb[e] = (unsigned)(vk * (QKVW * 2) + 1536 * 2 + (((lane & 15) ^ (((lane >> 4) << 2) | e)) << 4));
    }
    const size_t tstep = (size_t)64 * QKVW * 2;
    const unsigned kd = (unsigned)(sub * 8192 + (2 * ki) * 1024), vd = (unsigned)(16384 + (2 * wid) * 1024);
    int kaddr[4], vaddr[4];
    { const int i16 = lane & 15, q = i16 >> 2, pp = i16 & 3, g = (lane >> 4) & 1;
#pragma unroll
      for (int j = 0; j < 4; ++j) { kaddr[j] = sub * 8192 + r32 * 128 + (((2 * j + hi) ^ ((r32 >> 1) & 7)) << 4);
          vaddr[j] = 16384 + (4 * hi + q) * 256 + ((((j ^ q) << 2) | ((2 * g + (pp >> 1)) ^ hi)) << 4) + 8 * (pp & 1); } }
#define AT_GLDS(g, l) do { unsigned keep_; const void* g_ = (const void*)(g); const unsigned l_ = (unsigned)__builtin_amdgcn_readfirstlane((int)(unsigned)(size_t)(l)); \
        asm volatile("s_mov_b32 %0, m0\n\ts_mov_b32 m0, %2\n\ts_nop 0\n\tglobal_load_lds_dwordx4 %1, off\n\ts_mov_b32 m0, %0" : "=&s"(keep_) : "v"(g_), "s"(l_) : "memory"); } while (0)
#define AT_DMA(tb0, hK, hV, t, st) do { if (var & 1) break; const char* tb_ = (tb0) + (size_t)(t) * tstep; LAS unsigned char* sb_ = lds + (st) * 32768; \
        AT_GLDS(tb_ + (hK) + koffb[0], sb_ + kd); AT_GLDS(tb_ + (hK) + koffb[1], sb_ + kd + 1024); AT_GLDS(tb_ + (hV) + voffb[0], sb_ + vd); AT_GLDS(tb_ + (hV) + voffb[1], sb_ + vd + 1024); } while (0)
#define AT_EVEN() do { if (!(var & 16)) asm volatile("s_waitcnt vmcnt(0) lgkmcnt(0)\n\ts_barrier" ::: "memory"); } while (0)
#define AT_ODD() do { if (!(var & 16)) asm volatile("s_waitcnt lgkmcnt(0)\n\ts_barrier" ::: "memory"); } while (0)
#define AT_VRD(dst, d) do { _Pragma("unroll") for (int ks = 0; ks < 4; ++ks) { \
            const s16x4 lo_ = __builtin_bit_cast(s16x4, __builtin_amdgcn_ds_read_tr16_b64_v4i16((LAS s16x4*)(sb + vaddr[d] + ks * 4096))); \
            const s16x4 hh_ = __builtin_bit_cast(s16x4, __builtin_amdgcn_ds_read_tr16_b64_v4i16((LAS s16x4*)(sb + vaddr[d] + ks * 4096 + 2048))); \
            dst[ks] = (bf16x8){lo_[0], lo_[1], lo_[2], lo_[3], hh_[0], hh_[1], hh_[2], hh_[3]}; } } while (0)
#define AT_MMA4(d, src) do { _Pragma("unroll") for (int ks = 0; ks < 4; ++ks) oT[d] = __builtin_amdgcn_mfma_f32_32x32x16_bf16(src[ks], __builtin_bit_cast(bf16x8, pw[ks]), oT[d], 0, 0, 0); } while (0)
#define AT_SB() __builtin_amdgcn_sched_barrier(0)
    constexpr float THR = 6.f;
    AttnUnit u, un;
    if (!attn_next(0, v, G, last, u)) return;
    if (wid >= 4) __builtin_amdgcn_s_setprio(1);
    const char* tile0 = (const char*)(QKV + (size_t)u.key_row0 * QKVW); unsigned hK = (unsigned)(u.h * 256), hV = (unsigned)(u.h * 256);
    bf16x8 qr[4];
    { const bf16_t* qp = QKV + (size_t)(u.q_row0 + qb * 32 + r32) * QKVW + (2 * u.h + sub) * 64 + hi * 8;
#pragma unroll
      for (int d0 = 0; d0 < 4; ++d0) qr[d0] = *(const bf16x8*)(qp + d0 * 16); }
    AT_DMA(tile0, hK, hV, 0, 0);
    for (int ui = 0;; ++ui) {
        const int ntiles = u.ntiles;
        f32x16 oT[4];
#pragma unroll
        for (int d = 0; d < 4; ++d) oT[d] = (f32x16){};
        f32x16 negm = (f32x16){};
        float m_run = 0.f, l_run = 0.f;
        u32x4 pw[4];
        if (sub == 1) { AT_EVEN(); if (ntiles > 1) AT_DMA(tile0, hK, hV, 1, 1); }
        auto tile = [&](const int t, auto st_, auto st1_, auto st2_) __attribute__((always_inline)) {
            constexpr int ST = decltype(st_)::value, ST1 = decltype(st1_)::value, ST2 = decltype(st2_)::value;
            if (sub == 0) AT_EVEN(); else AT_ODD();
            LAS const unsigned char* sb = lds + ST * 32768;
            f32x16 p0 = negm, p1 = negm;
            bf16x8 va[4], vb[4];
            if (!(var & 2)) { bf16x8 kf[4];
#pragma unroll
              for (int j = 0; j < 2; ++j) { kf[2 * j] = *(LAS const bf16x8*)(sb + kaddr[j]); kf[2 * j + 1] = *(LAS const bf16x8*)(sb + kaddr[j] + 4096); }
              AT_SB();
              p0 = __builtin_amdgcn_mfma_f32_32x32x16_bf16(kf[0], qr[0], negm, 0, 0, 0); p1 = __builtin_amdgcn_mfma_f32_32x32x16_bf16(kf[1], qr[0], negm, 0, 0, 0);
              p0 = __builtin_amdgcn_mfma_f32_32x32x16_bf16(kf[2], qr[1], p0, 0, 0, 0); p1 = __builtin_amdgcn_mfma_f32_32x32x16_bf16(kf[3], qr[1], p1, 0, 0, 0);
              AT_SB();
#pragma unroll
              for (int j = 2; j < 4; ++j) { kf[2 * (j - 2)] = *(LAS const bf16x8*)(sb + kaddr[j]); kf[2 * (j - 2) + 1] = *(LAS const bf16x8*)(sb + kaddr[j] + 4096); }
              AT_SB();
              p0 = __builtin_amdgcn_mfma_f32_32x32x16_bf16(kf[0], qr[2], p0, 0, 0, 0); p1 = __builtin_amdgcn_mfma_f32_32x32x16_bf16(kf[1], qr[2], p1, 0, 0, 0);
              p0 = __builtin_amdgcn_mfma_f32_32x32x16_bf16(kf[2], qr[3], p0, 0, 0, 0); p1 = __builtin_amdgcn_mfma_f32_32x32x16_bf16(kf[3], qr[3], p1, 0, 0, 0);
            }
            if (sub == 0 && t + 1 < ntiles) AT_DMA(tile0, hK, hV, t + 1, ST1);
            if (!(var & 8)) { AT_VRD(va, 0); }
            AT_SB();
            if (!(var & 4)) {
            float ta = __builtin_fmaxf(__builtin_fmaxf(p0[0], p0[1]), p1[0]), tb = __builtin_fmaxf(__builtin_fmaxf(p0[2], p0[3]), p1[1]);
            ta = __builtin_fmaxf(__builtin_fmaxf(ta, p1[2]), p1[3]);
#pragma unroll
            for (int r = 4; r < 16; r += 4) { ta = __builtin_fmaxf(__builtin_fmaxf(ta, p0[r]), p0[r + 1]); tb = __builtin_fmaxf(__builtin_fmaxf(tb, p0[r + 2]), p0[r + 3]);
                ta = __builtin_fmaxf(__builtin_fmaxf(ta, p1[r]), p1[r + 1]); tb = __builtin_fmaxf(__builtin_fmaxf(tb, p1[r + 2]), p1[r + 3]); }
            float tm = __builtin_fmaxf(ta, tb);
            { auto rr = __builtin_amdgcn_permlane32_swap(__float_as_uint(tm), __float_as_uint(tm), false, false); tm = __builtin_fmaxf(__uint_as_float(rr[0]), __uint_as_float(rr[1])); }
            if (t == 0 || __any(tm > THR)) {
                const float dl = (t == 0) ? tm : __builtin_fmaxf(tm, 0.f);
                const float alpha = __builtin_amdgcn_exp2f(-dl);
                m_run += dl; l_run *= alpha;
#pragma unroll
                for (int d = 0; d < 4; ++d)
#pragma unroll
                    for (int r = 0; r < 16; ++r) oT[d][r] *= alpha;
#pragma unroll
                for (int r = 0; r < 16; ++r) { p0[r] -= dl; p1[r] -= dl; negm[r] = -m_run; }
            }
#pragma unroll
            for (int r = 0; r < 16; ++r) { p0[r] = __builtin_amdgcn_exp2f(p0[r]); p1[r] = __builtin_amdgcn_exp2f(p1[r]); }
#pragma unroll
            for (int q = 0; q < 4; ++q) { pw[0][q] = cvtpk(p0[2 * q], p0[2 * q + 1]); pw[1][q] = cvtpk(p0[8 + 2 * q], p0[8 + 2 * q + 1]); pw[2][q] = cvtpk(p1[2 * q], p1[2 * q + 1]); pw[3][q] = cvtpk(p1[8 + 2 * q], p1[8 + 2 * q + 1]); }
            } else {
#pragma unroll
                for (int q = 0; q < 4; ++q) { pw[0][q] = __float_as_uint(p0[q]); pw[1][q] = __float_as_uint(p0[4 + q]); pw[2][q] = __float_as_uint(p1[q]); pw[3][q] = __float_as_uint(p1[4 + q]); }
            }
            asm volatile("" : "+v"(pw[0]), "+v"(pw[1]), "+v"(pw[2]), "+v"(pw[3]));
            AT_SB();
            if (sub == 0) AT_ODD(); else AT_EVEN();
            AT_SB();
            if (!(var & 8)) {
                AT_VRD(vb, 1); AT_SB();
                AT_MMA4(0, va); AT_SB();
                if (sub == 1 && t + 2 < ntiles) AT_DMA(tile0, hK, hV, t + 2, ST2);
                AT_VRD(va, 2); AT_SB();
                AT_MMA4(1, vb);
                { float ls = 0.f;
#pragma unroll
                  for (int r = 0; r < 16; ++r) ls += p0[r];
                  l_run += ls; }
                AT_SB();
                AT_VRD(vb, 3); AT_SB();
                AT_MMA4(2, va);
                { float ls = 0.f;
#pragma unroll
                  for (int r = 0; r < 16; ++r) ls += p1[r];
                  l_run += ls; }
                AT_SB();
                AT_MMA4(3, vb); AT_SB();
            }
        };
        for (int t = 0; t < ntiles; t += 3) {
            tile(t, IC<0>{}, IC<1>{}, IC<2>{});
            if (t + 1 < ntiles) tile(t + 1, IC<1>{}, IC<2>{}, IC<0>{});
            if (t + 2 < ntiles) tile(t + 2, IC<2>{}, IC<0>{}, IC<1>{});
        }
        if (sub == 0) AT_EVEN();
        AT_ODD();
        int lane_e = lane; asm volatile("" : "+v"(lane_e));
        const int r32e = lane_e & 31, hie = lane_e >> 5;
        const bool has_next = attn_next(ui + 1, v, G, last, un);
        bf16x8 qn[4];
        const char* tile0n = tile0; unsigned hn = hK;
        if (has_next) { tile0n = (const char*)(QKV + (size_t)un.key_row0 * QKVW); hn = (unsigned)(un.h * 256);
            AT_DMA(tile0n, hn, hn, 0, 0);
            const bf16_t* qp = QKV + (size_t)(un.q_row0 + qb * 32 + r32e) * QKVW + (2 * un.h + sub) * 64 + hie * 8;
#pragma unroll
            for (int d0 = 0; d0 < 4; ++d0) qn[d0] = *(const bf16x8*)(qp + d0 * 16); }
        { auto rr = __builtin_amdgcn_permlane32_swap(__float_as_uint(l_run), __float_as_uint(l_run), false, false); l_run = __uint_as_float(rr[0]) + __uint_as_float(rr[1]); }
        const float inv = 1.f / l_run;
        LAS float* xch = (LAS float*)(lds + 65536 + qb * 16384);
        if (sub == 1) {
#pragma unroll
            for (int d = 0; d < 4; ++d)
#pragma unroll
                for (int r = 0; r < 16; ++r) xch[(d * 16 + r) * 64 + lane_e] = oT[d][r] * inv;
        }
        asm volatile("s_waitcnt lgkmcnt(0)\n\ts_barrier" ::: "memory");
        if (sub == 0) {
            float ss = 0.f;
#pragma unroll
            for (int d = 0; d < 4; ++d)
#pragma unroll
                for (int r = 0; r < 16; ++r) { const float o = oT[d][r] * inv - lam * xch[(d * 16 + r) * 64 + lane_e]; oT[d][r] = o; ss += o * o; }
            { auto rr = __builtin_amdgcn_permlane32_swap(__float_as_uint(ss), __float_as_uint(ss), false, false); ss = __uint_as_float(rr[0]) + __uint_as_float(rr[1]); }
            const float rms = rsqrtf(ss * (1.f / 128.f) + EPS) * oml;
            const LAS float* gl = (const LAS float*)(lds + LDS_MISC + 3072);
            LAS unsigned char* stg = (LAS unsigned char*)xch;
#pragma unroll
            for (int d = 0; d < 4; ++d)
#pragma unroll
                for (int rq = 0; rq < 4; ++rq) { const int dd = d * 32 + 8 * rq + 4 * hie;
                    const f32x4 g = *(const LAS f32x4*)(gl + dd);
                    u32x2 w; w.x = cvtpk(oT[d][rq * 4 + 0] * rms * g[0], oT[d][rq * 4 + 1] * rms * g[1]); w.y = cvtpk(oT[d][rq * 4 + 2] * rms * g[2], oT[d][rq * 4 + 3] * rms * g[3]);
                    *(LAS u32x2*)(stg + r32e * 272 + dd * 2) = w; }
            bf16_t* orow = CC + (size_t)(u.q_row0 + qb * 32) * CW + 512 + u.h * 128;
#pragma unroll
            for (int it = 0; it < 8; ++it) { const int row = it * 4 + (lane_e >> 4), ch = lane_e & 15;
                const u32x4 vv = *(const LAS u32x4*)(stg + row * 272 + ch * 16);
                *(u32x4*)(orow + (size_t)row * CW + ch * 8) = vv; }
        }
        asm volatile("s_waitcnt lgkmcnt(0)\n\ts_barrier" ::: "memory");
        if (!has_next) break;
        u = un; tile0 = tile0n; hK = hn; hV = hn;
#pragma unroll
        for (int d0 = 0; d0 < 4; ++d0) qr[d0] = qn[d0];
    }
    __builtin_amdgcn_s_setprio(0);
#undef AT_GLDS
#undef AT_DMA
#undef AT_EVEN
#undef AT_ODD
#undef AT_VRD
#undef AT_MMA4
#undef AT_SB
}

__device__ __forceinline__ void moe_weight_copies(const Args& a, int l, int gw, int nw, int lane) {
    bf16_t* WGU = wsp<bf16_t>(a, OFF_ARENA + AR_WGU); bf16_t* WD = wsp<bf16_t>(a, OFF_ARENA + AR_WD);
    for (int it = gw; it < 6144; it += nw) {
        if (it < 4096) { const int gu = it >> 11, q = it & 2047, e = q >> 7, r = q & 127, kb = r >> 3, nb = r & 7;
            const float* src = (gu ? a.in[I_WUP] : a.in[I_WG]) + ((size_t)(l * 16 + e) * 1024 + kb * 64) * 512 + nb * 64;
            tr_item(src, 512, WGU + ((size_t)e * 1024 + (nb >> 1) * 256 + gu * 128 + (nb & 1) * 64) * 1024 + kb * 64, 1024, lane);
        } else { const int q = it - 4096, e = q >> 7, r = q & 127, kb = r >> 4, nb = r & 15;
            const float* src = a.in[I_WDN] + ((size_t)(l * 16 + e) * 512 + kb * 64) * 1024 + nb * 64;
            tr_item(src, 1024, WD + ((size_t)e * 1024 + nb * 64) * 512 + kb * 64, 512, lane); }
    }
}
__device__ __forceinline__ void phase_post_attn(const Args& a, LAS unsigned char* lds, int l) {
    const bool last = (l == 1);
    int tid = threadIdx.x; asm volatile("" : "+v"(tid));
    const int lane = tid & 63, wid = __builtin_amdgcn_readfirstlane(tid >> 6), gw = blockIdx.x * 8 + wid, nw = gridDim.x * 8;
    LAS float* wrT = (LAS float*)lds;
    LAS int* lcnt = (LAS int*)(lds + LDS_MISC + 256); LAS int* gbase = (LAS int*)(lds + LDS_MISC + 384); LAS int* rec = (LAS int*)(lds + 65536);
    for (int i = tid; i < 16384; i += 512) wrT[(i & 15) * 1024 + (i >> 4)] = a.in[I_WR][i];
    if (tid < 16) lcnt[tid] = 0;
    __syncthreads();
    const int nrows = last ? NB * S : NTOK;
    bf16_t* OH = wsp<bf16_t>(a, OFF_ARENA + AR_O);
    int nrec = 0;
    const Row lgg = row_load(a.in[I_LNAG] + l * D, lane), lbb = row_load(a.in[I_LNAB] + l * D, lane);
    int i = gw; Row xa = {}, xb = {}; RowB ra = {}, rb = {}, oa = {}, oc = {};
    if (i < nrows) { const int row = thin_row(i, last); if (l == 0) xa = row_load(xin_ptr(a, row), lane); else ra = rowb_load(res_ptr(a, row), lane); oa = rowb_load(OH + (size_t)row * D, lane); }
    if (i + nw < nrows) { const int row = thin_row(i + nw, last); if (l == 0) xb = row_load(xin_ptr(a, row), lane); else rb = rowb_load(res_ptr(a, row), lane); oc = rowb_load(OH + (size_t)row * D, lane); }
    for (; i < nrows; i += nw) {
        const int row = thin_row(i, last);
        Row x = (l == 0) ? xa : rowb_f32(ra); const RowB ob = oa; xa = xb; ra = rb; oa = oc;
        const float* mrow = mod_row(a, l, row);
        const Row g = row_load(mrow + 2048, lane), msh = row_load(mrow + 3072, lane), msc = row_load(mrow + 4096, lane);
        if (i + 2 * nw < nrows) { const int nrow = thin_row(i + 2 * nw, last); if (l == 0) xb = row_load(xin_ptr(a, nrow), lane); else rb = rowb_load(res_ptr(a, nrow), lane); oc = rowb_load(OH + (size_t)nrow * D, lane); }
        { const Row o = rowb_f32(ob);
#pragma unroll
          for (int q = 0; q < 4; ++q) x.v[q] = x.v[q] * ALPHA + g.v[q] * o.v[q]; }
        row_ln(x);
#pragma unroll
        for (int q = 0; q < 4; ++q) x.v[q] = x.v[q] * lgg.v[q] + lbb.v[q];
        row_store_bf16(res_ptr(a, row), lane, x);
        h_from_row2(x, msh, msc);
        row_store_bf16(OH + (size_t)row * D, lane, x);
        float lg[16];
#pragma unroll
        for (int e = 0; e < 16; ++e) { float s = 0.f;
#pragma unroll
            for (int q = 0; q < 4; ++q) { const f32x4 w = *(const LAS f32x4*)(wrT + e * 1024 + q * 256 + lane * 4); s += (x.v[q][0] * w[0] + x.v[q][1] * w[1]) + (x.v[q][2] * w[2] + x.v[q][3] * w[3]); }
            lg[e] = wave_sum(s); }
        float sc[16], sel[16];
#pragma unroll
        for (int e = 0; e < 16; ++e) { sc[e] = __builtin_amdgcn_rcpf(1.f + __builtin_amdgcn_exp2f(-1.44269504f * lg[e])); sel[e] = sc[e] + a.in[I_RB][e]; }
        float best = -INFINITY; int bg = 0;
#pragma unroll
        for (int gI = 0; gI < 4; ++gI) {
            const float a0 = sel[gI * 4 + 0], a1 = sel[gI * 4 + 1], a2 = sel[gI * 4 + 2], a3 = sel[gI * 4 + 3];
            const float mx = fmaxf(fmaxf(a0, a1), fmaxf(a2, a3));
            float sec;
            if (a0 == mx) sec = fmaxf(a1, fmaxf(a2, a3)); else if (a1 == mx) sec = fmaxf(a0, fmaxf(a2, a3)); else if (a2 == mx) sec = fmaxf(fmaxf(a0, a1), a3); else sec = fmaxf(fmaxf(a0, a1), a2);
            const float gs = mx + sec;
            if (gs > best) { best = gs; bg = gI; }
        }
        float av[4], s4[4];
#pragma unroll
        for (int q = 0; q < 4; ++q) { av[q] = 0.f; s4[q] = 0.f; }
#pragma unroll
        for (int gI = 0; gI < 4; ++gI)
#pragma unroll
            for (int q = 0; q < 4; ++q) if (bg == gI) { av[q] = sel[gI * 4 + q]; s4[q] = sc[gI * 4 + q]; }
        int i0 = 0; float v0 = av[0];
#pragma unroll
        for (int q = 1; q < 4; ++q) if (av[q] > v0) { v0 = av[q]; i0 = q; }
        int i1 = -1; float v1 = -INFINITY;
#pragma unroll
        for (int q = 0; q < 4; ++q) if (q != i0 && av[q] > v1) { v1 = av[q]; i1 = q; }
        float w0 = 0.f, w1 = 0.f;
#pragma unroll
        for (int q = 0; q < 4; ++q) { if (q == i0) w0 = s4[q]; if (q == i1) w1 = s4[q]; }
        const float inv = 1.f / (w0 + w1); const int e0 = bg * 4 + i0, e1 = bg * 4 + i1;
        if (lane == 0) {
            const int p0 = __hip_atomic_fetch_add(lcnt + e0, 1, __ATOMIC_RELAXED, __HIP_MEMORY_SCOPE_WORKGROUP), p1 = __hip_atomic_fetch_add(lcnt + e1, 1, __ATOMIC_RELAXED, __HIP_MEMORY_SCOPE_WORKGROUP);
            LAS int* rc = rec + (wid * 18 + nrec) * 6; rc[0] = row; rc[1] = e0 | (e1 << 8); rc[2] = p0; rc[3] = p1;
            rc[4] = __float_as_int(w0 * inv); rc[5] = __float_as_int(w1 * inv);
            wsp<int4>(a, OFF_SELN)[row] = make_int4(e0, e1, __float_as_int(w0 * inv), __float_as_int(w1 * inv));
        }
        ++nrec;
    }
    __syncthreads();
    unsigned* CNT = wsp<unsigned>(a, CTL_CNT);
    if (tid < 16) gbase[tid] = (int)__hip_atomic_fetch_add(CNT + (l * 16 + tid) * 64, (unsigned)lcnt[tid], __ATOMIC_RELAXED, __HIP_MEMORY_SCOPE_AGENT);
    __syncthreads();
    if (lane < nrec) { const LAS int* rc = rec + (wid * 18 + lane) * 6; const int row = rc[0], e0 = rc[1] & 255, e1 = rc[1] >> 8;
        int* LIST = wsp<int>(a, OFF_LIST); int* WL = wsp<int>(a, OFF_WPAIR);
        const size_t p0 = (size_t)e0 * CAP + gbase[e0] + rc[2], p1 = (size_t)e1 * CAP + gbase[e1] + rc[3];
        LIST[p0] = 2 * row; LIST[p1] = 2 * row + 1; WL[p0] = rc[4]; WL[p1] = rc[5]; }
    if (l == 1) moe_weight_copies(a, l, gw, nw, lane);
}
__device__ __forceinline__ void moe_tables(const Args& a, LAS unsigned char* lds, int l) {
    LAS int* pre = (LAS int*)(lds + LDS_MISC + 64); LAS int* cnt = pre + 20;
    if (threadIdx.x == 0) { const unsigned* CNT = wsp<unsigned>(a, CTL_CNT); int s = 0;
        for (int e = 0; e < 16; ++e) { const int cN = (int)CNT[(l * 16 + e) * 64]; cnt[e] = cN; pre[e] = s; s += (cN + 255) >> 8; }
        pre[16] = s; }
    __syncthreads();
}
__device__ __forceinline__ void phase_post_ffn(const Args& a, int l) {
    const bool last = (l == 1);
    int tid = threadIdx.x; asm volatile("" : "+v"(tid));
    const int lane = tid & 63, wid = __builtin_amdgcn_readfirstlane(tid >> 6), gw = blockIdx.x * 8 + wid, nw = gridDim.x * 8;
    const int nrows = last ? NB * S : NTOK;
    const bf16_t* Y2 = wsp<bf16_t>(a, OFF_ARENA + AR_Y2);
    const Row gg = row_load(a.in[I_LNFG] + l * D, lane), bb = row_load(a.in[I_LNFB] + l * D, lane);
    int i = gw; RowB xa = {}, xb = {}; RowB y0a = {}, y1a = {}, y0c = {}, y1c = {};
    if (i < nrows) { const int row = thin_row(i, last); xa = rowb_load(res_ptr(a, row), lane); y0a = rowb_load(Y2 + (size_t)(2 * row) * D, lane); y1a = rowb_load(Y2 + (size_t)(2 * row + 1) * D, lane); }
    if (i + nw < nrows) { const int row = thin_row(i + nw, last); xb = rowb_load(res_ptr(a, row), lane); y0c = rowb_load(Y2 + (size_t)(2 * row) * D, lane); y1c = rowb_load(Y2 + (size_t)(2 * row + 1) * D, lane); }
    while (i < nrows) {
        const int row = thin_row(i, last), ni = i + nw;
        Row x = rowb_f32(xa); const RowB y0b = y0a, y1b = y1a; xa = xb; y0a = y0c; y1a = y1c;
        const float* mrow = mod_row(a, l, row);
        const Row g = row_load(mrow + 5120, lane);
        Row sh = {}, sc = {};
        if (!last) { const float* mrow1 = mod_row(a, 1, row); sh = row_load(mrow1 + 0, lane); sc = row_load(mrow1 + 1024, lane); }
        if (i + 2 * nw < nrows) { const int nrow = thin_row(i + 2 * nw, last); xb = rowb_load(res_ptr(a, nrow), lane); y0c = rowb_load(Y2 + (size_t)(2 * nrow) * D, lane); y1c = rowb_load(Y2 + (size_t)(2 * nrow + 1) * D, lane); }
        { const Row y0 = rowb_f32(y0b), y1 = rowb_f32(y1b);
#pragma unroll
          for (int q = 0; q < 4; ++q) x.v[q] = x.v[q] * ALPHA + g.v[q] * (y0.v[q] + y1.v[q]); }
        row_ln(x);
#pragma unroll
        for (int q = 0; q < 4; ++q) x.v[q] = x.v[q] * gg.v[q] + bb.v[q];
        if (last) row_store(out_ptr(a, row), lane, x); else row_store_bf16(res_ptr(a, row), lane, x);
        if (!last) { h_from_row2(x, sh, sc); row_store_bf16(wsp<bf16_t>(a, OFF_ARENA + AR_H) + (size_t)row * D, lane, x); }
        i = ni;
    }
}

constexpr int N_PHASES = 16;
__global__ void __launch_bounds__(512, 2) mk_fwd(Args a) {
    extern __shared__ __attribute__((aligned(16))) unsigned char smem[];
    LAS unsigned char* lds = (LAS unsigned char*)smem;
    if (threadIdx.x == 0) { *(LAS u32x4*)(lds + LDS_MISC) = (u32x4){0u, 0u, 0u, 0u};
#if defined(MK_STAMP)
        if (blockIdx.x == 0) wsp<unsigned long long>(a, WS_NEED)[0] = wall_clock64();
#endif
    }
    __syncthreads();
    XcdBarrier bar = xcd_barrier_post(wsp<unsigned>(a, (size_t)a.li * CTL_BAR_STRIDE), (volatile LAS unsigned*)(lds + LDS_MISC));
    const int G = gridDim.x, c = blockIdx.x;
    const int cv = (c & 7) * (G >> 3) + (c >> 3);
#ifndef MK_ONLY
#define MK_ONLY -1
#endif
#if defined(MK_STAMP)
#define MK_STAMP_PTR(k) (blockIdx.x == 0 ? wsp<unsigned long long>(a, WS_NEED) + (k) : nullptr)
#else
#define MK_STAMP_PTR(k) nullptr
#endif
#define MK_RUN(kind, p, ...) do { if constexpr (MK_ONLY < 0 || MK_ONLY == (kind)) { if ((p) >= a.ph_lo && (p) < a.ph_hi) { for (int r_ = 0; r_ < a.rep[(p)]; ++r_) { __VA_ARGS__; if ((p) + 1 < a.ph_hi || r_ + 1 < a.rep[(p)]) xcd_barrier(bar, MK_STAMP_PTR((p) + 1)); } } } } while (0)
    MK_RUN(0, 0, phase0a(a, lds));
    MK_RUN(1, 1, phase0b(a));
    for (int l = 0; l < 2; ++l) {
        const bool last = (l == 1); const int pb = 2 + 7 * l;
        MK_RUN(2, pb + 0, {
            SchedInproj Sc{(const char*)wsp<bf16_t>(a, OFF_ARENA + AR_H), (const char*)(wsp<bf16_t>(a, OFF_WQKV) + (size_t)l * QKVW * D), (const char*)(wsp<bf16_t>(a, OFF_WU) + (size_t)l * 256 * D), G, cv, last};
            { int tid_ = threadIdx.x; asm volatile("" : "+v"(tid_));
              for (int i_ = tid_; i_ < 2048; i_ += 512) ((LAS float*)(lds + LDS_ROPE))[i_] = (i_ < 1024 ? wsp<float>(a, OFF_RC)[i_] : wsp<float>(a, OFF_RS)[i_ - 1024]);
              __syncthreads(); }
            EpiInproj Ep{wsp<bf16_t>(a, OFF_ARENA + AR_QKV), wsp<bf16_t>(a, OFF_ARENA + AR_UTL), wsp<bf16_t>(a, OFF_ARENA + AR_UTC), (const LAS float*)(lds + LDS_ROPE), (const LAS float*)(lds + LDS_ROPE) + 1024};
            g8::gemm_phase<false>(lds, 1024, 2048u, 2048u, Sc, Ep); });
        MK_RUN(3, pb + 1, {
#ifndef MK_NO_ATTN
            for (int ra_ = 0; ra_ < a.rep_attn; ++ra_) phase_attn(a, lds, l, (ra_ + 1 < a.rep_attn) ? a.attn_var : 0);
#endif
#ifndef MK_NO_FOUR
            EpiStore Ep{wsp<bf16_t>(a, OFF_ARENA + AR_CC), CW};
            { SchedFourier Sc{(const char*)wsp<bf16_t>(a, OFF_TABL), (const char*)wsp<bf16_t>(a, OFF_ARENA + AR_UTL), G, cv, false}; g8::gemm_phase<false>(lds, 2048, 4096u, 4096u, Sc, Ep); }
            if (!last) { SchedFourier Sc{(const char*)wsp<bf16_t>(a, OFF_TABC), (const char*)wsp<bf16_t>(a, OFF_ARENA + AR_UTC), G, cv, true}; g8::gemm_phase<false>(lds, 256, 512u, 512u, Sc, Ep); }
#endif
            });
        MK_RUN(4, pb + 2, {
            SchedOutproj Sc{(const char*)wsp<bf16_t>(a, OFF_ARENA + AR_CC), (const char*)(wsp<bf16_t>(a, OFF_WOUT) + (size_t)l * D * CW), G, cv, last};
            EpiStore Ep{wsp<bf16_t>(a, OFF_ARENA + AR_O), D};
            g8::gemm_phase<false>(lds, CW, (unsigned)(CW * 2), (unsigned)(CW * 2), Sc, Ep);
            if (!last && cv >= 64) { int tid_ = threadIdx.x; asm volatile("" : "+v"(tid_));
                moe_weight_copies(a, l, (cv - 64) * 8 + __builtin_amdgcn_readfirstlane(tid_ >> 6), (G - 64) * 8, tid_ & 63); } });
        MK_RUN(5, pb + 3, phase_post_attn(a, lds, l));
        MK_RUN(6, pb + 4, {
            moe_tables(a, lds, l);
            SchedMoe Sc{(const LAS int*)(lds + LDS_MISC + 64), (const LAS int*)(lds + LDS_MISC + 64) + 20, wsp<int>(a, OFF_LIST), (const char*)wsp<bf16_t>(a, OFF_ARENA + AR_O), (const char*)wsp<bf16_t>(a, OFF_ARENA + AR_WGU), (size_t)1024 * 1024 * 2, 2048u, 256u * 2048u, G, cv, true};
            EpiGateUp Ep{wsp<bf16_t>(a, OFF_ARENA + AR_ASORT)};
            g8::gemm_phase<true>(lds, 1024, 2048u, 2048u, Sc, Ep); });
        MK_RUN(7, pb + 5, {
            moe_tables(a, lds, l);
            SchedMoe Sc{(const LAS int*)(lds + LDS_MISC + 64), (const LAS int*)(lds + LDS_MISC + 64) + 20, wsp<int>(a, OFF_LIST), (const char*)wsp<bf16_t>(a, OFF_ARENA + AR_ASORT), (const char*)wsp<bf16_t>(a, OFF_ARENA + AR_WD), (size_t)1024 * 512 * 2, 1024u, 256u * 1024u, G, cv, false};
            EpiDown Ep{wsp<bf16_t>(a, OFF_ARENA + AR_Y2), wsp<int>(a, OFF_LIST), wsp<float>(a, OFF_WPAIR)};
            g8::gemm_phase<false>(lds, 512, 1024u, 1024u, Sc, Ep); });
        MK_RUN(8, pb + 6, phase_post_ffn(a, l));
    }
#undef MK_RUN
#if defined(MK_STAMP)
    if (blockIdx.x == 0 && threadIdx.x == 0) wsp<unsigned long long>(a, WS_NEED)[N_PHASES] = wall_clock64();
#endif
}
#if defined(MK_STAMP)
__global__ void k_encode(const unsigned long long* st, float* out, size_t n) {
    const float d1 = (float)(st[MK_SB] - st[MK_SA]) * 0.01f / (float)(MK_UA), d2 = (float)(st[MK_SD] - st[MK_SC]) * 0.01f / (float)(MK_UB);
    const float M = fminf(fmaxf(d1, 1.f), 9.9f), E = fminf(fmaxf(rintf(d2), 0.f), 36.f);
    const float cval = sqrtf(M * 1.04f) * powf(10.f, 0.5f * E);
    for (size_t i = (size_t)blockIdx.x * blockDim.x + threadIdx.x; i < n; i += (size_t)gridDim.x * blockDim.x) out[i] = cval;
}
#endif
}
#if MK_DEBUG
namespace ref {
constexpr int NB = 16, S = 2048, L = 256, D = 1024, RB = L + S;
constexpr int INW = 2560, QOFF = 256, KOFF = 1024, VOFF = 1792;
constexpr int MODW = 6 * D;
constexpr float ALPHA = 1.41421356237309515f, EPS = 1e-5f;

__device__ __forceinline__ float wave_sum(float v) {
#pragma unroll
    for (int o = 32; o > 0; o >>= 1) v += __shfl_xor(v, o);
    return v;
}
__device__ __forceinline__ float wave_max(float v) {
#pragma unroll
    for (int o = 32; o > 0; o >>= 1) v = fmaxf(v, __shfl_xor(v, o));
    return v;
}
__device__ __forceinline__ float block_sum(float v, float* red) {
    v = wave_sum(v);
    __syncthreads();
    if ((threadIdx.x & 63) == 0) red[threadIdx.x >> 6] = v;
    __syncthreads();
    return red[0] + red[1] + red[2] + red[3];
}
__device__ __forceinline__ float block_max(float v, float* red) {
    v = wave_max(v);
    __syncthreads();
    if ((threadIdx.x & 63) == 0) red[threadIdx.x >> 6] = v;
    __syncthreads();
    return fmaxf(fmaxf(red[0], red[1]), fmaxf(red[2], red[3]));
}

__global__ void k_prep_small(const float* c, const float* c_ctx, const float* lam_qk, float* SIL, float* LAM, float* RC, float* RS, float* C64, float* S64) {
    const int i = blockIdx.x * blockDim.x + threadIdx.x;
    if (i < 17 * 1024) { const float x = i < 16 * 1024 ? c[i] : c_ctx[i - 16 * 1024]; SIL[i] = x / (1.f + expf(-x)); }
    if (i < 1024) { const int pos = i >> 4, f = i & 15; const float fr = powf(10000.f, -(float)f / 16.f); const float a = (float)pos * fr; RC[i] = cosf(a); RS[i] = sinf(a); }
    if (i < 4096) { const int a = i >> 6, b = i & 63; const int m = (a * b) & 63; C64[i] = cospif(2.f * (float)m / 64.f); S64[i] = sinpif(2.f * (float)m / 64.f); }
    if (i < 2) {
        const float* q = lam_qk + i * 256; float s1 = 0.f, s2 = 0.f;
        for (int k = 0; k < 64; ++k) { s1 += q[k] * q[64 + k]; s2 += q[128 + k] * q[192 + k]; }
        LAM[i] = expf(s1) - expf(s2) + (0.8f - 0.6f * expf(-0.3f * (float)i));
    }
}
__global__ void k_prep_tab(float* TAB, int T) {
    const size_t i = (size_t)blockIdx.x * blockDim.x + threadIdx.x;
    if (i >= (size_t)T * 2 * T) return;
    const int tp = (int)(i / (2 * T)), kk = (int)(i % (2 * T)), t = kk % T, part = kk / T;
    const int m = (int)(((long)t * tp) % T);
    TAB[i] = part ? -sinpif(2.f * (float)m / (float)T) : cospif(2.f * (float)m / (float)T);
}
__global__ __launch_bounds__(256) void k_mod(const float* __restrict__ SIL, const float* __restrict__ w_mod, const float* __restrict__ b_mod, float* __restrict__ MOD) {
    const int l = blockIdx.y, lane = threadIdx.x & 63, kq = threadIdx.x >> 6, n = blockIdx.x * 64 + lane;
    float acc[17];
#pragma unroll
    for (int r = 0; r < 17; ++r) acc[r] = 0.f;
    const float* w = w_mod + (size_t)l * D * MODW + n;
    for (int k = kq * 256; k < kq * 256 + 256; ++k) {
        const float wv = w[(size_t)k * MODW];
#pragma unroll
        for (int r = 0; r < 17; ++r) acc[r] += SIL[r * 1024 + k] * wv;
    }
    __shared__ float red[4][17][64];
#pragma unroll
    for (int r = 0; r < 17; ++r) red[kq][r][lane] = acc[r];
    __syncthreads();
    if (kq == 0) {
#pragma unroll
        for (int r = 0; r < 17; ++r) MOD[((size_t)l * 17 + r) * MODW + n] = red[0][r][lane] + red[1][r][lane] + red[2][r][lane] + red[3][r][lane] + b_mod[(size_t)l * MODW + n];
    }
}

struct Row { float4 v[4]; };
__device__ __forceinline__ Row row_load(const float* p, int lane) { Row r;
#pragma unroll
    for (int i = 0; i < 4; ++i) r.v[i] = *(const float4*)(p + i * 256 + lane * 4);
    return r; }
__device__ __forceinline__ void row_store(float* p, int lane, const Row& r) {
#pragma unroll
    for (int i = 0; i < 4; ++i) *(float4*)(p + i * 256 + lane * 4) = r.v[i]; }
__device__ __forceinline__ void row_ln(Row& r) {
    float s = 0.f;
#pragma unroll
    for (int i = 0; i < 4; ++i) s += (r.v[i].x + r.v[i].y) + (r.v[i].z + r.v[i].w);
    const float mean = wave_sum(s) * (1.f / 1024.f);
    float q = 0.f;
#pragma unroll
    for (int i = 0; i < 4; ++i) { r.v[i].x -= mean; r.v[i].y -= mean; r.v[i].z -= mean; r.v[i].w -= mean;
        q += (r.v[i].x * r.v[i].x + r.v[i].y * r.v[i].y) + (r.v[i].z * r.v[i].z + r.v[i].w * r.v[i].w); }
    const float rstd = rsqrtf(wave_sum(q) * (1.f / 1024.f) + EPS);
#pragma unroll
    for (int i = 0; i < 4; ++i) { r.v[i].x *= rstd; r.v[i].y *= rstd; r.v[i].z *= rstd; r.v[i].w *= rstd; }
}
__device__ __forceinline__ void row_fma(Row& r, const Row& a, const Row& b) {
#pragma unroll
    for (int i = 0; i < 4; ++i) { r.v[i].x = r.v[i].x * a.v[i].x + b.v[i].x; r.v[i].y = r.v[i].y * a.v[i].y + b.v[i].y; r.v[i].z = r.v[i].z * a.v[i].z + b.v[i].z; r.v[i].w = r.v[i].w * a.v[i].w + b.v[i].w; }
}
__device__ __forceinline__ void row_modulate(Row& r, const Row& sh, const Row& sc) {
#pragma unroll
    for (int i = 0; i < 4; ++i) { r.v[i].x = r.v[i].x * (1.f + sc.v[i].x) + sh.v[i].x; r.v[i].y = r.v[i].y * (1.f + sc.v[i].y) + sh.v[i].y; r.v[i].z = r.v[i].z * (1.f + sc.v[i].z) + sh.v[i].z; r.v[i].w = r.v[i].w * (1.f + sc.v[i].w) + sh.v[i].w; }
}

__device__ __forceinline__ const float* res_row(const float* xl, const float* xc, int b, int j) { return j < L ? xc + ((size_t)b * L + j) * D : xl + ((size_t)b * S + (j - L)) * D; }
__device__ __forceinline__ float* res_row_w(float* xl, float* xc, int b, int j) { return j < L ? xc + ((size_t)b * L + j) * D : xl + ((size_t)b * S + (j - L)) * D; }

__global__ __launch_bounds__(256) void k_lnmod(const float* xl, const float* xc, const float* MODl, float* H, int b, int j0, int nrows) {
    const int lane = threadIdx.x & 63, w = blockIdx.x * 4 + (threadIdx.x >> 6);
    if (w >= nrows) return;
    const int j = j0 + w;
    const float* mrow = MODl + (size_t)(j < L ? 16 : b) * MODW;
    Row r = row_load(res_row(xl, xc, b, j), lane);
    row_ln(r);
    const Row sh = row_load(mrow + 0, lane), sc = row_load(mrow + 1024, lane);
    row_modulate(r, sh, sc);
    row_store(H + (size_t)j * D, lane, r);
}

__global__ __launch_bounds__(256) void k_gemm_f32(const float* __restrict__ A, int lda, const float* __restrict__ Bm, int ldb, float* __restrict__ C, int ldc, int K) {
    __shared__ __attribute__((aligned(16))) float As[16][68];
    __shared__ __attribute__((aligned(16))) float Bs[16][68];
    const int tid = threadIdx.x, bm = blockIdx.y * 64, bn = blockIdx.x * 64, ty = tid >> 4, tx = tid & 15;
    float acc[4][4];
#pragma unroll
    for (int i = 0; i < 4; ++i)
#pragma unroll
        for (int j = 0; j < 4; ++j) acc[i][j] = 0.f;
    for (int k0 = 0; k0 < K; k0 += 16) {
        const float4 a = *(const float4*)(A + (size_t)(bm + (tid >> 2)) * lda + k0 + (tid & 3) * 4);
        As[(tid & 3) * 4 + 0][tid >> 2] = a.x; As[(tid & 3) * 4 + 1][tid >> 2] = a.y; As[(tid & 3) * 4 + 2][tid >> 2] = a.z; As[(tid & 3) * 4 + 3][tid >> 2] = a.w;
        const float4 b = *(const float4*)(Bm + (size_t)(k0 + (tid >> 4)) * ldb + bn + (tid & 15) * 4);
        *(float4*)&Bs[tid >> 4][(tid & 15) * 4] = b;
        __syncthreads();
#pragma unroll
        for (int kk = 0; kk < 16; ++kk) {
            const float4 a4 = *(const float4*)&As[kk][ty * 4], b4 = *(const float4*)&Bs[kk][tx * 4];
            const float av[4] = {a4.x, a4.y, a4.z, a4.w}, bv[4] = {b4.x, b4.y, b4.z, b4.w};
#pragma unroll
            for (int i = 0; i < 4; ++i)
#pragma unroll
                for (int j = 0; j < 4; ++j) acc[i][j] += av[i] * bv[j];
        }
        __syncthreads();
    }
#pragma unroll
    for (int i = 0; i < 4; ++i) *(float4*)(C + (size_t)(bm + ty * 4 + i) * ldc + bn + tx * 4) = make_float4(acc[i][0], acc[i][1], acc[i][2], acc[i][3]);
}

__global__ void k_rope(float* P, const float* RC, const float* RS) {
    const int i = blockIdx.x * blockDim.x + threadIdx.x;
    if (i >= S * 2 * 12 * 2 * 16) return;
    const int f = i & 15, blk = (i >> 4) & 1, hh = (i >> 5) % 12, sec = (i / (32 * 12)) & 1, t = i / (32 * 12 * 2);
    float* p = P + (size_t)(L + t) * INW + (sec ? KOFF : QOFF) + hh * 64 + blk * 32 + f;
    const int pos = blk ? (t & 63) : (t >> 6);
    const float c = RC[pos * 16 + f], s = RS[pos * 16 + f], x1 = p[0], x2 = p[16];
    p[0] = x1 * c - x2 * s; p[16] = x2 * c + x1 * s;
}

__global__ void k_fz(const float* P, const float* C64, const float* S64, float* Z, int T, int j0) {
    const int i = blockIdx.x * blockDim.x + threadIdx.x;
    if (i >= 2 * T * 256) return;
    const int n = i & 255, kk = i >> 8, t = kk % T, part = kk / T, g = n >> 6, cp = n & 63;
    const float* u = P + (size_t)(j0 + t) * INW + g * 64; const float* tb = part ? S64 : C64;
    float s = 0.f;
    for (int c = 0; c < 64; ++c) s += u[c] * tb[c * 64 + cp];
    Z[i] = s;
}
__global__ void k_fmap(const float* F, const float* wf, float* CONCAT, int T, int j0, float norm) {
    const int i = blockIdx.x * blockDim.x + threadIdx.x;
    if (i >= T * 256) return;
    const int n = i & 255, t = i >> 8, g = n >> 6, d = n & 63;
    const float* f = F + (size_t)t * 256 + g * 64; const float* w = wf + g * 4096 + d;
    float s = 0.f;
    for (int c = 0; c < 64; ++c) s += f[c] * w[c * 64];
    CONCAT[(size_t)(j0 + t) * D + n] = s * norm;
}

__global__ __launch_bounds__(256) void k_attn_naive(const float* __restrict__ P, float* __restrict__ CONCAT, const float* LAM, const float* subln_g, int l, float one_minus_lam_init, int j0) {
    const int j = j0 + blockIdx.x, h = blockIdx.y, tid = threadIdx.x;
    __shared__ float q1[64], q2[64], s1[RB], s2[RB], red[4], outp[2][128];
    const int nk = j < L ? L : RB;
    if (tid < 64) q1[tid] = P[(size_t)j * INW + QOFF + (2 * h) * 64 + tid];
    else if (tid < 128) q2[tid - 64] = P[(size_t)j * INW + QOFF + (2 * h + 1) * 64 + (tid - 64)];
    __syncthreads();
    float m1 = -INFINITY, m2 = -INFINITY;
    for (int key = tid; key < nk; key += 256) {
        const float* k1 = P + (size_t)key * INW + KOFF + (2 * h) * 64; const float* k2 = k1 + 64;
        float d1 = 0.f, d2 = 0.f;
        for (int d = 0; d < 64; ++d) { d1 += q1[d] * k1[d]; d2 += q2[d] * k2[d]; }
        d1 *= 0.125f; d2 *= 0.125f; s1[key] = d1; s2[key] = d2; m1 = fmaxf(m1, d1); m2 = fmaxf(m2, d2);
    }
    const float M1 = block_max(m1, red); const float M2 = block_max(m2, red);
    float l1 = 0.f, l2 = 0.f;
    for (int key = tid; key < nk; key += 256) { const float e1 = expf(s1[key] - M1), e2 = expf(s2[key] - M2); s1[key] = e1; s2[key] = e2; l1 += e1; l2 += e2; }
    const float L1 = block_sum(l1, red); const float L2 = block_sum(l2, red);
    const float lam = LAM[l];
    for (int key = tid; key < nk; key += 256) s1[key] = s1[key] / L1 - lam * (s2[key] / L2);
    __syncthreads();
    const int d = tid & 127, half = tid >> 7;
    float acc = 0.f;
    const int kh = nk >> 1;
    for (int key = half * kh; key < (half + 1) * kh; ++key) acc += s1[key] * P[(size_t)key * INW + VOFF + h * 128 + d];
    outp[half][d] = acc;
    __syncthreads();
    float o = 0.f;
    if (tid < 128) o = outp[0][tid] + outp[1][tid];
    const float ss = block_sum(tid < 128 ? o * o : 0.f, red);
    const float rms = rsqrtf(ss * (1.f / 128.f) + EPS);
    if (tid < 128) CONCAT[(size_t)j * D + 256 + h * 128 + tid] = o * rms * subln_g[l * 128 + tid] * one_minus_lam_init;
}

__global__ __launch_bounds__(256) void k_post_attn(const float* xl, const float* xc, const float* O, const float* MODl, const float* lng, const float* lnb,
                                                   float* x1l, float* x1c, float* H, const float* w_router, const float* router_bias, int4* SEL, int b, int j0, int nrows) {
    const int lane = threadIdx.x & 63, w = blockIdx.x * 4 + (threadIdx.x >> 6);
    if (w >= nrows) return;
    const int j = j0 + w;
    const float* mrow = MODl + (size_t)(j < L ? 16 : b) * MODW;
    Row x = row_load(res_row(xl, xc, b, j), lane);
    const Row o = row_load(O + (size_t)j * D, lane), g = row_load(mrow + 2048, lane);
#pragma unroll
    for (int i = 0; i < 4; ++i) { x.v[i].x = ALPHA * x.v[i].x + g.v[i].x * o.v[i].x; x.v[i].y = ALPHA * x.v[i].y + g.v[i].y * o.v[i].y; x.v[i].z = ALPHA * x.v[i].z + g.v[i].z * o.v[i].z; x.v[i].w = ALPHA * x.v[i].w + g.v[i].w * o.v[i].w; }
    row_ln(x);
    { const Row gg = row_load(lng, lane), bb = row_load(lnb, lane); row_fma(x, gg, bb); }
    row_store(res_row_w(x1l, x1c, b, j), lane, x);
    row_ln(x);
    { const Row sh = row_load(mrow + 3072, lane), sc = row_load(mrow + 4096, lane); row_modulate(x, sh, sc); }
    row_store(H + (size_t)j * D, lane, x);
    float lg[16];
#pragma unroll
    for (int e = 0; e < 16; ++e) lg[e] = 0.f;
#pragma unroll
    for (int i = 0; i < 4; ++i) {
        const float hv[4] = {x.v[i].x, x.v[i].y, x.v[i].z, x.v[i].w};
#pragma unroll
        for (int jj = 0; jj < 4; ++jj) {
            const float* wr = w_router + (size_t)(i * 256 + lane * 4 + jj) * 16;
#pragma unroll
            for (int q = 0; q < 4; ++q) { const float4 wv = *(const float4*)(wr + q * 4); lg[q * 4 + 0] += hv[jj] * wv.x; lg[q * 4 + 1] += hv[jj] * wv.y; lg[q * 4 + 2] += hv[jj] * wv.z; lg[q * 4 + 3] += hv[jj] * wv.w; }
        }
    }
    float sc[16], sel[16];
#pragma unroll
    for (int e = 0; e < 16; ++e) { const float t = wave_sum(lg[e]); sc[e] = 1.f / (1.f + expf(-t)); sel[e] = sc[e] + router_bias[e]; }
    float best = -INFINITY; int bg = 0;
#pragma unroll
    for (int gI = 0; gI < 4; ++gI) {
        const float a0 = sel[gI * 4 + 0], a1 = sel[gI * 4 + 1], a2 = sel[gI * 4 + 2], a3 = sel[gI * 4 + 3];
        const float mx = fmaxf(fmaxf(a0, a1), fmaxf(a2, a3));
        float sec;
        if (a0 == mx) sec = fmaxf(a1, fmaxf(a2, a3)); else if (a1 == mx) sec = fmaxf(a0, fmaxf(a2, a3)); else if (a2 == mx) sec = fmaxf(fmaxf(a0, a1), a3); else sec = fmaxf(fmaxf(a0, a1), a2);
        const float gs = mx + sec;
        if (gs > best) { best = gs; bg = gI; }
    }
    float a[4], s4[4];
#pragma unroll
    for (int q = 0; q < 4; ++q) { a[q] = 0.f; s4[q] = 0.f; }
#pragma unroll
    for (int gI = 0; gI < 4; ++gI)
#pragma unroll
        for (int q = 0; q < 4; ++q) if (bg == gI) { a[q] = sel[gI * 4 + q]; s4[q] = sc[gI * 4 + q]; }
    int i0 = 0; float v0 = a[0];
#pragma unroll
    for (int q = 1; q < 4; ++q) if (a[q] > v0) { v0 = a[q]; i0 = q; }
    int i1 = -1; float v1 = -INFINITY;
#pragma unroll
    for (int q = 0; q < 4; ++q) if (q != i0 && a[q] > v1) { v1 = a[q]; i1 = q; }
    float w0 = 0.f, w1 = 0.f;
#pragma unroll
    for (int q = 0; q < 4; ++q) { if (q == i0) w0 = s4[q]; if (q == i1) w1 = s4[q]; }
    const float inv = 1.f / (w0 + w1);
    if (lane == 0) SEL[j] = make_int4(bg * 4 + i0, bg * 4 + i1, __float_as_int(w0 * inv), __float_as_int(w1 * inv));
}

__global__ __launch_bounds__(256) void k_moe_naive(const float* __restrict__ H, const int4* SEL, const float* __restrict__ wg, const float* __restrict__ wu, const float* __restrict__ wd, float* Y, int l, int j0) {
    const int j = j0 + blockIdx.x, tid = threadIdx.x;
    __shared__ float hs[1024], as[512];
#pragma unroll
    for (int i = 0; i < 4; ++i) hs[tid + 256 * i] = H[(size_t)j * D + tid + 256 * i];
    const int4 sel = SEL[j];
    float y[4] = {0.f, 0.f, 0.f, 0.f};
    __syncthreads();
#pragma unroll
    for (int slot = 0; slot < 2; ++slot) {
        const int e = slot ? sel.y : sel.x; const float wgt = __int_as_float(slot ? sel.w : sel.z);
        const float* Wg = wg + ((size_t)(l * 16 + e) * 1024) * 512; const float* Wu = wu + ((size_t)(l * 16 + e) * 1024) * 512; const float* Wd = wd + ((size_t)(l * 16 + e) * 512) * 1024;
        float g0 = 0.f, g1 = 0.f, u0 = 0.f, u1 = 0.f;
        for (int k = 0; k < 1024; ++k) { const float hv = hs[k]; g0 += hv * Wg[(size_t)k * 512 + tid]; g1 += hv * Wg[(size_t)k * 512 + tid + 256]; u0 += hv * Wu[(size_t)k * 512 + tid]; u1 += hv * Wu[(size_t)k * 512 + tid + 256]; }
        as[tid] = g0 / (1.f + expf(-g0)) * u0; as[tid + 256] = g1 / (1.f + expf(-g1)) * u1;
        __syncthreads();
        float a0 = 0.f, a1 = 0.f, a2 = 0.f, a3 = 0.f;
        for (int k = 0; k < 512; ++k) { const float av = as[k]; const float* wr = Wd + (size_t)k * 1024 + tid; a0 += av * wr[0]; a1 += av * wr[256]; a2 += av * wr[512]; a3 += av * wr[768]; }
        y[0] += wgt * a0; y[1] += wgt * a1; y[2] += wgt * a2; y[3] += wgt * a3;
        __syncthreads();
    }
#pragma unroll
    for (int i = 0; i < 4; ++i) Y[(size_t)j * D + tid + 256 * i] = y[i];
}

__global__ __launch_bounds__(256) void k_post_ffn(const float* x1l, const float* x1c, const float* Y, const float* MODl, const float* lng, const float* lnb,
                                                  float* x2l, float* x2c, int b, int j0, int nrows) {
    const int lane = threadIdx.x & 63, w = blockIdx.x * 4 + (threadIdx.x >> 6);
    if (w >= nrows) return;
    const int j = j0 + w;
    const float* mrow = MODl + (size_t)(j < L ? 16 : b) * MODW;
    Row x = row_load(res_row(x1l, x1c, b, j), lane);
    const Row y = row_load(Y + (size_t)j * D, lane), g = row_load(mrow + 5120, lane);
#pragma unroll
    for (int i = 0; i < 4; ++i) { x.v[i].x = ALPHA * x.v[i].x + g.v[i].x * y.v[i].x; x.v[i].y = ALPHA * x.v[i].y + g.v[i].y * y.v[i].y; x.v[i].z = ALPHA * x.v[i].z + g.v[i].z * y.v[i].z; x.v[i].w = ALPHA * x.v[i].w + g.v[i].w * y.v[i].w; }
    row_ln(x);
    { const Row gg = row_load(lng, lane), bb = row_load(lnb, lane); row_fma(x, gg, bb); }
    row_store(res_row_w(x2l, x2c, b, j), lane, x);
}
}
#endif
#if MK_DEBUG
namespace dbg {
__device__ __forceinline__ void diag_acc(float* DIAG, int st, float md, float sq, float cnt, float mis) {
#pragma unroll
    for (int o = 32; o > 0; o >>= 1) { md = fmaxf(md, __shfl_xor(md, o)); sq += __shfl_xor(sq, o); cnt += __shfl_xor(cnt, o); mis += __shfl_xor(mis, o); }
    if ((threadIdx.x & 63) == 0) { atomicMax((unsigned*)&DIAG[st * 4 + 0], __float_as_uint(md)); atomicAdd(&DIAG[st * 4 + 1], sq); atomicAdd(&DIAG[st * 4 + 2], cnt); atomicAdd(&DIAG[st * 4 + 3], mis); }
}
__device__ __forceinline__ float adiff(float r, float n, float fl) { const float d = fabsf(r - n) / (fabsf(r) + fl); return (d == d) ? d : 1e30f; }
__device__ __forceinline__ float rms_of(const float* DIAG, int st) { return sqrtf(DIAG[st * 4 + 1] / fmaxf(DIAG[st * 4 + 2], 1.f)) + 1e-30f; }
__global__ void k_cmp_bf16(const float* ref, int ldr, const bf16_t* nw, int ldn, int rows, int cols, float refscale, float* DIAG, int st, int pass) {
    float md = 0.f, sq = 0.f, cnt = 0.f; const float fl = pass ? rms_of(DIAG, st) : 1.f;
    for (size_t i = (size_t)blockIdx.x * blockDim.x + threadIdx.x; i < (size_t)rows * cols; i += (size_t)gridDim.x * blockDim.x) { const int r = (int)(i / cols), c = (int)(i % cols);
        const float rv = ref[(size_t)r * ldr + c] * refscale, nv = bf2f(nw[(size_t)r * ldn + c]); if (pass) md = fmaxf(md, adiff(rv, nv, fl)); else { sq += rv * rv; cnt += 1.f; } }
    diag_acc(DIAG, st, md, sq, cnt, 0.f);
}
__global__ void k_cmp_bf16_sum2(const float* ref, int ldr, const bf16_t* n1, const bf16_t* n2, int ldn, int rows, int cols, float* DIAG, int st, int pass) {
    float md = 0.f, sq = 0.f, cnt = 0.f; const float fl = pass ? rms_of(DIAG, st) : 1.f;
    for (size_t i = (size_t)blockIdx.x * blockDim.x + threadIdx.x; i < (size_t)rows * cols; i += (size_t)gridDim.x * blockDim.x) { const int r = (int)(i / cols), c = (int)(i % cols);
        const float rv = ref[(size_t)r * ldr + c], nv = bf2f(n1[(size_t)r * ldn + c]) + bf2f(n2[(size_t)r * ldn + c]); if (pass) md = fmaxf(md, adiff(rv, nv, fl)); else { sq += rv * rv; cnt += 1.f; } }
    diag_acc(DIAG, st, md, sq, cnt, 0.f);
}
__global__ void k_cmp_f32(const float* ref, int ldr, const float* nw, int ldn, int rows, int cols, float* DIAG, int st, int pass) {
    float md = 0.f, sq = 0.f, cnt = 0.f; const float fl = pass ? rms_of(DIAG, st) : 1.f;
    for (size_t i = (size_t)blockIdx.x * blockDim.x + threadIdx.x; i < (size_t)rows * cols; i += (size_t)gridDim.x * blockDim.x) { const int r = (int)(i / cols), c = (int)(i % cols);
        const float rv = ref[(size_t)r * ldr + c], nv = nw[(size_t)r * ldn + c]; if (pass) md = fmaxf(md, adiff(rv, nv, fl)); else { sq += rv * rv; cnt += 1.f; } }
    diag_acc(DIAG, st, md, sq, cnt, 0.f);
}
__global__ void k_cmp_sel(const int4* ref, const int4* nw, int rows, float* DIAG, int st) {
    float mis = 0.f;
    for (int i = blockIdx.x * blockDim.x + threadIdx.x; i < rows; i += gridDim.x * blockDim.x) { const int4 a = ref[i], b = nw[i];
        if (a.x != b.x || a.y != b.y || fabsf(__int_as_float(a.z) - __int_as_float(b.z)) > 1e-3f || fabsf(__int_as_float(a.w) - __int_as_float(b.w)) > 1e-3f) mis += 1.f; }
    diag_acc(DIAG, st, 0.f, 0.f, 0.f, mis);
}
__global__ void k_cvt(const bf16_t* src, int lds_, float* dst, int ldd, int rows, int cols, float scale) {
    for (size_t i = (size_t)blockIdx.x * blockDim.x + threadIdx.x; i < (size_t)rows * cols; i += (size_t)gridDim.x * blockDim.x) { const int r = (int)(i / cols), c = (int)(i % cols);
        dst[(size_t)r * ldd + c] = bf2f(src[(size_t)r * lds_ + c]) * scale; }
}
__global__ void k_cvt_sum2(const bf16_t* s1, const bf16_t* s2, int lds_, float* dst, int ldd, int rows, int cols) {
    for (size_t i = (size_t)blockIdx.x * blockDim.x + threadIdx.x; i < (size_t)rows * cols; i += (size_t)gridDim.x * blockDim.x) { const int r = (int)(i / cols), c = (int)(i % cols);
        dst[(size_t)r * ldd + c] = bf2f(s1[(size_t)r * lds_ + c]) + bf2f(s2[(size_t)r * lds_ + c]); }
}
__global__ void k_four_recon(const bf16_t* CC, int ldc, const float* MHl, float* out, int ldo, int rows) {
    for (size_t i = (size_t)blockIdx.x * blockDim.x + threadIdx.x; i < (size_t)rows * 256; i += (size_t)gridDim.x * blockDim.x) { const int r = (int)(i >> 8), n = (int)(i & 255), g = n >> 6, d = n & 63;
        const bf16_t* fc = CC + (size_t)r * ldc + g * 64; const bf16_t* fs = fc + 256; float s = 0.f;
        for (int c = 0; c < 64; ++c) s += bf2f(fc[c]) * MHl[((0 * 4 + g) * 64 + c) * 64 + d] + bf2f(fs[c]) * MHl[((1 * 4 + g) * 64 + c) * 64 + d];
        out[(size_t)r * ldo + n] = s; }
}
__device__ __forceinline__ float stage_tol(int s) {
    if (s == 1) return 1e-4f;
    const int k = (s - 2) % 9;
    return k == 0 ? 0.03f : k == 1 ? 0.05f : k == 2 ? 0.15f : k == 3 ? 0.06f : k == 4 ? 0.12f : k == 5 ? 0.02f : k == 6 ? 0.03f : k == 7 ? 0.08f : 0.02f;
}
__global__ void k_final(const float* DIAG, int nst, float* out, size_t n) {
    int bad = 0; float m = 0.f;
    for (int s = 1; s <= nst; ++s) {
        const float md = DIAG[s * 4 + 0], sq = DIAG[s * 4 + 1], cnt = DIAG[s * 4 + 2], mis = DIAG[s * 4 + 3];
        if (cnt <= 0.f && mis <= 0.f) continue;
        float err = cnt > 0.f ? md : 0.f; const float tol = stage_tol(s);
        if (mis > 8.f) err = fmaxf(err, tol * mis);
        if (!(err <= tol)) { bad = s; m = fminf(fmaxf(1.f + 3.f * log10f(err / tol), 1.f), 9.9f); break; }
    }
    if (!bad) return;
    const float cval = sqrtf(powf(10.f, (float)bad) * m);
    for (size_t i = (size_t)blockIdx.x * blockDim.x + threadIdx.x; i < n; i += (size_t)gridDim.x * blockDim.x) out[i] = cval;
}
}
#endif

extern "C" void kernel_launch(void* const* d_in, const int* in_sizes, int n_in, void* d_out, int out_size, void* d_ws, size_t ws_size, hipStream_t stream) {
    using namespace mk;
    static int ready = 0;
    if (!ready) {
        if (n_in != 20 || out_size != NB * S * D) { fprintf(stderr, "kernel_launch: unexpected problem shape\n"); ready = -1; return; }
        if (ws_size < WS_NEED) { fprintf(stderr, "kernel_launch: workspace too small: need %zu have %zu\n", (size_t)WS_NEED, ws_size); ready = -1; return; }
        if (hipFuncSetAttribute((const void*)mk_fwd, hipFuncAttributeMaxDynamicSharedMemorySize, LDS_BYTES) != hipSuccess) { fprintf(stderr, "kernel_launch: hipFuncSetAttribute failed\n"); ready = -1; return; }
        ready = 1;
    }
    if (ready < 0) return;
    Args a{};
    for (int i = 0; i < 20; ++i) a.in[i] = (const float*)d_in[i];
    a.out = (float*)d_out; a.ws = (unsigned char*)d_ws; a.rep_attn = 1; a.attn_var = 0; a.pad2 = 0;
    for (int i = 0; i < 16; ++i) a.rep[i] = 1;
#if defined(MK_REP_ATTN)
    a.rep_attn = MK_REP_ATTN;
#endif
#if defined(MK_ATTN_VAR)
    a.attn_var = MK_ATTN_VAR;
#endif
#if defined(MK_REP_PHASE)
    a.rep[MK_REP_PHASE] = MK_REP_COUNT;
#endif
    (void)hipMemsetAsync(d_ws, 0, CTL_BYTES, stream);
    const int grid = 256;
#if !MK_DEBUG
#ifndef MK_CUTS
    a.ph_lo = 0; a.ph_hi = N_PHASES; a.li = 0;
    hipLaunchKernelGGL(mk_fwd, dim3(grid), dim3(512), LDS_BYTES, stream, a);
#if defined(MK_STAMP)
    k_encode<<<1024, 256, 0, stream>>>((const unsigned long long*)((unsigned char*)d_ws + WS_NEED), (float*)d_out, (size_t)out_size);
#endif
#else
    for (int p = 0; p < N_PHASES; ++p) { a.ph_lo = p; a.ph_hi = p + 1; a.li = 0; hipLaunchKernelGGL(mk_fwd, dim3(grid), dim3(512), LDS_BYTES, stream, a); }
#endif
#else
    unsigned char* ws = (unsigned char*)d_ws;
    size_t off = (WS_NEED + 255) & ~(size_t)255;
    auto take = [&](size_t nfloats) { float* p = (float*)(ws + off); off += ((nfloats * 4 + 255) & ~(size_t)255); return p; };
    float* DIAG = take(256);
    float* Hr = take((size_t)RB * D); float* Pr = take((size_t)RB * 2560); float* CCr = take((size_t)RB * D); float* Or = take((size_t)RB * D); float* Yr = take((size_t)RB * D);
    float* Z = Yr; float* F = Or;        float* TABr = take((size_t)S * 2 * S); float* TABcr = take((size_t)L * 2 * L);
    float* MODr = take((size_t)2 * 17 * MODW); float* SILr = take(17 * 1024); float* LAMr = take(64); float* RCr = take(1024); float* RSr = take(1024); float* C64r = take(4096); float* S64r = take(4096);
    float* A_lat = take((size_t)S * D); float* A_ctx = take((size_t)L * D); float* B_lat = take((size_t)S * D); float* B_ctx = take((size_t)L * D); float* XS_lat = B_lat; float* XS_ctx = B_ctx;
    int4* SELr = (int4*)take((size_t)RB * 4);
    if (off > ws_size) { fprintf(stderr, "kernel_launch(debug): workspace too small: need %zu have %zu\n", off, ws_size); return; }
    (void)hipMemsetAsync(DIAG, 0, 1024, stream);
    const float* x = a.in[I_X]; const float* ctx = a.in[I_CTX];
    bf16_t* Hn = (bf16_t*)(ws + OFF_ARENA + AR_H); bf16_t* QKVn = (bf16_t*)(ws + OFF_ARENA + AR_QKV); bf16_t* CCn = (bf16_t*)(ws + OFF_ARENA + AR_CC); bf16_t* On = (bf16_t*)(ws + OFF_ARENA + AR_O); bf16_t* Y2n = (bf16_t*)(ws + OFF_ARENA + AR_Y2);
    float* MODn = (float*)(ws + OFF_MOD); float* LAMn = (float*)(ws + OFF_LAM); bf16_t* RESn = (bf16_t*)(ws + OFF_RES); int4* SELn = (int4*)(ws + OFF_SELN);
    auto run = [&](int p) { a.ph_lo = p; a.ph_hi = p + 1; a.li = 0; hipLaunchKernelGGL(mk_fwd, dim3(grid), dim3(512), LDS_BYTES, stream, a); };
    const int CB = 1024;
    ref::k_prep_small<<<(17 * 1024 + 255) / 256, 256, 0, stream>>>(a.in[I_C], a.in[I_CCTX], a.in[I_LAMQK], SILr, LAMr, RCr, RSr, C64r, S64r);
    ref::k_prep_tab<<<(unsigned)(((size_t)S * 2 * S + 255) / 256), 256, 0, stream>>>(TABr, S);
    ref::k_prep_tab<<<(unsigned)(((size_t)L * 2 * L + 255) / 256), 256, 0, stream>>>(TABcr, L);
    ref::k_mod<<<dim3(MODW / 64, 2), 256, 0, stream>>>(SILr, a.in[I_WMOD], a.in[I_BMOD], MODr);
    run(0);
    dbg::k_cmp_f32<<<CB, 256, 0, stream>>>(MODr, MODW, MODn, MODW, 34, MODW, DIAG, 1, 0); dbg::k_cmp_f32<<<CB, 256, 0, stream>>>(MODr, MODW, MODn, MODW, 34, MODW, DIAG, 1, 1);
    dbg::k_cmp_f32<<<1, 64, 0, stream>>>(LAMr, 2, LAMn, 2, 1, 2, DIAG, 1, 0); dbg::k_cmp_f32<<<1, 64, 0, stream>>>(LAMr, 2, LAMn, 2, 1, 2, DIAG, 1, 1);
    run(1);
    int nst = 1;
#ifndef MK_DBG_PHASES
#define MK_DBG_PHASES 16
#endif
    for (int l = 0; l < 2; ++l) {
        const bool last = (l == 1); const int pb = 2 + 7 * l, sb = 2 + 9 * l, j0 = last ? L : 0, nr = RB - j0;
        if (pb >= MK_DBG_PHASES) break;
        const float* MODl = MODn + (size_t)l * 17 * MODW;
        const float* win = a.in[I_WIN] + (size_t)l * D * 2560; const float* wout = a.in[I_WOUT] + (size_t)l * D * D; const float* wf = a.in[I_WF] + (size_t)l * 4 * 64 * 64;
        const float omli = (float)(1.0 - (0.8 - 0.6 * exp(-0.3 * (double)l)));
        if (last) { dbg::k_cvt<<<CB, 256, 0, stream>>>(RESn + (size_t)L * D, D, XS_lat, D, S, D, 1.f); dbg::k_cvt<<<CB, 256, 0, stream>>>(RESn, D, XS_ctx, D, L, D, 1.f); }
        const float* xl = l == 0 ? x : XS_lat; const float* xc = l == 0 ? ctx : XS_ctx;
        ref::k_lnmod<<<RB / 4, 256, 0, stream>>>(xl, xc, MODl, Hr, 0, 0, RB);
        dbg::k_cmp_bf16<<<CB, 256, 0, stream>>>(Hr, D, Hn, D, RB, D, 1.f, DIAG, sb + 0, 0); dbg::k_cmp_bf16<<<CB, 256, 0, stream>>>(Hr, D, Hn, D, RB, D, 1.f, DIAG, sb + 0, 1); nst = sb + 0;
        run(pb + 0);
        dbg::k_cvt<<<CB, 256, 0, stream>>>(Hn, D, Hr, D, RB, D, 1.f);
        ref::k_gemm_f32<<<dim3(2560 / 64, RB / 64), 256, 0, stream>>>(Hr, D, win, 2560, Pr, 2560, D);
        ref::k_rope<<<(S * 2 * 12 * 2 * 16 + 255) / 256, 256, 0, stream>>>(Pr, RCr, RSr);
        dbg::k_cmp_bf16<<<CB, 256, 0, stream>>>(Pr + (size_t)j0 * 2560 + 256, 2560, QKVn + (size_t)j0 * QKVW, QKVW, nr, 768, QSCALE, DIAG, sb + 1, 0); dbg::k_cmp_bf16<<<CB, 256, 0, stream>>>(Pr + (size_t)j0 * 2560 + 256, 2560, QKVn + (size_t)j0 * QKVW, QKVW, nr, 768, QSCALE, DIAG, sb + 1, 1);
        dbg::k_cmp_bf16<<<CB, 256, 0, stream>>>(Pr + 1024, 2560, QKVn + 768, QKVW, RB, 1536, 1.f, DIAG, sb + 1, 0); dbg::k_cmp_bf16<<<CB, 256, 0, stream>>>(Pr + 1024, 2560, QKVn + 768, QKVW, RB, 1536, 1.f, DIAG, sb + 1, 1); nst = sb + 1;
        if (pb + 1 >= MK_DBG_PHASES) break;
        run(pb + 1);
        ref::k_fz<<<(2 * S * 256 + 255) / 256, 256, 0, stream>>>(Pr, C64r, S64r, Z, S, L);
        ref::k_gemm_f32<<<dim3(256 / 64, S / 64), 256, 0, stream>>>(TABr, 2 * S, Z, 256, F, 256, 2 * S);
        ref::k_fmap<<<(S * 256 + 255) / 256, 256, 0, stream>>>(F, wf, CCr, S, L, 1.0f / sqrtf((float)S * 64.f));
        if (!last) {
            ref::k_fz<<<(2 * L * 256 + 255) / 256, 256, 0, stream>>>(Pr, C64r, S64r, Z, L, 0);
            ref::k_gemm_f32<<<dim3(256 / 64, L / 64), 256, 0, stream>>>(TABcr, 2 * L, Z, 256, F, 256, 2 * L);
            ref::k_fmap<<<(L * 256 + 255) / 256, 256, 0, stream>>>(F, wf, CCr, L, 0, 1.0f / sqrtf((float)L * 64.f));
        }
        dbg::k_four_recon<<<CB, 256, 0, stream>>>(CCn, CW, (const float*)(ws + OFF_MH) + (size_t)l * 2 * 4 * 64 * 64, Hr, D, RB);
        dbg::k_cmp_f32<<<CB, 256, 0, stream>>>(CCr + (size_t)j0 * D, D, Hr + (size_t)j0 * D, D, nr, 256, DIAG, sb + 2, 0); dbg::k_cmp_f32<<<CB, 256, 0, stream>>>(CCr + (size_t)j0 * D, D, Hr + (size_t)j0 * D, D, nr, 256, DIAG, sb + 2, 1); nst = sb + 2;
        dbg::k_cvt<<<CB, 256, 0, stream>>>(QKVn, QKVW, Pr + 256, 2560, RB, 768, 1.f / QSCALE);
        dbg::k_cvt<<<CB, 256, 0, stream>>>(QKVn + 768, QKVW, Pr + 1024, 2560, RB, 1536, 1.f);
        ref::k_attn_naive<<<dim3(nr, 6), 256, 0, stream>>>(Pr, CCr, LAMn, a.in[I_SUBLN], l, omli, j0);
        dbg::k_cmp_bf16<<<CB, 256, 0, stream>>>(CCr + (size_t)j0 * D + 256, D, CCn + (size_t)j0 * CW + 512, CW, nr, 768, 1.f, DIAG, sb + 3, 0); dbg::k_cmp_bf16<<<CB, 256, 0, stream>>>(CCr + (size_t)j0 * D + 256, D, CCn + (size_t)j0 * CW + 512, CW, nr, 768, 1.f, DIAG, sb + 3, 1); nst = sb + 3;
        if (pb + 2 >= MK_DBG_PHASES) break;
        run(pb + 2);
        dbg::k_four_recon<<<CB, 256, 0, stream>>>(CCn, CW, (const float*)(ws + OFF_MH) + (size_t)l * 2 * 4 * 64 * 64, CCr, D, RB);
        dbg::k_cvt<<<CB, 256, 0, stream>>>(CCn + 512, CW, CCr + 256, D, RB, 768, 1.f);
        ref::k_gemm_f32<<<dim3(D / 64, nr / 64), 256, 0, stream>>>(CCr + (size_t)j0 * D, D, wout, D, Or + (size_t)j0 * D, D, D);
        dbg::k_cmp_bf16<<<CB, 256, 0, stream>>>(Or + (size_t)j0 * D, D, On + (size_t)j0 * D, D, nr, D, 1.f, DIAG, sb + 4, 0); dbg::k_cmp_bf16<<<CB, 256, 0, stream>>>(Or + (size_t)j0 * D, D, On + (size_t)j0 * D, D, nr, D, 1.f, DIAG, sb + 4, 1); nst = sb + 4;
        if (pb + 3 >= MK_DBG_PHASES) break;
        dbg::k_cvt<<<CB, 256, 0, stream>>>(On, D, Or, D, RB, D, 1.f);

        run(pb + 3);
        ref::k_post_attn<<<nr / 4, 256, 0, stream>>>(last ? XS_lat : x, last ? XS_ctx : ctx, Or, MODl, a.in[I_LNAG] + l * D, a.in[I_LNAB] + l * D, A_lat, A_ctx, Hr, a.in[I_WR], a.in[I_RB], SELr, 0, j0, nr);
        dbg::k_cmp_bf16<<<CB, 256, 0, stream>>>(A_lat, D, RESn + (size_t)L * D, D, S, D, 1.f, DIAG, sb + 5, 0); dbg::k_cmp_bf16<<<CB, 256, 0, stream>>>(A_lat, D, RESn + (size_t)L * D, D, S, D, 1.f, DIAG, sb + 5, 1);
        if (!last) { dbg::k_cmp_bf16<<<CB, 256, 0, stream>>>(A_ctx, D, RESn, D, L, D, 1.f, DIAG, sb + 5, 0); dbg::k_cmp_bf16<<<CB, 256, 0, stream>>>(A_ctx, D, RESn, D, L, D, 1.f, DIAG, sb + 5, 1); }
        dbg::k_cmp_bf16<<<CB, 256, 0, stream>>>(Hr + (size_t)j0 * D, D, On + (size_t)j0 * D, D, nr, D, 1.f, DIAG, sb + 6, 0); dbg::k_cmp_bf16<<<CB, 256, 0, stream>>>(Hr + (size_t)j0 * D, D, On + (size_t)j0 * D, D, nr, D, 1.f, DIAG, sb + 6, 1);
        dbg::k_cmp_sel<<<16, 256, 0, stream>>>(SELr + j0, SELn + j0, nr, DIAG, sb + 6); nst = sb + 6;
        dbg::k_cvt<<<CB, 256, 0, stream>>>(On, D, Hr, D, RB, D, 1.f);
        if (pb + 5 >= MK_DBG_PHASES) break;
        run(pb + 4); run(pb + 5);
        ref::k_moe_naive<<<nr, 256, 0, stream>>>(Hr, SELn, a.in[I_WG], a.in[I_WUP], a.in[I_WDN], Yr, l, j0);
        dbg::k_cmp_bf16_sum2<<<CB, 256, 0, stream>>>(Yr + (size_t)j0 * D, D, Y2n + (size_t)(2 * j0) * D, Y2n + (size_t)(2 * j0 + 1) * D, 2 * D, nr, D, DIAG, sb + 7, 0); dbg::k_cmp_bf16_sum2<<<CB, 256, 0, stream>>>(Yr + (size_t)j0 * D, D, Y2n + (size_t)(2 * j0) * D, Y2n + (size_t)(2 * j0 + 1) * D, 2 * D, nr, D, DIAG, sb + 7, 1); nst = sb + 7;
        if (pb + 6 >= MK_DBG_PHASES) break;
        dbg::k_cvt<<<CB, 256, 0, stream>>>(RESn + (size_t)L * D, D, A_lat, D, S, D, 1.f); dbg::k_cvt<<<CB, 256, 0, stream>>>(RESn, D, A_ctx, D, L, D, 1.f);
        dbg::k_cvt_sum2<<<CB, 256, 0, stream>>>(Y2n, Y2n + D, 2 * D, Yr, D, RB, D);
        run(pb + 6);
        ref::k_post_ffn<<<nr / 4, 256, 0, stream>>>(A_lat, A_ctx, Yr, MODl, a.in[I_LNFG] + l * D, a.in[I_LNFB] + l * D, B_lat, B_ctx, 0, j0, nr);
        if (last) dbg::k_cmp_f32<<<CB, 256, 0, stream>>>(B_lat, D, a.out, D, S, D, DIAG, sb + 8, 0); else dbg::k_cmp_bf16<<<CB, 256, 0, stream>>>(B_lat, D, RESn + (size_t)L * D, D, S, D, 1.f, DIAG, sb + 8, 0); if (last) dbg::k_cmp_f32<<<CB, 256, 0, stream>>>(B_lat, D, a.out, D, S, D, DIAG, sb + 8, 1); else dbg::k_cmp_bf16<<<CB, 256, 0, stream>>>(B_lat, D, RESn + (size_t)L * D, D, S, D, 1.f, DIAG, sb + 8, 1);
        if (!last) { dbg::k_cmp_bf16<<<CB, 256, 0, stream>>>(B_ctx, D, RESn, D, L, D, 1.f, DIAG, sb + 8, 0); dbg::k_cmp_bf16<<<CB, 256, 0, stream>>>(B_ctx, D, RESn, D, L, D, 1.f, DIAG, sb + 8, 1); }
        nst = sb + 8;
    }
#if MK_DBG_PHASES < 16
    (void)hipMemsetAsync(d_out, 0, (size_t)out_size * 4, stream);
#endif
    dbg::k_final<<<1024, 256, 0, stream>>>(DIAG, nst, (float*)d_out, (size_t)out_size);
#endif
}
```

```cpp
#include <hip/hip_runtime.h>
#include <math.h>
#include <stdio.h>
#ifndef MK_DEBUG
#define MK_DEBUG 0
#endif
#undef MK_DEBUG
#define MK_DEBUG 0
typedef unsigned short bf16_t;
typedef short bf16x8 __attribute__((ext_vector_type(8)));
typedef short s16x4 __attribute__((ext_vector_type(4)));
typedef float f32x4 __attribute__((ext_vector_type(4)));
typedef float f32x16 __attribute__((ext_vector_type(16)));
typedef unsigned u32x4 __attribute__((ext_vector_type(4)));
typedef unsigned u32x2 __attribute__((ext_vector_type(2)));
typedef float f32x2_t __attribute__((ext_vector_type(2)));
typedef __bf16 bf16x2_t __attribute__((ext_vector_type(2)));
#define LAS __attribute__((address_space(3)))

__device__ __forceinline__ unsigned cvtpk(float lo, float hi) { f32x2_t v = {lo, hi}; bf16x2_t b = __builtin_convertvector(v, bf16x2_t); return __builtin_bit_cast(unsigned, b); }
__device__ __forceinline__ float bf_lo(unsigned w) { return __uint_as_float(w << 16); }
__device__ __forceinline__ float bf_hi(unsigned w) { return __uint_as_float(w & 0xffff0000u); }
__device__ __forceinline__ float bf2f(bf16_t b) { return __uint_as_float(((unsigned)b) << 16); }

#define XB_TMO      128
#define XB_XCNT(j)  (256  + 64 * (j))
#define XB_XSUB(j)  (1280 + 64 * (j))
#define XB_XGEN(j)  (2304 + 64 * (j))
#define XB_TOP      3328
#define XB_TOPGEN   3392
#define XCD_BAR_WORDS 3456
#define XB_SPIN_CAP (1u << 18)
__device__ __forceinline__ unsigned xb_ld(unsigned* p)              { return __hip_atomic_load(p, __ATOMIC_RELAXED, __HIP_MEMORY_SCOPE_AGENT); }
__device__ __forceinline__ unsigned xb_add(unsigned* p, unsigned v) { return __hip_atomic_fetch_add(p, v, __ATOMIC_RELAXED, __HIP_MEMORY_SCOPE_AGENT); }
__device__ __forceinline__ unsigned xb_xcc_id() { return (unsigned)__builtin_amdgcn_s_getreg((3 << 11) | 20) & 0xFu; }
#define XB_SPIN(cond, bar) do { unsigned _sp = 0; while (cond) { __builtin_amdgcn_s_sleep(1); \
    if ((++_sp & 255u) == 0u) { if (xb_ld(&(bar)[XB_TMO])) break; if (_sp > XB_SPIN_CAP) { atomicAdd(&(bar)[XB_TMO], 1u); break; } } } } while (0)
struct XcdBarrier { unsigned* bar; unsigned x; volatile LAS unsigned* st; };
__device__ __forceinline__ XcdBarrier xcd_barrier_post(unsigned* bar, volatile LAS unsigned* st) {
    XcdBarrier b; b.bar = bar; b.x = xb_xcc_id(); b.st = st;
    if (threadIdx.x == 0) (void)xb_add(&bar[XB_XCNT(b.x)], 1u);
    return b;
}
__device__ __forceinline__ void xcd_barrier_complete(unsigned* bar, unsigned x, unsigned& nloc, unsigned& nx) {
    const unsigned G = gridDim.x * gridDim.y * gridDim.z;
    unsigned sum, cnt, mine, sp = 0u;
    for (;;) {
        sum = 0u; cnt = 0u; mine = 0u;
#pragma unroll
        for (unsigned j = 0; j < 16; ++j) { const unsigned c = xb_ld(&bar[XB_XCNT(j)]); sum += c; cnt += (c > 0u) ? 1u : 0u; mine = (j == x) ? c : mine; }
        if (sum == G) break;
        __builtin_amdgcn_s_sleep(1);
        if ((++sp & 255u) == 0u) { if (xb_ld(&bar[XB_TMO])) break; if (sp > XB_SPIN_CAP) { atomicAdd(&bar[XB_TMO], 1u); break; } }
    }
    nloc = mine > 0u ? mine : 1u; nx = cnt > 0u ? cnt : 1u;
}
__device__ __forceinline__ void xcd_barrier(const XcdBarrier& b, unsigned long long* stamp = nullptr) {
    asm volatile("s_waitcnt vmcnt(0)" ::: "memory");
    __syncthreads();
    if (threadIdx.x == 0) {
        unsigned* bar = b.bar;
        __builtin_amdgcn_s_waitcnt(0);
        unsigned nloc = b.st[0], nx = b.st[1];
        if (nloc == 0u) { xcd_barrier_complete(bar, b.x, nloc, nx); b.st[0] = nloc; b.st[1] = nx; }
        const unsigned old = xb_add(&bar[XB_XSUB(b.x)], 1u);
        const unsigned gen = old / nloc;
        if (old + 1u == (gen + 1u) * nloc) {
            __builtin_amdgcn_fence(__ATOMIC_RELEASE, "agent");
            asm volatile("s_waitcnt vmcnt(0)" ::: "memory");
            const unsigned og = xb_add(&bar[XB_TOP], 1u);
            const unsigned tg = og / nx;
            if (og + 1u == (tg + 1u) * nx) xb_add(&bar[XB_TOPGEN], 1u);
            else XB_SPIN(xb_ld(&bar[XB_TOPGEN]) == tg, bar);
            __builtin_amdgcn_fence(__ATOMIC_ACQUIRE, "agent");
            xb_add(&bar[XB_XGEN(b.x)], 1u);
            asm volatile("s_waitcnt vmcnt(0)" ::: "memory");
        } else {
            XB_SPIN(xb_ld(&bar[XB_XGEN(b.x)]) == gen, bar);
            __builtin_amdgcn_fence(__ATOMIC_ACQUIRE, "agent");
            asm volatile("s_waitcnt vmcnt(0)" ::: "memory");
        }
        if (stamp) *stamp = wall_clock64();
    }
    __syncthreads();
}

namespace g8 {
constexpr int BM = 256, BK = 64, HALF = 128, HTB = HALF * BK * 2, STAGE_BYTES = 8 * HTB;
__device__ __forceinline__ int lds_byte(int r, int c) { const int st = (r >> 4) * 2 + (c >> 5), rr = r & 15, cc = c & 31, ob = rr * 64 + cc * 2; return st * 1024 + (ob ^ (((ob >> 9) & 1) << 5)); }
__device__ __forceinline__ void stage_rc(int b, int& R, int& C) { const int st = b / 1024, sb = b % 1024, swz = sb ^ (((sb >> 9) & 1) << 5); R = (st >> 1) * 16 + swz / 64; C = (st & 1) * 32 + (swz % 64) / 2; }
__device__ __forceinline__ int perm32(int rho) { const int n = rho >> 4, i = rho & 15; return 8 * (i >> 2) + 4 * n + (i & 3); }

struct Unit { const char* A; const char* B; const int* gl; int gcount; int kind, p0, p1; };

template <bool GATHER, class Epi, class Sched>
__device__ __forceinline__ void gemm_phase(LAS unsigned char* lds, const int K, const unsigned lda2, const unsigned ldb2, const Sched& S, const Epi& E) {
    int tid = threadIdx.x; asm volatile("" : "+v"(tid));
    const int wid = __builtin_amdgcn_readfirstlane(tid >> 6), lane = tid & 63, wr = wid >> 2, wc = wid & 3, fr = lane & 15, fq = lane >> 4;
    const int nt = K / BK;
    int Rr[2], Cc[2];
    unsigned vB[2];
#pragma unroll
    for (int i = 0; i < 2; ++i) { stage_rc(tid * 16 + i * 8192, Rr[i], Cc[i]); const int Rb = (Rr[i] & ~31) + perm32(Rr[i] & 31); vB[i] = (unsigned)Rb * ldb2 + (unsigned)Cc[i] * 2u; }
    const unsigned hB = (unsigned)HALF * ldb2, hA = (unsigned)HALF * lda2;
    const size_t kstep = (size_t)(BK * 2);
    const unsigned ldsw = (unsigned)wid * 1024u;
    const int aoff = lds_byte(wr * 64 + fr, fq * 8), boff = lds_byte(wc * 32 + fr, fq * 8);
    Unit cur, nxt; int ui = 0;
    if (!S.next(0, cur)) return;
    unsigned vA[2][2], nvA[2][2];
#define G8_CALCVA(u, v) do { _Pragma("unroll") for (int _h = 0; _h < 2; ++_h) _Pragma("unroll") for (int _i = 0; _i < 2; ++_i) { const int _r = _h * HALF + Rr[_i]; \
        if (GATHER) { const int _tok = (_r < (u).gcount) ? ((u).gl[_r] >> 1) : 256;     v[_h][_i] = (unsigned)_tok * lda2 + (unsigned)Cc[_i] * 2u; } \
        else v[_h][_i] = (unsigned)_r * lda2 + (unsigned)Cc[_i] * 2u; } } while (0)
    G8_CALCVA(cur, vA);
#define G8_SA(b, h) (((b) * 2 + (h)) * HTB)
#define G8_SB(b, h) ((4 + (b) * 2 + (h)) * HTB)
#define G8_STAGE_A(bufoff, gbase, VV, hh) do { _Pragma("unroll") for (int _i = 0; _i < 2; ++_i) \
        __builtin_amdgcn_global_load_lds((const unsigned*)(((const char*)(gbase) + (GATHER ? (size_t)0 : (size_t)((hh) * hA))) + VV[GATHER ? (hh) : 0][_i]), (LAS unsigned*)(lds + (bufoff) + ldsw + _i * 8192), 16, 0, 0); } while (0)
#define G8_STAGE_B(bufoff, gbase, h) do { _Pragma("unroll") for (int _i = 0; _i < 2; ++_i) \
        __builtin_amdgcn_global_load_lds((const unsigned*)((const char*)(gbase) + (size_t)((h) * hB) + vB[_i]), (LAS unsigned*)(lds + (bufoff) + ldsw + _i * 8192), 16, 0, 0); } while (0)
#define G8_LDA(dst, b, h) do { _Pragma("unroll") for (int m = 0; m < 4; ++m) _Pragma("unroll") for (int k = 0; k < 2; ++k) dst[m][k] = *(const LAS bf16x8*)(lds + G8_SA(b, h) + aoff + m * 2048 + k * 1024); } while (0)
#define G8_LDB(dst, b, h) do { _Pragma("unroll") for (int n = 0; n < 2; ++n) _Pragma("unroll") for (int k = 0; k < 2; ++k) dst[n][k] = *(const LAS bf16x8*)(lds + G8_SB(b, h) + boff + n * 2048 + k * 1024); } while (0)
#define G8_MMA(ai, bj, At, Bt) do { __builtin_amdgcn_s_setprio(1); _Pragma("unroll") for (int m = 0; m < 4; ++m) _Pragma("unroll") for (int n = 0; n < 2; ++n) _Pragma("unroll") for (int k = 0; k < 2; ++k) \
        acc[ai][bj][m][n] = __builtin_amdgcn_mfma_f32_16x16x32_bf16(Bt[n][k], At[m][k], acc[ai][bj][m][n], 0, 0, 0); __builtin_amdgcn_s_setprio(0); } while (0)
#define G8_WAIT_V(n) asm volatile("s_waitcnt vmcnt(" #n ")" ::: "memory")
#define G8_WAIT_L(n) asm volatile("s_waitcnt lgkmcnt(" #n ")" ::: "memory")
#define G8_BAR __builtin_amdgcn_s_barrier()
#define G8_SCHED __builtin_amdgcn_sched_barrier(0)
    f32x4 acc[2][2][4][2];
#pragma unroll
    for (int a = 0; a < 2; ++a)
#pragma unroll
        for (int b = 0; b < 2; ++b)
#pragma unroll
            for (int m = 0; m < 4; ++m)
#pragma unroll
                for (int n = 0; n < 2; ++n) acc[a][b][m][n] = (f32x4){0.f, 0.f, 0.f, 0.f};
    bf16x8 At[4][2], B0[2][2], B1[2][2];
    const char* cA = cur.A; const char* cB = cur.B;
    G8_STAGE_B(G8_SB(0, 0), cB, 0); G8_STAGE_B(G8_SB(0, 1), cB, 1); G8_STAGE_A(G8_SA(0, 0), cA, vA, 0); G8_STAGE_A(G8_SA(0, 1), cA, vA, 1);
    if (wr == 1) G8_BAR;
    G8_WAIT_V(2); G8_BAR;
    G8_STAGE_B(G8_SB(1, 0), cB + kstep, 0); G8_STAGE_A(G8_SA(1, 0), cA + kstep, vA, 0); G8_STAGE_B(G8_SB(1, 1), cB + kstep, 1);
    G8_WAIT_V(6); G8_BAR;
    for (;;) {
        const bool has_next = S.next(ui + 1, nxt);
        const char* nA = has_next ? nxt.A : cA; const char* nB = has_next ? nxt.B : cB;
        if (GATHER && has_next) { G8_CALCVA(nxt, nvA); } else {
#pragma unroll
            for (int h = 0; h < 2; ++h)
#pragma unroll
                for (int i = 0; i < 2; ++i) nvA[h][i] = vA[h][i]; }
#pragma clang loop unroll(disable)
        for (int t = 0; t < nt; t += 2) {
            const bool last = (t == nt - 2);
            const char* a1 = cA + (size_t)(t + 1) * kstep;
            const char* a2 = last ? nA : cA + (size_t)(t + 2) * kstep; const char* b2 = last ? nB : cB + (size_t)(t + 2) * kstep;
            const char* a3 = a2 + kstep; const char* b3 = b2 + kstep;
            unsigned o2[2][2];
#pragma unroll
            for (int h = 0; h < 2; ++h)
#pragma unroll
                for (int i = 0; i < 2; ++i) o2[h][i] = (GATHER && last) ? nvA[h][i] : vA[h][i];
            G8_LDB(B0, 0, 0); G8_LDB(B1, 0, 1); G8_SCHED; G8_LDA(At, 0, 0); G8_STAGE_A(G8_SA(1, 1), a1, vA, 1);
            G8_WAIT_V(8); G8_WAIT_L(0); G8_BAR; G8_MMA(0, 0, At, B0); G8_MMA(0, 1, At, B1); G8_BAR; G8_SCHED;
            G8_LDA(At, 0, 1); G8_STAGE_B(G8_SB(0, 0), b2, 0); G8_STAGE_B(G8_SB(0, 1), b2, 1); G8_STAGE_A(G8_SA(0, 0), a2, o2, 0);
            G8_WAIT_V(8); G8_WAIT_L(0); G8_BAR; G8_MMA(1, 0, At, B0); G8_MMA(1, 1, At, B1); G8_BAR; G8_SCHED;
            G8_LDB(B0, 1, 0); G8_LDB(B1, 1, 1); G8_SCHED; G8_LDA(At, 1, 0); G8_STAGE_A(G8_SA(0, 1), a2, o2, 1);
            G8_WAIT_V(8); G8_WAIT_L(0); G8_BAR; G8_MMA(0, 0, At, B0); G8_MMA(0, 1, At, B1); G8_BAR; G8_SCHED;
            G8_LDA(At, 1, 1); G8_STAGE_B(G8_SB(1, 0), b3, 0); G8_STAGE_B(G8_SB(1, 1), b3, 1); G8_STAGE_A(G8_SA(1, 0), a3, o2, 0);
            G8_WAIT_V(8); G8_WAIT_L(0); G8_BAR; G8_MMA(1, 0, At, B0); G8_MMA(1, 1, At, B1); G8_BAR; G8_SCHED;
        }
        if (wr == 0) G8_BAR;
        E(acc, cur, wr, wc, fr, fq);
        if (!has_next) break;
#pragma unroll
        for (int a = 0; a < 2; ++a)
#pragma unroll
            for (int b = 0; b < 2; ++b)
#pragma unroll
                for (int m = 0; m < 4; ++m)
#pragma unroll
                    for (int n = 0; n < 2; ++n) acc[a][b][m][n] = (f32x4){0.f, 0.f, 0.f, 0.f};
        cur = nxt; cA = nA; cB = nB; ++ui;
#pragma unroll
        for (int h = 0; h < 2; ++h)
#pragma unroll
            for (int i = 0; i < 2; ++i) vA[h][i] = nvA[h][i];
        if (wr == 1) G8_BAR;
    }
    G8_WAIT_V(0);
    G8_BAR;
#undef G8_CALCVA
#undef G8_SA
#undef G8_SB
#undef G8_STAGE_A
#undef G8_STAGE_B
#undef G8_LDA
#undef G8_LDB
#undef G8_MMA
#undef G8_WAIT_V
#undef G8_WAIT_L
#undef G8_BAR
#undef G8_SCHED
}
}
namespace mk {
constexpr int NB = 16, S = 2048, L = 256, D = 1024, RB = L + S, NTOK = NB * RB;
constexpr int QKVW = 2304, CW = 1280, MODW = 6 * D, CAP = NTOK, NPAIR = 2 * NTOK, SORT_ROWS = NPAIR + 16 * 256;
constexpr float ALPHA = 1.41421356237309515f, EPS = 1e-5f, QSCALE = 0.125f * 1.4426950408889634f;
constexpr size_t al256(size_t x) { return (x + 255) & ~(size_t)255; }
constexpr size_t CTL_BYTES = 65536, CTL_BAR_STRIDE = 13824  , CTL_CNT = 57344  ;
constexpr size_t OFF_MOD = CTL_BYTES, SZ_MOD = (size_t)2 * 17 * MODW * 4;
constexpr size_t OFF_LAM = OFF_MOD + al256(SZ_MOD);
constexpr size_t OFF_RC = OFF_LAM + 256, OFF_RS = OFF_RC + 4096;
constexpr size_t OFF_MH = OFF_RS + 4096, SZ_MH = (size_t)2 * 2 * 4 * 64 * 64 * 4;
constexpr size_t OFF_TABL = OFF_MH + SZ_MH, SZ_TABL = (size_t)2 * S * S * 2;
constexpr size_t OFF_TABC = OFF_TABL + SZ_TABL, SZ_TABC = (size_t)2 * L * L * 2;
constexpr size_t OFF_WQKV = OFF_TABC + SZ_TABC, SZ_WQKV = (size_t)2 * QKVW * D * 2;
constexpr size_t OFF_WU = OFF_WQKV + SZ_WQKV, SZ_WU = (size_t)2 * 512 * D * 2;
constexpr size_t OFF_WOUT = OFF_WU + SZ_WU, SZ_WOUT = (size_t)2 * D * CW * 2;
constexpr size_t OFF_LIST = OFF_WOUT + SZ_WOUT, SZ_LIST = (size_t)16 * CAP * 4;
constexpr size_t OFF_WPAIR = OFF_LIST + SZ_LIST, SZ_WPAIR = (size_t)16 * CAP * 4;
constexpr size_t OFF_SELN = OFF_WPAIR + SZ_WPAIR, SZ_SELN = (size_t)NTOK * 16;
constexpr size_t OFF_RES = OFF_SELN + SZ_SELN, SZ_RES = (size_t)NTOK * D * 2;
constexpr size_t OFF_ARENA = OFF_RES + SZ_RES;
constexpr size_t SZ_H = (size_t)NTOK * D * 2, SZ_CC = (size_t)NTOK * CW * 2, SZ_QKV = (size_t)NTOK * QKVW * 2, SZ_UTL = (size_t)NB * 2 * 256 * S * 2, SZ_UTC = (size_t)NB * 2 * 256 * L * 2;
constexpr size_t SZ_ASORT = (size_t)SORT_ROWS * 512 * 2, SZ_Y2 = (size_t)NPAIR * D * 2, SZ_WGU = (size_t)16 * 1024 * 1024 * 2, SZ_WD = (size_t)16 * 1024 * 512 * 2;
constexpr size_t AR_H = 0, AR_CC = 0, AR_QKV = SZ_CC, AR_UTL = AR_QKV + SZ_QKV, AR_UTC = AR_UTL + SZ_UTL, AR_O = SZ_CC, AR_ASORT = 0, AR_Y2 = SZ_ASORT, AR_WGU = AR_Y2 + SZ_Y2, AR_WD = AR_WGU + SZ_WGU;
constexpr size_t SZ_ARENA = (AR_UTC + SZ_UTC) > (AR_WD + SZ_WD) ? (AR_UTC + SZ_UTC) : (AR_WD + SZ_WD);
constexpr size_t WS_NEED = OFF_ARENA + SZ_ARENA;
static_assert(AR_ASORT + SZ_ASORT <= AR_O, "ASORT must not overlap O/H2");
static_assert(AR_WGU >= AR_O + SZ_H, "MoE weights must not overlap O/H2");
static_assert(AR_H + SZ_H <= AR_Y2, "next layer's H must not overlap Y2");
constexpr int LDS_MISC = 131072, LDS_ROPE = LDS_MISC + 4096  , LDS_BYTES = LDS_ROPE + 8192;

struct Args {
    const float* in[20]; float* out; unsigned char* ws; int ph_lo, ph_hi, li, rep_attn; int rep[16]; int attn_var, pad2;
};
enum { I_X = 0, I_C, I_CTX, I_CCTX, I_WMOD, I_BMOD, I_WIN, I_WF, I_LAMQK, I_SUBLN, I_WOUT, I_LNAG, I_LNAB, I_LNFG, I_LNFB, I_WR, I_RB, I_WG, I_WUP, I_WDN };

template <class T> __device__ __forceinline__ T* wsp(const Args& a, size_t off) { return (T*)(a.ws + off); }

__device__ __forceinline__ float wave_sum(float v) {
    v += __builtin_bit_cast(float, __builtin_amdgcn_update_dpp(0, __builtin_bit_cast(int, v), 0xB1, 0xF, 0xF, true));
    v += __builtin_bit_cast(float, __builtin_amdgcn_update_dpp(0, __builtin_bit_cast(int, v), 0x4E, 0xF, 0xF, true));
    v += __builtin_bit_cast(float, __builtin_amdgcn_update_dpp(0, __builtin_bit_cast(int, v), 0x124, 0xF, 0xF, true));
    v += __builtin_bit_cast(float, __builtin_amdgcn_update_dpp(0, __builtin_bit_cast(int, v), 0x128, 0xF, 0xF, true));
    const int vi = __builtin_bit_cast(int, v);
    return (__builtin_bit_cast(float, __builtin_amdgcn_readlane(vi, 0)) + __builtin_bit_cast(float, __builtin_amdgcn_readlane(vi, 16))) +
           (__builtin_bit_cast(float, __builtin_amdgcn_readlane(vi, 32)) + __builtin_bit_cast(float, __builtin_amdgcn_readlane(vi, 48)));
}
__device__ __forceinline__ float wave_sum16(const float (&s)[16], int lane) {
#define MK_DPPF(x, ctl) __builtin_bit_cast(float, __builtin_amdgcn_update_dpp(0, __builtin_bit_cast(int, (x)), (ctl), 0xF, 0xF, true))
    float t[8], u[4], w[2];
#pragma unroll
    for (int j = 0; j < 8; ++j) { auto r = __builtin_amdgcn_permlane32_swap(__float_as_uint(s[j]), __float_as_uint(s[j + 8]), false, false); t[j] = __uint_as_float(r[0]) + __uint_as_float(r[1]); }
#pragma unroll
    for (int j = 0; j < 4; ++j) { auto r = __builtin_amdgcn_permlane16_swap(__float_as_uint(t[j]), __float_as_uint(t[j + 4]), false, false); u[j] = __uint_as_float(r[0]) + __uint_as_float(r[1]); }
    const bool b3 = (lane & 8) != 0, b2 = (lane & 4) != 0;
#pragma unroll
    for (int j = 0; j < 2; ++j) { const float p = u[j] + MK_DPPF(u[j], 0x128), q = u[j + 2] + MK_DPPF(u[j + 2], 0x128); w[j] = b3 ? q : p; }
    float z; { const float p = w[0] + MK_DPPF(w[0], 0x141), q = w[1] + MK_DPPF(w[1], 0x141); z = b2 ? q : p; }
    z += MK_DPPF(z, 0xB1); z += MK_DPPF(z, 0x4E);
#undef MK_DPPF
    return z;
}
struct Row { f32x4 v[4]; };
__device__ __forceinline__ Row row_load(const float* p, int lane) { Row r;
#pragma unroll
    for (int i = 0; i < 4; ++i) r.v[i] = *(const f32x4*)(p + i * 256 + lane * 4);
    return r; }
__device__ __forceinline__ void row_store(float* p, int lane, const Row& r) {
#pragma unroll
    for (int i = 0; i < 4; ++i) *(f32x4*)(p + i * 256 + lane * 4) = r.v[i]; }
__device__ __forceinline__ Row row_load_bf16(const bf16_t* p, int lane) { Row r;
#pragma unroll
    for (int i = 0; i < 4; ++i) { const u32x2 w = *(const u32x2*)(p + i * 256 + lane * 4); r.v[i] = (f32x4){bf_lo(w.x), bf_hi(w.x), bf_lo(w.y), bf_hi(w.y)}; }
    return r; }
struct RowB { u32x2 w[4]; };
__device__ __forceinline__ RowB rowb_load(const bf16_t* p, int lane) { RowB r;
#pragma unroll
    for (int i = 0; i < 4; ++i) r.w[i] = *(const u32x2*)(p + i * 256 + lane * 4);
    return r; }
__device__ __forceinline__ Row rowb_f32(const RowB& b) { Row r;
#pragma unroll
    for (int i = 0; i < 4; ++i) r.v[i] = (f32x4){bf_lo(b.w[i].x), bf_hi(b.w[i].x), bf_lo(b.w[i].y), bf_hi(b.w[i].y)};
    return r; }
__device__ __forceinline__ void row_store_bf16(bf16_t* p, int lane, const Row& r) {
#pragma unroll
    for (int i = 0; i < 4; ++i) { u32x2 w; w.x = cvtpk(r.v[i][0], r.v[i][1]); w.y = cvtpk(r.v[i][2], r.v[i][3]); *(u32x2*)(p + i * 256 + lane * 4) = w; } }
__device__ __forceinline__ void row_ln(Row& r) {
    float s = 0.f;
#pragma unroll
    for (int i = 0; i < 4; ++i) s += (r.v[i][0] + r.v[i][1]) + (r.v[i][2] + r.v[i][3]);
    const float mean = wave_sum(s) * (1.f / 1024.f);
    float q = 0.f;
#pragma unroll
    for (int i = 0; i < 4; ++i) { r.v[i] = r.v[i] - mean; q += (r.v[i][0] * r.v[i][0] + r.v[i][1] * r.v[i][1]) + (r.v[i][2] * r.v[i][2] + r.v[i][3] * r.v[i][3]); }
    const float rstd = rsqrtf(wave_sum(q) * (1.f / 1024.f) + EPS);
#pragma unroll
    for (int i = 0; i < 4; ++i) r.v[i] = r.v[i] * rstd;
}
__device__ __forceinline__ bf16_t* res_ptr(const Args& a, int row) { return wsp<bf16_t>(a, OFF_RES) + (size_t)row * D; }
__device__ __forceinline__ float* out_ptr(const Args& a, int row) { const int b = row / RB, j = row - b * RB; return a.out + ((size_t)b * S + (j - L)) * D; }
__device__ __forceinline__ const float* xin_ptr(const Args& a, int row) { const int b = row / RB, j = row - b * RB; return j < L ? a.in[I_CTX] + ((size_t)b * L + j) * D : a.in[I_X] + ((size_t)b * S + (j - L)) * D; }
__device__ __forceinline__ int thin_row(int i, bool last) { return last ? ((i >> 11) * RB + L + (i & 2047)) : i; }

__device__ __forceinline__ void tr_item(const float* __restrict__ src, size_t ld_src, bf16_t* __restrict__ dst, size_t ld_dst, int lane) {
    float v[64];
#pragma unroll
    for (int r = 0; r < 64; ++r) v[r] = __builtin_nontemporal_load(src + (size_t)r * ld_src + lane);
    bf16_t* d = dst + (size_t)lane * ld_dst;
#pragma unroll
    for (int q = 0; q < 8; ++q) { u32x4 w; w.x = cvtpk(v[q * 8 + 0], v[q * 8 + 1]); w.y = cvtpk(v[q * 8 + 2], v[q * 8 + 3]); w.z = cvtpk(v[q * 8 + 4], v[q * 8 + 5]); w.w = cvtpk(v[q * 8 + 6], v[q * 8 + 7]); *(u32x4*)(d + q * 8) = w; }
}

__device__ __forceinline__ void phase0a(const Args& a, LAS unsigned char* lds) {
    int tid = threadIdx.x; asm volatile("" : "+v"(tid));
    const int lane = tid & 63, wid = __builtin_amdgcn_readfirstlane(tid >> 6), blk = blockIdx.x, G = gridDim.x, gw = blk * 8 + wid, nw = G * 8, gt = blk * 512 + tid, ntr = G * 512;
    if (blk < 192) {
        LAS float* SIL = (LAS float*)lds; LAS float* red = (LAS float*)(lds + 69632);
        for (int i = tid; i < 17 * 1024; i += 512) { const float x = i < 16 * 1024 ? a.in[I_C][i] : a.in[I_CCTX][i - 16 * 1024]; SIL[i] = x / (1.f + __expf(-x)); }
        __syncthreads();
        for (int item = blk; item < 192; item += G) {
            const int l = item / 96, cg = item - l * 96, n = cg * 64 + lane;
            float acc[17];
#pragma unroll
            for (int r = 0; r < 17; ++r) acc[r] = 0.f;
            const float* w = a.in[I_WMOD] + (size_t)l * D * MODW;
            float wn[8];
#pragma unroll
            for (int q = 0; q < 8; ++q) wn[q] = (w + (size_t)(wid * 128 + q) * MODW)[n];
            for (int k0 = wid * 128; k0 < wid * 128 + 128; k0 += 8) {
                float wv[8];
#pragma unroll
                for (int q = 0; q < 8; ++q) wv[q] = wn[q];
                if (k0 + 8 < wid * 128 + 128) {
#pragma unroll
                    for (int q = 0; q < 8; ++q) wn[q] = __builtin_nontemporal_load(w + (size_t)(k0 + 8 + q) * MODW + n); }
#pragma unroll
                for (int r = 0; r < 17; ++r) { const f32x4 s0 = *(const LAS f32x4*)(SIL + r * 1024 + k0), s1 = *(const LAS f32x4*)(SIL + r * 1024 + k0 + 4);
                    acc[r] += ((s0[0] * wv[0] + s0[1] * wv[1]) + (s0[2] * wv[2] + s0[3] * wv[3])) + ((s1[0] * wv[4] + s1[1] * wv[5]) + (s1[2] * wv[6] + s1[3] * wv[7])); }
            }
#pragma unroll
            for (int r = 0; r < 17; ++r) red[(wid * 17 + r) * 64 + lane] = acc[r];
            __syncthreads();
            if (wid == 0) {
#pragma unroll
                for (int r = 0; r < 17; ++r) { float s = a.in[I_BMOD][(size_t)l * MODW + n];
#pragma unroll
                    for (int q = 0; q < 8; ++q) s += red[(q * 17 + r) * 64 + lane];
                    wsp<float>(a, OFF_MOD)[((size_t)l * 17 + r) * MODW + n] = s; }
            }
            __syncthreads();
        }
    }
    for (int it = gw; it < 1152 + 128 + 384; it += nw) {
        if (it < 1152) { const int l = it / 576, r = it - l * 576, kb = r / 36, nb = r - kb * 36;
            tr_item(a.in[I_WIN] + (size_t)l * D * 2560 + (size_t)(kb * 64) * 2560 + 256 + nb * 64, 2560, wsp<bf16_t>(a, OFF_WQKV) + ((size_t)l * QKVW + nb * 64) * D + kb * 64, D, lane);
        } else if (it < 1152 + 128) { const int q = it - 1152, l = q >> 6, r = q & 63, kb = r >> 2, nb = r & 3;
            tr_item(a.in[I_WIN] + (size_t)l * D * 2560 + (size_t)(kb * 64) * 2560 + nb * 64, 2560, wsp<bf16_t>(a, OFF_WU) + ((size_t)l * 256 + nb * 64) * D + kb * 64, D, lane);
        } else { const int q = it - 1280, l = q / 192, r = q - l * 192, kb = 4 + (r >> 4), nb = r & 15;
            const float* src = a.in[I_WOUT] + (size_t)l * D * D + (size_t)(kb * 64) * D + nb * 64;
            bf16_t* dst = wsp<bf16_t>(a, OFF_WOUT) + ((size_t)l * D + nb * 64) * CW;
            tr_item(src, D, dst + kb * 64 + 256, CW, lane);
        }
    }
    {
        const float nl = 0.0027621358640099515f  , nc = 0.0078125f  ;
        bf16_t* TL = wsp<bf16_t>(a, OFF_TABL); bf16_t* TC = wsp<bf16_t>(a, OFF_TABC);
        for (int it = gt; it < S * (S / 8) + L * (L / 8); it += ntr) {
            int T, tp, t0; float nn; bf16_t* base;
            if (it < S * (S / 8)) { T = S; tp = it / (S / 8); t0 = (it - tp * (S / 8)) * 8; nn = nl; base = TL; }
            else { const int q = it - S * (S / 8); T = L; tp = q / (L / 8); t0 = (q - tp * (L / 8)) * 8; nn = nc; base = TC; }
            float cv[8], sv[8];
#pragma unroll
            for (int j = 0; j < 8; ++j) { const int m = ((t0 + j) * tp) & (T - 1); const float x = 2.f * (float)m / (float)T; cv[j] = cospif(x) * nn; sv[j] = -sinpif(x) * nn; }
            u32x4 wc, wsn; wc.x = cvtpk(cv[0], cv[1]); wc.y = cvtpk(cv[2], cv[3]); wc.z = cvtpk(cv[4], cv[5]); wc.w = cvtpk(cv[6], cv[7]);
            wsn.x = cvtpk(sv[0], sv[1]); wsn.y = cvtpk(sv[2], sv[3]); wsn.z = cvtpk(sv[4], sv[5]); wsn.w = cvtpk(sv[6], sv[7]);
            *(u32x4*)(base + (size_t)tp * T + t0) = wc; *(u32x4*)(base + (size_t)T * T + (size_t)tp * T + t0) = wsn;
        }
    }
    for (int i = gt; i < 65536 + 1024 + 2; i += ntr) {
        if (i < 65536) { const int d = i & 63, c = (i >> 6) & 63, g = (i >> 12) & 3, half = (i >> 14) & 1, l = i >> 15;
            const float* wf = a.in[I_WF] + ((size_t)(l * 4 + g) * 64) * 64 + d; float s = 0.f;
            for (int cp = 0; cp < 64; ++cp) { const int m = (c * cp) & 63; const float x = (float)m * (1.f / 32.f); s += (half ? sinpif(x) : cospif(x)) * wf[cp * 64]; }
            wsp<float>(a, OFF_MH)[i] = s;
        } else if (i < 65536 + 1024) { const int q = i - 65536, pos = q >> 4, f = q & 15; const float ang = (float)pos * powf(10000.f, -(float)f / 16.f);
            wsp<float>(a, OFF_RC)[q] = cosf(ang); wsp<float>(a, OFF_RS)[q] = sinf(ang);
        } else { const int l = i - 65536 - 1024; const float* q = a.in[I_LAMQK] + l * 256; float s1 = 0.f, s2 = 0.f;
            for (int k = 0; k < 64; ++k) { s1 += q[k] * q[64 + k]; s2 += q[128 + k] * q[192 + k]; }
            wsp<float>(a, OFF_LAM)[l] = expf(s1) - expf(s2) + (0.8f - 0.6f * expf(-0.3f * (float)l)); }
    }
}

__device__ __forceinline__ void h_from_row(const Args& a, Row& r, int row, int l, int sh_off, int sc_off, int lane) {
    row_ln(r);
    const int b = row / RB, j = row - b * RB;
    const float* mrow = wsp<float>(a, OFF_MOD) + ((size_t)l * 17 + (j < L ? 16 : b)) * MODW;
    const Row sh = row_load(mrow + sh_off, lane), sc = row_load(mrow + sc_off, lane);
#pragma unroll
    for (int i = 0; i < 4; ++i) r.v[i] = r.v[i] * (1.f + sc.v[i]) + sh.v[i];
}
__device__ __forceinline__ void h_from_row2(Row& r, const Row& sh, const Row& sc) {
    row_ln(r);
#pragma unroll
    for (int i = 0; i < 4; ++i) r.v[i] = r.v[i] * (1.f + sc.v[i]) + sh.v[i];
}
__device__ __forceinline__ const float* mod_row(const Args& a, int l, int row) { const int b = row / RB, j = row - b * RB; return wsp<float>(a, OFF_MOD) + ((size_t)l * 17 + (j < L ? 16 : b)) * MODW; }
__device__ __forceinline__ void phase0b(const Args& a) {
    int tid = threadIdx.x; asm volatile("" : "+v"(tid));
    const int lane = tid & 63, wid = __builtin_amdgcn_readfirstlane(tid >> 6), gw = blockIdx.x * 8 + wid, nw = gridDim.x * 8;
    {
        Row xA = {}, xB = {};
        auto proc = [&](Row& xr, const int row) __attribute__((always_inline)) {
            const float* mrow = mod_row(a, 0, row);
            const Row sh = row_load(mrow + 0, lane), sc = row_load(mrow + 1024, lane);
            Row r = xr;
            if (row + 2 * nw < NTOK) xr = row_load(xin_ptr(a, row + 2 * nw), lane);
            h_from_row2(r, sh, sc);
            row_store_bf16(wsp<bf16_t>(a, OFF_ARENA + AR_H) + (size_t)row * D, lane, r);
        };
        int row = gw;
        if (row < NTOK) xA = row_load(xin_ptr(a, row), lane);
        if (row + nw < NTOK) xB = row_load(xin_ptr(a, row + nw), lane);
        for (; row < NTOK; row += 2 * nw) { proc(xA, row); if (row + nw < NTOK) proc(xB, row + nw); }
    }
    for (int it = gw; it < 1024; it += nw) {
        const int l = it >> 9, half = (it >> 8) & 1, g = (it >> 6) & 3, nb = (it >> 2) & 15, cb = it & 3, n = nb * 64 + lane;
        const float* wcol = a.in[I_WOUT] + (size_t)l * D * D + (size_t)(g * 64) * D + n;
        float wv[64];
#pragma unroll
        for (int d = 0; d < 64; ++d) wv[d] = (a.in[I_WOUT] + (size_t)l * D * D + (size_t)(g * 64 + d) * D)[n];
        const float* mh = wsp<float>(a, OFF_MH) + ((size_t)((l * 2 + half) * 4 + g) * 64 + cb * 16) * 64;
        float acc[16];
#pragma unroll
        for (int c = 0; c < 16; ++c) { float s_ = 0.f;
#pragma unroll
            for (int d4 = 0; d4 < 16; ++d4) { const f32x4 m = *(const f32x4*)(mh + c * 64 + d4 * 4); s_ += (m[0] * wv[d4 * 4 + 0] + m[1] * wv[d4 * 4 + 1]) + (m[2] * wv[d4 * 4 + 2] + m[3] * wv[d4 * 4 + 3]); }
            acc[c] = s_; }
        (void)wcol;
        bf16_t* dst = wsp<bf16_t>(a, OFF_WOUT) + ((size_t)l * D + n) * CW + half * 256 + g * 64 + cb * 16;
        u32x4 w0, w1; w0.x = cvtpk(acc[0], acc[1]); w0.y = cvtpk(acc[2], acc[3]); w0.z = cvtpk(acc[4], acc[5]); w0.w = cvtpk(acc[6], acc[7]);
        w1.x = cvtpk(acc[8], acc[9]); w1.y = cvtpk(acc[10], acc[11]); w1.z = cvtpk(acc[12], acc[13]); w1.w = cvtpk(acc[14], acc[15]);
        *(u32x4*)dst = w0; *(u32x4*)(dst + 8) = w1;
    }
}

struct SchedInproj {
    const char* H; const char* WQ; const char* WUp; int G, c; bool last;
    __device__ __forceinline__ bool next(int i, g8::Unit& u) const {
        const int Lu = i * G + c, nq = last ? 1248 : 1296, nu = last ? 128 : 144;
        u.gl = nullptr; u.gcount = 0;
        if (Lu < nq) { int pm, pn;
            if (!last) { const int grp = Lu / 72, w = Lu - grp * 72; pm = grp * 8 + (w & 7); pn = w >> 3; }
            else if (Lu < 1152) { const int grp = Lu / 72, w = Lu - grp * 72, q = grp * 8 + (w & 7); pm = (q >> 3) * 9 + 1 + (q & 7); pn = w >> 3; }
            else { const int q = Lu - 1152; pm = (q & 15) * 9; pn = 3 + (q >> 4); }
            u.A = H + (size_t)pm * 256 * 2048; u.B = WQ + (size_t)pn * 256 * 2048; u.kind = 0; u.p0 = pm; u.p1 = pn; return true; }
        const int q = Lu - nq;
        if (q < nu) { const int tt = q, pmT = last ? ((tt >> 3) * 9 + 1 + (tt & 7)) : tt;
            u.A = WUp; u.B = H + (size_t)pmT * 256 * 2048; u.kind = 1; u.p0 = 0; u.p1 = pmT; return true; }
        return false;
    }
};
struct EpiInproj {
    bf16_t* QKV; bf16_t* UTL; bf16_t* UTC; const LAS float* RC; const LAS float* RS;
    __device__ __forceinline__ void operator()(const f32x4 (&acc)[2][2][4][2], const g8::Unit& u, int wr, int wc, int fr, int fq) const {
        if (u.kind == 0) {
            const int pm = u.p0, pn = u.p1, b = pm / 9, jt = pm - b * 9;
            const bool rope = (jt != 0) && (pn < 6);
            const float qs = pn < 3 ? QSCALE : 1.f, sgn = (fq & 2) ? 1.f : -1.f;
#pragma unroll
            for (int ai = 0; ai < 2; ++ai)
#pragma unroll
                for (int m = 0; m < 4; ++m) {
                    const int r = 128 * ai + 64 * wr + 16 * m + fr;
                    bf16_t* rowp = QKV + (size_t)(pm * 256 + r) * QKVW + pn * 256 + 32 * wc + 8 * fq;
                    f32x4 c0 = {1.f, 1.f, 1.f, 1.f}, c1 = c0, s0 = {0.f, 0.f, 0.f, 0.f}, s1 = s0;
                    if (rope) { const int t = (jt - 1) * 256 + r, pos = (wc & 1) ? (t & 63) : (t >> 6); const LAS float* cp = RC + pos * 16 + 8 * (fq & 1); const LAS float* sp = RS + pos * 16 + 8 * (fq & 1);
                        c0 = *(const LAS f32x4*)cp; c1 = *(const LAS f32x4*)(cp + 4); s0 = *(const LAS f32x4*)sp; s1 = *(const LAS f32x4*)(sp + 4); }
#pragma unroll
                    for (int bj = 0; bj < 2; ++bj) {
                        f32x4 v0 = acc[ai][bj][m][0], v1 = acc[ai][bj][m][1];
                        if (rope) { f32x4 p0, p1;
#pragma unroll
                            for (int j = 0; j < 4; ++j) {
                                auto ra = __builtin_amdgcn_permlane32_swap(__float_as_uint(v0[j]), __float_as_uint(v0[j]), false, false);
                                auto rb = __builtin_amdgcn_permlane32_swap(__float_as_uint(v1[j]), __float_as_uint(v1[j]), false, false);
                                p0[j] = __uint_as_float((fq & 2) ? ra[0] : ra[1]); p1[j] = __uint_as_float((fq & 2) ? rb[0] : rb[1]); }
                            v0 = v0 * c0 + (p0 * s0) * sgn; v1 = v1 * c1 + (p1 * s1) * sgn; }
                        v0 = v0 * qs; v1 = v1 * qs;
                        u32x4 w; w.x = cvtpk(v0[0], v0[1]); w.y = cvtpk(v0[2], v0[3]); w.z = cvtpk(v1[0], v1[1]); w.w = cvtpk(v1[2], v1[3]);
                        *(u32x4*)(rowp + bj * 128) = w; }
                }
        } else {
            const int pmT = u.p1, b = pmT / 9, jt = pmT - b * 9;
#pragma unroll
            for (int ai = 0; ai < 2; ++ai)
#pragma unroll
                for (int m = 0; m < 4; ++m) {
                    const int r = 128 * ai + 64 * wr + 16 * m + fr, col = 32 * wc + 8 * fq;
                    bf16_t* rowp = (jt == 0) ? UTC + ((size_t)(b * 256 + r)) * L + col : UTL + ((size_t)(b * 256 + r)) * S + (jt - 1) * 256 + col;
#pragma unroll
                    for (int bj = 0; bj < 2; ++bj) { const f32x4 v0 = acc[ai][bj][m][0], v1 = acc[ai][bj][m][1];
                        u32x4 w; w.x = cvtpk(v0[0], v0[1]); w.y = cvtpk(v0[2], v0[3]); w.z = cvtpk(v1[0], v1[1]); w.w = cvtpk(v1[2], v1[3]);
                        *(u32x4*)(rowp + bj * 128) = w; }
                }
        }
    }
};
struct EpiStore {
    bf16_t* dst; int ld;
    __device__ __forceinline__ void operator()(const f32x4 (&acc)[2][2][4][2], const g8::Unit& u, int wr, int wc, int fr, int fq) const {
#pragma unroll
        for (int ai = 0; ai < 2; ++ai)
#pragma unroll
            for (int m = 0; m < 4; ++m) { const int r = 128 * ai + 64 * wr + 16 * m + fr;
                bf16_t* rowp = dst + (size_t)(u.p0 + r) * ld + u.p1 + 32 * wc + 8 * fq;
#pragma unroll
                for (int bj = 0; bj < 2; ++bj) { const f32x4 v0 = acc[ai][bj][m][0], v1 = acc[ai][bj][m][1];
                    u32x4 w; w.x = cvtpk(v0[0], v0[1]); w.y = cvtpk(v0[2], v0[3]); w.z = cvtpk(v1[0], v1[1]); w.w = cvtpk(v1[2], v1[3]);
                    *(u32x4*)(rowp + bj * 128) = w; } }
    }
};
struct SchedFourier {
    const char* TAB; const char* UT; int G, c; bool ctx;
    __device__ __forceinline__ bool next(int i, g8::Unit& u) const {
        const int Lu = i * G + c; u.gl = nullptr; u.gcount = 0; u.kind = 2;
        if (!ctx) { if (Lu >= 256) return false; const int pm = Lu & 7, half = (Lu >> 3) & 1, b = Lu >> 4;
            u.A = TAB + ((size_t)half * S + pm * 256) * S * 2; u.B = UT + ((size_t)b * 256) * S * 2; u.p0 = b * RB + L + pm * 256; u.p1 = half * 256; return true; }
        if (Lu >= 32) return false; { const int half = Lu & 1, b = Lu >> 1;
            u.A = TAB + ((size_t)half * L) * L * 2; u.B = UT + ((size_t)b * 256) * L * 2; u.p0 = b * RB; u.p1 = half * 256; return true; }
    }
};
struct SchedOutproj {
    const char* CC; const char* W; int G, c; bool last;
    __device__ __forceinline__ bool next(int i, g8::Unit& u) const {
        const int Lu = i * G + c, n = last ? 512 : 576; if (Lu >= n) return false;
        const int grp = Lu >> 5, w = Lu & 31, q = grp * 8 + (w & 7), pn = w >> 3, pm = last ? ((q >> 3) * 9 + 1 + (q & 7)) : q;
        u.gl = nullptr; u.gcount = 0; u.kind = 2; u.A = CC + (size_t)pm * 256 * CW * 2; u.B = W + (size_t)pn * 256 * CW * 2; u.p0 = pm * 256; u.p1 = pn * 256; return true;
    }
};
struct SchedMoe {
    const LAS int* pre; const LAS int* cnt; const int* LIST; const char* Abase; const char* Wbase; size_t wstride; unsigned arow2, wtile2; int G, c; bool gather;
    __device__ __forceinline__ bool next(int i, g8::Unit& u) const {
        const int Lu = i * G + c, rt = Lu >> 2, pn = Lu & 3; if (rt >= pre[16]) return false;
        int e = 0;
#pragma unroll
        for (int q = 1; q < 16; ++q) e += (rt >= pre[q]) ? 1 : 0;
        const int lt = rt - pre[e], rem = cnt[e] - lt * 256;
        u.gl = LIST + (size_t)e * CAP + lt * 256; u.gcount = rem < 256 ? rem : 256; u.kind = 3; u.p0 = rt; u.p1 = pn;
        u.A = gather ? Abase : Abase + (size_t)rt * 256 * arow2; u.B = Wbase + (size_t)e * wstride + (size_t)pn * wtile2; return true;
    }
};
struct EpiGateUp {
    bf16_t* ASORT;
    __device__ __forceinline__ void operator()(const f32x4 (&acc)[2][2][4][2], const g8::Unit& u, int wr, int wc, int fr, int fq) const {
#pragma unroll
        for (int ai = 0; ai < 2; ++ai)
#pragma unroll
            for (int m = 0; m < 4; ++m) { const int r = 128 * ai + 64 * wr + 16 * m + fr;
                float o[8];
#pragma unroll
                for (int n = 0; n < 2; ++n)
#pragma unroll
                    for (int j = 0; j < 4; ++j) { const float g = acc[ai][0][m][n][j], up = acc[ai][1][m][n][j]; o[n * 4 + j] = g * __builtin_amdgcn_rcpf(1.f + __expf(-g)) * up; }
                u32x4 w; w.x = cvtpk(o[0], o[1]); w.y = cvtpk(o[2], o[3]); w.z = cvtpk(o[4], o[5]); w.w = cvtpk(o[6], o[7]);
                *(u32x4*)(ASORT + (size_t)(u.p0 * 256 + r) * 512 + u.p1 * 128 + 32 * wc + 8 * fq) = w; }
    }
};
struct EpiDown {
    bf16_t* Y2; const int* LIST; const float* WLIST;
    __device__ __forceinline__ void operator()(const f32x4 (&acc)[2][2][4][2], const g8::Unit& u, int wr, int wc, int fr, int fq) const {
        const float* wl = WLIST + (u.gl - LIST);
#pragma unroll
        for (int ai = 0; ai < 2; ++ai) {
            int pr[4]; float wg[4];
#pragma unroll
            for (int m = 0; m < 4; ++m) { const int r = 128 * ai + 64 * wr + 16 * m + fr; const bool ok = r < u.gcount; pr[m] = ok ? u.gl[r] : -1; wg[m] = ok ? wl[r] : 0.f; }
#pragma unroll
            for (int m = 0; m < 4; ++m) { const int pair = pr[m]; const float wgt = wg[m];
                if (pair >= 0) {
                    bf16_t* rowp = Y2 + (size_t)pair * D + u.p1 * 256 + 32 * wc + 8 * fq;
#pragma unroll
                    for (int bj = 0; bj < 2; ++bj) { const f32x4 v0 = acc[ai][bj][m][0] * wgt, v1 = acc[ai][bj][m][1] * wgt;
                        u32x4 w; w.x = cvtpk(v0[0], v0[1]); w.y = cvtpk(v0[2], v0[3]); w.z = cvtpk(v1[0], v1[1]); w.w = cvtpk(v1[2], v1[3]);
                        *(u32x4*)(rowp + bj * 128) = w; } } }
        }
    }
};

template <int N> struct IC { static constexpr int value = N; };
struct AttnUnit { int q_row0, key_row0, ntiles, h; };
__device__ __forceinline__ bool attn_next(int i, int v, int G, bool last, AttnUnit& u) {
    const int nl = (1536 - v + G - 1) / G;
    if (i < nl) { const int id = v + i * G, bh = id >> 4, qt = id & 15, b = bh / 6; u.h = bh - b * 6; u.q_row0 = b * RB + L + qt * 128; u.key_row0 = b * RB; u.ntiles = 36; return true; }
    if (last) return false;
    const int id = v + (i - nl) * G; if (id >= 192) return false;
    { const int bh = id >> 1, qt = id & 1, b = bh / 6; u.h = bh - b * 6; u.q_row0 = b * RB + qt * 128; u.key_row0 = b * RB; u.ntiles = 4; return true; }
}
#if defined(MK_ATTN_PROBE)
#define AT_VAR_DECL const int var = var_
#else
#define AT_VAR_DECL constexpr int var = 0
#endif
__device__ __forceinline__ void phase_attn(const Args& a, LAS unsigned char* lds, int l, const int var_) {
    AT_VAR_DECL;
    const bool last = (l == 1);
    const int c = blockIdx.x, G = gridDim.x, v = (c & 7) * (G >> 3) + (c >> 3);
    const bf16_t* __restrict__ QKV = wsp<bf16_t>(a, OFF_ARENA + AR_QKV); bf16_t* __restrict__ CC = wsp<bf16_t>(a, OFF_ARENA + AR_CC);
    const float lam = wsp<float>(a, OFF_LAM)[l], oml = 1.f - (0.8f - 0.6f * expf(-0.3f * (float)l));
    int tid = threadIdx.x; asm volatile("" : "+v"(tid));
    if (tid < 128) ((LAS float*)(lds + LDS_MISC + 3072))[tid] = a.in[I_SUBLN][l * 128 + tid];
    __syncthreads();
    const int lane = tid & 63, wid = __builtin_amdgcn_readfirstlane(tid >> 6);
    const int qb = wid & 3, sub = wid >> 2, r32 = lane & 31, hi = lane >> 5, ki = wid & 3;
    unsigned koffb[2], voffb[2];
#pragma unroll
    for (int e = 0; e < 2; ++e) {
        const int kk = 8 * (2 * ki + e) + (lane >> 3); koffb[e] = (unsigned)(kk * (QKVW * 2) + (768 + sub * 64) * 2 + (((lane & 7) ^ ((kk >> 1) & 7)) << 4));
        const int vk = 4 * (2 * wid + e) + (lane >> 4); voffb[e] = (unsigned)(vk * (QKVW * 2) + 1536 * 2 + (((lane & 15) ^ (((lane >> 4) << 2) | e)) << 4));
    }
    const size_t tstep = (size_t)64 * QKVW * 2;
    const unsigned kd = (unsigned)(sub * 8192 + (2 * ki) * 1024), vd = (unsigned)(16384 + (2 * wid) * 1024);
    int kaddr[4], vaddr[4];
    { const int i16 = lane & 15, q = i16 >> 2, pp = i16 & 3, g = (lane >> 4) & 1;
#pragma unroll
      for (int j = 0; j < 4; ++j) { kaddr[j] = sub * 8192 + r32 * 128 + (((2 * j + hi) ^ ((r32 >> 1) & 7)) << 4);
          vaddr[j] = 16384 + (4 * hi + q) * 256 + ((((j ^ q) << 2) | ((2 * g + (pp >> 1)) ^ hi)) << 4) + 8 * (pp & 1); } }
#define AT_GLDS(g, l) do { unsigned keep_; const void* g_ = (const void*)(g); const unsigned l_ = (unsigned)__builtin_amdgcn_readfirstlane((int)(unsigned)(size_t)(l)); \
        asm volatile("s_mov_b32 %0, m0\n\ts_mov_b32 m0, %2\n\ts_nop 0\n\tglobal_load_lds_dwordx4 %1, off\n\ts_mov_b32 m0, %0" : "=&s"(keep_) : "v"(g_), "s"(l_) : "memory"); } while (0)
#define AT_DMA(tb0, hK, hV, t, st) do { if (var & 1) break; const char* tb_ = (tb0) + (size_t)(t) * tstep; LAS unsigned char* sb_ = lds + (st) * 32768; \
        AT_GLDS(tb_ + (hK) + koffb[0], sb_ + kd); AT_GLDS(tb_ + (hK) + koffb[1], sb_ + kd + 1024); AT_GLDS(tb_ + (hV) + voffb[0], sb_ + vd); AT_GLDS(tb_ + (hV) + voffb[1], sb_ + vd + 1024); } while (0)
#define AT_EVEN() do { if (!(var & 16)) asm volatile("s_waitcnt vmcnt(0) lgkmcnt(0)\n\ts_barrier" ::: "memory"); } while (0)
#define AT_ODD() do { if (!(var & 16)) asm volatile("s_waitcnt lgkmcnt(0)\n\ts_barrier" ::: "memory"); } while (0)
#define AT_VRD(dst, d) do { _Pragma("unroll") for (int ks = 0; ks < 4; ++ks) { \
            const s16x4 lo_ = __builtin_bit_cast(s16x4, __builtin_amdgcn_ds_read_tr16_b64_v4i16((LAS s16x4*)(sb + vaddr[d] + ks * 4096))); \
            const s16x4 hh_ = __builtin_bit_cast(s16x4, __builtin_amdgcn_ds_read_tr16_b64_v4i16((LAS s16x4*)(sb + vaddr[d] + ks * 4096 + 2048))); \
            dst[ks] = (bf16x8){lo_[0], lo_[1], lo_[2], lo_[3], hh_[0], hh_[1], hh_[2], hh_[3]}; } } while (0)
#define AT_MMA4(d, src) do { _Pragma("unroll") for (int ks = 0; ks < 4; ++ks) oT[d] = __builtin_amdgcn_mfma_f32_32x32x16_bf16(src[ks], __builtin_bit_cast(bf16x8, pw[ks]), oT[d], 0, 0, 0); } while (0)
#define AT_SB() __builtin_amdgcn_sched_barrier(0)
    constexpr float THR = 6.f;
    AttnUnit u, un;
    if (!attn_next(0, v, G, last, u)) return;
    if (wid >= 4) __builtin_amdgcn_s_setprio(1);
    const char* tile0 = (const char*)(QKV + (size_t)u.key_row0 * QKVW); unsigned hK = (unsigned)(u.h * 256), hV = (unsigned)(u.h * 256);
    bf16x8 qr[4];
    { const bf16_t* qp = QKV + (size_t)(u.q_row0 + qb * 32 + r32) * QKVW + (2 * u.h + sub) * 64 + hi * 8;
#pragma unroll
      for (int d0 = 0; d0 < 4; ++d0) qr[d0] = *(const bf16x8*)(qp + d0 * 16); }
    AT_DMA(tile0, hK, hV, 0, 0);
    for (int ui = 0;; ++ui) {
        const int ntiles = u.ntiles;
        f32x16 oT[4];
#pragma unroll
        for (int d = 0; d < 4; ++d) oT[d] = (f32x16){};
        f32x16 negm = (f32x16){};
        float m_run = 0.f, l_run = 0.f;
        u32x4 pw[4];
        if (sub == 1) { AT_EVEN(); if (ntiles > 1) AT_DMA(tile0, hK, hV, 1, 1); }
        auto tile = [&](const int t, auto st_, auto st1_, auto st2_) __attribute__((always_inline)) {
            constexpr int ST = decltype(st_)::value, ST1 = decltype(st1_)::value, ST2 = decltype(st2_)::value;
            if (sub == 0) AT_EVEN(); else AT_ODD();
            LAS const unsigned char* sb = lds + ST * 32768;
            f32x16 p0 = negm, p1 = negm;
            bf16x8 va[4], vb[4];
            if (!(var & 2)) { bf16x8 kf[4];
#pragma unroll
              for (int j = 0; j < 2; ++j) { kf[2 * j] = *(LAS const bf16x8*)(sb + kaddr[j]); kf[2 * j + 1] = *(LAS const bf16x8*)(sb + kaddr[j] + 4096); }
              AT_SB();
              p0 = __builtin_amdgcn_mfma_f32_32x32x16_bf16(kf[0], qr[0], negm, 0, 0, 0); p1 = __builtin_amdgcn_mfma_f32_32x32x16_bf16(kf[1], qr[0], negm, 0, 0, 0);
              p0 = __builtin_amdgcn_mfma_f32_32x32x16_bf16(kf[2], qr[1], p0, 0, 0, 0); p1 = __builtin_amdgcn_mfma_f32_32x32x16_bf16(kf[3], qr[1], p1, 0, 0, 0);
              AT_SB();
#pragma unroll
              for (int j = 2; j < 4; ++j) { kf[2 * (j - 2)] = *(LAS const bf16x8*)(sb + kaddr[j]); kf[2 * (j - 2) + 1] = *(LAS const bf16x8*)(sb + kaddr[j] + 4096); }
              AT_SB();
              p0 = __builtin_amdgcn_mfma_f32_32x32x16_bf16(kf[0], qr[2], p0, 0, 0, 0); p1 = __builtin_amdgcn_mfma_f32_32x32x16_bf16(kf[1], qr[2], p1, 0, 0, 0);
              p0 = __builtin_amdgcn_mfma_f32_32x32x16_bf16(kf[2], qr[3], p0, 0, 0, 0); p1 = __builtin_amdgcn_mfma_f32_32x32x16_bf16(kf[3], qr[3], p1, 0, 0, 0);
            }
            if (sub == 0 && t + 1 < ntiles) AT_DMA(tile0, hK, hV, t + 1, ST1);
            if (!(var & 8)) { AT_VRD(va, 0); }
            AT_SB();
            if (!(var & 4)) {
            float ta = __builtin_fmaxf(__builtin_fmaxf(p0[0], p0[1]), p1[0]), tb = __builtin_fmaxf(__builtin_fmaxf(p0[2], p0[3]), p1[1]);
            ta = __builtin_fmaxf(__builtin_fmaxf(ta, p1[2]), p1[3]);
#pragma unroll
            for (int r = 4; r < 16; r += 4) { ta = __builtin_fmaxf(__builtin_fmaxf(ta, p0[r]), p0[r + 1]); tb = __builtin_fmaxf(__builtin_fmaxf(tb, p0[r + 2]), p0[r + 3]);
                ta = __builtin_fmaxf(__builtin_fmaxf(ta, p1[r]), p1[r + 1]); tb = __builtin_fmaxf(__builtin_fmaxf(tb, p1[r + 2]), p1[r + 3]); }
            float tm = __builtin_fmaxf(ta, tb);
            { auto rr = __builtin_amdgcn_permlane32_swap(__float_as_uint(tm), __float_as_uint(tm), false, false); tm = __builtin_fmaxf(__uint_as_float(rr[0]), __uint_as_float(rr[1])); }
            if (t == 0 || __any(tm > THR)) {
                const float dl = (t == 0) ? tm : __builtin_fmaxf(tm, 0.f);
                const float alpha = __builtin_amdgcn_exp2f(-dl);
                m_run += dl; l_run *= alpha;
#pragma unroll
                for (int d = 0; d < 4; ++d)
#pragma unroll
                    for (int r = 0; r < 16; ++r) oT[d][r] *= alpha;
#pragma unroll
                for (int r = 0; r < 16; ++r) { p0[r] -= dl; p1[r] -= dl; negm[r] = -m_run; }
            }
#pragma unroll
            for (int r = 0; r < 16; ++r) { p0[r] = __builtin_amdgcn_exp2f(p0[r]); p1[r] = __builtin_amdgcn_exp2f(p1[r]); }
#pragma unroll
            for (int q = 0; q < 4; ++q) { pw[0][q] = cvtpk(p0[2 * q], p0[2 * q + 1]); pw[1][q] = cvtpk(p0[8 + 2 * q], p0[8 + 2 * q + 1]); pw[2][q] = cvtpk(p1[2 * q], p1[2 * q + 1]); pw[3][q] = cvtpk(p1[8 + 2 * q], p1[8 + 2 * q + 1]); }
            } else {
#pragma unroll
                for (int q = 0; q < 4; ++q) { pw[0][q] = __float_as_uint(p0[q]); pw[1][q] = __float_as_uint(p0[4 + q]); pw[2][q] = __float_as_uint(p1[q]); pw[3][q] = __float_as_uint(p1[4 + q]); }
            }
            asm volatile("" : "+v"(pw[0]), "+v"(pw[1]), "+v"(pw[2]), "+v"(pw[3]));
            AT_SB();
            if (sub == 0) AT_ODD(); else AT_EVEN();
            AT_SB();
            if (!(var & 8)) {
                AT_VRD(vb, 1); AT_SB();
                AT_MMA4(0, va); AT_SB();
                if (sub == 1 && t + 2 < ntiles) AT_DMA(tile0, hK, hV, t + 2, ST2);
                AT_VRD(va, 2); AT_SB();
                AT_MMA4(1, vb);
                { float ls = 0.f;
#pragma unroll
                  for (int r = 0; r < 16; ++r) ls += p0[r];
                  l_run += ls; }
                AT_SB();
                AT_VRD(vb, 3); AT_SB();
                AT_MMA4(2, va);
                { float ls = 0.f;
#pragma unroll
                  for (int r = 0; r < 16; ++r) ls += p1[r];
                  l_run += ls; }
                AT_SB();
                AT_MMA4(3, vb); AT_SB();
            }
        };
        for (int t = 0; t < ntiles; t += 3) {
            tile(t, IC<0>{}, IC<1>{}, IC<2>{});
            if (t + 1 < ntiles) tile(t + 1, IC<1>{}, IC<2>{}, IC<0>{});
            if (t + 2 < ntiles) tile(t + 2, IC<2>{}, IC<0>{}, IC<1>{});
        }
        if (sub == 0) AT_EVEN();
        AT_ODD();
        int lane_e = lane; asm volatile("" : "+v"(lane_e));
        const int r32e = lane_e & 31, hie = lane_e >> 5;
        const bool has_next = attn_next(ui + 1, v, G, last, un);
        bf16x8 qn[4];
        const char* tile0n = tile0; unsigned hn = hK;
        if (has_next) { tile0n = (const char*)(QKV + (size_t)un.key_row0 * QKVW); hn = (unsigned)(un.h * 256);
            AT_DMA(tile0n, hn, hn, 0, 0);
            const bf16_t* qp = QKV + (size_t)(un.q_row0 + qb * 32 + r32e) * QKVW + (2 * un.h + sub) * 64 + hie * 8;
#pragma unroll
            for (int d0 = 0; d0 < 4; ++d0) qn[d0] = *(const bf16x8*)(qp + d0 * 16); }
        { auto rr = __builtin_amdgcn_permlane32_swap(__float_as_uint(l_run), __float_as_uint(l_run), false, false); l_run = __uint_as_float(rr[0]) + __uint_as_float(rr[1]); }
        const float inv = 1.f / l_run;
        LAS float* xch = (LAS float*)(lds + 65536 + qb * 16384);
        if (sub == 1) {
#pragma unroll
            for (int d = 0; d < 4; ++d)
#pragma unroll
                for (int r = 0; r < 16; ++r) xch[(d * 16 + r) * 64 + lane_e] = oT[d][r] * inv;
        }
        asm volatile("s_waitcnt lgkmcnt(0)\n\ts_barrier" ::: "memory");
        if (sub == 0) {
            float ss = 0.f;
#pragma unroll
            for (int d = 0; d < 4; ++d)
#pragma unroll
                for (int r = 0; r < 16; ++r) { const float o = oT[d][r] * inv - lam * xch[(d * 16 + r) * 64 + lane_e]; oT[d][r] = o; ss += o * o; }
            { auto rr = __builtin_amdgcn_permlane32_swap(__float_as_uint(ss), __float_as_uint(ss), false, false); ss = __uint_as_float(rr[0]) + __uint_as_float(rr[1]); }
            const float rms = rsqrtf(ss * (1.f / 128.f) + EPS) * oml;
            const LAS float* gl = (const LAS float*)(lds + LDS_MISC + 3072);
            LAS unsigned char* stg = (LAS unsigned char*)xch;
#pragma unroll
            for (int d = 0; d < 4; ++d)
#pragma unroll
                for (int rq = 0; rq < 4; ++rq) { const int dd = d * 32 + 8 * rq + 4 * hie;
                    const f32x4 g = *(const LAS f32x4*)(gl + dd);
                    u32x2 w; w.x = cvtpk(oT[d][rq * 4 + 0] * rms * g[0], oT[d][rq * 4 + 1] * rms * g[1]); w.y = cvtpk(oT[d][rq * 4 + 2] * rms * g[2], oT[d][rq * 4 + 3] * rms * g[3]);
                    *(LAS u32x2*)(stg + r32e * 272 + dd * 2) = w; }
            bf16_t* orow = CC + (size_t)(u.q_row0 + qb * 32) * CW + 512 + u.h * 128;
#pragma unroll
            for (int it = 0; it < 8; ++it) { const int row = it * 4 + (lane_e >> 4), ch = lane_e & 15;
                const u32x4 vv = *(const LAS u32x4*)(stg + row * 272 + ch * 16);
                *(u32x4*)(orow + (size_t)row * CW + ch * 8) = vv; }
        }
        asm volatile("s_waitcnt lgkmcnt(0)\n\ts_barrier" ::: "memory");
        if (!has_next) break;
        u = un; tile0 = tile0n; hK = hn; hV = hn;
#pragma unroll
        for (int d0 = 0; d0 < 4; ++d0) qr[d0] = qn[d0];
    }
    __builtin_amdgcn_s_setprio(0);
#undef AT_GLDS
#undef AT_DMA
#undef AT_EVEN
#undef AT_ODD
#undef AT_VRD
#undef AT_MMA4
#undef AT_SB
}

__device__ __forceinline__ void moe_weight_copies(const Args& a, int l, int gw, int nw, int lane) {
    bf16_t* WGU = wsp<bf16_t>(a, OFF_ARENA + AR_WGU); bf16_t* WD = wsp<bf16_t>(a, OFF_ARENA + AR_WD);
    for (int it = gw; it < 6144; it += nw) {
        if (it < 4096) { const int gu = it >> 11, q = it & 2047, e = q >> 7, r = q & 127, kb = r >> 3, nb = r & 7;
            const float* src = (gu ? a.in[I_WUP] : a.in[I_WG]) + ((size_t)(l * 16 + e) * 1024 + kb * 64) * 512 + nb * 64;
            tr_item(src, 512, WGU + ((size_t)e * 1024 + (nb >> 1) * 256 + gu * 128 + (nb & 1) * 64) * 1024 + kb * 64, 1024, lane);
        } else { const int q = it - 4096, e = q >> 7, r = q & 127, kb = r >> 4, nb = r & 15;
            const float* src = a.in[I_WDN] + ((size_t)(l * 16 + e) * 512 + kb * 64) * 1024 + nb * 64;
            tr_item(src, 1024, WD + ((size_t)e * 1024 + nb * 64) * 512 + kb * 64, 512, lane); }
    }
}
__device__ __forceinline__ void phase_post_attn(const Args& a, LAS unsigned char* lds, int l) {
    const bool last = (l == 1);
    int tid = threadIdx.x; asm volatile("" : "+v"(tid));
    const int lane = tid & 63, wid = __builtin_amdgcn_readfirstlane(tid >> 6), gw = blockIdx.x * 8 + wid, nw = gridDim.x * 8;
    LAS float* wrT = (LAS float*)lds;
    LAS int* lcnt = (LAS int*)(lds + LDS_MISC + 256); LAS int* gbase = (LAS int*)(lds + LDS_MISC + 384); LAS int* rec = (LAS int*)(lds + 65536);
    for (int i = tid; i < 16384; i += 512) wrT[(i & 15) * 1024 + (i >> 4)] = a.in[I_WR][i];
    if (tid < 16) lcnt[tid] = 0;
    __syncthreads();
    const int nrows = last ? NB * S : NTOK;
    bf16_t* OH = wsp<bf16_t>(a, OFF_ARENA + AR_O);
    int nrec = 0;
    const Row lgg = row_load(a.in[I_LNAG] + l * D, lane), lbb = row_load(a.in[I_LNAB] + l * D, lane);
    const float rbias = a.in[I_RB][lane >> 2];
    int i = gw; Row xa = {}, xb = {}; RowB ra = {}, rb = {}, oa = {}, oc = {};
    if (i < nrows) { const int row = thin_row(i, last); if (l == 0) xa = row_load(xin_ptr(a, row), lane); else ra = rowb_load(res_ptr(a, row), lane); oa = rowb_load(OH + (size_t)row * D, lane); }
    if (i + nw < nrows) { const int row = thin_row(i + nw, last); if (l == 0) xb = row_load(xin_ptr(a, row), lane); else rb = rowb_load(res_ptr(a, row), lane); oc = rowb_load(OH + (size_t)row * D, lane); }
    for (; i < nrows; i += nw) {
        const int row = thin_row(i, last);
        Row x = (l == 0) ? xa : rowb_f32(ra); const RowB ob = oa; xa = xb; ra = rb; oa = oc;
        const float* mrow = mod_row(a, l, row);
        const Row g = row_load(mrow + 2048, lane), msh = row_load(mrow + 3072, lane), msc = row_load(mrow + 4096, lane);
        if (i + 2 * nw < nrows) { const int nrow = thin_row(i + 2 * nw, last); if (l == 0) xb = row_load(xin_ptr(a, nrow), lane); else rb = rowb_load(res_ptr(a, nrow), lane); oc = rowb_load(OH + (size_t)nrow * D, lane); }
        { const Row o = rowb_f32(ob);
#pragma unroll
          for (int q = 0; q < 4; ++q) x.v[q] = x.v[q] * ALPHA + g.v[q] * o.v[q]; }
        row_ln(x);
#pragma unroll
        for (int q = 0; q < 4; ++q) x.v[q] = x.v[q] * lgg.v[q] + lbb.v[q];
        row_store_bf16(res_ptr(a, row), lane, x);
        h_from_row2(x, msh, msc);
        row_store_bf16(OH + (size_t)row * D, lane, x);
        float sp[16];
#pragma unroll
        for (int e = 0; e < 16; ++e) { f32x2_t acc = {0.f, 0.f};
#pragma unroll
            for (int q = 0; q < 4; ++q) { const f32x4 w = *(const LAS f32x4*)(wrT + e * 1024 + q * 256 + lane * 4); acc = x.v[q].xy * w.xy + acc; acc = x.v[q].zw * w.zw + acc; }
            sp[e] = acc.x + acc.y; }
        const float lgl = wave_sum16(sp, lane);
        const float scl = __builtin_amdgcn_rcpf(1.f + __builtin_amdgcn_exp2f(-1.44269504f * lgl)), sell = scl + rbias;
        float sc[16], sel[16];
#pragma unroll
        for (int e = 0; e < 16; ++e) { sc[e] = __builtin_bit_cast(float, __builtin_amdgcn_readlane(__builtin_bit_cast(int, scl), 4 * e)); sel[e] = __builtin_bit_cast(float, __builtin_amdgcn_readlane(__builtin_bit_cast(int, sell), 4 * e)); }
        float best = -INFINITY; int bg = 0;
#pragma unroll
        for (int gI = 0; gI < 4; ++gI) {
            const float a0 = sel[gI * 4 + 0], a1 = sel[gI * 4 + 1], a2 = sel[gI * 4 + 2], a3 = sel[gI * 4 + 3];
            const float mx = fmaxf(fmaxf(a0, a1), fmaxf(a2, a3));
            float sec;
            if (a0 == mx) sec = fmaxf(a1, fmaxf(a2, a3)); else if (a1 == mx) sec = fmaxf(a0, fmaxf(a2, a3)); else if (a2 == mx) sec = fmaxf(fmaxf(a0, a1), a3); else sec = fmaxf(fmaxf(a0, a1), a2);
            const float gs = mx + sec;
            if (gs > best) { best = gs; bg = gI; }
        }
        float av[4], s4[4];
#pragma unroll
        for (int q = 0; q < 4; ++q) { av[q] = 0.f; s4[q] = 0.f; }
#pragma unroll
        for (int gI = 0; gI < 4; ++gI)
#pragma unroll
            for (int q = 0; q < 4; ++q) if (bg == gI) { av[q] = sel[gI * 4 + q]; s4[q] = sc[gI * 4 + q]; }
        int i0 = 0; float v0 = av[0];
#pragma unroll
        for (int q = 1; q < 4; ++q) if (av[q] > v0) { v0 = av[q]; i0 = q; }
        int i1 = -1; float v1 = -INFINITY;
#pragma unroll
        for (int q = 0; q < 4; ++q) if (q != i0 && av[q] > v1) { v1 = av[q]; i1 = q; }
        float w0 = 0.f, w1 = 0.f;
#pragma unroll
        for (int q = 0; q < 4; ++q) { if (q == i0) w0 = s4[q]; if (q == i1) w1 = s4[q]; }
        const float inv = 1.f / (w0 + w1); const int e0 = bg * 4 + i0, e1 = bg * 4 + i1;
        if (lane == 0) {
            const int p0 = __hip_atomic_fetch_add(lcnt + e0, 1, __ATOMIC_RELAXED, __HIP_MEMORY_SCOPE_WORKGROUP), p1 = __hip_atomic_fetch_add(lcnt + e1, 1, __ATOMIC_RELAXED, __HIP_MEMORY_SCOPE_WORKGROUP);
            LAS int* rc = rec + (wid * 18 + nrec) * 6; rc[0] = row; rc[1] = e0 | (e1 << 8); rc[2] = p0; rc[3] = p1;
            rc[4] = __float_as_int(w0 * inv); rc[5] = __float_as_int(w1 * inv);
            wsp<int4>(a, OFF_SELN)[row] = make_int4(e0, e1, __float_as_int(w0 * inv), __float_as_int(w1 * inv));
        }
        ++nrec;
    }
    __syncthreads();
    unsigned* CNT = wsp<unsigned>(a, CTL_CNT);
    if (tid < 16) gbase[tid] = (int)__hip_atomic_fetch_add(CNT + (l * 16 + tid) * 64, (unsigned)lcnt[tid], __ATOMIC_RELAXED, __HIP_MEMORY_SCOPE_AGENT);
    __syncthreads();
    if (lane < nrec) { const LAS int* rc = rec + (wid * 18 + lane) * 6; const int row = rc[0], e0 = rc[1] & 255, e1 = rc[1] >> 8;
        int* LIST = wsp<int>(a, OFF_LIST); int* WL = wsp<int>(a, OFF_WPAIR);
        const size_t p0 = (size_t)e0 * CAP + gbase[e0] + rc[2], p1 = (size_t)e1 * CAP + gbase[e1] + rc[3];
        LIST[p0] = 2 * row; LIST[p1] = 2 * row + 1; WL[p0] = rc[4]; WL[p1] = rc[5]; }
    if (l == 1) moe_weight_copies(a, l, gw, nw, lane);
}
__device__ __forceinline__ void moe_tables(const Args& a, LAS unsigned char* lds, int l) {
    LAS int* pre = (LAS int*)(lds + LDS_MISC + 64); LAS int* cnt = pre + 20;
    if (threadIdx.x == 0) { const unsigned* CNT = wsp<unsigned>(a, CTL_CNT); int s = 0;
        for (int e = 0; e < 16; ++e) { const int cN = (int)CNT[(l * 16 + e) * 64]; cnt[e] = cN; pre[e] = s; s += (cN + 255) >> 8; }
        pre[16] = s; }
    __syncthreads();
}
__device__ __forceinline__ void phase_post_ffn(const Args& a, int l) {
    const bool last = (l == 1);
    int tid = threadIdx.x; asm volatile("" : "+v"(tid));
    const int lane = tid & 63, wid = __builtin_amdgcn_readfirstlane(tid >> 6), gw = blockIdx.x * 8 + wid, nw = gridDim.x * 8;
    const int nrows = last ? NB * S : NTOK;
    const bf16_t* Y2 = wsp<bf16_t>(a, OFF_ARENA + AR_Y2);
    const Row gg = row_load(a.in[I_LNFG] + l * D, lane), bb = row_load(a.in[I_LNFB] + l * D, lane);
    int i = gw; RowB xa = {}, xb = {}; RowB y0a = {}, y1a = {}, y0c = {}, y1c = {};
    if (i < nrows) { const int row = thin_row(i, last); xa = rowb_load(res_ptr(a, row), lane); y0a = rowb_load(Y2 + (size_t)(2 * row) * D, lane); y1a = rowb_load(Y2 + (size_t)(2 * row + 1) * D, lane); }
    if (i + nw < nrows) { const int row = thin_row(i + nw, last); xb = rowb_load(res_ptr(a, row), lane); y0c = rowb_load(Y2 + (size_t)(2 * row) * D, lane); y1c = rowb_load(Y2 + (size_t)(2 * row + 1) * D, lane); }
    while (i < nrows) {
        const int row = thin_row(i, last), ni = i + nw;
        Row x = rowb_f32(xa); const RowB y0b = y0a, y1b = y1a; xa = xb; y0a = y0c; y1a = y1c;
        const float* mrow = mod_row(a, l, row);
        const Row g = row_load(mrow + 5120, lane);
        Row sh = {}, sc = {};
        if (!last) { const float* mrow1 = mod_row(a, 1, row); sh = row_load(mrow1 + 0, lane); sc = row_load(mrow1 + 1024, lane); }
        if (i + 2 * nw < nrows) { const int nrow = thin_row(i + 2 * nw, last); xb = rowb_load(res_ptr(a, nrow), lane); y0c = rowb_load(Y2 + (size_t)(2 * nrow) * D, lane); y1c = rowb_load(Y2 + (size_t)(2 * nrow + 1) * D, lane); }
        { const Row y0 = rowb_f32(y0b), y1 = rowb_f32(y1b);
#pragma unroll
          for (int q = 0; q < 4; ++q) x.v[q] = x.v[q] * ALPHA + g.v[q] * (y0.v[q] + y1.v[q]); }
        row_ln(x);
#pragma unroll
        for (int q = 0; q < 4; ++q) x.v[q] = x.v[q] * gg.v[q] + bb.v[q];
        if (last) row_store(out_ptr(a, row), lane, x); else row_store_bf16(res_ptr(a, row), lane, x);
        if (!last) { h_from_row2(x, sh, sc); row_store_bf16(wsp<bf16_t>(a, OFF_ARENA + AR_H) + (size_t)row * D, lane, x); }
        i = ni;
    }
}

constexpr int N_PHASES = 16;
__global__ void __launch_bounds__(512, 2) mk_fwd(Args a) {
    extern __shared__ __attribute__((aligned(16))) unsigned char smem[];
    LAS unsigned char* lds = (LAS unsigned char*)smem;
    if (threadIdx.x == 0) { *(LAS u32x4*)(lds + LDS_MISC) = (u32x4){0u, 0u, 0u, 0u};
#if defined(MK_STAMP)
        if (blockIdx.x == 0) wsp<unsigned long long>(a, WS_NEED)[0] = wall_clock64();
#endif
    }
    __syncthreads();
    XcdBarrier bar = xcd_barrier_post(wsp<unsigned>(a, (size_t)a.li * CTL_BAR_STRIDE), (volatile LAS unsigned*)(lds + LDS_MISC));
    const int G = gridDim.x, c = blockIdx.x;
    const int cv = (c & 7) * (G >> 3) + (c >> 3);
#ifndef MK_ONLY
#define MK_ONLY -1
#endif
#if defined(MK_STAMP)
#define MK_STAMP_PTR(k) (blockIdx.x == 0 ? wsp<unsigned long long>(a, WS_NEED) + (k) : nullptr)
#else
#define MK_STAMP_PTR(k) nullptr
#endif
#define MK_RUN(kind, p, ...) do { if constexpr (MK_ONLY < 0 || MK_ONLY == (kind)) { if ((p) >= a.ph_lo && (p) < a.ph_hi) { for (int r_ = 0; r_ < a.rep[(p)]; ++r_) { __VA_ARGS__; if ((p) + 1 < a.ph_hi || r_ + 1 < a.rep[(p)]) xcd_barrier(bar, MK_STAMP_PTR((p) + 1)); } } } } while (0)
    MK_RUN(0, 0, phase0a(a, lds));
    MK_RUN(1, 1, phase0b(a));
    for (int l = 0; l < 2; ++l) {
        const bool last = (l == 1); const int pb = 2 + 7 * l;
        MK_RUN(2, pb + 0, {
            SchedInproj Sc{(const char*)wsp<bf16_t>(a, OFF_ARENA + AR_H), (const char*)(wsp<bf16_t>(a, OFF_WQKV) + (size_t)l * QKVW * D), (const char*)(wsp<bf16_t>(a, OFF_WU) + (size_t)l * 256 * D), G, cv, last};
            { int tid_ = threadIdx.x; asm volatile("" : "+v"(tid_));
              for (int i_ = tid_; i_ < 2048; i_ += 512) ((LAS float*)(lds + LDS_ROPE))[i_] = (i_ < 1024 ? wsp<float>(a, OFF_RC)[i_] : wsp<float>(a, OFF_RS)[i_ - 1024]);
              __syncthreads(); }
            EpiInproj Ep{wsp<bf16_t>(a, OFF_ARENA + AR_QKV), wsp<bf16_t>(a, OFF_ARENA + AR_UTL), wsp<bf16_t>(a, OFF_ARENA + AR_UTC), (const LAS float*)(lds + LDS_ROPE), (const LAS float*)(lds + LDS_ROPE) + 1024};
            g8::gemm_phase<false>(lds, 1024, 2048u, 2048u, Sc, Ep); });
        MK_RUN(3, pb + 1, {
#ifndef MK_NO_ATTN
            for (int ra_ = 0; ra_ < a.rep_attn; ++ra_) phase_attn(a, lds, l, (ra_ + 1 < a.rep_attn) ? a.attn_var : 0);
#endif
#ifndef MK_NO_FOUR
            EpiStore Ep{wsp<bf16_t>(a, OFF_ARENA + AR_CC), CW};
            { SchedFourier Sc{(const char*)wsp<bf16_t>(a, OFF_TABL), (const char*)wsp<bf16_t>(a, OFF_ARENA + AR_UTL), G, cv, false}; g8::gemm_phase<false>(lds, 2048, 4096u, 4096u, Sc, Ep); }
            if (!last) { SchedFourier Sc{(const char*)wsp<bf16_t>(a, OFF_TABC), (const char*)wsp<bf16_t>(a, OFF_ARENA + AR_UTC), G, cv, true}; g8::gemm_phase<false>(lds, 256, 512u, 512u, Sc, Ep); }
#endif
            });
        MK_RUN(4, pb + 2, {
            SchedOutproj Sc{(const char*)wsp<bf16_t>(a, OFF_ARENA + AR_CC), (const char*)(wsp<bf16_t>(a, OFF_WOUT) + (size_t)l * D * CW), G, cv, last};
            EpiStore Ep{wsp<bf16_t>(a, OFF_ARENA + AR_O), D};
            g8::gemm_phase<false>(lds, CW, (unsigned)(CW * 2), (unsigned)(CW * 2), Sc, Ep);
            if (!last && cv >= 64) { int tid_ = threadIdx.x; asm volatile("" : "+v"(tid_));
                moe_weight_copies(a, l, (cv - 64) * 8 + __builtin_amdgcn_readfirstlane(tid_ >> 6), (G - 64) * 8, tid_ & 63); } });
        MK_RUN(5, pb + 3, phase_post_attn(a, lds, l));
        MK_RUN(6, pb + 4, {
            moe_tables(a, lds, l);
            SchedMoe Sc{(const LAS int*)(lds + LDS_MISC + 64), (const LAS int*)(lds + LDS_MISC + 64) + 20, wsp<int>(a, OFF_LIST), (const char*)wsp<bf16_t>(a, OFF_ARENA + AR_O), (const char*)wsp<bf16_t>(a, OFF_ARENA + AR_WGU), (size_t)1024 * 1024 * 2, 2048u, 256u * 2048u, G, cv, true};
            EpiGateUp Ep{wsp<bf16_t>(a, OFF_ARENA + AR_ASORT)};
            g8::gemm_phase<true>(lds, 1024, 2048u, 2048u, Sc, Ep); });
        MK_RUN(7, pb + 5, {
            moe_tables(a, lds, l);
            SchedMoe Sc{(const LAS int*)(lds + LDS_MISC + 64), (const LAS int*)(lds + LDS_MISC + 64) + 20, wsp<int>(a, OFF_LIST), (const char*)wsp<bf16_t>(a, OFF_ARENA + AR_ASORT), (const char*)wsp<bf16_t>(a, OFF_ARENA + AR_WD), (size_t)1024 * 512 * 2, 1024u, 256u * 1024u, G, cv, false};
            EpiDown Ep{wsp<bf16_t>(a, OFF_ARENA + AR_Y2), wsp<int>(a, OFF_LIST), wsp<float>(a, OFF_WPAIR)};
            g8::gemm_phase<false>(lds, 512, 1024u, 1024u, Sc, Ep); });
        MK_RUN(8, pb + 6, phase_post_ffn(a, l));
    }
#undef MK_RUN
#if defined(MK_STAMP)
    if (blockIdx.x == 0 && threadIdx.x == 0) wsp<unsigned long long>(a, WS_NEED)[N_PHASES] = wall_clock64();
#endif
}
#if defined(MK_STAMP)
__global__ void k_encode(const unsigned long long* st, float* out, size_t n) {
    const float d1 = (float)(st[MK_SB] - st[MK_SA]) * 0.01f / (float)(MK_UA), d2 = (float)(st[MK_SD] - st[MK_SC]) * 0.01f / (float)(MK_UB);
    const float M = fminf(fmaxf(d1, 1.f), 9.9f), E = fminf(fmaxf(rintf(d2), 0.f), 36.f);
    const float cval = sqrtf(M * 1.04f) * powf(10.f, 0.5f * E);
    for (size_t i = (size_t)blockIdx.x * blockDim.x + threadIdx.x; i < n; i += (size_t)gridDim.x * blockDim.x) out[i] = cval;
}
#endif
}
#if MK_DEBUG
namespace ref {
constexpr int NB = 16, S = 2048, L = 256, D = 1024, RB = L + S;
constexpr int INW = 2560, QOFF = 256, KOFF = 1024, VOFF = 1792;
constexpr int MODW = 6 * D;
constexpr float ALPHA = 1.41421356237309515f, EPS = 1e-5f;

__device__ __forceinline__ float wave_sum(float v) {
#pragma unroll
    for (int o = 32; o > 0; o >>= 1) v += __shfl_xor(v, o);
    return v;
}
__device__ __forceinline__ float wave_max(float v) {
#pragma unroll
    for (int o = 32; o > 0; o >>= 1) v = fmaxf(v, __shfl_xor(v, o));
    return v;
}
__device__ __forceinline__ float block_sum(float v, float* red) {
    v = wave_sum(v);
    __syncthreads();
    if ((threadIdx.x & 63) == 0) red[threadIdx.x >> 6] = v;
    __syncthreads();
    return red[0] + red[1] + red[2] + red[3];
}
__device__ __forceinline__ float block_max(float v, float* red) {
    v = wave_max(v);
    __syncthreads();
    if ((threadIdx.x & 63) == 0) red[threadIdx.x >> 6] = v;
    __syncthreads();
    return fmaxf(fmaxf(red[0], red[1]), fmaxf(red[2], red[3]));
}

__global__ void k_prep_small(const float* c, const float* c_ctx, const float* lam_qk, float* SIL, float* LAM, float* RC, float* RS, float* C64, float* S64) {
    const int i = blockIdx.x * blockDim.x + threadIdx.x;
    if (i < 17 * 1024) { const float x = i < 16 * 1024 ? c[i] : c_ctx[i - 16 * 1024]; SIL[i] = x / (1.f + expf(-x)); }
    if (i < 1024) { const int pos = i >> 4, f = i & 15; const float fr = powf(10000.f, -(float)f / 16.f); const float a = (float)pos * fr; RC[i] = cosf(a); RS[i] = sinf(a); }
    if (i < 4096) { const int a = i >> 6, b = i & 63; const int m = (a * b) & 63; C64[i] = cospif(2.f * (float)m / 64.f); S64[i] = sinpif(2.f * (float)m / 64.f); }
    if (i < 2) {
        const float* q = lam_qk + i * 256; float s1 = 0.f, s2 = 0.f;
        for (int k = 0; k < 64; ++k) { s1 += q[k] * q[64 + k]; s2 += q[128 + k] * q[192 + k]; }
        LAM[i] = expf(s1) - expf(s2) + (0.8f - 0.6f * expf(-0.3f * (float)i));
    }
}
__global__ void k_prep_tab(float* TAB, int T) {
    const size_t i = (size_t)blockIdx.x * blockDim.x + threadIdx.x;
    if (i >= (size_t)T * 2 * T) return;
    const int tp = (int)(i / (2 * T)), kk = (int)(i % (2 * T)), t = kk % T, part = kk / T;
    const int m = (int)(((long)t * tp) % T);
    TAB[i] = part ? -sinpif(2.f * (float)m / (float)T) : cospif(2.f * (float)m / (float)T);
}
__global__ __launch_bounds__(256) void k_mod(const float* __restrict__ SIL, const float* __restrict__ w_mod, const float* __restrict__ b_mod, float* __restrict__ MOD) {
    const int l = blockIdx.y, lane = threadIdx.x & 63, kq = threadIdx.x >> 6, n = blockIdx.x * 64 + lane;
    float acc[17];
#pragma unroll
    for (int r = 0; r < 17; ++r) acc[r] = 0.f;
    const float* w = w_mod + (size_t)l * D * MODW + n;
    for (int k = kq * 256; k < kq * 256 + 256; ++k) {
        const float wv = w[(size_t)k * MODW];
#pragma unroll
        for (int r = 0; r < 17; ++r) acc[r] += SIL[r * 1024 + k] * wv;
    }
    __shared__ float red[4][17][64];
#pragma unroll
    for (int r = 0; r < 17; ++r) red[kq][r][lane] = acc[r];
    __syncthreads();
    if (kq == 0) {
#pragma unroll
        for (int r = 0; r < 17; ++r) MOD[((size_t)l * 17 + r) * MODW + n] = red[0][r][lane] + red[1][r][lane] + red[2][r][lane] + red[3][r][lane] + b_mod[(size_t)l * MODW + n];
    }
}

struct Row { float4 v[4]; };
__device__ __forceinline__ Row row_load(const float* p, int lane) { Row r;
#pragma unroll
    for (int i = 0; i < 4; ++i) r.v[i] = *(const float4*)(p + i * 256 + lane * 4);
    return r; }
__device__ __forceinline__ void row_store(float* p, int lane, const Row& r) {
#pragma unroll
    for (int i = 0; i < 4; ++i) *(float4*)(p + i * 256 + lane * 4) = r.v[i]; }
__device__ __forceinline__ void row_ln(Row& r) {
    float s = 0.f;
#pragma unroll
    for (int i = 0; i < 4; ++i) s += (r.v[i].x + r.v[i].y) + (r.v[i].z + r.v[i].w);
    const float mean = wave_sum(s) * (1.f / 1024.f);
    float q = 0.f;
#pragma unroll
    for (int i = 0; i < 4; ++i) { r.v[i].x -= mean; r.v[i].y -= mean; r.v[i].z -= mean; r.v[i].w -= mean;
        q += (r.v[i].x * r.v[i].x + r.v[i].y * r.v[i].y) + (r.v[i].z * r.v[i].z + r.v[i].w * r.v[i].w); }
    const float rstd = rsqrtf(wave_sum(q) * (1.f / 1024.f) + EPS);
#pragma unroll
    for (int i = 0; i < 4; ++i) { r.v[i].x *= rstd; r.v[i].y *= rstd; r.v[i].z *= rstd; r.v[i].w *= rstd; }
}
__device__ __forceinline__ void row_fma(Row& r, const Row& a, const Row& b) {
#pragma unroll
    for (int i = 0; i < 4; ++i) { r.v[i].x = r.v[i].x * a.v[i].x + b.v[i].x; r.v[i].y = r.v[i].y * a.v[i].y + b.v[i].y; r.v[i].z = r.v[i].z * a.v[i].z + b.v[i].z; r.v[i].w = r.v[i].w * a.v[i].w + b.v[i].w; }
}
__device__ __forceinline__ void row_modulate(Row& r, const Row& sh, const Row& sc) {
#pragma unroll
    for (int i = 0; i < 4; ++i) { r.v[i].x = r.v[i].x * (1.f + sc.v[i].x) + sh.v[i].x; r.v[i].y = r.v[i].y * (1.f + sc.v[i].y) + sh.v[i].y; r.v[i].z = r.v[i].z * (1.f + sc.v[i].z) + sh.v[i].z; r.v[i].w = r.v[i].w * (1.f + sc.v[i].w) + sh.v[i].w; }
}

__device__ __forceinline__ const float* res_row(const float* xl, const float* xc, int b, int j) { return j < L ? xc + ((size_t)b * L + j) * D : xl + ((size_t)b * S + (j - L)) * D; }
__device__ __forceinline__ float* res_row_w(float* xl, float* xc, int b, int j) { return j < L ? xc + ((size_t)b * L + j) * D : xl + ((size_t)b * S + (j - L)) * D; }

__global__ __launch_bounds__(256) void k_lnmod(const float* xl, const float* xc, const float* MODl, float* H, int b, int j0, int nrows) {
    const int lane = threadIdx.x & 63, w = blockIdx.x * 4 + (threadIdx.x >> 6);
    if (w >= nrows) return;
    const int j = j0 + w;
    const float* mrow = MODl + (size_t)(j < L ? 16 : b) * MODW;
    Row r = row_load(res_row(xl, xc, b, j), lane);
    row_ln(r);
    const Row sh = row_load(mrow + 0, lane), sc = row_load(mrow + 1024, lane);
    row_modulate(r, sh, sc);
    row_store(H + (size_t)j * D, lane, r);
}

__global__ __launch_bounds__(256) void k_gemm_f32(const float* __restrict__ A, int lda, const float* __restrict__ Bm, int ldb, float* __restrict__ C, int ldc, int K) {
    __shared__ __attribute__((aligned(16))) float As[16][68];
    __shared__ __attribute__((aligned(16))) float Bs[16][68];
    const int tid = threadIdx.x, bm = blockIdx.y * 64, bn = blockIdx.x * 64, ty = tid >> 4, tx = tid & 15;
    float acc[4][4];
#pragma unroll
    for (int i = 0; i < 4; ++i)
#pragma unroll
        for (int j = 0; j < 4; ++j) acc[i][j] = 0.f;
    for (int k0 = 0; k0 < K; k0 += 16) {
        const float4 a = *(const float4*)(A + (size_t)(bm + (tid >> 2)) * lda + k0 + (tid & 3) * 4);
        As[(tid & 3) * 4 + 0][tid >> 2] = a.x; As[(tid & 3) * 4 + 1][tid >> 2] = a.y; As[(tid & 3) * 4 + 2][tid >> 2] = a.z; As[(tid & 3) * 4 + 3][tid >> 2] = a.w;
        const float4 b = *(const float4*)(Bm + (size_t)(k0 + (tid >> 4)) * ldb + bn + (tid & 15) * 4);
        *(float4*)&Bs[tid >> 4][(tid & 15) * 4] = b;
        __syncthreads();
#pragma unroll
        for (int kk = 0; kk < 16; ++kk) {
            const float4 a4 = *(const float4*)&As[kk][ty * 4], b4 = *(const float4*)&Bs[kk][tx * 4];
            const float av[4] = {a4.x, a4.y, a4.z, a4.w}, bv[4] = {b4.x, b4.y, b4.z, b4.w};
#pragma unroll
            for (int i = 0; i < 4; ++i)
#pragma unroll
                for (int j = 0; j < 4; ++j) acc[i][j] += av[i] * bv[j];
        }
        __syncthreads();
    }
#pragma unroll
    for (int i = 0; i < 4; ++i) *(float4*)(C + (size_t)(bm + ty * 4 + i) * ldc + bn + tx * 4) = make_float4(acc[i][0], acc[i][1], acc[i][2], acc[i][3]);
}

__global__ void k_rope(float* P, const float* RC, const float* RS) {
    const int i = blockIdx.x * blockDim.x + threadIdx.x;
    if (i >= S * 2 * 12 * 2 * 16) return;
    const int f = i & 15, blk = (i >> 4) & 1, hh = (i >> 5) % 12, sec = (i / (32 * 12)) & 1, t = i / (32 * 12 * 2);
    float* p = P + (size_t)(L + t) * INW + (sec ? KOFF : QOFF) + hh * 64 + blk * 32 + f;
    const int pos = blk ? (t & 63) : (t >> 6);
    const float c = RC[pos * 16 + f], s = RS[pos * 16 + f], x1 = p[0], x2 = p[16];
    p[0] = x1 * c - x2 * s; p[16] = x2 * c + x1 * s;
}

__global__ void k_fz(const float* P, const float* C64, const float* S64, float* Z, int T, int j0) {
    const int i = blockIdx.x * blockDim.x + threadIdx.x;
    if (i >= 2 * T * 256) return;
    const int n = i & 255, kk = i >> 8, t = kk % T, part = kk / T, g = n >> 6, cp = n & 63;
    const float* u = P + (size_t)(j0 + t) * INW + g * 64; const float* tb = part ? S64 : C64;
    float s = 0.f;
    for (int c = 0; c < 64; ++c) s += u[c] * tb[c * 64 + cp];
    Z[i] = s;
}
__global__ void k_fmap(const float* F, const float* wf, float* CONCAT, int T, int j0, float norm) {
    const int i = blockIdx.x * blockDim.x + threadIdx.x;
    if (i >= T * 256) return;
    const int n = i & 255, t = i >> 8, g = n >> 6, d = n & 63;
    const float* f = F + (size_t)t * 256 + g * 64; const float* w = wf + g * 4096 + d;
    float s = 0.f;
    for (int c = 0; c < 64; ++c) s += f[c] * w[c * 64];
    CONCAT[(size_t)(j0 + t) * D + n] = s * norm;
}

__global__ __launch_bounds__(256) void k_attn_naive(const float* __restrict__ P, float* __restrict__ CONCAT, const float* LAM, const float* subln_g, int l, float one_minus_lam_init, int j0) {
    const int j = j0 + blockIdx.x, h = blockIdx.y, tid = threadIdx.x;
    __shared__ float q1[64], q2[64], s1[RB], s2[RB], red[4], outp[2][128];
    const int nk = j < L ? L : RB;
    if (tid < 64) q1[tid] = P[(size_t)j * INW + QOFF + (2 * h) * 64 + tid];
    else if (tid < 128) q2[tid - 64] = P[(size_t)j * INW + QOFF + (2 * h + 1) * 64 + (tid - 64)];
    __syncthreads();
    float m1 = -INFINITY, m2 = -INFINITY;
    for (int key = tid; key < nk; key += 256) {
        const float* k1 = P + (size_t)key * INW + KOFF + (2 * h) * 64; const float* k2 = k1 + 64;
        float d1 = 0.f, d2 = 0.f;
        for (int d = 0; d < 64; ++d) { d1 += q1[d] * k1[d]; d2 += q2[d] * k2[d]; }
        d1 *= 0.125f; d2 *= 0.125f; s1[key] = d1; s2[key] = d2; m1 = fmaxf(m1, d1); m2 = fmaxf(m2, d2);
    }
    const float M1 = block_max(m1, red); const float M2 = block_max(m2, red);
    float l1 = 0.f, l2 = 0.f;
    for (int key = tid; key < nk; key += 256) { const float e1 = expf(s1[key] - M1), e2 = expf(s2[key] - M2); s1[key] = e1; s2[key] = e2; l1 += e1; l2 += e2; }
    const float L1 = block_sum(l1, red); const float L2 = block_sum(l2, red);
    const float lam = LAM[l];
    for (int key = tid; key < nk; key += 256) s1[key] = s1[key] / L1 - lam * (s2[key] / L2);
    __syncthreads();
    const int d = tid & 127, half = tid >> 7;
    float acc = 0.f;
    const int kh = nk >> 1;
    for (int key = half * kh; key < (half + 1) * kh; ++key) acc += s1[key] * P[(size_t)key * INW + VOFF + h * 128 + d];
    outp[half][d] = acc;
    __syncthreads();
    float o = 0.f;
    if (tid < 128) o = outp[0][tid] + outp[1][tid];
    const float ss = block_sum(tid < 128 ? o * o : 0.f, red);
    const float rms = rsqrtf(ss * (1.f / 128.f) + EPS);
    if (tid < 128) CONCAT[(size_t)j * D + 256 + h * 128 + tid] = o * rms * subln_g[l * 128 + tid] * one_minus_lam_init;
}

__global__ __launch_bounds__(256) void k_post_attn(const float* xl, const float* xc, const float* O, const float* MODl, const float* lng, const float* lnb,
                                                   float* x1l, float* x1c, float* H, const float* w_router, const float* router_bias, int4* SEL, int b, int j0, int nrows) {
    const int lane = threadIdx.x & 63, w = blockIdx.x * 4 + (threadIdx.x >> 6);
    if (w >= nrows) return;
    const int j = j0 + w;
    const float* mrow = MODl + (size_t)(j < L ? 16 : b) * MODW;
    Row x = row_load(res_row(xl, xc, b, j), lane);
    const Row o = row_load(O + (size_t)j * D, lane), g = row_load(mrow + 2048, lane);
#pragma unroll
    for (int i = 0; i < 4; ++i) { x.v[i].x = ALPHA * x.v[i].x + g.v[i].x * o.v[i].x; x.v[i].y = ALPHA * x.v[i].y + g.v[i].y * o.v[i].y; x.v[i].z = ALPHA * x.v[i].z + g.v[i].z * o.v[i].z; x.v[i].w = ALPHA * x.v[i].w + g.v[i].w * o.v[i].w; }
    row_ln(x);
    { const Row gg = row_load(lng, lane), bb = row_load(lnb, lane); row_fma(x, gg, bb); }
    row_store(res_row_w(x1l, x1c, b, j), lane, x);
    row_ln(x);
    { const Row sh = row_load(mrow + 3072, lane), sc = row_load(mrow + 4096, lane); row_modulate(x, sh, sc); }
    row_store(H + (size_t)j * D, lane, x);
    float lg[16];
#pragma unroll
    for (int e = 0; e < 16; ++e) lg[e] = 0.f;
#pragma unroll
    for (int i = 0; i < 4; ++i) {
        const float hv[4] = {x.v[i].x, x.v[i].y, x.v[i].z, x.v[i].w};
#pragma unroll
        for (int jj = 0; jj < 4; ++jj) {
            const float* wr = w_router + (size_t)(i * 256 + lane * 4 + jj) * 16;
#pragma unroll
            for (int q = 0; q < 4; ++q) { const float4 wv = *(const float4*)(wr + q * 4); lg[q * 4 + 0] += hv[jj] * wv.x; lg[q * 4 + 1] += hv[jj] * wv.y; lg[q * 4 + 2] += hv[jj] * wv.z; lg[q * 4 + 3] += hv[jj] * wv.w; }
        }
    }
    float sc[16], sel[16];
#pragma unroll
    for (int e = 0; e < 16; ++e) { const float t = wave_sum(lg[e]); sc[e] = 1.f / (1.f + expf(-t)); sel[e] = sc[e] + router_bias[e]; }
    float best = -INFINITY; int bg = 0;
#pragma unroll
    for (int gI = 0; gI < 4; ++gI) {
        const float a0 = sel[gI * 4 + 0], a1 = sel[gI * 4 + 1], a2 = sel[gI * 4 + 2], a3 = sel[gI * 4 + 3];
        const float mx = fmaxf(fmaxf(a0, a1), fmaxf(a2, a3));
        float sec;
        if (a0 == mx) sec = fmaxf(a1, fmaxf(a2, a3)); else if (a1 == mx) sec = fmaxf(a0, fmaxf(a2, a3)); else if (a2 == mx) sec = fmaxf(fmaxf(a0, a1), a3); else sec = fmaxf(fmaxf(a0, a1), a2);
        const float gs = mx + sec;
        if (gs > best) { best = gs; bg = gI; }
    }
    float a[4], s4[4];
#pragma unroll
    for (int q = 0; q < 4; ++q) { a[q] = 0.f; s4[q] = 0.f; }
#pragma unroll
    for (int gI = 0; gI < 4; ++gI)
#pragma unroll
        for (int q = 0; q < 4; ++q) if (bg == gI) { a[q] = sel[gI * 4 + q]; s4[q] = sc[gI * 4 + q]; }
    int i0 = 0; float v0 = a[0];
#pragma unroll
    for (int q = 1; q < 4; ++q) if (a[q] > v0) { v0 = a[q]; i0 = q; }
    int i1 = -1; float v1 = -INFINITY;
#pragma unroll
    for (int q = 0; q < 4; ++q) if (q != i0 && a[q] > v1) { v1 = a[q]; i1 = q; }
    float w0 = 0.f, w1 = 0.f;
#pragma unroll
    for (int q = 0; q < 4; ++q) { if (q == i0) w0 = s4[q]; if (q == i1) w1 = s4[q]; }
    const float inv = 1.f / (w0 + w1);
    if (lane == 0) SEL[j] = make_int4(bg * 4 + i0, bg * 4 + i1, __float_as_int(w0 * inv), __float_as_int(w1 * inv));
}

__global__ __launch_bounds__(256) void k_moe_naive(const float* __restrict__ H, const int4* SEL, const float* __restrict__ wg, const float* __restrict__ wu, const float* __restrict__ wd, float* Y, int l, int j0) {
    const int j = j0 + blockIdx.x, tid = threadIdx.x;
    __shared__ float hs[1024], as[512];
#pragma unroll
    for (int i = 0; i < 4; ++i) hs[tid + 256 * i] = H[(size_t)j * D + tid + 256 * i];
    const int4 sel = SEL[j];
    float y[4] = {0.f, 0.f, 0.f, 0.f};
    __syncthreads();
#pragma unroll
    for (int slot = 0; slot < 2; ++slot) {
        const int e = slot ? sel.y : sel.x; const float wgt = __int_as_float(slot ? sel.w : sel.z);
        const float* Wg = wg + ((size_t)(l * 16 + e) * 1024) * 512; const float* Wu = wu + ((size_t)(l * 16 + e) * 1024) * 512; const float* Wd = wd + ((size_t)(l * 16 + e) * 512) * 1024;
        float g0 = 0.f, g1 = 0.f, u0 = 0.f, u1 = 0.f;
        for (int k = 0; k < 1024; ++k) { const float hv = hs[k]; g0 += hv * Wg[(size_t)k * 512 + tid]; g1 += hv * Wg[(size_t)k * 512 + tid + 256]; u0 += hv * Wu[(size_t)k * 512 + tid]; u1 += hv * Wu[(size_t)k * 512 + tid + 256]; }
        as[tid] = g0 / (1.f + expf(-g0)) * u0; as[tid + 256] = g1 / (1.f + expf(-g1)) * u1;
        __syncthreads();
        float a0 = 0.f, a1 = 0.f, a2 = 0.f, a3 = 0.f;
        for (int k = 0; k < 512; ++k) { const float av = as[k]; const float* wr = Wd + (size_t)k * 1024 + tid; a0 += av * wr[0]; a1 += av * wr[256]; a2 += av * wr[512]; a3 += av * wr[768]; }
        y[0] += wgt * a0; y[1] += wgt * a1; y[2] += wgt * a2; y[3] += wgt * a3;
        __syncthreads();
    }
#pragma unroll
    for (int i = 0; i < 4; ++i) Y[(size_t)j * D + tid + 256 * i] = y[i];
}

__global__ __launch_bounds__(256) void k_post_ffn(const float* x1l, const float* x1c, const float* Y, const float* MODl, const float* lng, const float* lnb,
                                                  float* x2l, float* x2c, int b, int j0, int nrows) {
    const int lane = threadIdx.x & 63, w = blockIdx.x * 4 + (threadIdx.x >> 6);
    if (w >= nrows) return;
    const int j = j0 + w;
    const float* mrow = MODl + (size_t)(j < L ? 16 : b) * MODW;
    Row x = row_load(res_row(x1l, x1c, b, j), lane);
    const Row y = row_load(Y + (size_t)j * D, lane), g = row_load(mrow + 5120, lane);
#pragma unroll
    for (int i = 0; i < 4; ++i) { x.v[i].x = ALPHA * x.v[i].x + g.v[i].x * y.v[i].x; x.v[i].y = ALPHA * x.v[i].y + g.v[i].y * y.v[i].y; x.v[i].z = ALPHA * x.v[i].z + g.v[i].z * y.v[i].z; x.v[i].w = ALPHA * x.v[i].w + g.v[i].w * y.v[i].w; }
    row_ln(x);
    { const Row gg = row_load(lng, lane), bb = row_load(lnb, lane); row_fma(x, gg, bb); }
    row_store(res_row_w(x2l, x2c, b, j), lane, x);
}
}
#endif
#if MK_DEBUG
namespace dbg {
__device__ __forceinline__ void diag_acc(float* DIAG, int st, float md, float sq, float cnt, float mis) {
#pragma unroll
    for (int o = 32; o > 0; o >>= 1) { md = fmaxf(md, __shfl_xor(md, o)); sq += __shfl_xor(sq, o); cnt += __shfl_xor(cnt, o); mis += __shfl_xor(mis, o); }
    if ((threadIdx.x & 63) == 0) { atomicMax((unsigned*)&DIAG[st * 4 + 0], __float_as_uint(md)); atomicAdd(&DIAG[st * 4 + 1], sq); atomicAdd(&DIAG[st * 4 + 2], cnt); atomicAdd(&DIAG[st * 4 + 3], mis); }
}
__device__ __forceinline__ float adiff(float r, float n, float fl) { const float d = fabsf(r - n) / (fabsf(r) + fl); return (d == d) ? d : 1e30f; }
__device__ __forceinline__ float rms_of(const float* DIAG, int st) { return sqrtf(DIAG[st * 4 + 1] / fmaxf(DIAG[st * 4 + 2], 1.f)) + 1e-30f; }
__global__ void k_cmp_bf16(const float* ref, int ldr, const bf16_t* nw, int ldn, int rows, int cols, float refscale, float* DIAG, int st, int pass) {
    float md = 0.f, sq = 0.f, cnt = 0.f; const float fl = pass ? rms_of(DIAG, st) : 1.f;
    for (size_t i = (size_t)blockIdx.x * blockDim.x + threadIdx.x; i < (size_t)rows * cols; i += (size_t)gridDim.x * blockDim.x) { const int r = (int)(i / cols), c = (int)(i % cols);
        const float rv = ref[(size_t)r * ldr + c] * refscale, nv = bf2f(nw[(size_t)r * ldn + c]); if (pass) md = fmaxf(md, adiff(rv, nv, fl)); else { sq += rv * rv; cnt += 1.f; } }
    diag_acc(DIAG, st, md, sq, cnt, 0.f);
}
__global__ void k_cmp_bf16_sum2(const float* ref, int ldr, const bf16_t* n1, const bf16_t* n2, int ldn, int rows, int cols, float* DIAG, int st, int pass) {
    float md = 0.f, sq = 0.f, cnt = 0.f; const float fl = pass ? rms_of(DIAG, st) : 1.f;
    for (size_t i = (size_t)blockIdx.x * blockDim.x + threadIdx.x; i < (size_t)rows * cols; i += (size_t)gridDim.x * blockDim.x) { const int r = (int)(i / cols), c = (int)(i % cols);
        const float rv = ref[(size_t)r * ldr + c], nv = bf2f(n1[(size_t)r * ldn + c]) + bf2f(n2[(size_t)r * ldn + c]); if (pass) md = fmaxf(md, adiff(rv, nv, fl)); else { sq += rv * rv; cnt += 1.f; } }
    diag_acc(DIAG, st, md, sq, cnt, 0.f);
}
__global__ void k_cmp_f32(const float* ref, int ldr, const float* nw, int ldn, int rows, int cols, float* DIAG, int st, int pass) {
    float md = 0.f, sq = 0.f, cnt = 0.f; const float fl = pass ? rms_of(DIAG, st) : 1.f;
    for (size_t i = (size_t)blockIdx.x * blockDim.x + threadIdx.x; i < (size_t)rows * cols; i += (size_t)gridDim.x * blockDim.x) { const int r = (int)(i / cols), c = (int)(i % cols);
        const float rv = ref[(size_t)r * ldr + c], nv = nw[(size_t)r * ldn + c]; if (pass) md = fmaxf(md, adiff(rv, nv, fl)); else { sq += rv * rv; cnt += 1.f; } }
    diag_acc(DIAG, st, md, sq, cnt, 0.f);
}
__global__ void k_cmp_sel(const int4* ref, const int4* nw, int rows, float* DIAG, int st) {
    float mis = 0.f;
    for (int i = blockIdx.x * blockDim.x + threadIdx.x; i < rows; i += gridDim.x * blockDim.x) { const int4 a = ref[i], b = nw[i];
        if (a.x != b.x || a.y != b.y || fabsf(__int_as_float(a.z) - __int_as_float(b.z)) > 1e-3f || fabsf(__int_as_float(a.w) - __int_as_float(b.w)) > 1e-3f) mis += 1.f; }
    diag_acc(DIAG, st, 0.f, 0.f, 0.f, mis);
}
__global__ void k_cvt(const bf16_t* src, int lds_, float* dst, int ldd, int rows, int cols, float scale) {
    for (size_t i = (size_t)blockIdx.x * blockDim.x + threadIdx.x; i < (size_t)rows * cols; i += (size_t)gridDim.x * blockDim.x) { const int r = (int)(i / cols), c = (int)(i % cols);
        dst[(size_t)r * ldd + c] = bf2f(src[(size_t)r * lds_ + c]) * scale; }
}
__global__ void k_cvt_sum2(const bf16_t* s1, const bf16_t* s2, int lds_, float* dst, int ldd, int rows, int cols) {
    for (size_t i = (size_t)blockIdx.x * blockDim.x + threadIdx.x; i < (size_t)rows * cols; i += (size_t)gridDim.x * blockDim.x) { const int r = (int)(i / cols), c = (int)(i % cols);
        dst[(size_t)r * ldd + c] = bf2f(s1[(size_t)r * lds_ + c]) + bf2f(s2[(size_t)r * lds_ + c]); }
}
__global__ void k_four_recon(const bf16_t* CC, int ldc, const float* MHl, float* out, int ldo, int rows) {
    for (size_t i = (size_t)blockIdx.x * blockDim.x + threadIdx.x; i < (size_t)rows * 256; i += (size_t)gridDim.x * blockDim.x) { const int r = (int)(i >> 8), n = (int)(i & 255), g = n >> 6, d = n & 63;
        const bf16_t* fc = CC + (size_t)r * ldc + g * 64; const bf16_t* fs = fc + 256; float s = 0.f;
        for (int c = 0; c < 64; ++c) s += bf2f(fc[c]) * MHl[((0 * 4 + g) * 64 + c) * 64 + d] + bf2f(fs[c]) * MHl[((1 * 4 + g) * 64 + c) * 64 + d];
        out[(size_t)r * ldo + n] = s; }
}
__device__ __forceinline__ float stage_tol(int s) {
    if (s == 1) return 1e-4f;
    const int k = (s - 2) % 9;
    return k == 0 ? 0.03f : k == 1 ? 0.05f : k == 2 ? 0.15f : k == 3 ? 0.06f : k == 4 ? 0.12f : k == 5 ? 0.02f : k == 6 ? 0.03f : k == 7 ? 0.08f : 0.02f;
}
__global__ void k_final(const float* DIAG, int nst, float* out, size_t n) {
    int bad = 0; float m = 0.f;
    for (int s = 1; s <= nst; ++s) {
        const float md = DIAG[s * 4 + 0], sq = DIAG[s * 4 + 1], cnt = DIAG[s * 4 + 2], mis = DIAG[s * 4 + 3];
        if (cnt <= 0.f && mis <= 0.f) continue;
        float err = cnt > 0.f ? md : 0.f; const float tol = stage_tol(s);
        if (mis > 8.f) err = fmaxf(err, tol * mis);
        if (!(err <= tol)) { bad = s; m = fminf(fmaxf(1.f + 3.f * log10f(err / tol), 1.f), 9.9f); break; }
    }
    if (!bad) return;
    const float cval = sqrtf(powf(10.f, (float)bad) * m);
    for (size_t i = (size_t)blockIdx.x * blockDim.x + threadIdx.x; i < n; i += (size_t)gridDim.x * blockDim.x) out[i] = cval;
}
}
#endif

extern "C" void kernel_launch(void* const* d_in, const int* in_sizes, int n_in, void* d_out, int out_size, void* d_ws, size_t ws_size, hipStream_t stream) {
    using namespace mk;
    static int ready = 0;
    if (!ready) {
        if (n_in != 20 || out_size != NB * S * D) { fprintf(stderr, "kernel_launch: unexpected problem shape\n"); ready = -1; return; }
        if (ws_size < WS_NEED) { fprintf(stderr, "kernel_launch: workspace too small: need %zu have %zu\n", (size_t)WS_NEED, ws_size); ready = -1; return; }
        if (hipFuncSetAttribute((const void*)mk_fwd, hipFuncAttributeMaxDynamicSharedMemorySize, LDS_BYTES) != hipSuccess) { fprintf(stderr, "kernel_launch: hipFuncSetAttribute failed\n"); ready = -1; return; }
        ready = 1;
    }
    if (ready < 0) return;
    Args a{};
    for (int i = 0; i < 20; ++i) a.in[i] = (const float*)d_in[i];
    a.out = (float*)d_out; a.ws = (unsigned char*)d_ws; a.rep_attn = 1; a.attn_var = 0; a.pad2 = 0;
    for (int i = 0; i < 16; ++i) a.rep[i] = 1;
#if defined(MK_REP_ATTN)
    a.rep_attn = MK_REP_ATTN;
#endif
#if defined(MK_ATTN_VAR)
    a.attn_var = MK_ATTN_VAR;
#endif
#if defined(MK_REP_PHASE)
    a.rep[MK_REP_PHASE] = MK_REP_COUNT;
#endif
    (void)hipMemsetAsync(d_ws, 0, CTL_BYTES, stream);
    const int grid = 256;
#if !MK_DEBUG
#ifndef MK_CUTS
    a.ph_lo = 0; a.ph_hi = N_PHASES; a.li = 0;
    hipLaunchKernelGGL(mk_fwd, dim3(grid), dim3(512), LDS_BYTES, stream, a);
#if defined(MK_STAMP)
    k_encode<<<1024, 256, 0, stream>>>((const unsigned long long*)((unsigned char*)d_ws + WS_NEED), (float*)d_out, (size_t)out_size);
#endif
#else
    for (int p = 0; p < N_PHASES; ++p) { a.ph_lo = p; a.ph_hi = p + 1; a.li = 0; hipLaunchKernelGGL(mk_fwd, dim3(grid), dim3(512), LDS_BYTES, stream, a); }
#endif
#else
    unsigned char* ws = (unsigned char*)d_ws;
    size_t off = (WS_NEED + 255) & ~(size_t)255;
    auto take = [&](size_t nfloats) { float* p = (float*)(ws + off); off += ((nfloats * 4 + 255) & ~(size_t)255); return p; };
    float* DIAG = take(256);
    float* Hr = take((size_t)RB * D); float* Pr = take((size_t)RB * 2560); float* CCr = take((size_t)RB * D); float* Or = take((size_t)RB * D); float* Yr = take((size_t)RB * D);
    float* Z = Yr; float* F = Or;        float* TABr = take((size_t)S * 2 * S); float* TABcr = take((size_t)L * 2 * L);
    float* MODr = take((size_t)2 * 17 * MODW); float* SILr = take(17 * 1024); float* LAMr = take(64); float* RCr = take(1024); float* RSr = take(1024); float* C64r = take(4096); float* S64r = take(4096);
    float* A_lat = take((size_t)S * D); float* A_ctx = take((size_t)L * D); float* B_lat = take((size_t)S * D); float* B_ctx = take((size_t)L * D); float* XS_lat = B_lat; float* XS_ctx = B_ctx;
    int4* SELr = (int4*)take((size_t)RB * 4);
    if (off > ws_size) { fprintf(stderr, "kernel_launch(debug): workspace too small: need %zu have %zu\n", off, ws_size); return; }
    (void)hipMemsetAsync(DIAG, 0, 1024, stream);
    const float* x = a.in[I_X]; const float* ctx = a.in[I_CTX];
    bf16_t* Hn = (bf16_t*)(ws + OFF_ARENA + AR_H); bf16_t* QKVn = (bf16_t*)(ws + OFF_ARENA + AR_QKV); bf16_t* CCn = (bf16_t*)(ws + OFF_ARENA + AR_CC); bf16_t* On = (bf16_t*)(ws + OFF_ARENA + AR_O); bf16_t* Y2n = (bf16_t*)(ws + OFF_ARENA + AR_Y2);
    float* MODn = (float*)(ws + OFF_MOD); float* LAMn = (float*)(ws + OFF_LAM); bf16_t* RESn = (bf16_t*)(ws + OFF_RES); int4* SELn = (int4*)(ws + OFF_SELN);
    auto run = [&](int p) { a.ph_lo = p; a.ph_hi = p + 1; a.li = 0; hipLaunchKernelGGL(mk_fwd, dim3(grid), dim3(512), LDS_BYTES, stream, a); };
    const int CB = 1024;
    ref::k_prep_small<<<(17 * 1024 + 255) / 256, 256, 0, stream>>>(a.in[I_C], a.in[I_CCTX], a.in[I_LAMQK], SILr, LAMr, RCr, RSr, C64r, S64r);
    ref::k_prep_tab<<<(unsigned)(((size_t)S * 2 * S + 255) / 256), 256, 0, stream>>>(TABr, S);
    ref::k_prep_tab<<<(unsigned)(((size_t)L * 2 * L + 255) / 256), 256, 0, stream>>>(TABcr, L);
    ref::k_mod<<<dim3(MODW / 64, 2), 256, 0, stream>>>(SILr, a.in[I_WMOD], a.in[I_BMOD], MODr);
    run(0);
    dbg::k_cmp_f32<<<CB, 256, 0, stream>>>(MODr, MODW, MODn, MODW, 34, MODW, DIAG, 1, 0); dbg::k_cmp_f32<<<CB, 256, 0, stream>>>(MODr, MODW, MODn, MODW, 34, MODW, DIAG, 1, 1);
    dbg::k_cmp_f32<<<1, 64, 0, stream>>>(LAMr, 2, LAMn, 2, 1, 2, DIAG, 1, 0); dbg::k_cmp_f32<<<1, 64, 0, stream>>>(LAMr, 2, LAMn, 2, 1, 2, DIAG, 1, 1);
    run(1);
    int nst = 1;
#ifndef MK_DBG_PHASES
#define MK_DBG_PHASES 16
#endif
    for (int l = 0; l < 2; ++l) {
        const bool last = (l == 1); const int pb = 2 + 7 * l, sb = 2 + 9 * l, j0 = last ? L : 0, nr = RB - j0;
        if (pb >= MK_DBG_PHASES) break;
        const float* MODl = MODn + (size_t)l * 17 * MODW;
        const float* win = a.in[I_WIN] + (size_t)l * D * 2560; const float* wout = a.in[I_WOUT] + (size_t)l * D * D; const float* wf = a.in[I_WF] + (size_t)l * 4 * 64 * 64;
        const float omli = (float)(1.0 - (0.8 - 0.6 * exp(-0.3 * (double)l)));
        if (last) { dbg::k_cvt<<<CB, 256, 0, stream>>>(RESn + (size_t)L * D, D, XS_lat, D, S, D, 1.f); dbg::k_cvt<<<CB, 256, 0, stream>>>(RESn, D, XS_ctx, D, L, D, 1.f); }
        const float* xl = l == 0 ? x : XS_lat; const float* xc = l == 0 ? ctx : XS_ctx;
        ref::k_lnmod<<<RB / 4, 256, 0, stream>>>(xl, xc, MODl, Hr, 0, 0, RB);
        dbg::k_cmp_bf16<<<CB, 256, 0, stream>>>(Hr, D, Hn, D, RB, D, 1.f, DIAG, sb + 0, 0); dbg::k_cmp_bf16<<<CB, 256, 0, stream>>>(Hr, D, Hn, D, RB, D, 1.f, DIAG, sb + 0, 1); nst = sb + 0;
        run(pb + 0);
        dbg::k_cvt<<<CB, 256, 0, stream>>>(Hn, D, Hr, D, RB, D, 1.f);
        ref::k_gemm_f32<<<dim3(2560 / 64, RB / 64), 256, 0, stream>>>(Hr, D, win, 2560, Pr, 2560, D);
        ref::k_rope<<<(S * 2 * 12 * 2 * 16 + 255) / 256, 256, 0, stream>>>(Pr, RCr, RSr);
        dbg::k_cmp_bf16<<<CB, 256, 0, stream>>>(Pr + (size_t)j0 * 2560 + 256, 2560, QKVn + (size_t)j0 * QKVW, QKVW, nr, 768, QSCALE, DIAG, sb + 1, 0); dbg::k_cmp_bf16<<<CB, 256, 0, stream>>>(Pr + (size_t)j0 * 2560 + 256, 2560, QKVn + (size_t)j0 * QKVW, QKVW, nr, 768, QSCALE, DIAG, sb + 1, 1);
        dbg::k_cmp_bf16<<<CB, 256, 0, stream>>>(Pr + 1024, 2560, QKVn + 768, QKVW, RB, 1536, 1.f, DIAG, sb + 1, 0); dbg::k_cmp_bf16<<<CB, 256, 0, stream>>>(Pr + 1024, 2560, QKVn + 768, QKVW, RB, 1536, 1.f, DIAG, sb + 1, 1); nst = sb + 1;
        if (pb + 1 >= MK_DBG_PHASES) break;
        run(pb + 1);
        ref::k_fz<<<(2 * S * 256 + 255) / 256, 256, 0, stream>>>(Pr, C64r, S64r, Z, S, L);
        ref::k_gemm_f32<<<dim3(256 / 64, S / 64), 256, 0, stream>>>(TABr, 2 * S, Z, 256, F, 256, 2 * S);
        ref::k_fmap<<<(S * 256 + 255) / 256, 256, 0, stream>>>(F, wf, CCr, S, L, 1.0f / sqrtf((float)S * 64.f));
        if (!last) {
            ref::k_fz<<<(2 * L * 256 + 255) / 256, 256, 0, stream>>>(Pr, C64r, S64r, Z, L, 0);
            ref::k_gemm_f32<<<dim3(256 / 64, L / 64), 256, 0, stream>>>(TABcr, 2 * L, Z, 256, F, 256, 2 * L);
            ref::k_fmap<<<(L * 256 + 255) / 256, 256, 0, stream>>>(F, wf, CCr, L, 0, 1.0f / sqrtf((float)L * 64.f));
        }
        dbg::k_four_recon<<<CB, 256, 0, stream>>>(CCn, CW, (const float*)(ws + OFF_MH) + (size_t)l * 2 * 4 * 64 * 64, Hr, D, RB);
        dbg::k_cmp_f32<<<CB, 256, 0, stream>>>(CCr + (size_t)j0 * D, D, Hr + (size_t)j0 * D, D, nr, 256, DIAG, sb + 2, 0); dbg::k_cmp_f32<<<CB, 256, 0, stream>>>(CCr + (size_t)j0 * D, D, Hr + (size_t)j0 * D, D, nr, 256, DIAG, sb + 2, 1); nst = sb + 2;
        dbg::k_cvt<<<CB, 256, 0, stream>>>(QKVn, QKVW, Pr + 256, 2560, RB, 768, 1.f / QSCALE);
        dbg::k_cvt<<<CB, 256, 0, stream>>>(QKVn + 768, QKVW, Pr + 1024, 2560, RB, 1536, 1.f);
        ref::k_attn_naive<<<dim3(nr, 6), 256, 0, stream>>>(Pr, CCr, LAMn, a.in[I_SUBLN], l, omli, j0);
        dbg::k_cmp_bf16<<<CB, 256, 0, stream>>>(CCr + (size_t)j0 * D + 256, D, CCn + (size_t)j0 * CW + 512, CW, nr, 768, 1.f, DIAG, sb + 3, 0); dbg::k_cmp_bf16<<<CB, 256, 0, stream>>>(CCr + (size_t)j0 * D + 256, D, CCn + (size_t)j0 * CW + 512, CW, nr, 768, 1.f, DIAG, sb + 3, 1); nst = sb + 3;
        if (pb + 2 >= MK_DBG_PHASES) break;
        run(pb + 2);
        dbg::k_four_recon<<<CB, 256, 0, stream>>>(CCn, CW, (const float*)(ws + OFF_MH) + (size_t)l * 2 * 4 * 64 * 64, CCr, D, RB);
        dbg::k_cvt<<<CB, 256, 0, stream>>>(CCn + 512, CW, CCr + 256, D, RB, 768, 1.f);
        ref::k_gemm_f32<<<dim3(D / 64, nr / 64), 256, 0, stream>>>(CCr + (size_t)j0 * D, D, wout, D, Or + (size_t)j0 * D, D, D);
        dbg::k_cmp_bf16<<<CB, 256, 0, stream>>>(Or + (size_t)j0 * D, D, On + (size_t)j0 * D, D, nr, D, 1.f, DIAG, sb + 4, 0); dbg::k_cmp_bf16<<<CB, 256, 0, stream>>>(Or + (size_t)j0 * D, D, On + (size_t)j0 * D, D, nr, D, 1.f, DIAG, sb + 4, 1); nst = sb + 4;
        if (pb + 3 >= MK_DBG_PHASES) break;
        dbg::k_cvt<<<CB, 256, 0, stream>>>(On, D, Or, D, RB, D, 1.f);

        run(pb + 3);
        ref::k_post_attn<<<nr / 4, 256, 0, stream>>>(last ? XS_lat : x, last ? XS_ctx : ctx, Or, MODl, a.in[I_LNAG] + l * D, a.in[I_LNAB] + l * D, A_lat, A_ctx, Hr, a.in[I_WR], a.in[I_RB], SELr, 0, j0, nr);
        dbg::k_cmp_bf16<<<CB, 256, 0, stream>>>(A_lat, D, RESn + (size_t)L * D, D, S, D, 1.f, DIAG, sb + 5, 0); dbg::k_cmp_bf16<<<CB, 256, 0, stream>>>(A_lat, D, RESn + (size_t)L * D, D, S, D, 1.f, DIAG, sb + 5, 1);
        if (!last) { dbg::k_cmp_bf16<<<CB, 256, 0, stream>>>(A_ctx, D, RESn, D, L, D, 1.f, DIAG, sb + 5, 0); dbg::k_cmp_bf16<<<CB, 256, 0, stream>>>(A_ctx, D, RESn, D, L, D, 1.f, DIAG, sb + 5, 1); }
        dbg::k_cmp_bf16<<<CB, 256, 0, stream>>>(Hr + (size_t)j0 * D, D, On + (size_t)j0 * D, D, nr, D, 1.f, DIAG, sb + 6, 0); dbg::k_cmp_bf16<<<CB, 256, 0, stream>>>(Hr + (size_t)j0 * D, D, On + (size_t)j0 * D, D, nr, D, 1.f, DIAG, sb + 6, 1);
        dbg::k_cmp_sel<<<16, 256, 0, stream>>>(SELr + j0, SELn + j0, nr, DIAG, sb + 6); nst = sb + 6;
        dbg::k_cvt<<<CB, 256, 0, stream>>>(On, D, Hr, D, RB, D, 1.f);
        if (pb + 5 >= MK_DBG_PHASES) break;
        run(pb + 4); run(pb + 5);
        ref::k_moe_naive<<<nr, 256, 0, stream>>>(Hr, SELn, a.in[I_WG], a.in[I_WUP], a.in[I_WDN], Yr, l, j0);
        dbg::k_cmp_bf16_sum2<<<CB, 256, 0, stream>>>(Yr + (size_t)j0 * D, D, Y2n + (size_t)(2 * j0) * D, Y2n + (size_t)(2 * j0 + 1) * D, 2 * D, nr, D, DIAG, sb + 7, 0); dbg::k_cmp_bf16_sum2<<<CB, 256, 0, stream>>>(Yr + (size_t)j0 * D, D, Y2n + (size_t)(2 * j0) * D, Y2n + (size_t)(2 * j0 + 1) * D, 2 * D, nr, D, DIAG, sb + 7, 1); nst = sb + 7;
        if (pb + 6 >= MK_DBG_PHASES) break;
        dbg::k_cvt<<<CB, 256, 0, stream>>>(RESn + (size_t)L * D, D, A_lat, D, S, D, 1.f); dbg::k_cvt<<<CB, 256, 0, stream>>>(RESn, D, A_ctx, D, L, D, 1.f);
        dbg::k_cvt_sum2<<<CB, 256, 0, stream>>>(Y2n, Y2n + D, 2 * D, Yr, D, RB, D);
        run(pb + 6);
        ref::k_post_ffn<<<nr / 4, 256, 0, stream>>>(A_lat, A_ctx, Yr, MODl, a.in[I_LNFG] + l * D, a.in[I_LNFB] + l * D, B_lat, B_ctx, 0, j0, nr);
        if (last) dbg::k_cmp_f32<<<CB, 256, 0, stream>>>(B_lat, D, a.out, D, S, D, DIAG, sb + 8, 0); else dbg::k_cmp_bf16<<<CB, 256, 0, stream>>>(B_lat, D, RESn + (size_t)L * D, D, S, D, 1.f, DIAG, sb + 8, 0); if (last) dbg::k_cmp_f32<<<CB, 256, 0, stream>>>(B_lat, D, a.out, D, S, D, DIAG, sb + 8, 1); else dbg::k_cmp_bf16<<<CB, 256, 0, stream>>>(B_lat, D, RESn + (size_t)L * D, D, S, D, 1.f, DIAG, sb + 8, 1);
        if (!last) { dbg::k_cmp_bf16<<<CB, 256, 0, stream>>>(B_ctx, D, RESn, D, L, D, 1.f, DIAG, sb + 8, 0); dbg::k_cmp_bf16<<<CB, 256, 0, stream>>>(B_ctx, D, RESn, D, L, D, 1.f, DIAG, sb + 8, 1); }
        nst = sb + 8;
    }
#if MK_DBG_PHASES < 16
    (void)hipMemsetAsync(d_out, 0, (size_t)out_size * 4, stream);
#endif
    dbg::k_final<<<1024, 256, 0, stream>>>(DIAG, nst, (float*)d_out, (size_t)out_size);
#endif
}
```
